# Optimizing an MI355X kernel written in HIP

```python
import math
import jax, jax.numpy as jnp
from jax import lax
import numpy as np

D_MODEL = 1024
BATCH = 8
SEQ = 2048
DEPTH = 2

CTX_LEN = 256
GRID_W = 64
EPS = 1e-6
ROPE_BASE = 10000.0

D_MIX = D_MODEL
N_MIXERS = 4
GROUP_W = D_MIX // N_MIXERS
HEAD_DIM = 64
CHUNK = 64

RET_HEADS = GROUP_W // HEAD_DIM
RET_DK = HEAD_DIM
GLA_HEADS = 4
GLA_DV = GROUP_W // GLA_HEADS
GLA_DK = GLA_DV // 2
GLA_QK = GLA_HEADS * GLA_DK
GLA_RANK = 16
GLA_TAU = 16.0
GLA_CHUNK = 16
SSD_HEADS = GROUP_W // HEAD_DIM
SSD_GROUPS = 2
SSD_STATE = 64
SSD_CONV = 5
SSD_BC = SSD_GROUPS * SSD_STATE
SSD_CONV_CH = GROUP_W + 2 * SSD_BC
MLSTM_HEADS = 4
MLSTM_DH = GROUP_W // MLSTM_HEADS
N_EXPERTS = 16
EC_CAPACITY = 2
EXPERT_FF = 1536

RET_COLS = 4 * GROUP_W
GLA_COLS = 2 * GLA_QK + 2 * GROUP_W + GLA_RANK
SSD_COLS = GROUP_W + SSD_CONV_CH + 2 * SSD_HEADS
MLSTM_COLS = 4 * GROUP_W + 4 * MLSTM_HEADS
IN_COLS = RET_COLS + GLA_COLS + SSD_COLS + MLSTM_COLS

kernel_name = 'hybrid_bidir_ret_gla_ssd_mlstm_ec'

F32 = jnp.float32


def rms_norm(x, w):
    xf = x.astype(F32)
    y = xf * lax.rsqrt(jnp.mean(jnp.square(xf), axis=-1, keepdims=True) + EPS)
    return (y * w).astype(x.dtype)


def modulate(x, w, shift, scale):
    return rms_norm(x, w) * (1 + scale) + shift


def to_heads(t, n_heads):
    b, n, _ = t.shape
    return t.reshape(b, n, n_heads, -1).transpose(0, 2, 1, 3)


def from_heads(t):
    b, h, n, d = t.shape
    return t.transpose(0, 2, 1, 3).reshape(b, n, h * d)


def head_norm(y, w, center):
    if center:
        y = y - jnp.mean(y, axis=-1, keepdims=True)
    y = y * lax.rsqrt(jnp.mean(jnp.square(y), axis=-1, keepdims=True) + EPS)
    return from_heads(y) * w


def _rotate(t, pos):
    nf = t.shape[-1] // 2
    inv = ROPE_BASE ** (-jnp.arange(nf, dtype=F32) / nf)
    ang = pos[:, None] * inv[None, :]
    cos, sin = jnp.cos(ang).astype(t.dtype), jnp.sin(ang).astype(t.dtype)
    t1, t2 = t[..., :nf], t[..., nf:]
    return jnp.concatenate([t1 * cos - t2 * sin, t1 * sin + t2 * cos], axis=-1)


def axial_rope(t, rows, cols):
    half = t.shape[-1] // 2
    return jnp.concatenate([_rotate(t[..., :half], rows), _rotate(t[..., half:], cols)], axis=-1)


def depthwise_conv(x, w, b):
    pad = (w.shape[0] - 1) // 2
    y = lax.conv_general_dilated(x, w[:, None, :], window_strides=(1,), padding=[(pad, pad)],
                                 dimension_numbers=('NWC', 'WIO', 'NWC'),
                                 feature_group_count=x.shape[-1])
    return y + b


def _causal_mask(n):
    return jnp.tril(jnp.ones((n, n), dtype=bool))


def scalar_decay_scan(q, k, v, log_a, state, with_output):
    b, h, n_tok, dk = q.shape
    dv = v.shape[-1]
    n = n_tok // CHUNK
    qc = q.astype(F32).reshape(b, h, n, CHUNK, dk)
    kc = k.astype(F32).reshape(b, h, n, CHUNK, dk)
    vc = v.astype(F32).reshape(b, h, n, CHUNK, dv)
    g = jnp.cumsum(log_a.astype(F32).reshape(b, h, n, CHUNK), axis=-1)
    g_last = g[..., -1]
    kv = jnp.einsum('bhncd,bhnce->bhnde', kc * jnp.exp(g_last[..., None] - g)[..., None], vc)

    def step(s, inp):
        a, kv_c = inp
        return a[..., None, None] * s + kv_c, s

    s_fin, s_in = lax.scan(step, state, (jnp.moveaxis(jnp.exp(g_last), 2, 0), jnp.moveaxis(kv, 2, 0)))
    if not with_output:
        return None, s_fin
    s_in = jnp.moveaxis(s_in, 0, 2)
    decay = jnp.exp(jnp.where(_causal_mask(CHUNK), g[..., :, None] - g[..., None, :], -jnp.inf))
    scores = jnp.einsum('bhnid,bhnjd->bhnij', qc, kc) * decay
    o = (jnp.einsum('bhnij,bhnje->bhnie', scores, vc)
         + jnp.einsum('bhnid,bhnde->bhnie', qc * jnp.exp(g)[..., None], s_in))
    return o.reshape(b, h, n_tok, dv), s_fin


def gla_scan(q, k, v, log_a, state, with_output):
    b, h, n_tok, dk = q.shape
    dv = v.shape[-1]
    n = n_tok // GLA_CHUNK
    qc = q.astype(F32).reshape(b, h, n, GLA_CHUNK, dk)
    kc = k.astype(F32).reshape(b, h, n, GLA_CHUNK, dk)
    vc = v.astype(F32).reshape(b, h, n, GLA_CHUNK, dv)
    g = jnp.cumsum(log_a.astype(F32).reshape(b, h, n, GLA_CHUNK, dk), axis=3)
    g_last = g[:, :, :, -1]
    kv = jnp.einsum('bhncd,bhnce->bhnde', kc * jnp.exp(g_last[:, :, :, None] - g), vc)

    def step(s, inp):
        a, kv_c = inp
        return a[..., None] * s + kv_c, s

    s_fin, s_in = lax.scan(step, state, (jnp.moveaxis(jnp.exp(g_last), 2, 0), jnp.moveaxis(kv, 2, 0)))
    if not with_output:
        return None, s_fin
    s_in = jnp.moveaxis(s_in, 0, 2)
    diff = g[:, :, :, :, None, :] - g[:, :, :, None, :, :]
    decay = jnp.exp(jnp.where(_causal_mask(GLA_CHUNK)[:, :, None], diff, -jnp.inf))
    scores = jnp.einsum('bhnid,bhnjd,bhnijd->bhnij', qc, kc, decay)
    o = (jnp.einsum('bhnij,bhnje->bhnie', scores, vc)
         + jnp.einsum('bhnid,bhnde->bhnie', qc * jnp.exp(g), s_in))
    return o.reshape(b, h, n_tok, dv), s_fin


def mlstm_scan(q, k, v, log_f, i_pre, state, with_output):
    b, h, n_tok, dk = q.shape
    dv = v.shape[-1]
    n = n_tok // CHUNK
    qc = q.astype(F32).reshape(b, h, n, CHUNK, dk)
    kc = k.astype(F32).reshape(b, h, n, CHUNK, dk)
    vc = v.astype(F32).reshape(b, h, n, CHUNK, dv)
    g = jnp.cumsum(log_f.astype(F32).reshape(b, h, n, CHUNK), axis=-1)
    ig = i_pre.astype(F32).reshape(b, h, n, CHUNK)
    g_last = g[..., -1]
    w_end = g_last[..., None] - g + ig
    b_max = jnp.max(w_end, axis=-1)
    e = jnp.exp(w_end - b_max[..., None])
    kv = jnp.einsum('bhnc,bhncd,bhnce->bhnde', e, kc, vc)
    ksum = jnp.einsum('bhnc,bhncd->bhnd', e, kc)

    def step(carry, inp):
        c_s, n_s, m_s = carry
        a, b_c, kv_c, k_c = inp
        m_new = jnp.maximum(a + m_s, b_c)
        old = jnp.exp(a + m_s - m_new)
        new = jnp.exp(b_c - m_new)
        return (old[..., None, None] * c_s + new[..., None, None] * kv_c,
                old[..., None] * n_s + new[..., None] * k_c, m_new), carry

    mv = lambda t: jnp.moveaxis(t, 2, 0)
    final, (c_in, n_in, m_in) = lax.scan(step, state, (mv(g_last), mv(b_max), mv(kv), mv(ksum)))
    if not with_output:
        return None, final
    c_in, n_in, m_in = [jnp.moveaxis(t, 0, 2) for t in (c_in, n_in, m_in)]
    d_log = jnp.where(_causal_mask(CHUNK), g[..., :, None] - g[..., None, :] + ig[..., None, :], -jnp.inf)
    m_inter = g + m_in[..., None]
    m_tot = jnp.maximum(m_inter, jnp.max(d_log, axis=-1))
    qk = jnp.einsum('bhnid,bhnjd->bhnij', qc, kc) * jnp.exp(d_log - m_tot[..., None])
    s_inter = jnp.exp(m_inter - m_tot)
    num = (jnp.einsum('bhnij,bhnje->bhnie', qk, vc)
           + s_inter[..., None] * jnp.einsum('bhnid,bhnde->bhnie', qc, c_in))
    den = jnp.sum(qk, axis=-1) + s_inter * jnp.einsum('bhnid,bhnd->bhni', qc, n_in)
    hout = num / jnp.maximum(jnp.abs(den), jnp.exp(-m_tot))[..., None]
    return hout.reshape(b, h, n_tok, dv), final


def _seq_flip(t, reverse):
    return jnp.flip(t, axis=2) if reverse else t


def bidirectional(scan_fn, ctx_dirs, lat_dirs, init_state, ctx_out):
    y_ctx, y_lat = None, None
    for d in range(2):
        rev = d == 1
        o_c, s_c = scan_fn(*[_seq_flip(t, rev) for t in ctx_dirs[d]], init_state, ctx_out)
        o_l, _ = scan_fn(*[_seq_flip(t, rev) for t in lat_dirs[d]], s_c, True)
        o_l = _seq_flip(o_l, rev)
        y_lat = o_l if y_lat is None else y_lat + o_l
        if ctx_out:
            o_c = _seq_flip(o_c, rev)
            y_ctx = o_c if y_ctx is None else y_ctx + o_c
    return y_ctx, y_lat


def retention_mixer(u_ctx, u_lat, decay_logit, norm_w, rows, cols, ctx_out):
    log_gamma = jax.nn.log_sigmoid(decay_logit.astype(F32))

    def prep(u, rope):
        q, k, v, g = jnp.split(u, 4, axis=-1)
        q = to_heads(q, RET_HEADS) * RET_DK ** -0.5
        k = to_heads(k, RET_HEADS)
        if rope:
            q, k = axial_rope(q, rows, cols), axial_rope(k, rows, cols)
        v = to_heads(v, RET_HEADS)
        b, h, n, _ = q.shape
        dirs = [(q, k, v, jnp.broadcast_to(log_gamma[d][None, :, None], (b, h, n))) for d in range(2)]
        return dirs, g

    ctx_dirs, g_ctx = prep(u_ctx, False)
    lat_dirs, g_lat = prep(u_lat, True)
    s0 = jnp.zeros((u_lat.shape[0], RET_HEADS, RET_DK, RET_DK), F32)
    o_ctx, o_lat = bidirectional(scalar_decay_scan, ctx_dirs, lat_dirs, s0, ctx_out)
    out = lambda o, g: (head_norm(o, norm_w, True) * jax.nn.silu(g.astype(F32))).astype(g.dtype)
    return (out(o_ctx, g_ctx) if ctx_out else None), out(o_lat, g_lat)


def gla_mixer(u_ctx, u_lat, gate_w, gate_b, norm_w, ctx_out):
    cuts = [GLA_QK, 2 * GLA_QK, 2 * GLA_QK + GROUP_W, 2 * GLA_QK + 2 * GROUP_W]

    def prep(u):
        q, k, v, r, lr = jnp.split(u, cuts, axis=-1)
        q = to_heads(q, GLA_HEADS) * GLA_DK ** -0.5
        k = to_heads(k, GLA_HEADS)
        v = to_heads(v, GLA_HEADS)
        dirs = []
        for d in range(2):
            log_a = jax.nn.log_sigmoid((lr @ gate_w[d] + gate_b[d]).astype(F32)) / GLA_TAU
            dirs.append((q, k, v, to_heads(log_a, GLA_HEADS)))
        return dirs, r

    ctx_dirs, r_ctx = prep(u_ctx)
    lat_dirs, r_lat = prep(u_lat)
    s0 = jnp.zeros((u_lat.shape[0], GLA_HEADS, GLA_DK, GLA_DV), F32)
    o_ctx, o_lat = bidirectional(gla_scan, ctx_dirs, lat_dirs, s0, ctx_out)
    out = lambda o, r: (head_norm(o, norm_w, False) * jax.nn.silu(r.astype(F32))).astype(r.dtype)
    return (out(o_ctx, r_ctx) if ctx_out else None), out(o_lat, r_lat)


def ssd_mixer(u_ctx, u_lat, conv_w, conv_b, dt_bias, a_log, d_skip, norm_w, ctx_out):
    a_neg = -jnp.exp(a_log.astype(F32))
    rep = SSD_HEADS // SSD_GROUPS

    def prep(u):
        z, xbc, dt = jnp.split(u, [GROUP_W, GROUP_W + SSD_CONV_CH], axis=-1)
        xbc = jax.nn.silu(depthwise_conv(xbc, conv_w, conv_b))
        xs, bm, cm = jnp.split(xbc, [GROUP_W, GROUP_W + SSD_BC], axis=-1)
        xs = to_heads(xs, SSD_HEADS)
        bm = jnp.repeat(to_heads(bm, SSD_GROUPS), rep, axis=1)
        cm = jnp.repeat(to_heads(cm, SSD_GROUPS), rep, axis=1)
        dirs = []
        for d in range(2):
            dt_d = jax.nn.softplus(dt[..., d * SSD_HEADS:(d + 1) * SSD_HEADS].astype(F32) + dt_bias[d])
            dt_d = dt_d.transpose(0, 2, 1)
            dirs.append((cm, bm, xs * dt_d[..., None], dt_d * a_neg[d][:, None]))
        return dirs, xs, z

    ctx_dirs, x_ctx, z_ctx = prep(u_ctx)
    lat_dirs, x_lat, z_lat = prep(u_lat)
    s0 = jnp.zeros((u_lat.shape[0], SSD_HEADS, SSD_STATE, HEAD_DIM), F32)
    o_ctx, o_lat = bidirectional(scalar_decay_scan, ctx_dirs, lat_dirs, s0, ctx_out)

    def out(o, xs, z):
        y = from_heads(o + d_skip[:, None, None] * xs)
        return rms_norm(y * jax.nn.silu(z.astype(F32)), norm_w).astype(z.dtype)

    return (out(o_ctx, x_ctx, z_ctx) if ctx_out else None), out(o_lat, x_lat, z_lat)


def mlstm_mixer(u_ctx, u_lat, gate_b, norm_w, ctx_out):
    def prep(u):
        q, k, v, o, gates = jnp.split(u, [GROUP_W, 2 * GROUP_W, 3 * GROUP_W, 4 * GROUP_W], axis=-1)
        q = to_heads(q, MLSTM_HEADS)
        k = to_heads(k, MLSTM_HEADS) * MLSTM_DH ** -0.5
        v = to_heads(v, MLSTM_HEADS)
        b, n, _ = gates.shape
        gates = gates.astype(F32).reshape(b, n, 2, 2, MLSTM_HEADS) + gate_b
        dirs = [(q, k, v, jax.nn.log_sigmoid(gates[:, :, d, 1]).transpose(0, 2, 1),
                 gates[:, :, d, 0].transpose(0, 2, 1)) for d in range(2)]
        return dirs, o

    ctx_dirs, o_ctx_gate = prep(u_ctx)
    lat_dirs, o_lat_gate = prep(u_lat)
    b = u_lat.shape[0]
    s0 = (jnp.zeros((b, MLSTM_HEADS, MLSTM_DH, MLSTM_DH), F32),
          jnp.zeros((b, MLSTM_HEADS, MLSTM_DH), F32),
          jnp.zeros((b, MLSTM_HEADS), F32))
    h_ctx, h_lat = bidirectional(mlstm_scan, ctx_dirs, lat_dirs, s0, ctx_out)
    out = lambda h, og: (jax.nn.sigmoid(og.astype(F32)) * head_norm(h, norm_w, False)).astype(og.dtype)
    return (out(h_ctx, o_ctx_gate) if ctx_out else None), out(h_lat, o_lat_gate)


def parallel_mixers(u_ctx, u_lat, ret_decay_logit, ret_norm_w, gla_gate_w, gla_gate_b, gla_norm_w,
                    ssd_conv_w, ssd_conv_b, ssd_dt_bias, ssd_a_log, ssd_d, ssd_norm_w,
                    mlstm_gate_b, mlstm_norm_w, rows, cols, ctx_out):
    cuts = [RET_COLS, RET_COLS + GLA_COLS, RET_COLS + GLA_COLS + SSD_COLS]
    a_c, b_c, s_c, m_c = jnp.split(u_ctx, cuts, axis=-1)
    a_l, b_l, s_l, m_l = jnp.split(u_lat, cuts, axis=-1)
    outs = [retention_mixer(a_c, a_l, ret_decay_logit, ret_norm_w, rows, cols, ctx_out),
            gla_mixer(b_c, b_l, gla_gate_w, gla_gate_b, gla_norm_w, ctx_out),
            ssd_mixer(s_c, s_l, ssd_conv_w, ssd_conv_b, ssd_dt_bias, ssd_a_log, ssd_d, ssd_norm_w, ctx_out),
            mlstm_mixer(m_c, m_l, mlstm_gate_b, mlstm_norm_w, ctx_out)]
    y_lat = jnp.concatenate([o[1] for o in outs], axis=-1)
    y_ctx = jnp.concatenate([o[0] for o in outs], axis=-1) if ctx_out else None
    return y_ctx, y_lat


def expert_choice_ffn(h, router_w, w_gate, w_up, w_down):
    n_tok = h.shape[1]
    cap = EC_CAPACITY * n_tok // N_EXPERTS
    aff = jax.nn.softmax(jnp.einsum('btd,de->bte', h, router_w).astype(F32), axis=-1)
    top_aff, top_idx = lax.top_k(jnp.swapaxes(aff, 1, 2), cap)
    xs = jax.vmap(lambda hb, ib: hb[ib])(h, top_idx)
    hid = (jax.nn.silu(jnp.einsum('becd,edf->becf', xs, w_gate))
           * jnp.einsum('becd,edf->becf', xs, w_up))
    out = jnp.einsum('becf,efd->becd', hid, w_down) * top_aff[..., None].astype(h.dtype)
    b, e, cp, d = out.shape
    return jax.vmap(lambda o, i: jax.ops.segment_sum(o, i, num_segments=n_tok))(
        out.reshape(b, e * cp, d), top_idx.reshape(b, e * cp))


def setup_inputs(seed: int = 0) -> dict:
    key = jax.random.key(seed)
    kit = iter(jax.random.split(key, 40))
    nrm = lambda shape, scale: jax.random.normal(next(kit), shape, F32) * scale
    gam = 1.0 - 2.0 ** (-5.0 - jnp.arange(RET_HEADS, dtype=F32))
    ret_logit = jnp.log(gam / (1.0 - gam))
    dt0 = jnp.exp(jax.random.uniform(next(kit), (DEPTH, 2, SSD_HEADS), F32,
                                     minval=math.log(1e-3), maxval=math.log(1e-1)))
    i_bias = nrm((DEPTH, 2, MLSTM_HEADS), 0.1)
    f_bias = jnp.linspace(3.0, 6.0, MLSTM_HEADS, dtype=F32) + nrm((DEPTH, 2, MLSTM_HEADS), 0.1)
    return {
        'x': nrm((BATCH, SEQ, D_MODEL), 1.0),
        'c': nrm((BATCH, D_MODEL), 1.0),
        'ctx': nrm((BATCH, CTX_LEN, D_MODEL), 1.0),
        'c_ctx': nrm((D_MODEL,), 1.0),
        'w_mod': nrm((DEPTH, D_MODEL, 6 * D_MODEL), 0.5 * D_MODEL ** -0.5),
        'b_mod': nrm((DEPTH, 6 * D_MODEL), 0.02),
        'norm1_w': 1.0 + nrm((DEPTH, D_MODEL), 0.05),
        'norm2_w': 1.0 + nrm((DEPTH, D_MODEL), 0.05),
        'w_in': nrm((DEPTH, D_MODEL, IN_COLS), D_MODEL ** -0.5),
        'w_out': nrm((DEPTH, D_MIX, D_MODEL), D_MIX ** -0.5),
        'ret_decay_logit': ret_logit + nrm((DEPTH, 2, RET_HEADS), 0.1),
        'ret_norm_w': 1.0 + nrm((DEPTH, GROUP_W), 0.05),
        'gla_gate_w': nrm((DEPTH, 2, GLA_RANK, GLA_QK), GLA_RANK ** -0.5),
        'gla_gate_b': nrm((DEPTH, 2, GLA_QK), 0.5),
        'gla_norm_w': 1.0 + nrm((DEPTH, GROUP_W), 0.05),
        'ssd_conv_w': nrm((DEPTH, SSD_CONV, SSD_CONV_CH), SSD_CONV ** -0.5),
        'ssd_conv_b': nrm((DEPTH, SSD_CONV_CH), 0.02),
        'ssd_dt_bias': dt0 + jnp.log(-jnp.expm1(-dt0)),
        'ssd_a_log': jnp.log(jax.random.uniform(next(kit), (DEPTH, 2, SSD_HEADS), F32, minval=1.0, maxval=16.0)),
        'ssd_d': 1.0 + nrm((DEPTH, SSD_HEADS), 0.1),
        'ssd_norm_w': 1.0 + nrm((DEPTH, GROUP_W), 0.05),
        'mlstm_gate_b': jnp.stack([i_bias, f_bias], axis=2),
        'mlstm_norm_w': 1.0 + nrm((DEPTH, GROUP_W), 0.05),
        'router_w': nrm((DEPTH, D_MODEL, N_EXPERTS), D_MODEL ** -0.5),
        'expert_w_gate': nrm((DEPTH, N_EXPERTS, D_MODEL, EXPERT_FF), D_MODEL ** -0.5),
        'expert_w_up': nrm((DEPTH, N_EXPERTS, D_MODEL, EXPERT_FF), D_MODEL ** -0.5),
        'expert_w_down': nrm((DEPTH, N_EXPERTS, EXPERT_FF, D_MODEL), EXPERT_FF ** -0.5),
        'final_norm_w': 1.0 + nrm((D_MODEL,), 0.05),
    }


def reference(x, c, ctx, c_ctx, w_mod, b_mod, norm1_w, norm2_w, w_in, w_out,
              ret_decay_logit, ret_norm_w, gla_gate_w, gla_gate_b, gla_norm_w,
              ssd_conv_w, ssd_conv_b, ssd_dt_bias, ssd_a_log, ssd_d, ssd_norm_w,
              mlstm_gate_b, mlstm_norm_w, router_w, expert_w_gate, expert_w_up, expert_w_down,
              final_norm_w):
    n_lat = x.shape[1]
    ROWS = n_lat // GRID_W
    rows = jnp.repeat(jnp.arange(ROWS), GRID_W).astype(F32)
    cols = jnp.tile(jnp.arange(GRID_W), ROWS).astype(F32)
    h_ctx, h_lat = ctx, x
    for l in range(DEPTH):
        ctx_out = l < DEPTH - 1
        sh1, sc1, g1, sh2, sc2, g2 = jnp.split((jax.nn.silu(c) @ w_mod[l] + b_mod[l])[:, None, :], 6, axis=-1)
        csh1, csc1, cg1, csh2, csc2, cg2 = jnp.split(jax.nn.silu(c_ctx) @ w_mod[l] + b_mod[l], 6, axis=-1)
        u_lat = modulate(h_lat, norm1_w[l], sh1, sc1) @ w_in[l]
        u_ctx = modulate(h_ctx, norm1_w[l], csh1, csc1) @ w_in[l]
        y_ctx, y_lat = parallel_mixers(u_ctx, u_lat, ret_decay_logit[l], ret_norm_w[l],
                                       gla_gate_w[l], gla_gate_b[l], gla_norm_w[l],
                                       ssd_conv_w[l], ssd_conv_b[l], ssd_dt_bias[l], ssd_a_log[l],
                                       ssd_d[l], ssd_norm_w[l], mlstm_gate_b[l], mlstm_norm_w[l],
                                       rows, cols, ctx_out)
        h_lat = h_lat + g1 * (y_lat @ w_out[l])
        h_lat = h_lat + g2 * expert_choice_ffn(modulate(h_lat, norm2_w[l], sh2, sc2), router_w[l],
                                               expert_w_gate[l], expert_w_up[l], expert_w_down[l])
        if ctx_out:
            h_ctx = h_ctx + cg1 * (y_ctx @ w_out[l])
            h_ctx = h_ctx + cg2 * expert_choice_ffn(modulate(h_ctx, norm2_w[l], csh2, csc2), router_w[l],
                                                   expert_w_gate[l], expert_w_up[l], expert_w_down[l])
    return rms_norm(h_lat, final_norm_w)
```

```cpp
#include <hip/hip_runtime.h>
#include <hip/hip_cooperative_groups.h>
#include <cstdio>
#include <cstdint>
#define GAS __attribute__((address_space(1)))
#define LAS __attribute__((address_space(3)))
namespace pg8 {
#define PG8_LAS __attribute__((address_space(3)))
typedef unsigned short bf16_t;
typedef short bf16x8 __attribute__((ext_vector_type(8)));
typedef float f32x4 __attribute__((ext_vector_type(4)));
typedef unsigned u32x4 __attribute__((ext_vector_type(4)));
constexpr int BM = 256, BK = 64, HALF = 128, HTB = HALF * BK * 2  , STAGE_BYTES = 8 * HTB, NXCD = 8, WGM = 8;

__host__ __device__ __forceinline__ int lds_byte(int r, int c) { const int st = (r >> 4) * 2 + (c >> 5), rr = r & 15, cc = c & 31, ob = rr * 64 + cc * 2; return st * 1024 + (ob ^ (((ob >> 9) & 1) << 5)); }
__host__ __device__ __forceinline__ void stage_rc(int b, int& R, int& C) { const int st = b / 1024, sb = b % 1024, swz = sb ^ (((sb >> 9) & 1) << 5); R = (st >> 1) * 16 + swz / 64; C = (st & 1) * 32 + (swz % 64) / 2; }
__host__ __device__ __forceinline__ int perm32(int rho) { const int n = rho >> 4, i = rho & 15; return 8 * (i >> 2) + 4 * n + (i & 3); }

struct Unit { int pm, pn; };
struct Gemm { const bf16_t* A; const bf16_t* Bt; int M, N, K; };

struct StaticOrder {
    int nM, nN, nwg, G, c;
    __host__ __device__ void init(int M, int N, int G_, int c_) { nM = M / BM; nN = N / BM; nwg = nM * nN; G = G_; c = c_; }
    __host__ __device__ bool next(int i, Unit& u) const {
        const long L = (long)i * G + c; if (L >= nwg) return false;
        int wgid = (int)L; { const int q = nwg / NXCD, r = nwg % NXCD, xcd = wgid % NXCD, off = wgid / NXCD; wgid = (xcd < r ? xcd * (q + 1) : r * (q + 1) + (xcd - r) * q) + off; }
        const int nig = WGM * nN, gid = wgid / nig, fm = gid * WGM, gsz = (nM - fm) < WGM ? (nM - fm) : WGM;
        u.pm = fm + ((wgid % nig) % gsz); u.pn = (wgid % nig) / gsz; return true;
    }
    __device__ __forceinline__ void a_ready(const Unit&) const {}
    __device__ __forceinline__ void done(const Unit&) const {}
};

__device__ __forceinline__ unsigned cvt_pk_bf16(float lo, float hi) { unsigned r; asm volatile("v_cvt_pk_bf16_f32 %0, %1, %2" : "=v"(r) : "v"(lo), "v"(hi)); return r; }

struct EpiStoreBf16 {
    static constexpr bool PERM = true, AFTER_DRAIN = false;
    bf16_t* O; int ldc; int pm_div, pn_per;
    __device__ __forceinline__ void operator()(const f32x4 (&acc)[2][2][4][2], const Unit& u, int wr, int wc, int fr, int fq) const {
        const int row0 = u.pm * BM + wr * 64 + fr; int pnl = u.pn; if (pm_div) pnl -= (u.pm / pm_div) * pn_per;
        const int col0 = pnl * BM + wc * 32 + 8 * fq;
#pragma unroll
        for (int ai = 0; ai < 2; ++ai)
#pragma unroll
            for (int m = 0; m < 4; ++m) { bf16_t* rowp = O + (size_t)(row0 + ai * HALF + m * 16) * ldc + col0;
#pragma unroll
                for (int bj = 0; bj < 2; ++bj) { const f32x4 v0 = acc[ai][bj][m][0], v1 = acc[ai][bj][m][1];
                    u32x4 w; w.x = cvt_pk_bf16(v0[0], v0[1]); w.y = cvt_pk_bf16(v0[2], v0[3]); w.z = cvt_pk_bf16(v1[0], v1[1]); w.w = cvt_pk_bf16(v1[2], v1[3]);
                    *(u32x4*)(rowp + bj * HALF) = w; } }
    }
};
struct EpiSwiGLU {
    static constexpr bool PERM = false, AFTER_DRAIN = false;
    bf16_t* O;
    __device__ __forceinline__ void operator()(const f32x4 (&acc)[2][2][4][2], const Unit& u, int wr, int wc, int fr, int fq) const {
        const int e = u.pm / 9, pnl = u.pn - e * 12;
        const int row0 = u.pm * BM + wr * 64 + fr, col0 = pnl * 128 + (4 * wc + fq) * 8;
#pragma unroll
        for (int ai = 0; ai < 2; ++ai)
#pragma unroll
            for (int m = 0; m < 4; ++m) {
                float h[8];
#pragma unroll
                for (int bj = 0; bj < 2; ++bj)
#pragma unroll
                    for (int j = 0; j < 4; ++j) { const float g = acc[ai][bj][m][0][j], up = acc[ai][bj][m][1][j]; h[bj * 4 + j] = g / (1.0f + __expf(-g)) * up; }
                u32x4 w; w.x = cvt_pk_bf16(h[0], h[1]); w.y = cvt_pk_bf16(h[2], h[3]); w.z = cvt_pk_bf16(h[4], h[5]); w.w = cvt_pk_bf16(h[6], h[7]);
                *(u32x4*)(O + (size_t)(row0 + ai * HALF + m * 16) * 1536 + col0) = w; }
    }
};
struct EpiOutProj {
    static constexpr bool PERM = false, AFTER_DRAIN = false;
    float* H; const float* mod;
    __device__ __forceinline__ void operator()(const f32x4 (&acc)[2][2][4][2], const Unit& u, int wr, int wc, int fr, int fq) const {
        const int s = u.pm < 64 ? (u.pm >> 3) : 8;
        const float* g1 = mod + s * 6144 + 2048;
        const int row0 = u.pm * BM + wr * 64 + fr, col0 = u.pn * BM + wc * 32 + 4 * fq;
#pragma unroll
        for (int bj = 0; bj < 2; ++bj)
#pragma unroll
            for (int n = 0; n < 2; ++n) { const f32x4 gv = *(const f32x4*)(g1 + col0 + bj * HALF + n * 16);
#pragma unroll
                for (int ai = 0; ai < 2; ++ai)
#pragma unroll
                    for (int m = 0; m < 4; ++m) { float* p = H + (size_t)(row0 + ai * HALF + m * 16) * 1024 + col0 + bj * HALF + n * 16;
                        const f32x4 old = *(const f32x4*)p; *(f32x4*)p = old + gv * acc[ai][bj][m][n]; } }
    }
};
struct GroupedOrder {
    int MT, NT, c;
    __device__ __forceinline__ bool next(int i, Unit& u) const {
        const int xcd = c & 7, j = i * 32 + (c >> 3), per = MT * NT;
        if (j >= 2 * per) return false;
        const int e = 2 * xcd + j / per, q = j % per;
        u.pm = e * 9 + q % MT; u.pn = e * NT + q / MT; return true;
    }
    __device__ __forceinline__ void a_ready(const Unit&) const {}
    __device__ __forceinline__ void done(const Unit&) const {}
};

template <class Epi, class Sched, bool ALIGN_EPI = false, bool SP2 = false>
__device__ __forceinline__ void gemm_phase(PG8_LAS unsigned char* lds, const Gemm g, const Sched& S, const Epi& E) {
    int tid_ = threadIdx.x; asm volatile("" : "+v"(tid_));
    const int tid = tid_, wid = __builtin_amdgcn_readfirstlane(tid >> 6), lane = tid & 63, wr = wid >> 2, wc = wid & 3, fr = lane & 15, fq = lane >> 4;
    const int K = g.K, nt = K / BK;
    unsigned voffA[2], voffB[2];
#pragma unroll
    for (int i = 0; i < 2; ++i) { int R, C; stage_rc(tid * 16 + i * 8192, R, C); const int Rb = Epi::PERM ? ((R & ~31) + perm32(R & 31)) : R;
        voffA[i] = (unsigned)(R * K + C) * 2u; voffB[i] = (unsigned)(Rb * K + C) * 2u; }
    const size_t kstep = (size_t)(BK * 2);
    const size_t hstep = (size_t)HALF * K * 2;
    const size_t tstep = 2 * hstep;
    const unsigned ldsw = (unsigned)wid * 1024u;
    const int aoff = lds_byte(wr * 64 + fr, fq * 8), boff = lds_byte(wc * 32 + fr, fq * 8);
#define PG8_SA(b, h) (((b) * 2 + (h)) * HTB)
#define PG8_SB(b, h) ((4 + (b) * 2 + (h)) * HTB)
#define PG8_STAGE(bufoff, gbase, voff) do { _Pragma("unroll") for (int _i = 0; _i < 2; ++_i) \
        __builtin_amdgcn_global_load_lds((const unsigned*)((const char*)(gbase) + (voff)[_i]), (PG8_LAS unsigned*)(lds + (bufoff) + ldsw + _i * 8192), 16, 0, 0); } while (0)
#define PG8_LDA(dst, b, h) do { _Pragma("unroll") for (int m = 0; m < 4; ++m) _Pragma("unroll") for (int k = 0; k < 2; ++k) dst[m][k] = *(const PG8_LAS bf16x8*)(lds + PG8_SA(b, h) + aoff + m * 2048 + k * 1024); } while (0)
#define PG8_LDB(dst, b, h) do { _Pragma("unroll") for (int n = 0; n < 2; ++n) _Pragma("unroll") for (int k = 0; k < 2; ++k) dst[n][k] = *(const PG8_LAS bf16x8*)(lds + PG8_SB(b, h) + boff + n * 2048 + k * 1024); } while (0)
#define PG8_MMA(ai, bj, At, Bt) do { __builtin_amdgcn_s_setprio(1); _Pragma("unroll") for (int m = 0; m < 4; ++m) _Pragma("unroll") for (int n = 0; n < 2; ++n) _Pragma("unroll") for (int k = 0; k < 2; ++k) \
        acc[ai][bj][m][n] = __builtin_amdgcn_mfma_f32_16x16x32_bf16(Bt[n][k], At[m][k], acc[ai][bj][m][n], 0, 0, 0); __builtin_amdgcn_s_setprio(0); } while (0)
#define PG8_WAIT_V(n) asm volatile("s_waitcnt vmcnt(" #n ")" ::: "memory")
#define PG8_WAIT_L(n) asm volatile("s_waitcnt lgkmcnt(" #n ")" ::: "memory")
#define PG8_BAR __builtin_amdgcn_s_barrier()
#define PG8_SCHED __builtin_amdgcn_sched_barrier(0)
    Unit cur, nxt; int ui = 0;
    if (!S.next(0, cur)) return;
    f32x4 acc[2][2][4][2];
#pragma unroll
    for (int a = 0; a < 2; ++a)
#pragma unroll
        for (int b = 0; b < 2; ++b)
#pragma unroll
            for (int m = 0; m < 4; ++m)
#pragma unroll
                for (int n = 0; n < 2; ++n) acc[a][b][m][n] = (f32x4){0.f, 0.f, 0.f, 0.f};
    bf16x8 At[4][2], B0[2][2], B1[2][2];
    const char* cA = (const char*)g.A + (size_t)cur.pm * tstep; const char* cB = (const char*)g.Bt + (size_t)cur.pn * tstep;
    S.a_ready(cur);
    if constexpr (SP2) {
        PG8_STAGE(PG8_SB(0, 0), cB, voffB); PG8_STAGE(PG8_SB(0, 1), cB + hstep, voffB); PG8_STAGE(PG8_SA(0, 0), cA, voffA); PG8_STAGE(PG8_SA(0, 1), cA + hstep, voffA);
        if (wr == 1) PG8_BAR;
        PG8_WAIT_V(2); PG8_BAR;
        PG8_STAGE(PG8_SB(1, 0), cB + kstep, voffB); PG8_STAGE(PG8_SA(1, 0), cA + kstep, voffA); PG8_STAGE(PG8_SB(1, 1), cB + hstep + kstep, voffB);
        PG8_WAIT_V(6); PG8_BAR;
    } else {
        PG8_STAGE(PG8_SB(0, 0), cB, voffB); PG8_STAGE(PG8_SA(0, 0), cA, voffA); PG8_STAGE(PG8_SB(0, 1), cB + hstep, voffB); PG8_STAGE(PG8_SA(0, 1), cA + hstep, voffA);
        if (wr == 1) PG8_BAR;
        PG8_WAIT_V(4); PG8_BAR;
        PG8_STAGE(PG8_SB(1, 0), cB + kstep, voffB); PG8_STAGE(PG8_SA(1, 0), cA + kstep, voffA); PG8_STAGE(PG8_SB(1, 1), cB + hstep + kstep, voffB);
        PG8_WAIT_V(6); PG8_BAR;
    }
    for (;;) {
        const bool has_next = S.next(ui + 1, nxt);
        const char* nA = has_next ? (const char*)g.A + (size_t)nxt.pm * tstep : cA; const char* nB = has_next ? (const char*)g.Bt + (size_t)nxt.pn * tstep : cB;
        for (int t = 0; t < nt; t += 2) {
            const bool last = (t == nt - 2);
            const char* a1 = cA + (size_t)(t + 1) * kstep;
            const char* a2 = last ? nA : cA + (size_t)(t + 2) * kstep; const char* b2 = last ? nB : cB + (size_t)(t + 2) * kstep;
            const char* a3 = a2 + kstep; const char* b3 = b2 + kstep;
            if (last && has_next) S.a_ready(nxt);
            if constexpr (SP2) {
            PG8_LDB(B0, 0, 0); PG8_LDB(B1, 0, 1); PG8_SCHED; PG8_LDA(At, 0, 0); PG8_STAGE(PG8_SA(1, 1), a1 + hstep, voffA);
            PG8_WAIT_V(8); PG8_WAIT_L(0); PG8_BAR; PG8_MMA(0, 0, At, B0); PG8_MMA(0, 1, At, B1); PG8_BAR; PG8_SCHED;
            PG8_LDA(At, 0, 1); PG8_STAGE(PG8_SB(0, 0), b2, voffB); PG8_STAGE(PG8_SB(0, 1), b2 + hstep, voffB); PG8_STAGE(PG8_SA(0, 0), a2, voffA);
            PG8_WAIT_V(8); PG8_WAIT_L(0); PG8_BAR; PG8_MMA(1, 0, At, B0); PG8_MMA(1, 1, At, B1); PG8_BAR; PG8_SCHED;
            PG8_LDB(B0, 1, 0); PG8_LDB(B1, 1, 1); PG8_SCHED; PG8_LDA(At, 1, 0); PG8_STAGE(PG8_SA(0, 1), a2 + hstep, voffA);
            PG8_WAIT_V(8); PG8_WAIT_L(0); PG8_BAR; PG8_MMA(0, 0, At, B0); PG8_MMA(0, 1, At, B1); PG8_BAR; PG8_SCHED;
            PG8_LDA(At, 1, 1); PG8_STAGE(PG8_SB(1, 0), b3, voffB); PG8_STAGE(PG8_SB(1, 1), b3 + hstep, voffB); PG8_STAGE(PG8_SA(1, 0), a3, voffA);
            PG8_WAIT_V(8); PG8_WAIT_L(0); PG8_BAR; PG8_MMA(1, 0, At, B0); PG8_MMA(1, 1, At, B1); PG8_BAR; PG8_SCHED;
            } else {
            PG8_LDB(B0, 0, 0); PG8_SCHED; PG8_LDA(At, 0, 0); PG8_STAGE(PG8_SA(1, 1), a1 + hstep, voffA);
            PG8_WAIT_L(8); PG8_BAR; PG8_WAIT_L(0); PG8_MMA(0, 0, At, B0); PG8_BAR; PG8_SCHED;
            PG8_LDB(B1, 0, 1); PG8_STAGE(PG8_SB(0, 0), b2, voffB);
            PG8_BAR; PG8_WAIT_L(0); PG8_MMA(0, 1, At, B1); PG8_BAR;
            PG8_LDA(At, 0, 1); PG8_STAGE(PG8_SA(0, 0), a2, voffA);
            PG8_BAR; PG8_WAIT_L(0); PG8_MMA(1, 0, At, B0); PG8_BAR; PG8_SCHED;
            PG8_STAGE(PG8_SB(0, 1), b2 + hstep, voffB);
            PG8_WAIT_V(6); PG8_BAR; PG8_MMA(1, 1, At, B1); PG8_BAR;
            PG8_LDB(B0, 1, 0); PG8_SCHED; PG8_LDA(At, 1, 0); PG8_STAGE(PG8_SA(0, 1), a2 + hstep, voffA);
            PG8_WAIT_L(8); PG8_BAR; PG8_WAIT_L(0); PG8_MMA(0, 0, At, B0); PG8_BAR; PG8_SCHED;
            PG8_LDB(B1, 1, 1); PG8_STAGE(PG8_SB(1, 0), b3, voffB);
            PG8_BAR; PG8_WAIT_L(0); PG8_MMA(0, 1, At, B1); PG8_BAR;
            PG8_LDA(At, 1, 1); PG8_STAGE(PG8_SA(1, 0), a3, voffA);
            PG8_BAR; PG8_WAIT_L(0); PG8_MMA(1, 0, At, B0); PG8_BAR; PG8_SCHED;
            PG8_STAGE(PG8_SB(1, 1), b3 + hstep, voffB);
            PG8_WAIT_V(6); PG8_BAR; PG8_MMA(1, 1, At, B1); PG8_BAR;
            }
        }
        if constexpr (ALIGN_EPI) { if (wr == 0) PG8_BAR; }
        if constexpr (!Epi::AFTER_DRAIN) { E(acc, cur, wr, wc, fr, fq); S.done(cur); }
        if (!has_next) break;
#pragma unroll
        for (int a = 0; a < 2; ++a)
#pragma unroll
            for (int b = 0; b < 2; ++b)
#pragma unroll
                for (int m = 0; m < 4; ++m)
#pragma unroll
                    for (int n = 0; n < 2; ++n) acc[a][b][m][n] = (f32x4){0.f, 0.f, 0.f, 0.f};
        cur = nxt; cA = nA; cB = nB; ++ui;
        if constexpr (ALIGN_EPI) { if (wr == 1) PG8_BAR; }
    }
    PG8_WAIT_V(0);
    if constexpr (!ALIGN_EPI) { if (wr == 0) PG8_BAR; }
    PG8_BAR;
    if constexpr (Epi::AFTER_DRAIN) { E.fused(acc, cur, wr, wc, fr, fq, lds, wid, lane); S.done(cur); }
#undef PG8_SA
#undef PG8_SB
#undef PG8_STAGE
#undef PG8_LDA
#undef PG8_LDB
#undef PG8_MMA
#undef PG8_WAIT_V
#undef PG8_WAIT_L
#undef PG8_BAR
#undef PG8_SCHED
}
}

#ifndef PG8_SP2
#define PG8_SP2 true
#endif
#ifndef PG8_ALIGN
#define PG8_ALIGN true
#endif

constexpr int D = 1024, NB = 8, SEQ = 2048, CTXL = 256, NLAT = NB * SEQ, NCTX = NB * CTXL, NROWS = NLAT + NCTX;
constexpr int INC = 3624, INP = 3840, NE = 16, FF = 1536, SLOTS = 2304, MODW = 6144;
constexpr float EPS = 1e-6f;
constexpr int C_RET = 0, C_GLA = 1024, C_SSD = 1808, C_ML = 2584;
constexpr size_t MiB = 1u << 20;
constexpr size_t WS_CTL = 0, CTL_ZERO_BYTES = 1 * MiB;
constexpr size_t WS_MOD = 1 * MiB, WS_WTIN = 2 * MiB, WS_WTOUT = 18 * MiB, WS_WTGU = 22 * MiB, WS_WTDN = 214 * MiB, WS_H = 310 * MiB, WS_HN = 382 * MiB,
                 WS_U = 418 * MiB  , WS_O2 = 553 * MiB  , WS_Y = 625 * MiB  , WS_AFFT = 697 * MiB, WS_SLOT = 699 * MiB, WS_END = 701 * MiB;
constexpr int CW_BAR = 4096;
constexpr int RING_BYTES = 131072, LDSCTL_OFF = RING_BYTES, MISC_OFF = LDSCTL_OFF + 320, LDS_BYTES = 147456;
constexpr int NWAVES = 8, NPHASES = 20;

typedef unsigned short bf16;
typedef unsigned v4u __attribute__((ext_vector_type(4)));
typedef unsigned v2u __attribute__((ext_vector_type(2)));
typedef float f32x4 __attribute__((ext_vector_type(4)));
typedef GAS unsigned gu32;
#define LDS_WAIT() asm volatile("s_waitcnt lgkmcnt(0)" ::: "memory")
#define VM_WAIT() asm volatile("s_waitcnt vmcnt(0)" ::: "memory")

#define XB_TMO      128
#define XB_XCNT(j)  (256  + 64 * (j))
#define XB_XSUB(j)  (1280 + 64 * (j))
#define XB_XGEN(j)  (2304 + 64 * (j))
#define XB_TOP      3328
#define XB_TOPGEN   3392
#define XCD_BAR_WORDS 3456
#define XB_SPIN_CAP (1u << 18)

__device__ __forceinline__ unsigned xb_ld(unsigned* p)              { return __hip_atomic_load(p, __ATOMIC_RELAXED, __HIP_MEMORY_SCOPE_AGENT); }
__device__ __forceinline__ unsigned xb_add(unsigned* p, unsigned v) { return __hip_atomic_fetch_add(p, v, __ATOMIC_RELAXED, __HIP_MEMORY_SCOPE_AGENT); }
__device__ __forceinline__ unsigned xb_xcc_id() { return (unsigned)__builtin_amdgcn_s_getreg((3 << 11) | 20) & 0xFu; }
#define XB_SPIN(cond, bar) do { unsigned _sp = 0; while (cond) { __builtin_amdgcn_s_sleep(1); \
    if ((++_sp & 255u) == 0u) { if (xb_ld(&(bar)[XB_TMO])) break; if (_sp > XB_SPIN_CAP) { atomicAdd(&(bar)[XB_TMO], 1u); break; } } } } while (0)

struct XcdBarrier {
    unsigned* bar; unsigned x;
    volatile LAS unsigned* st;
};

__device__ __forceinline__ XcdBarrier xcd_barrier_post(unsigned* bar, volatile LAS unsigned* st) {
    XcdBarrier b; b.bar = bar; b.x = xb_xcc_id(); b.st = st;
    if (threadIdx.x == 0) (void)xb_add(&bar[XB_XCNT(b.x)], 1u);
    return b;
}
__device__ __forceinline__ void xcd_barrier_complete(unsigned* bar, unsigned x, unsigned& nloc, unsigned& nx) {
    const unsigned G = gridDim.x * gridDim.y * gridDim.z;
    unsigned sum, cnt, mine, sp = 0u;
    for (;;) {
        sum = 0u; cnt = 0u; mine = 0u;
#pragma unroll
        for (unsigned j = 0; j < 16; ++j) { const unsigned c = xb_ld(&bar[XB_XCNT(j)]); sum += c; cnt += (c > 0u) ? 1u : 0u; mine = (j == x) ? c : mine; }
        if (sum == G) break;
        __builtin_amdgcn_s_sleep(1);
        if ((++sp & 255u) == 0u) { if (xb_ld(&bar[XB_TMO])) break; if (sp > XB_SPIN_CAP) { atomicAdd(&bar[XB_TMO], 1u); break; } }
    }
    nloc = mine > 0u ? mine : 1u; nx = cnt > 0u ? cnt : 1u;
}

__device__ __forceinline__ void xcd_barrier(const XcdBarrier& b) {
    asm volatile("s_waitcnt vmcnt(0)" ::: "memory");
    __syncthreads();
    if (threadIdx.x == 0) {
        unsigned* bar = b.bar;
        __builtin_amdgcn_s_waitcnt(0);
        unsigned nloc = b.st[0], nx = b.st[1];
        if (nloc == 0u) { xcd_barrier_complete(bar, b.x, nloc, nx); b.st[0] = nloc; b.st[1] = nx; }
        const unsigned old = xb_add(&bar[XB_XSUB(b.x)], 1u);
        const unsigned gen = old / nloc;
        if (old + 1u == (gen + 1u) * nloc) {
            __builtin_amdgcn_fence(__ATOMIC_RELEASE, "agent");
            asm volatile("s_waitcnt vmcnt(0)" ::: "memory");
            const unsigned og = xb_add(&bar[XB_TOP], 1u);
            const unsigned tg = og / nx;
            if (og + 1u == (tg + 1u) * nx) xb_add(&bar[XB_TOPGEN], 1u);
            else XB_SPIN(xb_ld(&bar[XB_TOPGEN]) == tg, bar);
            __builtin_amdgcn_fence(__ATOMIC_ACQUIRE, "agent");
            xb_add(&bar[XB_XGEN(b.x)], 1u);
            asm volatile("s_waitcnt vmcnt(0)" ::: "memory");
        } else {
            XB_SPIN(xb_ld(&bar[XB_XGEN(b.x)]) == gen, bar);
            __builtin_amdgcn_fence(__ATOMIC_ACQUIRE, "agent");
            asm volatile("s_waitcnt vmcnt(0)" ::: "memory");
        }
    }
    __syncthreads();
}


struct Frame {
    LAS unsigned char* lds;
    int vcu, G;
    unsigned char* ws;
};
struct Ids { int tid, lane, wave; };
__device__ __forceinline__ const float* inp(const LAS unsigned char* lds, int i) {
    const LAS unsigned* t = (const LAS unsigned*)(lds + 131072) + 2 * i;
    const unsigned lo = __builtin_amdgcn_readfirstlane(t[0]), hi = __builtin_amdgcn_readfirstlane(t[1]);
    return (const float*)(((unsigned long long)hi << 32) | lo); }
__device__ __forceinline__ Ids fresh_ids() { int t = threadIdx.x; asm volatile("" : "+v"(t)); Ids I; I.tid = t; I.lane = t & 63; I.wave = __builtin_amdgcn_readfirstlane(t >> 6); return I; }
__device__ __forceinline__ float wave_sum(float v) {
#pragma unroll
    for (int o = 1; o < 64; o <<= 1) v += __shfl_xor(v, o);
    return v;
}
__device__ __forceinline__ float bf_lo(unsigned w) { return __uint_as_float(w << 16); }
__device__ __forceinline__ float bf_hi(unsigned w) { return __uint_as_float(w & 0xffff0000u); }
__device__ __forceinline__ f32x4 ld_bf4(const bf16* p) { const v2u w = *(const v2u*)p; return (f32x4){bf_lo(w.x), bf_hi(w.x), bf_lo(w.y), bf_hi(w.y)}; }
__device__ __forceinline__ void st_bf4(bf16* p, f32x4 v) { v2u w; w.x = pg8::cvt_pk_bf16(v.x, v.y); w.y = pg8::cvt_pk_bf16(v.z, v.w); *(v2u*)p = w; }
__device__ __forceinline__ float silu_f(float x) { return x / (1.0f + expf(-x)); }
__device__ __forceinline__ float sigmoid_f(float x) { return 1.0f / (1.0f + expf(-x)); }
__device__ __forceinline__ float log_sigmoid_f(float z) { return fminf(z, 0.f) - log1pf(expf(-fabsf(z))); }
__device__ __forceinline__ float softplus_f(float x) { return fmaxf(x, 0.f) + log1pf(expf(-fabsf(x))); }
__device__ __forceinline__ int row_sample(int r) { return r < NLAT ? (r >> 11) : 8; }

template <class RowMap>
__device__ __forceinline__ void transpose_item(const float* W, int ldw, int nvalid, int k0, int n0, bf16* WT, int ldt, const RowMap& f, LAS float* scr, int lane) {
#pragma unroll 8
    for (int i = 0; i < 32; ++i) { const int kk = 2 * i + (lane >> 5), c = n0 + (lane & 31); scr[kk * 33 + (lane & 31)] = c < nvalid ? W[(size_t)(k0 + kk) * ldw + c] : 0.f; }
    LDS_WAIT(); asm volatile("" ::: "memory");
    const int c8 = lane & 7;
#pragma unroll
    for (int j = 0; j < 4; ++j) { const int n = (lane >> 3) + 8 * j, col = n0 + n; const LAS float* s = scr + (8 * c8) * 33 + n;
        if (col < nvalid) { v4u o; o.x = pg8::cvt_pk_bf16(s[0 * 33], s[1 * 33]); o.y = pg8::cvt_pk_bf16(s[2 * 33], s[3 * 33]); o.z = pg8::cvt_pk_bf16(s[4 * 33], s[5 * 33]); o.w = pg8::cvt_pk_bf16(s[6 * 33], s[7 * 33]);
            *(v4u*)(WT + (size_t)f(col) * ldt + k0 + 8 * c8) = o; } }
    LDS_WAIT(); asm volatile("" ::: "memory");
}
struct MapId { int off; __device__ __forceinline__ int operator()(int c) const { return off + c; } };
struct MapGU { int off, n; __device__ __forceinline__ int operator()(int h) const { const int hl = h & 127, q = hl >> 3, wc = q >> 2, fq = q & 3, rem = hl & 7, bj = rem >> 2, j = rem & 3;
    return off + 256 * (h >> 7) + 128 * bj + 32 * wc + 16 * n + 4 * fq + j; } };

__device__ __forceinline__ void p0_prologue(Frame& F) {
    const Ids I = fresh_ids();
    const float* cvec = inp(F.lds, 1); const float* cctx = inp(F.lds, 3); const float* w_mod = inp(F.lds, 4); const float* b_mod = inp(F.lds, 5);
    float* MOD = (float*)(F.ws + WS_MOD);
    {
        LAS float* sil = (LAS float*)F.lds;
        LAS float* part = (LAS float*)(F.lds + 40960);
        for (int i = I.tid; i < 9 * 1024; i += 512) { const int s = i >> 10, k = i & 1023; const float c = s < 8 ? cvec[s * 1024 + k] : cctx[k]; sil[i] = silu_f(c); }
        __syncthreads();
        for (int item = F.vcu; item < 192; item += F.G) {
            const int l = item / 96, col = (item % 96) * 64 + I.lane;
            float acc[9];
#pragma unroll
            for (int s = 0; s < 9; ++s) acc[s] = 0.f;
            const float* wp = w_mod + (size_t)l * 1024 * MODW + (size_t)(I.wave * 128) * MODW + col;
            for (int k = 0; k < 128; ++k) { const float wv = wp[(size_t)k * MODW];
#pragma unroll
                for (int s = 0; s < 9; ++s) acc[s] += sil[s * 1024 + I.wave * 128 + k] * wv; }
#pragma unroll
            for (int s = 0; s < 9; ++s) part[(I.wave * 9 + s) * 64 + I.lane] = acc[s];
            __syncthreads();
            for (int i = I.tid; i < 9 * 64; i += 512) { const int s = i >> 6, ln = i & 63; float t = 0.f;
#pragma unroll
                for (int w = 0; w < 8; ++w) t += part[(w * 9 + s) * 64 + ln];
                const int cc = (item % 96) * 64 + ln; MOD[((size_t)l * 9 + s) * MODW + cc] = t + b_mod[l * MODW + cc]; }
            __syncthreads();
        }
        __syncthreads();
    }
    {
        bf16* wtin = (bf16*)(F.ws + WS_WTIN);
        const int nchunk = 2 * (INP - INC) * 128;
        for (int i = F.vcu * 512 + I.tid; i < nchunk; i += F.G * 512) { const int l = i / ((INP - INC) * 128), r = i % ((INP - INC) * 128);
            *(v4u*)(wtin + ((size_t)l * INP + INC) * 1024 + (size_t)r * 8) = (v4u){0u, 0u, 0u, 0u}; }
    }
    {
        LAS float* scr = (LAS float*)(F.lds + I.wave * 16384);
        const int gw = F.vcu * NWAVES + I.wave, NGW = F.G * NWAVES;
        constexpr int I_IN = 16 * 114, I_OUT = 16 * 32, I_E = 768, PER_L = I_IN + I_OUT + 16 * 3 * I_E;
        for (int it = gw; it < 2 * PER_L; it += NGW) {
            const int l = it / PER_L; int r = it % PER_L;
            if (r < I_IN) { const int kb = r / 114, nb = r % 114;
                transpose_item(inp(F.lds, 8) + (size_t)l * 1024 * INC, INC, INC, 64 * kb, 32 * nb, (bf16*)(F.ws + WS_WTIN) + (size_t)l * INP * 1024, 1024, MapId{0}, scr, I.lane); continue; }
            r -= I_IN;
            if (r < I_OUT) { const int kb = r / 32, nb = r % 32;
                transpose_item(inp(F.lds, 9) + (size_t)l * 1024 * 1024, 1024, 1024, 64 * kb, 32 * nb, (bf16*)(F.ws + WS_WTOUT) + (size_t)l * 1024 * 1024, 1024, MapId{0}, scr, I.lane); continue; }
            r -= I_OUT;
            const int e = r / (3 * I_E), q = r % (3 * I_E), kind = q / I_E, t = q % I_E;
            if (kind < 2) { const int kb = t / 48, nb = t % 48;
                transpose_item((kind ? inp(F.lds, 25) : inp(F.lds, 24)) + ((size_t)l * NE + e) * 1024 * FF, FF, FF, 64 * kb, 32 * nb, (bf16*)(F.ws + WS_WTGU) + (size_t)l * NE * 3072 * 1024, 1024, MapGU{e * 3072, kind}, scr, I.lane); }
            else { const int kb = t / 32, nb = t % 32;
                transpose_item(inp(F.lds, 26) + ((size_t)l * NE + e) * FF * 1024, 1024, 1024, 64 * kb, 32 * nb, (bf16*)(F.ws + WS_WTDN) + (size_t)l * NE * 1024 * FF, FF, MapId{e * 1024}, scr, I.lane); }
        }
    }
}

__device__ __forceinline__ void load_row_f32(const float* p, int lane, f32x4 (&v)[4]) {
#pragma unroll
    for (int j = 0; j < 4; ++j) v[j] = *(const f32x4*)(p + 4 * lane + 256 * j);
}
__device__ __forceinline__ float row_sumsq(const f32x4 (&v)[4]) { float s = 0.f;
#pragma unroll
    for (int j = 0; j < 4; ++j) s += (v[j].x * v[j].x + v[j].y * v[j].y) + (v[j].z * v[j].z + v[j].w * v[j].w);
    return wave_sum(s); }
__device__ __forceinline__ void add_expert_out(f32x4 (&v)[4], int r, int lane, const int* slotmap, const float* afft, const bf16* EO, const float* g2) {
    f32x4 acc[4];
#pragma unroll
    for (int j = 0; j < 4; ++j) acc[j] = (f32x4){0.f, 0.f, 0.f, 0.f};
    for (int e = 0; e < NE; ++e) {
        const int slot = __builtin_amdgcn_readfirstlane(slotmap[r * 16 + e]);
        if (slot >= 0) { const float a = afft[(size_t)e * NROWS + r]; const bf16* er = EO + (size_t)slot * 1024;
#pragma unroll
            for (int j = 0; j < 4; ++j) acc[j] += a * ld_bf4(er + 4 * lane + 256 * j); }
    }
#pragma unroll
    for (int j = 0; j < 4; ++j) v[j] += *(const f32x4*)(g2 + 4 * lane + 256 * j) * acc[j];
}
__device__ __forceinline__ void p1_norm1(Frame& F, int l) {
    const Ids I = fresh_ids();
    const int gw = F.vcu * NWAVES + I.wave, NGW = F.G * NWAVES;
    float* H = (float*)(F.ws + WS_H); bf16* HN = (bf16*)(F.ws + WS_HN);
    const float* MOD = (const float*)(F.ws + WS_MOD); const float* nw = inp(F.lds, 6) + l * 1024;
    for (int r = gw; r < NROWS; r += NGW) {
        const int s = row_sample(r); f32x4 v[4];
        if (l == 0) load_row_f32(r < NLAT ? inp(F.lds, 0) + (size_t)r * D : inp(F.lds, 2) + (size_t)(r - NLAT) * D, I.lane, v);
        else { load_row_f32(H + (size_t)r * D, I.lane, v);
            add_expert_out(v, r, I.lane, (const int*)(F.ws + WS_SLOT), (const float*)(F.ws + WS_AFFT), (const bf16*)(F.ws + WS_O2), MOD + ((size_t)(l - 1) * 9 + s) * MODW + 5120); }
        const float rstd = 1.0f / sqrtf(row_sumsq(v) * (1.0f / D) + EPS);
        const float* m = MOD + ((size_t)l * 9 + s) * MODW;
#pragma unroll
        for (int j = 0; j < 4; ++j) { const int k = 4 * I.lane + 256 * j;
            *(f32x4*)(H + (size_t)r * D + k) = v[j];
            const f32x4 w = *(const f32x4*)(nw + k), sh = *(const f32x4*)(m + k), sc = *(const f32x4*)(m + 1024 + k);
            st_bf4(HN + (size_t)r * D + k, (v[j] * rstd * w) * (sc + 1.0f) + sh); }
    }
}
__device__ __forceinline__ void p_final(Frame& F, float* out) {
    const Ids I = fresh_ids();
    const int gw = F.vcu * NWAVES + I.wave, NGW = F.G * NWAVES;
    const float* H = (const float*)(F.ws + WS_H); const float* MOD = (const float*)(F.ws + WS_MOD); const float* nw = inp(F.lds, 27);
    for (int r = gw; r < NLAT; r += NGW) {
        const int s = row_sample(r); f32x4 v[4];
        load_row_f32(H + (size_t)r * D, I.lane, v);
        add_expert_out(v, r, I.lane, (const int*)(F.ws + WS_SLOT), (const float*)(F.ws + WS_AFFT), (const bf16*)(F.ws + WS_O2), MOD + ((size_t)1 * 9 + s) * MODW + 5120);
        const float rstd = 1.0f / sqrtf(row_sumsq(v) * (1.0f / D) + EPS);
#pragma unroll
        for (int j = 0; j < 4; ++j) { const int k = 4 * I.lane + 256 * j; *(f32x4*)(out + (size_t)r * D + k) = v[j] * rstd * *(const f32x4*)(nw + k); }
    }
}
__device__ __forceinline__ void p6_norm2_router(Frame& F, int l, int nrows) {
    const Ids I = fresh_ids();
    const int gw = F.vcu * NWAVES + I.wave, NGW = F.G * NWAVES;
    const float* H = (const float*)(F.ws + WS_H); bf16* HN = (bf16*)(F.ws + WS_HN); float* AFFT = (float*)(F.ws + WS_AFFT);
    const float* MOD = (const float*)(F.ws + WS_MOD); const float* nw = inp(F.lds, 7) + l * 1024; const float* rw = inp(F.lds, 23) + (size_t)l * 1024 * NE;
    LAS float* wt = (LAS float*)F.lds;
    for (int i = I.tid; i < 1024 * 4; i += 512) { const int k = i >> 2, q = i & 3; const f32x4 w = *(const f32x4*)(rw + k * 16 + 4 * q);
        wt[(4 * q + 0) * 1024 + k] = w.x; wt[(4 * q + 1) * 1024 + k] = w.y; wt[(4 * q + 2) * 1024 + k] = w.z; wt[(4 * q + 3) * 1024 + k] = w.w; }
    __syncthreads();
    for (int r = gw; r < nrows; r += NGW) {
        const int s = row_sample(r); f32x4 v[4];
        load_row_f32(H + (size_t)r * D, I.lane, v);
        const float rstd = 1.0f / sqrtf(row_sumsq(v) * (1.0f / D) + EPS);
        const float* m = MOD + ((size_t)l * 9 + s) * MODW;
#pragma unroll
        for (int j = 0; j < 4; ++j) { const int k = 4 * I.lane + 256 * j;
            const f32x4 w = *(const f32x4*)(nw + k), sh = *(const f32x4*)(m + 3072 + k), sc = *(const f32x4*)(m + 4096 + k);
            v[j] = (v[j] * rstd * w) * (sc + 1.0f) + sh;
            st_bf4(HN + (size_t)r * D + k, v[j]); }
        float lg[NE];
#pragma unroll
        for (int e = 0; e < NE; ++e) { float a = 0.f;
#pragma unroll
            for (int j = 0; j < 4; ++j) { const f32x4 w = *(const LAS f32x4*)(wt + e * 1024 + 4 * I.lane + 256 * j); a += (v[j].x * w.x + v[j].y * w.y) + (v[j].z * w.z + v[j].w * w.w); }
            lg[e] = wave_sum(a); }
        float mx = lg[0];
#pragma unroll
        for (int e = 1; e < NE; ++e) mx = fmaxf(mx, lg[e]);
        float den = 0.f;
#pragma unroll
        for (int e = 0; e < NE; ++e) { lg[e] = expf(lg[e] - mx); den += lg[e]; }
        const float inv = 1.0f / den; float mine = 0.f;
#pragma unroll
        for (int e = 0; e < NE; ++e) mine = (I.lane == e) ? lg[e] * inv : mine;
        if (I.lane < NE) AFFT[(size_t)I.lane * NROWS + r] = mine;
    }
    __syncthreads();
}
__device__ __forceinline__ void p4_combine(Frame& F, int l, int nrows) {
    const Ids I = fresh_ids();
    const int gw = F.vcu * NWAVES + I.wave, NGW = F.G * NWAVES;
    const bf16* O2 = (const bf16*)(F.ws + WS_O2); const bf16* U = (const bf16*)(F.ws + WS_U); bf16* Y = (bf16*)(F.ws + WS_Y);
    const int mixer = I.lane >> 4, c = (I.lane & 15) * 16;
    const float* nwp = (mixer == 0 ? inp(F.lds, 11) : mixer == 1 ? inp(F.lds, 14) : mixer == 2 ? inp(F.lds, 20) : inp(F.lds, 22)) + l * 256 + c;
    const int gcol = mixer == 0 ? C_RET + 768 + c : mixer == 1 ? C_GLA + 512 + c : mixer == 2 ? C_SSD + c : C_ML + 768 + c;
    float nw[16];
#pragma unroll
    for (int i = 0; i < 16; ++i) nw[i] = nwp[i];
    for (int r = gw; r < nrows; r += NGW) {
        float o[16], g[16];
        const bf16* p0 = O2 + (size_t)r * D + 16 * I.lane; const bf16* p1 = p0 + (size_t)NROWS * D; const bf16* pg = U + (size_t)r * INP + gcol;
#pragma unroll
        for (int q = 0; q < 4; ++q) { const f32x4 a = ld_bf4(p0 + 4 * q), b = ld_bf4(p1 + 4 * q), gg = ld_bf4(pg + 4 * q);
#pragma unroll
            for (int i = 0; i < 4; ++i) { o[4 * q + i] = a[i] + b[i]; g[4 * q + i] = gg[i]; } }
        if (mixer == 2) {
#pragma unroll
            for (int i = 0; i < 16; ++i) o[i] *= silu_f(g[i]);
        }
        float s1 = 0.f;
#pragma unroll
        for (int i = 0; i < 16; ++i) s1 += o[i];
        s1 += __shfl_xor(s1, 1); s1 += __shfl_xor(s1, 2);
        const float mean = mixer == 0 ? s1 * (1.0f / 64.0f) : 0.f;
        float s2 = 0.f;
#pragma unroll
        for (int i = 0; i < 16; ++i) { o[i] -= mean; s2 += o[i] * o[i]; }
        s2 += __shfl_xor(s2, 1); s2 += __shfl_xor(s2, 2);
        float s4 = s2 + __shfl_xor(s2, 4); s4 += __shfl_xor(s4, 8);
        const float rs = mixer == 2 ? 1.0f / sqrtf(s4 * (1.0f / 256.0f) + EPS) : 1.0f / sqrtf(s2 * (1.0f / 64.0f) + EPS);
        float y[16];
#pragma unroll
        for (int i = 0; i < 16; ++i) { const float gate = mixer == 2 ? 1.0f : (mixer == 3 ? sigmoid_f(g[i]) : silu_f(g[i])); y[i] = o[i] * rs * nw[i] * gate; }
        bf16* yp = Y + (size_t)r * D + 16 * I.lane;
        v4u w0, w1;
        w0.x = pg8::cvt_pk_bf16(y[0], y[1]); w0.y = pg8::cvt_pk_bf16(y[2], y[3]); w0.z = pg8::cvt_pk_bf16(y[4], y[5]); w0.w = pg8::cvt_pk_bf16(y[6], y[7]);
        w1.x = pg8::cvt_pk_bf16(y[8], y[9]); w1.y = pg8::cvt_pk_bf16(y[10], y[11]); w1.z = pg8::cvt_pk_bf16(y[12], y[13]); w1.w = pg8::cvt_pk_bf16(y[14], y[15]);
        *(v4u*)yp = w0; *(v4u*)(yp + 8) = w1;
    }
}

__device__ __forceinline__ int block_excl_scan(int v, LAS int* wsum, int lane, int wave, int& total) {
    int inc = v;
#pragma unroll
    for (int off = 1; off < 64; off <<= 1) { const int o = __shfl_up(inc, off); if (lane >= off) inc += o; }
    if (lane == 63) wsum[wave] = inc;
    __syncthreads();
    int base = 0, tot = 0;
#pragma unroll
    for (int w = 0; w < 8; ++w) { const int s = wsum[w]; base += (w < wave) ? s : 0; tot += s; }
    __syncthreads();
    total = tot; return base + inc - v;
}
__device__ __forceinline__ void p7_topk(Frame& F, int l) {
    const Ids I = fresh_ids();
    const float* AFFT = (const float*)(F.ws + WS_AFFT); int* SLOT = (int*)(F.ws + WS_SLOT);
    const bf16* HN = (const bf16*)(F.ws + WS_HN); bf16* XS = (bf16*)(F.ws + WS_Y);
    LAS unsigned* hist = (LAS unsigned*)F.lds;
    LAS unsigned* misc = hist + 256;
    LAS int* wsum = (LAS int*)(hist + 264);
    LAS int* selrow = (LAS int*)(hist + 272);
    const int nitems = (l == 0 ? 16 : 8) * NE;
    for (int item = F.vcu; item < nitems; item += F.G) {
        const int set = item >> 4, e = item & 15;
        const int n = set < 8 ? SEQ : CTXL, cap = n >> 3;
        const int row0 = set < 8 ? set * SEQ : NLAT + (set - 8) * CTXL, slotbase = set < 8 ? set * 256 : 2048 + (set - 8) * 32;
        unsigned key[4]; const int i0 = 4 * I.tid; const bool valid = i0 < n;
        { f32x4 a = (f32x4){0.f, 0.f, 0.f, 0.f}; if (valid) a = *(const f32x4*)(AFFT + (size_t)e * NROWS + row0 + i0);
          key[0] = __float_as_uint(a.x); key[1] = __float_as_uint(a.y); key[2] = __float_as_uint(a.z); key[3] = __float_as_uint(a.w); }
        unsigned prefix = 0u, kk = (unsigned)cap;
        for (int pass = 3; pass >= 0; --pass) {
            const int shift = 8 * pass;
            if (I.tid < 256) hist[I.tid] = 0u;
            __syncthreads();
            if (valid) {
#pragma unroll
                for (int j = 0; j < 4; ++j) { const bool match = pass == 3 || ((key[j] >> (shift + 8)) == (prefix >> (shift + 8)));
                    if (match) atomicAdd((unsigned*)&hist[(key[j] >> shift) & 255u], 1u); }
            }
            __syncthreads();
            if (I.wave == 0) {
                const unsigned h0 = hist[4 * I.lane], h1 = hist[4 * I.lane + 1], h2 = hist[4 * I.lane + 2], h3 = hist[4 * I.lane + 3];
                const unsigned s = h0 + h1 + h2 + h3; unsigned t = s;
#pragma unroll
                for (int off = 1; off < 64; off <<= 1) { const unsigned o = __shfl_down(t, off); if (I.lane + off < 64) t += o; }
                const unsigned above = t - s, c3 = above + h3, c2 = c3 + h2, c1 = c2 + h1, c0 = c1 + h0;
                int d = -1; unsigned nk = 0u;
                if (above < kk && c3 >= kk) { d = 3; nk = kk - above; }
                else if (c3 < kk && c2 >= kk) { d = 2; nk = kk - c3; }
                else if (c2 < kk && c1 >= kk) { d = 1; nk = kk - c2; }
                else if (c1 < kk && c0 >= kk) { d = 0; nk = kk - c1; }
                if (d >= 0) { misc[0] = prefix | ((unsigned)(4 * I.lane + d) << shift); misc[1] = nk; }
            }
            __syncthreads();
            prefix = misc[0]; kk = misc[1];
        }
        int ceq = 0; bool gt[4], eq[4];
#pragma unroll
        for (int j = 0; j < 4; ++j) { gt[j] = valid && key[j] > prefix; eq[j] = valid && key[j] == prefix; ceq += eq[j] ? 1 : 0; }
        int tot; int erank = block_excl_scan(ceq, wsum, I.lane, I.wave, tot);
        bool sel[4]; int csel = 0;
#pragma unroll
        for (int j = 0; j < 4; ++j) { sel[j] = gt[j] || (eq[j] && (unsigned)erank < kk); erank += eq[j] ? 1 : 0; csel += sel[j] ? 1 : 0; }
        int slot = block_excl_scan(csel, wsum, I.lane, I.wave, tot);
        if (valid) {
#pragma unroll
            for (int j = 0; j < 4; ++j) { const int r = row0 + i0 + j;
                if (sel[j]) { if (slot < cap) { selrow[slot] = r; SLOT[r * 16 + e] = e * SLOTS + slotbase + slot; } else SLOT[r * 16 + e] = -1; ++slot; }
                else SLOT[r * 16 + e] = -1; }
        }
        __syncthreads();
        for (int s = I.wave; s < cap; s += NWAVES) { const bf16* src = HN + (size_t)selrow[s] * D; bf16* dst = XS + (size_t)(e * SLOTS + slotbase + s) * D;
            const v4u a = *(const v4u*)(src + 8 * I.lane), b = *(const v4u*)(src + 512 + 8 * I.lane);
            *(v4u*)(dst + 8 * I.lane) = a; *(v4u*)(dst + 512 + 8 * I.lane) = b; }
        __syncthreads();
    }
}

constexpr int SC_Q = 0, SC_K = 2048, SC_V = 4096, SC_A = 6144, SC_X = 8192, SC_OP = 10240, SC_DP = 26624;
__device__ __forceinline__ void p3_scan(Frame& F, int l, bool ctx_out) {
    const Ids I = fresh_ids();
    const bf16* U = (const bf16*)(F.ws + WS_U); bf16* O2 = (bf16*)(F.ws + WS_O2);
    LAS float* sm = (LAS float*)F.lds;
    const int tk = I.tid >> 4, d0 = (I.tid & 15) * 4;
    for (int item = F.vcu; item < 256; item += F.G) {
        const int dir = item & 1, h = (item >> 1) & 3, mixer = (item >> 3) & 3, b = item >> 5;
        float S[8], nst[8];
#pragma unroll
        for (int i = 0; i < 8; ++i) { S[i] = 0.f; nst[i] = 0.f; }
        const float ret_gamma = sigmoid_f(inp(F.lds, 10)[(l * 2 + dir) * 4 + h]);
        const float ssd_dtb = inp(F.lds, 17)[(l * 2 + dir) * 4 + h], ssd_aneg = -expf(inp(F.lds, 18)[(l * 2 + dir) * 4 + h]), ssd_dskip = inp(F.lds, 19)[l * 4 + h];
        const float ml_bi = inp(F.lds, 21)[((l * 2 + dir) * 2 + 0) * 4 + h], ml_bf = inp(F.lds, 21)[((l * 2 + dir) * 2 + 1) * 4 + h];
        for (int batch = 0; batch < 72; ++batch) {
            const bool isctx = batch < 8; const int len = isctx ? CTXL : SEQ, pos0 = (isctx ? batch : batch - 8) * 32, rowbase = isctx ? NLAT + b * CTXL : b * SEQ;
            {
                const int pos = pos0 + tk, t = dir ? len - 1 - pos : pos; const bf16* ur = U + (size_t)(rowbase + t) * INP;
                f32x4 q4, k4, v4, a4, x4 = (f32x4){0.f, 0.f, 0.f, 0.f};
                if (mixer == 0) {
                    q4 = ld_bf4(ur + C_RET + h * 64 + d0) * 0.125f; k4 = ld_bf4(ur + C_RET + 256 + h * 64 + d0); v4 = ld_bf4(ur + C_RET + 512 + h * 64 + d0);
                    a4 = (f32x4){ret_gamma, ret_gamma, ret_gamma, ret_gamma};
                    if (!isctx) {
                        const int dd = d0 & 31; const bool first = dd < 16; const int fi = dd & 15, poff = first ? 16 : -16;
                        const float posv = (d0 < 32) ? (float)(t >> 6) : (float)(t & 63);
                        const f32x4 qp = ld_bf4(ur + C_RET + h * 64 + d0 + poff) * 0.125f, kp = ld_bf4(ur + C_RET + 256 + h * 64 + d0 + poff);
#pragma unroll
                        for (int j = 0; j < 4; ++j) { const float ang = posv * exp2f(-(float)(fi + j) * (13.287712379549449f / 16.0f)); const float cs = __cosf(ang), sn = __sinf(ang);
                            q4[j] = first ? q4[j] * cs - qp[j] * sn : qp[j] * sn + q4[j] * cs; k4[j] = first ? k4[j] * cs - kp[j] * sn : kp[j] * sn + k4[j] * cs; }
                    }
                } else if (mixer == 1) {
                    v4 = ld_bf4(ur + C_GLA + 256 + h * 64 + d0);
                    if (d0 < 32) {
                        q4 = ld_bf4(ur + C_GLA + h * 32 + d0) * 0.17677669529663687f; k4 = ld_bf4(ur + C_GLA + 128 + h * 32 + d0);
                        const float* gw_ = inp(F.lds, 12) + (size_t)(l * 2 + dir) * 16 * 128 + h * 32 + d0; const float* gb_ = inp(F.lds, 13) + (l * 2 + dir) * 128 + h * 32 + d0;
                        f32x4 z = *(const f32x4*)gb_;
#pragma unroll
                        for (int q = 0; q < 4; ++q) { const f32x4 lr = ld_bf4(ur + C_GLA + 768 + 4 * q);
#pragma unroll
                            for (int i = 0; i < 4; ++i) z += lr[i] * *(const f32x4*)(gw_ + (4 * q + i) * 128); }
#pragma unroll
                        for (int j = 0; j < 4; ++j) a4[j] = expf(log_sigmoid_f(z[j]) * (1.0f / 16.0f));
                    } else { q4 = (f32x4){0.f, 0.f, 0.f, 0.f}; k4 = q4; a4 = (f32x4){1.f, 1.f, 1.f, 1.f}; }
                } else if (mixer == 2) {
                    const int g = h >> 1; const float* cw = inp(F.lds, 15) + (size_t)l * 5 * 512; const float* cb = inp(F.lds, 16) + l * 512;
                    const int chx = h * 64 + d0, chb = 256 + g * 64 + d0, chc = 384 + g * 64 + d0;
                    f32x4 ax = *(const f32x4*)(cb + chx), ab = *(const f32x4*)(cb + chb), ac = *(const f32x4*)(cb + chc);
#pragma unroll
                    for (int w = 0; w < 5; ++w) { const int tt = t + w - 2;
                        if (tt >= 0 && tt < len) { const bf16* up = U + (size_t)(rowbase + tt) * INP + C_SSD + 256;
                            ax += ld_bf4(up + chx) * *(const f32x4*)(cw + w * 512 + chx); ab += ld_bf4(up + chb) * *(const f32x4*)(cw + w * 512 + chb); ac += ld_bf4(up + chc) * *(const f32x4*)(cw + w * 512 + chc); } }
                    const float dtr = bf_lo((unsigned)ur[C_SSD + 768 + dir * 4 + h]);
                    const float dt = softplus_f(dtr + ssd_dtb), aa = expf(dt * ssd_aneg);
#pragma unroll
                    for (int j = 0; j < 4; ++j) { x4[j] = silu_f(ax[j]); k4[j] = silu_f(ab[j]); q4[j] = silu_f(ac[j]); v4[j] = x4[j] * dt; a4[j] = aa; }
                } else {
                    q4 = ld_bf4(ur + C_ML + h * 64 + d0); k4 = ld_bf4(ur + C_ML + 256 + h * 64 + d0) * 0.125f; v4 = ld_bf4(ur + C_ML + 512 + h * 64 + d0);
                    const float ip = bf_lo((unsigned)ur[C_ML + 1024 + dir * 8 + h]) + ml_bi, fp = bf_lo((unsigned)ur[C_ML + 1024 + dir * 8 + 4 + h]) + ml_bf;
                    const float wgt = expf(ip), aa = sigmoid_f(fp);
                    k4 = k4 * wgt; a4 = (f32x4){aa, aa, aa, aa};
                }
                *(LAS f32x4*)(sm + SC_Q + tk * 64 + d0) = q4; *(LAS f32x4*)(sm + SC_K + tk * 64 + d0) = k4; *(LAS f32x4*)(sm + SC_V + tk * 64 + d0) = v4;
                *(LAS f32x4*)(sm + SC_A + tk * 64 + d0) = a4; *(LAS f32x4*)(sm + SC_X + tk * 64 + d0) = x4;
            }
            __syncthreads();
            {
                const int k0 = I.wave * 8;
                for (int t = 0; t < 32; ++t) {
                    const float vv = sm[SC_V + t * 64 + I.lane];
                    const f32x4 a0 = *(const LAS f32x4*)(sm + SC_A + t * 64 + k0), a1 = *(const LAS f32x4*)(sm + SC_A + t * 64 + k0 + 4);
                    const f32x4 kq0 = *(const LAS f32x4*)(sm + SC_K + t * 64 + k0), kq1 = *(const LAS f32x4*)(sm + SC_K + t * 64 + k0 + 4);
                    const f32x4 q0 = *(const LAS f32x4*)(sm + SC_Q + t * 64 + k0), q1 = *(const LAS f32x4*)(sm + SC_Q + t * 64 + k0 + 4);
                    float acc = 0.f, dacc = 0.f;
#pragma unroll
                    for (int i = 0; i < 4; ++i) { S[i] = a0[i] * S[i] + kq0[i] * vv; acc += q0[i] * S[i]; S[4 + i] = a1[i] * S[4 + i] + kq1[i] * vv; acc += q1[i] * S[4 + i]; }
                    sm[SC_OP + (t * 8 + I.wave) * 64 + I.lane] = acc;
                    if (mixer == 3) {
#pragma unroll
                        for (int i = 0; i < 4; ++i) { nst[i] = a0[i] * nst[i] + kq0[i]; dacc += q0[i] * nst[i]; nst[4 + i] = a1[i] * nst[4 + i] + kq1[i]; dacc += q1[i] * nst[4 + i]; }
                        if (I.lane == 0) sm[SC_DP + t * 8 + I.wave] = dacc;
                    }
                }
            }
            __syncthreads();
            if (!isctx || ctx_out) {
                const int pos = pos0 + tk, t = dir ? len - 1 - pos : pos;
                f32x4 o = (f32x4){0.f, 0.f, 0.f, 0.f};
#pragma unroll
                for (int w = 0; w < 8; ++w) o += *(const LAS f32x4*)(sm + SC_OP + (tk * 8 + w) * 64 + d0);
                if (mixer == 3) { float den = 0.f;
#pragma unroll
                    for (int w = 0; w < 8; ++w) den += sm[SC_DP + tk * 8 + w];
                    o = o * (1.0f / fmaxf(fabsf(den), 1.0f)); }
                if (mixer == 2 && dir == 0) o += *(const LAS f32x4*)(sm + SC_X + tk * 64 + d0) * ssd_dskip;
                st_bf4(O2 + ((size_t)dir * NROWS + rowbase + t) * D + mixer * 256 + h * 64 + d0, o);
            }
        }
        __syncthreads();
    }
}

struct Args { const float* in[28]; float* out; unsigned char* ws; int ph_lo, ph_hi, use_bar, never; };
__global__ void __launch_bounds__(NWAVES * 64, 2) fwd_kernel(Args args) {
    extern __shared__ __attribute__((aligned(16))) unsigned char lds[];
    Frame F;
    F.lds = (LAS unsigned char*)lds;
        F.G = gridDim.x; { const int bx = blockIdx.x; F.vcu = (F.G % 8 == 0) ? (bx % 8) * (F.G / 8) + bx / 8 : bx; }
    F.ws = args.ws;
    if (args.never) cooperative_groups::this_grid().sync();
    for (int u = threadIdx.x; u < (LDS_BYTES - LDSCTL_OFF) / 4; u += NWAVES * 64) ((LAS unsigned*)(F.lds + LDSCTL_OFF))[u] = 0u;
    __syncthreads();
    if (threadIdx.x == 0) { LAS unsigned long long* tab = (LAS unsigned long long*)(F.lds + LDSCTL_OFF);
#pragma unroll
        for (int i = 0; i < 28; ++i) tab[i] = (unsigned long long)args.in[i];
        tab[28] = (unsigned long long)args.out; }
    __syncthreads();
    XcdBarrier bar; bar.bar = (unsigned*)(F.ws + WS_CTL) + CW_BAR; bar.x = 0; bar.st = nullptr;
    if (args.use_bar) bar = xcd_barrier_post((unsigned*)(F.ws + WS_CTL) + CW_BAR, (volatile LAS unsigned*)(F.lds + MISC_OFF) + 8);
    const int lo = args.ph_lo, hi = args.ph_hi;
#define IN(k) (lo <= (k) && (k) < hi)
#define SEAM(k) do { if (IN(k) && IN((k) + 1)) xcd_barrier(bar); } while (0)
    #ifndef NO_P0
    if (IN(0)) { p0_prologue(F); }
#endif
    SEAM(0);
#pragma unroll
    for (int l = 0; l < 2; ++l) {
        const int pb = 1 + 9 * l;
        const bool ctx_out = l == 0;
        const int mrows = ctx_out ? NROWS : NLAT;
#ifndef NO_P1
        if (IN(pb + 0)) { p1_norm1(F, l); }
#endif
        SEAM(pb + 0);
        if (IN(pb + 1)) {
            pg8::Gemm g{(const bf16*)(F.ws + WS_HN), (const bf16*)(F.ws + WS_WTIN) + (size_t)l * INP * 1024, NROWS, INP, D}; pg8::StaticOrder S; S.init(NROWS, INP, F.G, (int)blockIdx.x);
            pg8::EpiStoreBf16 E{(bf16*)(F.ws + WS_U), INP, 0, 0};
            pg8::gemm_phase<pg8::EpiStoreBf16, pg8::StaticOrder, PG8_ALIGN, PG8_SP2>(F.lds, g, S, E);
        }
        SEAM(pb + 1);
#ifndef NO_SCAN
        if (IN(pb + 2)) { p3_scan(F, l, ctx_out); }
#endif
        SEAM(pb + 2);
#ifndef NO_P4
        if (IN(pb + 3)) { p4_combine(F, l, mrows); }
#endif
        SEAM(pb + 3);
        if (IN(pb + 4)) {
            pg8::Gemm g{(const bf16*)(F.ws + WS_Y), (const bf16*)(F.ws + WS_WTOUT) + (size_t)l * 1024 * 1024, mrows, D, D}; pg8::StaticOrder S; S.init(mrows, D, F.G, (int)blockIdx.x);
            pg8::EpiOutProj E{(float*)(F.ws + WS_H), (const float*)(F.ws + WS_MOD) + (size_t)l * 9 * MODW};
            pg8::gemm_phase<pg8::EpiOutProj, pg8::StaticOrder, PG8_ALIGN, PG8_SP2>(F.lds, g, S, E);
        }
        SEAM(pb + 4);
#ifndef NO_P6
        if (IN(pb + 5)) { p6_norm2_router(F, l, mrows); }
#endif
        SEAM(pb + 5);
#ifndef NO_P7
        if (IN(pb + 6)) { p7_topk(F, l); }
#endif
        SEAM(pb + 6);
        if (IN(pb + 7)) {
            pg8::Gemm g{(const bf16*)(F.ws + WS_Y), (const bf16*)(F.ws + WS_WTGU) + (size_t)l * NE * 3072 * 1024, NE * SLOTS, NE * 3072, D};
            pg8::GroupedOrder S{ctx_out ? 9 : 8, 12, (int)blockIdx.x};
            pg8::EpiSwiGLU E{(bf16*)(F.ws + WS_U)};
            pg8::gemm_phase<pg8::EpiSwiGLU, pg8::GroupedOrder, PG8_ALIGN, PG8_SP2>(F.lds, g, S, E);
        }
        SEAM(pb + 7);
        if (IN(pb + 8)) {
            pg8::Gemm g{(const bf16*)(F.ws + WS_U), (const bf16*)(F.ws + WS_WTDN) + (size_t)l * NE * 1024 * FF, NE * SLOTS, NE * 1024, FF};
            pg8::GroupedOrder S{ctx_out ? 9 : 8, 4, (int)blockIdx.x};
            pg8::EpiStoreBf16 E{(bf16*)(F.ws + WS_O2), D, 9, 4};
            pg8::gemm_phase<pg8::EpiStoreBf16, pg8::GroupedOrder, PG8_ALIGN, PG8_SP2>(F.lds, g, S, E);
        }
        SEAM(pb + 8);
    }
#ifndef NO_PF
    if (IN(19)) { p_final(F, (float*)inp(F.lds, 28)); }
#endif
#undef IN
#undef SEAM
}

#ifndef MK_ONE_LAUNCH
#define MK_ONE_LAUNCH 0
#endif
extern "C" void kernel_launch(void* const* d_in, const int* in_sizes, int n_in, void* d_out, int out_size, void* d_ws, size_t ws_size, hipStream_t stream) {
    static int grid = 0;
    if (grid == 0) {
        if (n_in != 28 || out_size != NLAT * D || ws_size < WS_END) { fprintf(stderr, "kernel_launch: unexpected problem (n_in %d, out %d, ws %zu < %zu)\n", n_in, out_size, ws_size, (size_t)WS_END); grid = -1; return; }
        int dev = 0, cus = 0, per_cu = 0;
        if (hipGetDevice(&dev) != hipSuccess || hipDeviceGetAttribute(&cus, hipDeviceAttributeMultiprocessorCount, dev) != hipSuccess) { grid = -1; return; }
        if (hipFuncSetAttribute((const void*)fwd_kernel, hipFuncAttributeMaxDynamicSharedMemorySize, LDS_BYTES) != hipSuccess) { fprintf(stderr, "kernel_launch: hipFuncSetAttribute failed\n"); grid = -1; return; }
        if (hipOccupancyMaxActiveBlocksPerMultiprocessor(&per_cu, (const void*)fwd_kernel, NWAVES * 64, LDS_BYTES) != hipSuccess || per_cu < 1) { fprintf(stderr, "kernel_launch: occupancy query says %d\n", per_cu); (void)hipGetLastError(); per_cu = 1; }
        grid = cus;
        if (grid != 256) { fprintf(stderr, "kernel_launch: built for 256 CUs, device has %d\n", cus); grid = -1; return; }
    }
    if (grid < 0) return;
    (void)hipMemsetAsync((char*)d_ws + WS_CTL, 0, CTL_ZERO_BYTES, stream);
    Args a{};
    for (int i = 0; i < 28; ++i) a.in[i] = (const float*)d_in[i];
    a.out = (float*)d_out; a.ws = (unsigned char*)d_ws; a.never = 0;
#if MK_ONE_LAUNCH
    a.ph_lo = 0; a.ph_hi = NPHASES; a.use_bar = 1;
    void* kargs[] = {&a};
    hipError_t e = hipLaunchCooperativeKernel((const void*)fwd_kernel, dim3(grid), dim3(NWAVES * 64), kargs, LDS_BYTES, stream);
    if (e != hipSuccess) fprintf(stderr, "kernel_launch: cooperative launch failed: %s\n", hipGetErrorString(e));
#else
    for (int ph = 0; ph < NPHASES; ++ph) { a.ph_lo = ph; a.ph_hi = ph + 1; a.use_bar = 0;
        hipLaunchKernelGGL(fwd_kernel, dim3(grid), dim3(NWAVES * 64), LDS_BYTES, stream, a); }
#endif
}
```

```cpp
#include <hip/hip_runtime.h>
#include <hip/hip_cooperative_groups.h>
#include <cstdio>
#include <cstdint>
#define GAS __attribute__((address_space(1)))
#define LAS __attribute__((address_space(3)))
namespace pg8 {
#define PG8_LAS __attribute__((address_space(3)))
typedef unsigned short bf16_t;
typedef short bf16x8 __attribute__((ext_vector_type(8)));
typedef float f32x4 __attribute__((ext_vector_type(4)));
typedef unsigned u32x4 __attribute__((ext_vector_type(4)));
constexpr int BM = 256, BK = 64, HALF = 128, HTB = HALF * BK * 2  , STAGE_BYTES = 8 * HTB, NXCD = 8, WGM = 8;

__host__ __device__ __forceinline__ int lds_byte(int r, int c) { const int st = (r >> 4) * 2 + (c >> 5), rr = r & 15, cc = c & 31, ob = rr * 64 + cc * 2; return st * 1024 + (ob ^ (((ob >> 9) & 1) << 5)); }
__host__ __device__ __forceinline__ void stage_rc(int b, int& R, int& C) { const int st = b / 1024, sb = b % 1024, swz = sb ^ (((sb >> 9) & 1) << 5); R = (st >> 1) * 16 + swz / 64; C = (st & 1) * 32 + (swz % 64) / 2; }
__host__ __device__ __forceinline__ int perm32(int rho) { const int n = rho >> 4, i = rho & 15; return 8 * (i >> 2) + 4 * n + (i & 3); }

struct Unit { int pm, pn; };
struct Gemm { const bf16_t* A; const bf16_t* Bt; int M, N, K; };

struct StaticOrder {
    int nM, nN, nwg, G, c;
    __host__ __device__ void init(int M, int N, int G_, int c_) { nM = M / BM; nN = N / BM; nwg = nM * nN; G = G_; c = c_; }
    __host__ __device__ bool next(int i, Unit& u) const {
        const long L = (long)i * G + c; if (L >= nwg) return false;
        int wgid = (int)L; { const int q = nwg / NXCD, r = nwg % NXCD, xcd = wgid % NXCD, off = wgid / NXCD; wgid = (xcd < r ? xcd * (q + 1) : r * (q + 1) + (xcd - r) * q) + off; }
        const int nig = WGM * nN, gid = wgid / nig, fm = gid * WGM, gsz = (nM - fm) < WGM ? (nM - fm) : WGM;
        u.pm = fm + ((wgid % nig) % gsz); u.pn = (wgid % nig) / gsz; return true;
    }
    __device__ __forceinline__ void a_ready(const Unit&) const {}
    __device__ __forceinline__ void done(const Unit&) const {}
};

__device__ __forceinline__ unsigned cvt_pk_bf16(float lo, float hi) { unsigned r; asm volatile("v_cvt_pk_bf16_f32 %0, %1, %2" : "=v"(r) : "v"(lo), "v"(hi)); return r; }

struct EpiStoreBf16 {
    static constexpr bool PERM = true, AFTER_DRAIN = false;
    bf16_t* O; int ldc; int pm_div, pn_per;
    __device__ __forceinline__ void operator()(const f32x4 (&acc)[2][2][4][2], const Unit& u, int wr, int wc, int fr, int fq) const {
        const int row0 = u.pm * BM + wr * 64 + fr; int pnl = u.pn; if (pm_div) pnl -= (u.pm / pm_div) * pn_per;
        const int col0 = pnl * BM + wc * 32 + 8 * fq;
#pragma unroll
        for (int ai = 0; ai < 2; ++ai)
#pragma unroll
            for (int m = 0; m < 4; ++m) { bf16_t* rowp = O + (size_t)(row0 + ai * HALF + m * 16) * ldc + col0;
#pragma unroll
                for (int bj = 0; bj < 2; ++bj) { const f32x4 v0 = acc[ai][bj][m][0], v1 = acc[ai][bj][m][1];
                    u32x4 w; w.x = cvt_pk_bf16(v0[0], v0[1]); w.y = cvt_pk_bf16(v0[2], v0[3]); w.z = cvt_pk_bf16(v1[0], v1[1]); w.w = cvt_pk_bf16(v1[2], v1[3]);
                    *(u32x4*)(rowp + bj * HALF) = w; } }
    }
};
struct EpiSwiGLU {
    static constexpr bool PERM = false, AFTER_DRAIN = false;
    bf16_t* O;
    __device__ __forceinline__ void operator()(const f32x4 (&acc)[2][2][4][2], const Unit& u, int wr, int wc, int fr, int fq) const {
        const int e = u.pm / 9, pnl = u.pn - e * 12;
        const int row0 = u.pm * BM + wr * 64 + fr, col0 = pnl * 128 + (4 * wc + fq) * 8;
#pragma unroll
        for (int ai = 0; ai < 2; ++ai)
#pragma unroll
            for (int m = 0; m < 4; ++m) {
                float h[8];
#pragma unroll
                for (int bj = 0; bj < 2; ++bj)
#pragma unroll
                    for (int j = 0; j < 4; ++j) { const float g = acc[ai][bj][m][0][j], up = acc[ai][bj][m][1][j]; h[bj * 4 + j] = g / (1.0f + __expf(-g)) * up; }
                u32x4 w; w.x = cvt_pk_bf16(h[0], h[1]); w.y = cvt_pk_bf16(h[2], h[3]); w.z = cvt_pk_bf16(h[4], h[5]); w.w = cvt_pk_bf16(h[6], h[7]);
                *(u32x4*)(O + (size_t)(row0 + ai * HALF + m * 16) * 1536 + col0) = w; }
    }
};
struct EpiOutProj {
    static constexpr bool PERM = false, AFTER_DRAIN = false;
    float* H; const float* mod;
    __device__ __forceinline__ void operator()(const f32x4 (&acc)[2][2][4][2], const Unit& u, int wr, int wc, int fr, int fq) const {
        const int s = u.pm < 64 ? (u.pm >> 3) : 8;
        const float* g1 = mod + s * 6144 + 2048;
        const int row0 = u.pm * BM + wr * 64 + fr, col0 = u.pn * BM + wc * 32 + 4 * fq;
#pragma unroll
        for (int bj = 0; bj < 2; ++bj)
#pragma unroll
            for (int n = 0; n < 2; ++n) { const f32x4 gv = *(const f32x4*)(g1 + col0 + bj * HALF + n * 16);
#pragma unroll
                for (int ai = 0; ai < 2; ++ai)
#pragma unroll
                    for (int m = 0; m < 4; ++m) { float* p = H + (size_t)(row0 + ai * HALF + m * 16) * 1024 + col0 + bj * HALF + n * 16;
                        const f32x4 old = *(const f32x4*)p; *(f32x4*)p = old + gv * acc[ai][bj][m][n]; } }
    }
};
struct GroupedOrder {
    int MT, NT, c;
    __device__ __forceinline__ bool next(int i, Unit& u) const {
        const int xcd = c & 7, j = i * 32 + (c >> 3), per = MT * NT;
        if (j >= 2 * per) return false;
        const int e = 2 * xcd + j / per, q = j % per;
        u.pm = e * 9 + q % MT; u.pn = e * NT + q / MT; return true;
    }
    __device__ __forceinline__ void a_ready(const Unit&) const {}
    __device__ __forceinline__ void done(const Unit&) const {}
};

template <class Epi, class Sched, bool ALIGN_EPI = false, bool SP2 = false>
__device__ __forceinline__ void gemm_phase(PG8_LAS unsigned char* lds, const Gemm g, const Sched& S, const Epi& E) {
    int tid_ = threadIdx.x; asm volatile("" : "+v"(tid_));
    const int tid = tid_, wid = __builtin_amdgcn_readfirstlane(tid >> 6), lane = tid & 63, wr = wid >> 2, wc = wid & 3, fr = lane & 15, fq = lane >> 4;
    const int K = g.K, nt = K / BK;
    unsigned voffA[2], voffB[2];
#pragma unroll
    for (int i = 0; i < 2; ++i) { int R, C; stage_rc(tid * 16 + i * 8192, R, C); const int Rb = Epi::PERM ? ((R & ~31) + perm32(R & 31)) : R;
        voffA[i] = (unsigned)(R * K + C) * 2u; voffB[i] = (unsigned)(Rb * K + C) * 2u; }
    const size_t kstep = (size_t)(BK * 2);
    const size_t hstep = (size_t)HALF * K * 2;
    const size_t tstep = 2 * hstep;
    const unsigned ldsw = (unsigned)wid * 1024u;
    const int aoff = lds_byte(wr * 64 + fr, fq * 8), boff = lds_byte(wc * 32 + fr, fq * 8);
#define PG8_SA(b, h) (((b) * 2 + (h)) * HTB)
#define PG8_SB(b, h) ((4 + (b) * 2 + (h)) * HTB)
#define PG8_STAGE(bufoff, gbase, voff) do { _Pragma("unroll") for (int _i = 0; _i < 2; ++_i) \
        __builtin_amdgcn_global_load_lds((const unsigned*)((const char*)(gbase) + (voff)[_i]), (PG8_LAS unsigned*)(lds + (bufoff) + ldsw + _i * 8192), 16, 0, 0); } while (0)
#define PG8_LDA(dst, b, h) do { _Pragma("unroll") for (int m = 0; m < 4; ++m) _Pragma("unroll") for (int k = 0; k < 2; ++k) dst[m][k] = *(const PG8_LAS bf16x8*)(lds + PG8_SA(b, h) + aoff + m * 2048 + k * 1024); } while (0)
#define PG8_LDB(dst, b, h) do { _Pragma("unroll") for (int n = 0; n < 2; ++n) _Pragma("unroll") for (int k = 0; k < 2; ++k) dst[n][k] = *(const PG8_LAS bf16x8*)(lds + PG8_SB(b, h) + boff + n * 2048 + k * 1024); } while (0)
#define PG8_MMA(ai, bj, At, Bt) do { __builtin_amdgcn_s_setprio(1); _Pragma("unroll") for (int m = 0; m < 4; ++m) _Pragma("unroll") for (int n = 0; n < 2; ++n) _Pragma("unroll") for (int k = 0; k < 2; ++k) \
        acc[ai][bj][m][n] = __builtin_amdgcn_mfma_f32_16x16x32_bf16(Bt[n][k], At[m][k], acc[ai][bj][m][n], 0, 0, 0); __builtin_amdgcn_s_setprio(0); } while (0)
#define PG8_WAIT_V(n) asm volatile("s_waitcnt vmcnt(" #n ")" ::: "memory")
#define PG8_WAIT_L(n) asm volatile("s_waitcnt lgkmcnt(" #n ")" ::: "memory")
#define PG8_BAR __builtin_amdgcn_s_barrier()
#define PG8_SCHED __builtin_amdgcn_sched_barrier(0)
    Unit cur, nxt; int ui = 0;
    if (!S.next(0, cur)) return;
    f32x4 acc[2][2][4][2];
#pragma unroll
    for (int a = 0; a < 2; ++a)
#pragma unroll
        for (int b = 0; b < 2; ++b)
#pragma unroll
            for (int m = 0; m < 4; ++m)
#pragma unroll
                for (int n = 0; n < 2; ++n) acc[a][b][m][n] = (f32x4){0.f, 0.f, 0.f, 0.f};
    bf16x8 At[4][2], B0[2][2], B1[2][2];
    const char* cA = (const char*)g.A + (size_t)cur.pm * tstep; const char* cB = (const char*)g.Bt + (size_t)cur.pn * tstep;
    S.a_ready(cur);
    if constexpr (SP2) {
        PG8_STAGE(PG8_SB(0, 0), cB, voffB); PG8_STAGE(PG8_SB(0, 1), cB + hstep, voffB); PG8_STAGE(PG8_SA(0, 0), cA, voffA); PG8_STAGE(PG8_SA(0, 1), cA + hstep, voffA);
        if (wr == 1) PG8_BAR;
        PG8_WAIT_V(2); PG8_BAR;
        PG8_STAGE(PG8_SB(1, 0), cB + kstep, voffB); PG8_STAGE(PG8_SA(1, 0), cA + kstep, voffA); PG8_STAGE(PG8_SB(1, 1), cB + hstep + kstep, voffB);
        PG8_WAIT_V(6); PG8_BAR;
    } else {
        PG8_STAGE(PG8_SB(0, 0), cB, voffB); PG8_STAGE(PG8_SA(0, 0), cA, voffA); PG8_STAGE(PG8_SB(0, 1), cB + hstep, voffB); PG8_STAGE(PG8_SA(0, 1), cA + hstep, voffA);
        if (wr == 1) PG8_BAR;
        PG8_WAIT_V(4); PG8_BAR;
        PG8_STAGE(PG8_SB(1, 0), cB + kstep, voffB); PG8_STAGE(PG8_SA(1, 0), cA + kstep, voffA); PG8_STAGE(PG8_SB(1, 1), cB + hstep + kstep, voffB);
        PG8_WAIT_V(6); PG8_BAR;
    }
    for (;;) {
        const bool has_next = S.next(ui + 1, nxt);
        const char* nA = has_next ? (const char*)g.A + (size_t)nxt.pm * tstep : cA; const char* nB = has_next ? (const char*)g.Bt + (size_t)nxt.pn * tstep : cB;
        for (int t = 0; t < nt; t += 2) {
            const bool last = (t == nt - 2);
            const char* a1 = cA + (size_t)(t + 1) * kstep;
            const char* a2 = last ? nA : cA + (size_t)(t + 2) * kstep; const char* b2 = last ? nB : cB + (size_t)(t + 2) * kstep;
            const char* a3 = a2 + kstep; const char* b3 = b2 + kstep;
            if (last && has_next) S.a_ready(nxt);
            if constexpr (SP2) {
            PG8_LDB(B0, 0, 0); PG8_LDB(B1, 0, 1); PG8_SCHED; PG8_LDA(At, 0, 0); PG8_STAGE(PG8_SA(1, 1), a1 + hstep, voffA);
            PG8_WAIT_V(8); PG8_WAIT_L(0); PG8_BAR; PG8_MMA(0, 0, At, B0); PG8_MMA(0, 1, At, B1); PG8_BAR; PG8_SCHED;
            PG8_LDA(At, 0, 1); PG8_STAGE(PG8_SB(0, 0), b2, voffB); PG8_STAGE(PG8_SB(0, 1), b2 + hstep, voffB); PG8_STAGE(PG8_SA(0, 0), a2, voffA);
            PG8_WAIT_V(8); PG8_WAIT_L(0); PG8_BAR; PG8_MMA(1, 0, At, B0); PG8_MMA(1, 1, At, B1); PG8_BAR; PG8_SCHED;
            PG8_LDB(B0, 1, 0); PG8_LDB(B1, 1, 1); PG8_SCHED; PG8_LDA(At, 1, 0); PG8_STAGE(PG8_SA(0, 1), a2 + hstep, voffA);
            PG8_WAIT_V(8); PG8_WAIT_L(0); PG8_BAR; PG8_MMA(0, 0, At, B0); PG8_MMA(0, 1, At, B1); PG8_BAR; PG8_SCHED;
            PG8_LDA(At, 1, 1); PG8_STAGE(PG8_SB(1, 0), b3, voffB); PG8_STAGE(PG8_SB(1, 1), b3 + hstep, voffB); PG8_STAGE(PG8_SA(1, 0), a3, voffA);
            PG8_WAIT_V(8); PG8_WAIT_L(0); PG8_BAR; PG8_MMA(1, 0, At, B0); PG8_MMA(1, 1, At, B1); PG8_BAR; PG8_SCHED;
            } else {
            PG8_LDB(B0, 0, 0); PG8_SCHED; PG8_LDA(At, 0, 0); PG8_STAGE(PG8_SA(1, 1), a1 + hstep, voffA);
            PG8_WAIT_L(8); PG8_BAR; PG8_WAIT_L(0); PG8_MMA(0, 0, At, B0); PG8_BAR; PG8_SCHED;
            PG8_LDB(B1, 0, 1); PG8_STAGE(PG8_SB(0, 0), b2, voffB);
            PG8_BAR; PG8_WAIT_L(0); PG8_MMA(0, 1, At, B1); PG8_BAR;
            PG8_LDA(At, 0, 1); PG8_STAGE(PG8_SA(0, 0), a2, voffA);
            PG8_BAR; PG8_WAIT_L(0); PG8_MMA(1, 0, At, B0); PG8_BAR; PG8_SCHED;
            PG8_STAGE(PG8_SB(0, 1), b2 + hstep, voffB);
            PG8_WAIT_V(6); PG8_BAR; PG8_MMA(1, 1, At, B1); PG8_BAR;
            PG8_LDB(B0, 1, 0); PG8_SCHED; PG8_LDA(At, 1, 0); PG8_STAGE(PG8_SA(0, 1), a2 + hstep, voffA);
            PG8_WAIT_L(8); PG8_BAR; PG8_WAIT_L(0); PG8_MMA(0, 0, At, B0); PG8_BAR; PG8_SCHED;
            PG8_LDB(B1, 1, 1); PG8_STAGE(PG8_SB(1, 0), b3, voffB);
            PG8_BAR; PG8_WAIT_L(0); PG8_MMA(0, 1, At, B1); PG8_BAR;
            PG8_LDA(At, 1, 1); PG8_STAGE(PG8_SA(1, 0), a3, voffA);
            PG8_BAR; PG8_WAIT_L(0); PG8_MMA(1, 0, At, B0); PG8_BAR; PG8_SCHED;
            PG8_STAGE(PG8_SB(1, 1), b3 + hstep, voffB);
            PG8_WAIT_V(6); PG8_BAR; PG8_MMA(1, 1, At, B1); PG8_BAR;
            }
        }
        if constexpr (ALIGN_EPI) { if (wr == 0) PG8_BAR; }
        if constexpr (!Epi::AFTER_DRAIN) { E(acc, cur, wr, wc, fr, fq); S.done(cur); }
        if (!has_next) break;
#pragma unroll
        for (int a = 0; a < 2; ++a)
#pragma unroll
            for (int b = 0; b < 2; ++b)
#pragma unroll
                for (int m = 0; m < 4; ++m)
#pragma unroll
                    for (int n = 0; n < 2; ++n) acc[a][b][m][n] = (f32x4){0.f, 0.f, 0.f, 0.f};
        cur = nxt; cA = nA; cB = nB; ++ui;
        if constexpr (ALIGN_EPI) { if (wr == 1) PG8_BAR; }
    }
    PG8_WAIT_V(0);
    if constexpr (!ALIGN_EPI) { if (wr == 0) PG8_BAR; }
    PG8_BAR;
    if constexpr (Epi::AFTER_DRAIN) { E.fused(acc, cur, wr, wc, fr, fq, lds, wid, lane); S.done(cur); }
#undef PG8_SA
#undef PG8_SB
#undef PG8_STAGE
#undef PG8_LDA
#undef PG8_LDB
#undef PG8_MMA
#undef PG8_WAIT_V
#undef PG8_WAIT_L
#undef PG8_BAR
#undef PG8_SCHED
}
}

#ifndef PG8_SP2
#define PG8_SP2 true
#endif
#ifndef PG8_ALIGN
#define PG8_ALIGN true
#endif

constexpr int D = 1024, NB = 8, SEQ = 2048, CTXL = 256, NLAT = NB * SEQ, NCTX = NB * CTXL, NROWS = NLAT + NCTX;
constexpr int INC = 3624, INP = 3840, NE = 16, FF = 1536, SLOTS = 2304, MODW = 6144;
constexpr float EPS = 1e-6f;
constexpr int C_RET = 0, C_GLA = 1024, C_SSD = 1808, C_ML = 2584;
constexpr size_t MiB = 1u << 20;
constexpr size_t WS_CTL = 0, CTL_ZERO_BYTES = 1 * MiB;
constexpr size_t WS_MOD = 1 * MiB, WS_WTIN = 2 * MiB, WS_WTOUT = 18 * MiB, WS_WTGU = 22 * MiB, WS_WTDN = 214 * MiB, WS_H = 310 * MiB, WS_HN = 382 * MiB,
                 WS_U = 418 * MiB  , WS_O2 = 553 * MiB  , WS_Y = 625 * MiB  , WS_AFFT = 697 * MiB, WS_SLOT = 699 * MiB, WS_END = 701 * MiB;
constexpr int CW_BAR = 4096;
constexpr int RING_BYTES = 131072, LDSCTL_OFF = RING_BYTES, MISC_OFF = LDSCTL_OFF + 320, LDS_BYTES = 147456;
constexpr int NWAVES = 8, NPHASES = 20;

typedef unsigned short bf16;
typedef unsigned v4u __attribute__((ext_vector_type(4)));
typedef unsigned v2u __attribute__((ext_vector_type(2)));
typedef float f32x4 __attribute__((ext_vector_type(4)));
typedef GAS unsigned gu32;
#define LDS_WAIT() asm volatile("s_waitcnt lgkmcnt(0)" ::: "memory")
#define VM_WAIT() asm volatile("s_waitcnt vmcnt(0)" ::: "memory")

#define XB_TMO      128
#define XB_XCNT(j)  (256  + 64 * (j))
#define XB_XSUB(j)  (1280 + 64 * (j))
#define XB_XGEN(j)  (2304 + 64 * (j))
#define XB_TOP      3328
#define XB_TOPGEN   3392
#define XCD_BAR_WORDS 3456
#define XB_SPIN_CAP (1u << 18)

__device__ __forceinline__ unsigned xb_ld(unsigned* p)              { return __hip_atomic_load(p, __ATOMIC_RELAXED, __HIP_MEMORY_SCOPE_AGENT); }
__device__ __forceinline__ unsigned xb_add(unsigned* p, unsigned v) { return __hip_atomic_fetch_add(p, v, __ATOMIC_RELAXED, __HIP_MEMORY_SCOPE_AGENT); }
__device__ __forceinline__ unsigned xb_xcc_id() { return (unsigned)__builtin_amdgcn_s_getreg((3 << 11) | 20) & 0xFu; }
#define XB_SPIN(cond, bar) do { unsigned _sp = 0; while (cond) { __builtin_amdgcn_s_sleep(1); \
    if ((++_sp & 255u) == 0u) { if (xb_ld(&(bar)[XB_TMO])) break; if (_sp > XB_SPIN_CAP) { atomicAdd(&(bar)[XB_TMO], 1u); break; } } } } while (0)

struct XcdBarrier {
    unsigned* bar; unsigned x;
    volatile LAS unsigned* st;
};

__device__ __forceinline__ XcdBarrier xcd_barrier_post(unsigned* bar, volatile LAS unsigned* st) {
    XcdBarrier b; b.bar = bar; b.x = xb_xcc_id(); b.st = st;
    if (threadIdx.x == 0) (void)xb_add(&bar[XB_XCNT(b.x)], 1u);
    return b;
}
__device__ __forceinline__ void xcd_barrier_complete(unsigned* bar, unsigned x, unsigned& nloc, unsigned& nx) {
    const unsigned G = gridDim.x * gridDim.y * gridDim.z;
    unsigned sum, cnt, mine, sp = 0u;
    for (;;) {
        sum = 0u; cnt = 0u; mine = 0u;
#pragma unroll
        for (unsigned j = 0; j < 16; ++j) { const unsigned c = xb_ld(&bar[XB_XCNT(j)]); sum += c; cnt += (c > 0u) ? 1u : 0u; mine = (j == x) ? c : mine; }
        if (sum == G) break;
        __builtin_amdgcn_s_sleep(1);
        if ((++sp & 255u) == 0u) { if (xb_ld(&bar[XB_TMO])) break; if (sp > XB_SPIN_CAP) { atomicAdd(&bar[XB_TMO], 1u); break; } }
    }
    nloc = mine > 0u ? mine : 1u; nx = cnt > 0u ? cnt : 1u;
}

__device__ __forceinline__ void xcd_barrier(const XcdBarrier& b) {
    asm volatile("s_waitcnt vmcnt(0)" ::: "memory");
    __syncthreads();
    if (threadIdx.x == 0) {
        unsigned* bar = b.bar;
        __builtin_amdgcn_s_waitcnt(0);
        unsigned nloc = b.st[0], nx = b.st[1];
        if (nloc == 0u) { xcd_barrier_complete(bar, b.x, nloc, nx); b.st[0] = nloc; b.st[1] = nx; }
        const unsigned old = xb_add(&bar[XB_XSUB(b.x)], 1u);
        const unsigned gen = old / nloc;
        if (old + 1u == (gen + 1u) * nloc) {
            __builtin_amdgcn_fence(__ATOMIC_RELEASE, "agent");
            asm volatile("s_waitcnt vmcnt(0)" ::: "memory");
            const unsigned og = xb_add(&bar[XB_TOP], 1u);
            const unsigned tg = og / nx;
            if (og + 1u == (tg + 1u) * nx) xb_add(&bar[XB_TOPGEN], 1u);
            else XB_SPIN(xb_ld(&bar[XB_TOPGEN]) == tg, bar);
            __builtin_amdgcn_fence(__ATOMIC_ACQUIRE, "agent");
            xb_add(&bar[XB_XGEN(b.x)], 1u);
            asm volatile("s_waitcnt vmcnt(0)" ::: "memory");
        } else {
            XB_SPIN(xb_ld(&bar[XB_XGEN(b.x)]) == gen, bar);
            __builtin_amdgcn_fence(__ATOMIC_ACQUIRE, "agent");
            asm volatile("s_waitcnt vmcnt(0)" ::: "memory");
        }
    }
    __syncthreads();
}


struct Frame {
    LAS unsigned char* lds;
    int vcu, G;
    unsigned char* ws;
};
struct Ids { int tid, lane, wave; };
__device__ __forceinline__ const float* inp(const LAS unsigned char* lds, int i) {
    const LAS unsigned* t = (const LAS unsigned*)(lds + 131072) + 2 * i;
    const unsigned lo = __builtin_amdgcn_readfirstlane(t[0]), hi = __builtin_amdgcn_readfirstlane(t[1]);
    return (const float*)(((unsigned long long)hi << 32) | lo); }
__device__ __forceinline__ Ids fresh_ids() { int t = threadIdx.x; asm volatile("" : "+v"(t)); Ids I; I.tid = t; I.lane = t & 63; I.wave = __builtin_amdgcn_readfirstlane(t >> 6); return I; }
__device__ __forceinline__ float wave_sum(float v) {
#pragma unroll
    for (int o = 1; o < 64; o <<= 1) v += __shfl_xor(v, o);
    return v;
}
__device__ __forceinline__ float bf_lo(unsigned w) { return __uint_as_float(w << 16); }
__device__ __forceinline__ float bf_hi(unsigned w) { return __uint_as_float(w & 0xffff0000u); }
__device__ __forceinline__ f32x4 ld_bf4(const bf16* p) { const v2u w = *(const v2u*)p; return (f32x4){bf_lo(w.x), bf_hi(w.x), bf_lo(w.y), bf_hi(w.y)}; }
__device__ __forceinline__ void st_bf4(bf16* p, f32x4 v) { v2u w; w.x = pg8::cvt_pk_bf16(v.x, v.y); w.y = pg8::cvt_pk_bf16(v.z, v.w); *(v2u*)p = w; }
__device__ __forceinline__ float silu_f(float x) { return x / (1.0f + expf(-x)); }
__device__ __forceinline__ float sigmoid_f(float x) { return 1.0f / (1.0f + expf(-x)); }
__device__ __forceinline__ float log_sigmoid_f(float z) { return fminf(z, 0.f) - log1pf(expf(-fabsf(z))); }
__device__ __forceinline__ float softplus_f(float x) { return fmaxf(x, 0.f) + log1pf(expf(-fabsf(x))); }
__device__ __forceinline__ int row_sample(int r) { return r < NLAT ? (r >> 11) : 8; }

template <class RowMap>
__device__ __forceinline__ void transpose_item(const float* W, int ldw, int nvalid, int k0, int n0, bf16* WT, int ldt, const RowMap& f, LAS float* scr, int lane) {
#pragma unroll 8
    for (int i = 0; i < 32; ++i) { const int kk = 2 * i + (lane >> 5), c = n0 + (lane & 31); scr[kk * 33 + (lane & 31)] = c < nvalid ? W[(size_t)(k0 + kk) * ldw + c] : 0.f; }
    LDS_WAIT(); asm volatile("" ::: "memory");
    const int c8 = lane & 7;
#pragma unroll
    for (int j = 0; j < 4; ++j) { const int n = (lane >> 3) + 8 * j, col = n0 + n; const LAS float* s = scr + (8 * c8) * 33 + n;
        if (col < nvalid) { v4u o; o.x = pg8::cvt_pk_bf16(s[0 * 33], s[1 * 33]); o.y = pg8::cvt_pk_bf16(s[2 * 33], s[3 * 33]); o.z = pg8::cvt_pk_bf16(s[4 * 33], s[5 * 33]); o.w = pg8::cvt_pk_bf16(s[6 * 33], s[7 * 33]);
            *(v4u*)(WT + (size_t)f(col) * ldt + k0 + 8 * c8) = o; } }
    LDS_WAIT(); asm volatile("" ::: "memory");
}
struct MapId { int off; __device__ __forceinline__ int operator()(int c) const { return off + c; } };
struct MapGU { int off, n; __device__ __forceinline__ int operator()(int h) const { const int hl = h & 127, q = hl >> 3, wc = q >> 2, fq = q & 3, rem = hl & 7, bj = rem >> 2, j = rem & 3;
    return off + 256 * (h >> 7) + 128 * bj + 32 * wc + 16 * n + 4 * fq + j; } };

__device__ __forceinline__ void p0_prologue(Frame& F) {
    const Ids I = fresh_ids();
    const float* cvec = inp(F.lds, 1); const float* cctx = inp(F.lds, 3); const float* w_mod = inp(F.lds, 4); const float* b_mod = inp(F.lds, 5);
    float* MOD = (float*)(F.ws + WS_MOD);
    {
        LAS float* sil = (LAS float*)F.lds;
        LAS float* part = (LAS float*)(F.lds + 40960);
        for (int i = I.tid; i < 9 * 1024; i += 512) { const int s = i >> 10, k = i & 1023; const float c = s < 8 ? cvec[s * 1024 + k] : cctx[k]; sil[i] = silu_f(c); }
        __syncthreads();
        for (int item = F.vcu; item < 192; item += F.G) {
            const int l = item / 96, col = (item % 96) * 64 + I.lane;
            float acc[9];
#pragma unroll
            for (int s = 0; s < 9; ++s) acc[s] = 0.f;
            const float* wp = w_mod + (size_t)l * 1024 * MODW + (size_t)(I.wave * 128) * MODW + col;
            for (int k = 0; k < 128; ++k) { const float wv = wp[(size_t)k * MODW];
#pragma unroll
                for (int s = 0; s < 9; ++s) acc[s] += sil[s * 1024 + I.wave * 128 + k] * wv; }
#pragma unroll
            for (int s = 0; s < 9; ++s) part[(I.wave * 9 + s) * 64 + I.lane] = acc[s];
            __syncthreads();
            for (int i = I.tid; i < 9 * 64; i += 512) { const int s = i >> 6, ln = i & 63; float t = 0.f;
#pragma unroll
                for (int w = 0; w < 8; ++w) t += part[(w * 9 + s) * 64 + ln];
                const int cc = (item % 96) * 64 + ln; MOD[((size_t)l * 9 + s) * MODW + cc] = t + b_mod[l * MODW + cc]; }
            __syncthreads();
        }
        __syncthreads();
    }
    {
        bf16* wtin = (bf16*)(F.ws + WS_WTIN);
        const int nchunk = 2 * (INP - INC) * 128;
        for (int i = F.vcu * 512 + I.tid; i < nchunk; i += F.G * 512) { const int l = i / ((INP - INC) * 128), r = i % ((INP - INC) * 128);
            *(v4u*)(wtin + ((size_t)l * INP + INC) * 1024 + (size_t)r * 8) = (v4u){0u, 0u, 0u, 0u}; }
    }
    {
        LAS float* scr = (LAS float*)(F.lds + I.wave * 16384);
        const int gw = F.vcu * NWAVES + I.wave, NGW = F.G * NWAVES;
        constexpr int I_IN = 16 * 114, I_OUT = 16 * 32, I_E = 768, PER_L = I_IN + I_OUT + 16 * 3 * I_E;
        for (int it = gw; it < 2 * PER_L; it += NGW) {
            const int l = it / PER_L; int r = it % PER_L;
            if (r < I_IN) { const int kb = r / 114, nb = r % 114;
                transpose_item(inp(F.lds, 8) + (size_t)l * 1024 * INC, INC, INC, 64 * kb, 32 * nb, (bf16*)(F.ws + WS_WTIN) + (size_t)l * INP * 1024, 1024, MapId{0}, scr, I.lane); continue; }
            r -= I_IN;
            if (r < I_OUT) { const int kb = r / 32, nb = r % 32;
                transpose_item(inp(F.lds, 9) + (size_t)l * 1024 * 1024, 1024, 1024, 64 * kb, 32 * nb, (bf16*)(F.ws + WS_WTOUT) + (size_t)l * 1024 * 1024, 1024, MapId{0}, scr, I.lane); continue; }
            r -= I_OUT;
            const int e = r / (3 * I_E), q = r % (3 * I_E), kind = q / I_E, t = q % I_E;
            if (kind < 2) { const int kb = t / 48, nb = t % 48;
                transpose_item((kind ? inp(F.lds, 25) : inp(F.lds, 24)) + ((size_t)l * NE + e) * 1024 * FF, FF, FF, 64 * kb, 32 * nb, (bf16*)(F.ws + WS_WTGU) + (size_t)l * NE * 3072 * 1024, 1024, MapGU{e * 3072, kind}, scr, I.lane); }
            else { const int kb = t / 32, nb = t % 32;
                transpose_item(inp(F.lds, 26) + ((size_t)l * NE + e) * FF * 1024, 1024, 1024, 64 * kb, 32 * nb, (bf16*)(F.ws + WS_WTDN) + (size_t)l * NE * 1024 * FF, FF, MapId{e * 1024}, scr, I.lane); }
        }
    }
}

__device__ __forceinline__ void load_row_f32(const float* p, int lane, f32x4 (&v)[4]) {
#pragma unroll
    for (int j = 0; j < 4; ++j) v[j] = *(const f32x4*)(p + 4 * lane + 256 * j);
}
__device__ __forceinline__ float row_sumsq(const f32x4 (&v)[4]) { float s = 0.f;
#pragma unroll
    for (int j = 0; j < 4; ++j) s += (v[j].x * v[j].x + v[j].y * v[j].y) + (v[j].z * v[j].z + v[j].w * v[j].w);
    return wave_sum(s); }
__device__ __forceinline__ void add_expert_out(f32x4 (&v)[4], int r, int lane, const int* slotmap, const float* afft, const bf16* EO, const float* g2) {
    f32x4 acc[4];
#pragma unroll
    for (int j = 0; j < 4; ++j) acc[j] = (f32x4){0.f, 0.f, 0.f, 0.f};
    for (int e = 0; e < NE; ++e) {
        const int slot = __builtin_amdgcn_readfirstlane(slotmap[r * 16 + e]);
        if (slot >= 0) { const float a = afft[(size_t)e * NROWS + r]; const bf16* er = EO + (size_t)slot * 1024;
#pragma unroll
            for (int j = 0; j < 4; ++j) acc[j] += a * ld_bf4(er + 4 * lane + 256 * j); }
    }
#pragma unroll
    for (int j = 0; j < 4; ++j) v[j] += *(const f32x4*)(g2 + 4 * lane + 256 * j) * acc[j];
}
__device__ __forceinline__ void p1_norm1(Frame& F, int l) {
    const Ids I = fresh_ids();
    const int gw = F.vcu * NWAVES + I.wave, NGW = F.G * NWAVES;
    float* H = (float*)(F.ws + WS_H); bf16* HN = (bf16*)(F.ws + WS_HN);
    const float* MOD = (const float*)(F.ws + WS_MOD); const float* nw = inp(F.lds, 6) + l * 1024;
    for (int r = gw; r < NROWS; r += NGW) {
        const int s = row_sample(r); f32x4 v[4];
        if (l == 0) load_row_f32(r < NLAT ? inp(F.lds, 0) + (size_t)r * D : inp(F.lds, 2) + (size_t)(r - NLAT) * D, I.lane, v);
        else { load_row_f32(H + (size_t)r * D, I.lane, v);
            add_expert_out(v, r, I.lane, (const int*)(F.ws + WS_SLOT), (const float*)(F.ws + WS_AFFT), (const bf16*)(F.ws + WS_O2), MOD + ((size_t)(l - 1) * 9 + s) * MODW + 5120); }
        const float rstd = 1.0f / sqrtf(row_sumsq(v) * (1.0f / D) + EPS);
        const float* m = MOD + ((size_t)l * 9 + s) * MODW;
#pragma unroll
        for (int j = 0; j < 4; ++j) { const int k = 4 * I.lane + 256 * j;
            *(f32x4*)(H + (size_t)r * D + k) = v[j];
            const f32x4 w = *(const f32x4*)(nw + k), sh = *(const f32x4*)(m + k), sc = *(const f32x4*)(m + 1024 + k);
            st_bf4(HN + (size_t)r * D + k, (v[j] * rstd * w) * (sc + 1.0f) + sh); }
    }
}
__device__ __forceinline__ void p_final(Frame& F, float* out) {
    const Ids I = fresh_ids();
    const int gw = F.vcu * NWAVES + I.wave, NGW = F.G * NWAVES;
    const float* H = (const float*)(F.ws + WS_H); const float* MOD = (const float*)(F.ws + WS_MOD); const float* nw = inp(F.lds, 27);
    for (int r = gw; r < NLAT; r += NGW) {
        const int s = row_sample(r); f32x4 v[4];
        load_row_f32(H + (size_t)r * D, I.lane, v);
        add_expert_out(v, r, I.lane, (const int*)(F.ws + WS_SLOT), (const float*)(F.ws + WS_AFFT), (const bf16*)(F.ws + WS_O2), MOD + ((size_t)1 * 9 + s) * MODW + 5120);
        const float rstd = 1.0f / sqrtf(row_sumsq(v) * (1.0f / D) + EPS);
#pragma unroll
        for (int j = 0; j < 4; ++j) { const int k = 4 * I.lane + 256 * j; *(f32x4*)(out + (size_t)r * D + k) = v[j] * rstd * *(const f32x4*)(nw + k); }
    }
}
__device__ __forceinline__ void p6_norm2_router(Frame& F, int l, int nrows) {
    const Ids I = fresh_ids();
    const int gw = F.vcu * NWAVES + I.wave, NGW = F.G * NWAVES;
    const float* H = (const float*)(F.ws + WS_H); bf16* HN = (bf16*)(F.ws + WS_HN); float* AFFT = (float*)(F.ws + WS_AFFT);
    const float* MOD = (const float*)(F.ws + WS_MOD); const float* nw = inp(F.lds, 7) + l * 1024; const float* rw = inp(F.lds, 23) + (size_t)l * 1024 * NE;
    LAS float* wt = (LAS float*)F.lds;
    for (int i = I.tid; i < 1024 * 4; i += 512) { const int k = i >> 2, q = i & 3; const f32x4 w = *(const f32x4*)(rw + k * 16 + 4 * q);
        wt[(4 * q + 0) * 1024 + k] = w.x; wt[(4 * q + 1) * 1024 + k] = w.y; wt[(4 * q + 2) * 1024 + k] = w.z; wt[(4 * q + 3) * 1024 + k] = w.w; }
    __syncthreads();
    for (int r = gw; r < nrows; r += NGW) {
        const int s = row_sample(r); f32x4 v[4];
        load_row_f32(H + (size_t)r * D, I.lane, v);
        const float rstd = 1.0f / sqrtf(row_sumsq(v) * (1.0f / D) + EPS);
        const float* m = MOD + ((size_t)l * 9 + s) * MODW;
#pragma unroll
        for (int j = 0; j < 4; ++j) { const int k = 4 * I.lane + 256 * j;
            const f32x4 w = *(const f32x4*)(nw + k), sh = *(const f32x4*)(m + 3072 + k), sc = *(const f32x4*)(m + 4096 + k);
            v[j] = (v[j] * rstd * w) * (sc + 1.0f) + sh;
            st_bf4(HN + (size_t)r * D + k, v[j]); }
        float lg[NE];
#pragma unroll
        for (int e = 0; e < NE; ++e) { float a = 0.f;
#pragma unroll
            for (int j = 0; j < 4; ++j) { const f32x4 w = *(const LAS f32x4*)(wt + e * 1024 + 4 * I.lane + 256 * j); a += (v[j].x * w.x + v[j].y * w.y) + (v[j].z * w.z + v[j].w * w.w); }
            lg[e] = wave_sum(a); }
        float mx = lg[0];
#pragma unroll
        for (int e = 1; e < NE; ++e) mx = fmaxf(mx, lg[e]);
        float den = 0.f;
#pragma unroll
        for (int e = 0; e < NE; ++e) { lg[e] = expf(lg[e] - mx); den += lg[e]; }
        const float inv = 1.0f / den; float mine = 0.f;
#pragma unroll
        for (int e = 0; e < NE; ++e) mine = (I.lane == e) ? lg[e] * inv : mine;
        if (I.lane < NE) AFFT[(size_t)I.lane * NROWS + r] = mine;
    }
    __syncthreads();
}
__device__ __forceinline__ void p4_combine(Frame& F, int l, int nrows) {
    const Ids I = fresh_ids();
    const int gw = F.vcu * NWAVES + I.wave, NGW = F.G * NWAVES;
    const bf16* O2 = (const bf16*)(F.ws + WS_O2); const bf16* U = (const bf16*)(F.ws + WS_U); bf16* Y = (bf16*)(F.ws + WS_Y);
    const int mixer = I.lane >> 4, c = (I.lane & 15) * 16;
    const float* nwp = (mixer == 0 ? inp(F.lds, 11) : mixer == 1 ? inp(F.lds, 14) : mixer == 2 ? inp(F.lds, 20) : inp(F.lds, 22)) + l * 256 + c;
    const int gcol = mixer == 0 ? C_RET + 768 + c : mixer == 1 ? C_GLA + 512 + c : mixer == 2 ? C_SSD + c : C_ML + 768 + c;
    float nw[16];
#pragma unroll
    for (int i = 0; i < 16; ++i) nw[i] = nwp[i];
    for (int r = gw; r < nrows; r += NGW) {
        float o[16], g[16];
        const bf16* p0 = O2 + (size_t)r * D + 16 * I.lane; const bf16* p1 = p0 + (size_t)NROWS * D; const bf16* pg = U + (size_t)r * INP + gcol;
#pragma unroll
        for (int q = 0; q < 4; ++q) { const f32x4 a = ld_bf4(p0 + 4 * q), b = ld_bf4(p1 + 4 * q), gg = ld_bf4(pg + 4 * q);
#pragma unroll
            for (int i = 0; i < 4; ++i) { o[4 * q + i] = a[i] + b[i]; g[4 * q + i] = gg[i]; } }
        if (mixer == 2) {
#pragma unroll
            for (int i = 0; i < 16; ++i) o[i] *= silu_f(g[i]);
        }
        float s1 = 0.f;
#pragma unroll
        for (int i = 0; i < 16; ++i) s1 += o[i];
        s1 += __shfl_xor(s1, 1); s1 += __shfl_xor(s1, 2);
        const float mean = mixer == 0 ? s1 * (1.0f / 64.0f) : 0.f;
        float s2 = 0.f;
#pragma unroll
        for (int i = 0; i < 16; ++i) { o[i] -= mean; s2 += o[i] * o[i]; }
        s2 += __shfl_xor(s2, 1); s2 += __shfl_xor(s2, 2);
        float s4 = s2 + __shfl_xor(s2, 4); s4 += __shfl_xor(s4, 8);
        const float rs = mixer == 2 ? 1.0f / sqrtf(s4 * (1.0f / 256.0f) + EPS) : 1.0f / sqrtf(s2 * (1.0f / 64.0f) + EPS);
        float y[16];
#pragma unroll
        for (int i = 0; i < 16; ++i) { const float gate = mixer == 2 ? 1.0f : (mixer == 3 ? sigmoid_f(g[i]) : silu_f(g[i])); y[i] = o[i] * rs * nw[i] * gate; }
        bf16* yp = Y + (size_t)r * D + 16 * I.lane;
        v4u w0, w1;
        w0.x = pg8::cvt_pk_bf16(y[0], y[1]); w0.y = pg8::cvt_pk_bf16(y[2], y[3]); w0.z = pg8::cvt_pk_bf16(y[4], y[5]); w0.w = pg8::cvt_pk_bf16(y[6], y[7]);
        w1.x = pg8::cvt_pk_bf16(y[8], y[9]); w1.y = pg8::cvt_pk_bf16(y[10], y[11]); w1.z = pg8::cvt_pk_bf16(y[12], y[13]); w1.w = pg8::cvt_pk_bf16(y[14], y[15]);
        *(v4u*)yp = w0; *(v4u*)(yp + 8) = w1;
    }
}

__device__ __forceinline__ int block_excl_scan(int v, LAS int* wsum, int lane, int wave, int& total) {
    int inc = v;
#pragma unroll
    for (int off = 1; off < 64; off <<= 1) { const int o = __shfl_up(inc, off); if (lane >= off) inc += o; }
    if (lane == 63) wsum[wave] = inc;
    __syncthreads();
    int base = 0, tot = 0;
#pragma unroll
    for (int w = 0; w < 8; ++w) { const int s = wsum[w]; base += (w < wave) ? s : 0; tot += s; }
    __syncthreads();
    total = tot; return base + inc - v;
}
__device__ __forceinline__ void p7_topk(Frame& F, int l) {
    const Ids I = fresh_ids();
    const float* AFFT = (const float*)(F.ws + WS_AFFT); int* SLOT = (int*)(F.ws + WS_SLOT);
    const bf16* HN = (const bf16*)(F.ws + WS_HN); bf16* XS = (bf16*)(F.ws + WS_Y);
    LAS unsigned* hist = (LAS unsigned*)F.lds;
    LAS unsigned* misc = hist + 256;
    LAS int* wsum = (LAS int*)(hist + 264);
    LAS int* selrow = (LAS int*)(hist + 272);
    const int nitems = (l == 0 ? 16 : 8) * NE;
    for (int item = F.vcu; item < nitems; item += F.G) {
        const int set = item >> 4, e = item & 15;
        const int n = set < 8 ? SEQ : CTXL, cap = n >> 3;
        const int row0 = set < 8 ? set * SEQ : NLAT + (set - 8) * CTXL, slotbase = set < 8 ? set * 256 : 2048 + (set - 8) * 32;
        unsigned key[4]; const int i0 = 4 * I.tid; const bool valid = i0 < n;
        { f32x4 a = (f32x4){0.f, 0.f, 0.f, 0.f}; if (valid) a = *(const f32x4*)(AFFT + (size_t)e * NROWS + row0 + i0);
          key[0] = __float_as_uint(a.x); key[1] = __float_as_uint(a.y); key[2] = __float_as_uint(a.z); key[3] = __float_as_uint(a.w); }
        unsigned prefix = 0u, kk = (unsigned)cap;
        for (int pass = 3; pass >= 0; --pass) {
            const int shift = 8 * pass;
            if (I.tid < 256) hist[I.tid] = 0u;
            __syncthreads();
            if (valid) {
#pragma unroll
                for (int j = 0; j < 4; ++j) { const bool match = pass == 3 || ((key[j] >> (shift + 8)) == (prefix >> (shift + 8)));
                    if (match) atomicAdd((unsigned*)&hist[(key[j] >> shift) & 255u], 1u); }
            }
            __syncthreads();
            if (I.wave == 0) {
                const unsigned h0 = hist[4 * I.lane], h1 = hist[4 * I.lane + 1], h2 = hist[4 * I.lane + 2], h3 = hist[4 * I.lane + 3];
                const unsigned s = h0 + h1 + h2 + h3; unsigned t = s;
#pragma unroll
                for (int off = 1; off < 64; off <<= 1) { const unsigned o = __shfl_down(t, off); if (I.lane + off < 64) t += o; }
                const unsigned above = t - s, c3 = above + h3, c2 = c3 + h2, c1 = c2 + h1, c0 = c1 + h0;
                int d = -1; unsigned nk = 0u;
                if (above < kk && c3 >= kk) { d = 3; nk = kk - above; }
                else if (c3 < kk && c2 >= kk) { d = 2; nk = kk - c3; }
                else if (c2 < kk && c1 >= kk) { d = 1; nk = kk - c2; }
                else if (c1 < kk && c0 >= kk) { d = 0; nk = kk - c1; }
                if (d >= 0) { misc[0] = prefix | ((unsigned)(4 * I.lane + d) << shift); misc[1] = nk; }
            }
            __syncthreads();
            prefix = misc[0]; kk = misc[1];
        }
        int ceq = 0; bool gt[4], eq[4];
#pragma unroll
        for (int j = 0; j < 4; ++j) { gt[j] = valid && key[j] > prefix; eq[j] = valid && key[j] == prefix; ceq += eq[j] ? 1 : 0; }
        int tot; int erank = block_excl_scan(ceq, wsum, I.lane, I.wave, tot);
        bool sel[4]; int csel = 0;
#pragma unroll
        for (int j = 0; j < 4; ++j) { sel[j] = gt[j] || (eq[j] && (unsigned)erank < kk); erank += eq[j] ? 1 : 0; csel += sel[j] ? 1 : 0; }
        int slot = block_excl_scan(csel, wsum, I.lane, I.wave, tot);
        if (valid) {
#pragma unroll
            for (int j = 0; j < 4; ++j) { const int r = row0 + i0 + j;
                if (sel[j]) { if (slot < cap) { selrow[slot] = r; SLOT[r * 16 + e] = e * SLOTS + slotbase + slot; } else SLOT[r * 16 + e] = -1; ++slot; }
                else SLOT[r * 16 + e] = -1; }
        }
        __syncthreads();
        for (int s = I.wave; s < cap; s += NWAVES) { const bf16* src = HN + (size_t)selrow[s] * D; bf16* dst = XS + (size_t)(e * SLOTS + slotbase + s) * D;
            const v4u a = *(const v4u*)(src + 8 * I.lane), b = *(const v4u*)(src + 512 + 8 * I.lane);
            *(v4u*)(dst + 8 * I.lane) = a; *(v4u*)(dst + 512 + 8 * I.lane) = b; }
        __syncthreads();
    }
}

constexpr int SC_Q = 0, SC_K = 2048, SC_V = 4096, SC_A = 6144, SC_X = 8192, SC_OP = 10240, SC_DP = 26624;
__device__ __forceinline__ void p3_scan(Frame& F, int l, bool ctx_out) {
    const Ids I = fresh_ids();
    const bf16* U = (const bf16*)(F.ws + WS_U); bf16* O2 = (bf16*)(F.ws + WS_O2);
    LAS float* sm = (LAS float*)F.lds;
    const int tk = I.tid >> 4, d0 = (I.tid & 15) * 4;
    for (int item = F.vcu; item < 256; item += F.G) {
        const int dir = item & 1, h = (item >> 1) & 3, mixer = (item >> 3) & 3, b = item >> 5;
        float S[8], nst[8];
#pragma unroll
        for (int i = 0; i < 8; ++i) { S[i] = 0.f; nst[i] = 0.f; }
        const float ret_gamma = sigmoid_f(inp(F.lds, 10)[(l * 2 + dir) * 4 + h]);
        const float ssd_dtb = inp(F.lds, 17)[(l * 2 + dir) * 4 + h], ssd_aneg = -expf(inp(F.lds, 18)[(l * 2 + dir) * 4 + h]), ssd_dskip = inp(F.lds, 19)[l * 4 + h];
        const float ml_bi = inp(F.lds, 21)[((l * 2 + dir) * 2 + 0) * 4 + h], ml_bf = inp(F.lds, 21)[((l * 2 + dir) * 2 + 1) * 4 + h];
        for (int batch = 0; batch < 72; ++batch) {
            const bool isctx = batch < 8; const int len = isctx ? CTXL : SEQ, pos0 = (isctx ? batch : batch - 8) * 32, rowbase = isctx ? NLAT + b * CTXL : b * SEQ;
            {
                const int pos = pos0 + tk, t = dir ? len - 1 - pos : pos; const bf16* ur = U + (size_t)(rowbase + t) * INP;
                f32x4 q4, k4, v4, a4, x4 = (f32x4){0.f, 0.f, 0.f, 0.f};
                if (mixer == 0) {
                    q4 = ld_bf4(ur + C_RET + h * 64 + d0) * 0.125f; k4 = ld_bf4(ur + C_RET + 256 + h * 64 + d0); v4 = ld_bf4(ur + C_RET + 512 + h * 64 + d0);
                    a4 = (f32x4){ret_gamma, ret_gamma, ret_gamma, ret_gamma};
                    if (!isctx) {
                        const int dd = d0 & 31; const bool first = dd < 16; const int fi = dd & 15, poff = first ? 16 : -16;
                        const float posv = (d0 < 32) ? (float)(t >> 6) : (float)(t & 63);
                        const f32x4 qp = ld_bf4(ur + C_RET + h * 64 + d0 + poff) * 0.125f, kp = ld_bf4(ur + C_RET + 256 + h * 64 + d0 + poff);
#pragma unroll
                        for (int j = 0; j < 4; ++j) { const float ang = posv * exp2f(-(float)(fi + j) * (13.287712379549449f / 16.0f)); const float cs = __cosf(ang), sn = __sinf(ang);
                            q4[j] = first ? q4[j] * cs - qp[j] * sn : qp[j] * sn + q4[j] * cs; k4[j] = first ? k4[j] * cs - kp[j] * sn : kp[j] * sn + k4[j] * cs; }
                    }
                } else if (mixer == 1) {
                    v4 = ld_bf4(ur + C_GLA + 256 + h * 64 + d0);
                    if (d0 < 32) {
                        q4 = ld_bf4(ur + C_GLA + h * 32 + d0) * 0.17677669529663687f; k4 = ld_bf4(ur + C_GLA + 128 + h * 32 + d0);
                        const float* gw_ = inp(F.lds, 12) + (size_t)(l * 2 + dir) * 16 * 128 + h * 32 + d0; const float* gb_ = inp(F.lds, 13) + (l * 2 + dir) * 128 + h * 32 + d0;
                        f32x4 z = *(const f32x4*)gb_;
#pragma unroll
                        for (int q = 0; q < 4; ++q) { const f32x4 lr = ld_bf4(ur + C_GLA + 768 + 4 * q);
#pragma unroll
                            for (int i = 0; i < 4; ++i) z += lr[i] * *(const f32x4*)(gw_ + (4 * q + i) * 128); }
#pragma unroll
                        for (int j = 0; j < 4; ++j) a4[j] = expf(log_sigmoid_f(z[j]) * (1.0f / 16.0f));
                    } else { q4 = (f32x4){0.f, 0.f, 0.f, 0.f}; k4 = q4; a4 = (f32x4){1.f, 1.f, 1.f, 1.f}; }
                } else if (mixer == 2) {
                    const int g = h >> 1; const float* cw = inp(F.lds, 15) + (size_t)l * 5 * 512; const float* cb = inp(F.lds, 16) + l * 512;
                    const int chx = h * 64 + d0, chb = 256 + g * 64 + d0, chc = 384 + g * 64 + d0;
                    f32x4 ax = *(const f32x4*)(cb + chx), ab = *(const f32x4*)(cb + chb), ac = *(const f32x4*)(cb + chc);
#pragma unroll
                    for (int w = 0; w < 5; ++w) { const int tt = t + w - 2;
                        if (tt >= 0 && tt < len) { const bf16* up = U + (size_t)(rowbase + tt) * INP + C_SSD + 256;
                            ax += ld_bf4(up + chx) * *(const f32x4*)(cw + w * 512 + chx); ab += ld_bf4(up + chb) * *(const f32x4*)(cw + w * 512 + chb); ac += ld_bf4(up + chc) * *(const f32x4*)(cw + w * 512 + chc); } }
                    const float dtr = bf_lo((unsigned)ur[C_SSD + 768 + dir * 4 + h]);
                    const float dt = softplus_f(dtr + ssd_dtb), aa = expf(dt * ssd_aneg);
#pragma unroll
                    for (int j = 0; j < 4; ++j) { x4[j] = silu_f(ax[j]); k4[j] = silu_f(ab[j]); q4[j] = silu_f(ac[j]); v4[j] = x4[j] * dt; a4[j] = aa; }
                } else {
                    q4 = ld_bf4(ur + C_ML + h * 64 + d0); k4 = ld_bf4(ur + C_ML + 256 + h * 64 + d0) * 0.125f; v4 = ld_bf4(ur + C_ML + 512 + h * 64 + d0);
                    const float ip = bf_lo((unsigned)ur[C_ML + 1024 + dir * 8 + h]) + ml_bi, fp = bf_lo((unsigned)ur[C_ML + 1024 + dir * 8 + 4 + h]) + ml_bf;
                    const float wgt = expf(ip), aa = sigmoid_f(fp);
                    k4 = k4 * wgt; a4 = (f32x4){aa, aa, aa, aa};
                }
                *(LAS f32x4*)(sm + SC_Q + tk * 64 + d0) = q4; *(LAS f32x4*)(sm + SC_K + tk * 64 + d0) = k4; *(LAS f32x4*)(sm + SC_V + tk * 64 + d0) = v4;
                *(LAS f32x4*)(sm + SC_A + tk * 64 + d0) = a4; *(LAS f32x4*)(sm + SC_X + tk * 64 + d0) = x4;
            }
            __syncthreads();
            {
                const int k0 = I.wave * 8;
                for (int t = 0; t < 32; ++t) {
                    const float vv = sm[SC_V + t * 64 + I.lane];
                    const f32x4 a0 = *(const LAS f32x4*)(sm + SC_A + t * 64 + k0), a1 = *(const LAS f32x4*)(sm + SC_A + t * 64 + k0 + 4);
                    const f32x4 kq0 = *(const LAS f32x4*)(sm + SC_K + t * 64 + k0), kq1 = *(const LAS f32x4*)(sm + SC_K + t * 64 + k0 + 4);
                    const f32x4 q0 = *(const LAS f32x4*)(sm + SC_Q + t * 64 + k0), q1 = *(const LAS f32x4*)(sm + SC_Q + t * 64 + k0 + 4);
                    float acc = 0.f, dacc = 0.f;
#pragma unroll
                    for (int i = 0; i < 4; ++i) { S[i] = a0[i] * S[i] + kq0[i] * vv; acc += q0[i] * S[i]; S[4 + i] = a1[i] * S[4 + i] + kq1[i] * vv; acc += q1[i] * S[4 + i]; }
                    sm[SC_OP + (t * 8 + I.wave) * 64 + I.lane] = acc;
                    if (mixer == 3) {
#pragma unroll
                        for (int i = 0; i < 4; ++i) { nst[i] = a0[i] * nst[i] + kq0[i]; dacc += q0[i] * nst[i]; nst[4 + i] = a1[i] * nst[4 + i] + kq1[i]; dacc += q1[i] * nst[4 + i]; }
                        if (I.lane == 0) sm[SC_DP + t * 8 + I.wave] = dacc;
                    }
                }
            }
            __syncthreads();
            if (!isctx || ctx_out) {
                const int pos = pos0 + tk, t = dir ? len - 1 - pos : pos;
                f32x4 o = (f32x4){0.f, 0.f, 0.f, 0.f};
#pragma unroll
                for (int w = 0; w < 8; ++w) o += *(const LAS f32x4*)(sm + SC_OP + (tk * 8 + w) * 64 + d0);
                if (mixer == 3) { float den = 0.f;
#pragma unroll
                    for (int w = 0; w < 8; ++w) den += sm[SC_DP + tk * 8 + w];
                    o = o * (1.0f / fmaxf(fabsf(den), 1.0f)); }
                if (mixer == 2 && dir == 0) o += *(const LAS f32x4*)(sm + SC_X + tk * 64 + d0) * ssd_dskip;
                st_bf4(O2 + ((size_t)dir * NROWS + rowbase + t) * D + mixer * 256 + h * 64 + d0, o);
            }
        }
        __syncthreads();
    }
}

struct Args { const float* in[28]; float* out; unsigned char* ws; int ph_lo, ph_hi, use_bar, never; };
__global__ void __launch_bounds__(NWAVES * 64, 2) fwd_kernel(Args args) {
    extern __shared__ __attribute__((aligned(16))) unsigned char lds[];
    Frame F;
    F.lds = (LAS unsigned char*)lds;
        F.G = gridDim.x; { const int bx = blockIdx.x; F.vcu = (F.G % 8 == 0) ? (bx % 8) * (F.G / 8) + bx / 8 : bx; }
    F.ws = args.ws;
    if (args.never) cooperative_groups::this_grid().sync();
    for (int u = threadIdx.x; u < (LDS_BYTES - LDSCTL_OFF) / 4; u += NWAVES * 64) ((LAS unsigned*)(F.lds + LDSCTL_OFF))[u] = 0u;
    __syncthreads();
    if (threadIdx.x == 0) { LAS unsigned long long* tab = (LAS unsigned long long*)(F.lds + LDSCTL_OFF);
#pragma unroll
        for (int i = 0; i < 28; ++i) tab[i] = (unsigned long long)args.in[i];
        tab[28] = (unsigned long long)args.out; }
    __syncthreads();
    XcdBarrier bar; bar.bar = (unsigned*)(F.ws + WS_CTL) + CW_BAR; bar.x = 0; bar.st = nullptr;
    if (args.use_bar) bar = xcd_barrier_post((unsigned*)(F.ws + WS_CTL) + CW_BAR, (volatile LAS unsigned*)(F.lds + MISC_OFF) + 8);
    const int lo = args.ph_lo, hi = args.ph_hi;
#define IN(k) (lo <= (k) && (k) < hi)
#define SEAM(k) do { if (IN(k) && IN((k) + 1)) xcd_barrier(bar); } while (0)
    #ifndef NO_P0
    if (IN(0)) { p0_prologue(F); }
#endif
    SEAM(0);
#pragma unroll
    for (int l = 0; l < 2; ++l) {
        const int pb = 1 + 9 * l;
        const bool ctx_out = l == 0;
        const int mrows = ctx_out ? NROWS : NLAT;
#ifndef NO_P1
        if (IN(pb + 0)) { p1_norm1(F, l); }
#endif
        SEAM(pb + 0);
        if (IN(pb + 1)) {
            pg8::Gemm g{(const bf16*)(F.ws + WS_HN), (const bf16*)(F.ws + WS_WTIN) + (size_t)l * INP * 1024, NROWS, INP, D}; pg8::StaticOrder S; S.init(NROWS, INP, F.G, (int)blockIdx.x);
            pg8::EpiStoreBf16 E{(bf16*)(F.ws + WS_U), INP, 0, 0};
            pg8::gemm_phase<pg8::EpiStoreBf16, pg8::StaticOrder, PG8_ALIGN, PG8_SP2>(F.lds, g, S, E);
        }
        SEAM(pb + 1);
#ifndef NO_SCAN
        if (IN(pb + 2)) { p3_scan(F, l, ctx_out); }
#endif
        SEAM(pb + 2);
#ifndef NO_P4
        if (IN(pb + 3)) { p4_combine(F, l, mrows); }
#endif
        SEAM(pb + 3);
        if (IN(pb + 4)) {
            pg8::Gemm g{(const bf16*)(F.ws + WS_Y), (const bf16*)(F.ws + WS_WTOUT) + (size_t)l * 1024 * 1024, mrows, D, D}; pg8::StaticOrder S; S.init(mrows, D, F.G, (int)blockIdx.x);
            pg8::EpiOutProj E{(float*)(F.ws + WS_H), (const float*)(F.ws + WS_MOD) + (size_t)l * 9 * MODW};
            pg8::gemm_phase<pg8::EpiOutProj, pg8::StaticOrder, PG8_ALIGN, PG8_SP2>(F.lds, g, S, E);
        }
        SEAM(pb + 4);
#ifndef NO_P6
        if (IN(pb + 5)) { p6_norm2_router(F, l, mrows); }
#endif
        SEAM(pb + 5);
#ifndef NO_P7
        if (IN(pb + 6)) { p7_topk(F, l); }
#endif
        SEAM(pb + 6);
        if (IN(pb + 7)) {
            pg8::Gemm g{(const bf16*)(F.ws + WS_Y), (const bf16*)(F.ws + WS_WTGU) + (size_t)l * NE * 3072 * 1024, NE * SLOTS, NE * 3072, D};
            pg8::GroupedOrder S{ctx_out ? 9 : 8, 12, (int)blockIdx.x};
            pg8::EpiSwiGLU E{(bf16*)(F.ws + WS_U)};
            pg8::gemm_phase<pg8::EpiSwiGLU, pg8::GroupedOrder, PG8_ALIGN, PG8_SP2>(F.lds, g, S, E);
        }
        SEAM(pb + 7);
        if (IN(pb + 8)) {
            pg8::Gemm g{(const bf16*)(F.ws + WS_U), (const bf16*)(F.ws + WS_WTDN) + (size_t)l * NE * 1024 * FF, NE * SLOTS, NE * 1024, FF};
            pg8::GroupedOrder S{ctx_out ? 9 : 8, 4, (int)blockIdx.x};
            pg8::EpiStoreBf16 E{(bf16*)(F.ws + WS_O2), D, 9, 4};
            pg8::gemm_phase<pg8::EpiStoreBf16, pg8::GroupedOrder, PG8_ALIGN, PG8_SP2>(F.lds, g, S, E);
        }
        SEAM(pb + 8);
    }
#ifndef NO_PF
    if (IN(19)) { p_final(F, (float*)inp(F.lds, 28)); }
#endif
#undef IN
#undef SEAM
}

#ifndef MK_ONE_LAUNCH
#define MK_ONE_LAUNCH 1
#endif
extern "C" void kernel_launch(void* const* d_in, const int* in_sizes, int n_in, void* d_out, int out_size, void* d_ws, size_t ws_size, hipStream_t stream) {
    static int grid = 0;
    if (grid == 0) {
        if (n_in != 28 || out_size != NLAT * D || ws_size < WS_END) { fprintf(stderr, "kernel_launch: unexpected problem (n_in %d, out %d, ws %zu < %zu)\n", n_in, out_size, ws_size, (size_t)WS_END); grid = -1; return; }
        int dev = 0, cus = 0, per_cu = 0;
        if (hipGetDevice(&dev) != hipSuccess || hipDeviceGetAttribute(&cus, hipDeviceAttributeMultiprocessorCount, dev) != hipSuccess) { grid = -1; return; }
        if (hipFuncSetAttribute((const void*)fwd_kernel, hipFuncAttributeMaxDynamicSharedMemorySize, LDS_BYTES) != hipSuccess) { fprintf(stderr, "kernel_launch: hipFuncSetAttribute failed\n"); grid = -1; return; }
        if (hipOccupancyMaxActiveBlocksPerMultiprocessor(&per_cu, (const void*)fwd_kernel, NWAVES * 64, LDS_BYTES) != hipSuccess || per_cu < 1) { fprintf(stderr, "kernel_launch: occupancy query says %d\n", per_cu); (void)hipGetLastError(); per_cu = 1; }
        grid = cus;
        if (grid != 256) { fprintf(stderr, "kernel_launch: built for 256 CUs, device has %d\n", cus); grid = -1; return; }
    }
    if (grid < 0) return;
    (void)hipMemsetAsync((char*)d_ws + WS_CTL, 0, CTL_ZERO_BYTES, stream);
    Args a{};
    for (int i = 0; i < 28; ++i) a.in[i] = (const float*)d_in[i];
    a.out = (float*)d_out; a.ws = (unsigned char*)d_ws; a.never = 0;
#if MK_ONE_LAUNCH
    a.ph_lo = 0; a.ph_hi = NPHASES; a.use_bar = 1;
    void* kargs[] = {&a};
    hipError_t e = hipLaunchCooperativeKernel((const void*)fwd_kernel, dim3(grid), dim3(NWAVES * 64), kargs, LDS_BYTES, stream);
    if (e != hipSuccess) fprintf(stderr, "kernel_launch: cooperative launch failed: %s\n", hipGetErrorString(e));
#else
    for (int ph = 0; ph < NPHASES; ++ph) { a.ph_lo = ph; a.ph_hi = ph + 1; a.use_bar = 0;
        hipLaunchKernelGGL(fwd_kernel, dim3(grid), dim3(NWAVES * 64), LDS_BYTES, stream, a); }
#endif
}
```

```cpp
#include <hip/hip_runtime.h>
#include <hip/hip_cooperative_groups.h>
#include <cstdio>
#include <cstdint>
#define GAS __attribute__((address_space(1)))
#define LAS __attribute__((address_space(3)))
namespace pg8 {
#define PG8_LAS __attribute__((address_space(3)))
typedef unsigned short bf16_t;
typedef short bf16x8 __attribute__((ext_vector_type(8)));
typedef float f32x4 __attribute__((ext_vector_type(4)));
typedef unsigned u32x4 __attribute__((ext_vector_type(4)));
constexpr int BM = 256, BK = 64, HALF = 128, HTB = HALF * BK * 2  , STAGE_BYTES = 8 * HTB, NXCD = 8, WGM = 8;

__host__ __device__ __forceinline__ int lds_byte(int r, int c) { const int st = (r >> 4) * 2 + (c >> 5), rr = r & 15, cc = c & 31, ob = rr * 64 + cc * 2; return st * 1024 + (ob ^ (((ob >> 9) & 1) << 5)); }
__host__ __device__ __forceinline__ void stage_rc(int b, int& R, int& C) { const int st = b / 1024, sb = b % 1024, swz = sb ^ (((sb >> 9) & 1) << 5); R = (st >> 1) * 16 + swz / 64; C = (st & 1) * 32 + (swz % 64) / 2; }
__host__ __device__ __forceinline__ int perm32(int rho) { const int n = rho >> 4, i = rho & 15; return 8 * (i >> 2) + 4 * n + (i & 3); }

struct Unit { int pm, pn; };
struct Gemm { const bf16_t* A; const bf16_t* Bt; int M, N, K; };

struct StaticOrder {
    int nM, nN, nwg, G, c;
    __host__ __device__ void init(int M, int N, int G_, int c_) { nM = M / BM; nN = N / BM; nwg = nM * nN; G = G_; c = c_; }
    __host__ __device__ bool next(int i, Unit& u) const {
        const long L = (long)i * G + c; if (L >= nwg) return false;
        int wgid = (int)L; { const int q = nwg / NXCD, r = nwg % NXCD, xcd = wgid % NXCD, off = wgid / NXCD; wgid = (xcd < r ? xcd * (q + 1) : r * (q + 1) + (xcd - r) * q) + off; }
        const int nig = WGM * nN, gid = wgid / nig, fm = gid * WGM, gsz = (nM - fm) < WGM ? (nM - fm) : WGM;
        u.pm = fm + ((wgid % nig) % gsz); u.pn = (wgid % nig) / gsz; return true;
    }
    __device__ __forceinline__ void a_ready(const Unit&) const {}
    __device__ __forceinline__ void done(const Unit&) const {}
};

__device__ __forceinline__ unsigned cvt_pk_bf16(float lo, float hi) { unsigned r; asm volatile("v_cvt_pk_bf16_f32 %0, %1, %2" : "=v"(r) : "v"(lo), "v"(hi)); return r; }
typedef float f32x2_t __attribute__((ext_vector_type(2))); typedef __bf16 bf16x2_t __attribute__((ext_vector_type(2)));
__device__ __forceinline__ unsigned cvt_pk_safe(float lo, float hi) { const f32x2_t v = {lo, hi}; const bf16x2_t b = __builtin_convertvector(v, bf16x2_t); return __builtin_bit_cast(unsigned, b); }

struct EpiStoreBf16 {
    static constexpr bool PERM = true, AFTER_DRAIN = false;
    bf16_t* O; int ldc; int pm_div, pn_per;
    __device__ __forceinline__ void operator()(const f32x4 (&acc)[2][2][4][2], const Unit& u, int wr, int wc, int fr, int fq) const {
        const int row0 = u.pm * BM + wr * 64 + fr; int pnl = u.pn; if (pm_div) pnl -= (u.pm / pm_div) * pn_per;
        const int col0 = pnl * BM + wc * 32 + 8 * fq;
#pragma unroll
        for (int ai = 0; ai < 2; ++ai)
#pragma unroll
            for (int m = 0; m < 4; ++m) { bf16_t* rowp = O + (size_t)(row0 + ai * HALF + m * 16) * ldc + col0;
#pragma unroll
                for (int bj = 0; bj < 2; ++bj) { const f32x4 v0 = acc[ai][bj][m][0], v1 = acc[ai][bj][m][1];
                    u32x4 w; w.x = cvt_pk_bf16(v0[0], v0[1]); w.y = cvt_pk_bf16(v0[2], v0[3]); w.z = cvt_pk_bf16(v1[0], v1[1]); w.w = cvt_pk_bf16(v1[2], v1[3]);
                    *(u32x4*)(rowp + bj * HALF) = w; } }
    }
};
struct EpiSwiGLU {
    static constexpr bool PERM = false, AFTER_DRAIN = false;
    bf16_t* O;
    __device__ __forceinline__ void operator()(const f32x4 (&acc)[2][2][4][2], const Unit& u, int wr, int wc, int fr, int fq) const {
        const int e = u.pm / 9, pnl = u.pn - e * 12;
        const int row0 = u.pm * BM + wr * 64 + fr, col0 = pnl * 128 + (4 * wc + fq) * 8;
#pragma unroll
        for (int ai = 0; ai < 2; ++ai)
#pragma unroll
            for (int m = 0; m < 4; ++m) {
                float h[8];
#pragma unroll
                for (int bj = 0; bj < 2; ++bj)
#pragma unroll
                    for (int j = 0; j < 4; ++j) { const float g = acc[ai][bj][m][0][j], up = acc[ai][bj][m][1][j]; h[bj * 4 + j] = g / (1.0f + __expf(-g)) * up; }
                u32x4 w; w.x = cvt_pk_bf16(h[0], h[1]); w.y = cvt_pk_bf16(h[2], h[3]); w.z = cvt_pk_bf16(h[4], h[5]); w.w = cvt_pk_bf16(h[6], h[7]);
                *(u32x4*)(O + (size_t)(row0 + ai * HALF + m * 16) * 1536 + col0) = w; }
    }
};
struct EpiOutProj {
    static constexpr bool PERM = false, AFTER_DRAIN = false;
    float* H; const float* mod;
    __device__ __forceinline__ void operator()(const f32x4 (&acc)[2][2][4][2], const Unit& u, int wr, int wc, int fr, int fq) const {
        const int s = u.pm < 64 ? (u.pm >> 3) : 8;
        const float* g1 = mod + s * 6144 + 2048;
        const int row0 = u.pm * BM + wr * 64 + fr, col0 = u.pn * BM + wc * 32 + 4 * fq;
#pragma unroll
        for (int bj = 0; bj < 2; ++bj)
#pragma unroll
            for (int n = 0; n < 2; ++n) { const f32x4 gv = *(const f32x4*)(g1 + col0 + bj * HALF + n * 16);
#pragma unroll
                for (int ai = 0; ai < 2; ++ai)
#pragma unroll
                    for (int m = 0; m < 4; ++m) { float* p = H + (size_t)(row0 + ai * HALF + m * 16) * 1024 + col0 + bj * HALF + n * 16;
                        const f32x4 old = *(const f32x4*)p; *(f32x4*)p = old + gv * acc[ai][bj][m][n]; } }
    }
};
struct GroupedOrder {
    int MT, NT, c;
    __device__ __forceinline__ bool next(int i, Unit& u) const {
        const int xcd = c & 7, j = i * 32 + (c >> 3), per = MT * NT;
        if (j >= 2 * per) return false;
        const int e = 2 * xcd + j / per, q = j % per;
        u.pm = e * 9 + q % MT; u.pn = e * NT + q / MT; return true;
    }
    __device__ __forceinline__ void a_ready(const Unit&) const {}
    __device__ __forceinline__ void done(const Unit&) const {}
};

template <class Epi, class Sched, bool ALIGN_EPI = false, bool SP2 = false>
__device__ __forceinline__ void gemm_phase(PG8_LAS unsigned char* lds, const Gemm g, const Sched& S, const Epi& E) {
    int tid_ = threadIdx.x; asm volatile("" : "+v"(tid_));
    const int tid = tid_, wid = __builtin_amdgcn_readfirstlane(tid >> 6), lane = tid & 63, wr = wid >> 2, wc = wid & 3, fr = lane & 15, fq = lane >> 4;
    const int K = g.K, nt = K / BK;
    unsigned voffA[2], voffB[2];
#pragma unroll
    for (int i = 0; i < 2; ++i) { int R, C; stage_rc(tid * 16 + i * 8192, R, C); const int Rb = Epi::PERM ? ((R & ~31) + perm32(R & 31)) : R;
        voffA[i] = (unsigned)(R * K + C) * 2u; voffB[i] = (unsigned)(Rb * K + C) * 2u; }
    const size_t kstep = (size_t)(BK * 2);
    const size_t hstep = (size_t)HALF * K * 2;
    const size_t tstep = 2 * hstep;
    const unsigned ldsw = (unsigned)wid * 1024u;
    const int aoff = lds_byte(wr * 64 + fr, fq * 8), boff = lds_byte(wc * 32 + fr, fq * 8);
#define PG8_SA(b, h) (((b) * 2 + (h)) * HTB)
#define PG8_SB(b, h) ((4 + (b) * 2 + (h)) * HTB)
#define PG8_STAGE(bufoff, gbase, voff) do { _Pragma("unroll") for (int _i = 0; _i < 2; ++_i) \
        __builtin_amdgcn_global_load_lds((const unsigned*)((const char*)(gbase) + (voff)[_i]), (PG8_LAS unsigned*)(lds + (bufoff) + ldsw + _i * 8192), 16, 0, 0); } while (0)
#define PG8_LDA(dst, b, h) do { _Pragma("unroll") for (int m = 0; m < 4; ++m) _Pragma("unroll") for (int k = 0; k < 2; ++k) dst[m][k] = *(const PG8_LAS bf16x8*)(lds + PG8_SA(b, h) + aoff + m * 2048 + k * 1024); } while (0)
#define PG8_LDB(dst, b, h) do { _Pragma("unroll") for (int n = 0; n < 2; ++n) _Pragma("unroll") for (int k = 0; k < 2; ++k) dst[n][k] = *(const PG8_LAS bf16x8*)(lds + PG8_SB(b, h) + boff + n * 2048 + k * 1024); } while (0)
#define PG8_MMA(ai, bj, At, Bt) do { __builtin_amdgcn_s_setprio(1); _Pragma("unroll") for (int m = 0; m < 4; ++m) _Pragma("unroll") for (int n = 0; n < 2; ++n) _Pragma("unroll") for (int k = 0; k < 2; ++k) \
        acc[ai][bj][m][n] = __builtin_amdgcn_mfma_f32_16x16x32_bf16(Bt[n][k], At[m][k], acc[ai][bj][m][n], 0, 0, 0); __builtin_amdgcn_s_setprio(0); } while (0)
#define PG8_WAIT_V(n) asm volatile("s_waitcnt vmcnt(" #n ")" ::: "memory")
#define PG8_WAIT_L(n) asm volatile("s_waitcnt lgkmcnt(" #n ")" ::: "memory")
#define PG8_BAR __builtin_amdgcn_s_barrier()
#define PG8_SCHED __builtin_amdgcn_sched_barrier(0)
    Unit cur, nxt; int ui = 0;
    if (!S.next(0, cur)) return;
    f32x4 acc[2][2][4][2];
#pragma unroll
    for (int a = 0; a < 2; ++a)
#pragma unroll
        for (int b = 0; b < 2; ++b)
#pragma unroll
            for (int m = 0; m < 4; ++m)
#pragma unroll
                for (int n = 0; n < 2; ++n) acc[a][b][m][n] = (f32x4){0.f, 0.f, 0.f, 0.f};
    bf16x8 At[4][2], B0[2][2], B1[2][2];
    const char* cA = (const char*)g.A + (size_t)cur.pm * tstep; const char* cB = (const char*)g.Bt + (size_t)cur.pn * tstep;
    S.a_ready(cur);
    if constexpr (SP2) {
        PG8_STAGE(PG8_SB(0, 0), cB, voffB); PG8_STAGE(PG8_SB(0, 1), cB + hstep, voffB); PG8_STAGE(PG8_SA(0, 0), cA, voffA); PG8_STAGE(PG8_SA(0, 1), cA + hstep, voffA);
        if (wr == 1) PG8_BAR;
        PG8_WAIT_V(2); PG8_BAR;
        PG8_STAGE(PG8_SB(1, 0), cB + kstep, voffB); PG8_STAGE(PG8_SA(1, 0), cA + kstep, voffA); PG8_STAGE(PG8_SB(1, 1), cB + hstep + kstep, voffB);
        PG8_WAIT_V(6); PG8_BAR;
    } else {
        PG8_STAGE(PG8_SB(0, 0), cB, voffB); PG8_STAGE(PG8_SA(0, 0), cA, voffA); PG8_STAGE(PG8_SB(0, 1), cB + hstep, voffB); PG8_STAGE(PG8_SA(0, 1), cA + hstep, voffA);
        if (wr == 1) PG8_BAR;
        PG8_WAIT_V(4); PG8_BAR;
        PG8_STAGE(PG8_SB(1, 0), cB + kstep, voffB); PG8_STAGE(PG8_SA(1, 0), cA + kstep, voffA); PG8_STAGE(PG8_SB(1, 1), cB + hstep + kstep, voffB);
        PG8_WAIT_V(6); PG8_BAR;
    }
    for (;;) {
        const bool has_next = S.next(ui + 1, nxt);
        const char* nA = has_next ? (const char*)g.A + (size_t)nxt.pm * tstep : cA; const char* nB = has_next ? (const char*)g.Bt + (size_t)nxt.pn * tstep : cB;
        for (int t = 0; t < nt; t += 2) {
            const bool last = (t == nt - 2);
            const char* a1 = cA + (size_t)(t + 1) * kstep;
            const char* a2 = last ? nA : cA + (size_t)(t + 2) * kstep; const char* b2 = last ? nB : cB + (size_t)(t + 2) * kstep;
            const char* a3 = a2 + kstep; const char* b3 = b2 + kstep;
            if (last && has_next) S.a_ready(nxt);
            if constexpr (SP2) {
            PG8_LDB(B0, 0, 0); PG8_LDB(B1, 0, 1); PG8_SCHED; PG8_LDA(At, 0, 0); PG8_STAGE(PG8_SA(1, 1), a1 + hstep, voffA);
            PG8_WAIT_V(8); PG8_WAIT_L(0); PG8_BAR; PG8_MMA(0, 0, At, B0); PG8_MMA(0, 1, At, B1); PG8_BAR; PG8_SCHED;
            PG8_LDA(At, 0, 1); PG8_STAGE(PG8_SB(0, 0), b2, voffB); PG8_STAGE(PG8_SB(0, 1), b2 + hstep, voffB); PG8_STAGE(PG8_SA(0, 0), a2, voffA);
            PG8_WAIT_V(8); PG8_WAIT_L(0); PG8_BAR; PG8_MMA(1, 0, At, B0); PG8_MMA(1, 1, At, B1); PG8_BAR; PG8_SCHED;
            PG8_LDB(B0, 1, 0); PG8_LDB(B1, 1, 1); PG8_SCHED; PG8_LDA(At, 1, 0); PG8_STAGE(PG8_SA(0, 1), a2 + hstep, voffA);
            PG8_WAIT_V(8); PG8_WAIT_L(0); PG8_BAR; PG8_MMA(0, 0, At, B0); PG8_MMA(0, 1, At, B1); PG8_BAR; PG8_SCHED;
            PG8_LDA(At, 1, 1); PG8_STAGE(PG8_SB(1, 0), b3, voffB); PG8_STAGE(PG8_SB(1, 1), b3 + hstep, voffB); PG8_STAGE(PG8_SA(1, 0), a3, voffA);
            PG8_WAIT_V(8); PG8_WAIT_L(0); PG8_BAR; PG8_MMA(1, 0, At, B0); PG8_MMA(1, 1, At, B1); PG8_BAR; PG8_SCHED;
            } else {
            PG8_LDB(B0, 0, 0); PG8_SCHED; PG8_LDA(At, 0, 0); PG8_STAGE(PG8_SA(1, 1), a1 + hstep, voffA);
            PG8_WAIT_L(8); PG8_BAR; PG8_WAIT_L(0); PG8_MMA(0, 0, At, B0); PG8_BAR; PG8_SCHED;
            PG8_LDB(B1, 0, 1); PG8_STAGE(PG8_SB(0, 0), b2, voffB);
            PG8_BAR; PG8_WAIT_L(0); PG8_MMA(0, 1, At, B1); PG8_BAR;
            PG8_LDA(At, 0, 1); PG8_STAGE(PG8_SA(0, 0), a2, voffA);
            PG8_BAR; PG8_WAIT_L(0); PG8_MMA(1, 0, At, B0); PG8_BAR; PG8_SCHED;
            PG8_STAGE(PG8_SB(0, 1), b2 + hstep, voffB);
            PG8_WAIT_V(6); PG8_BAR; PG8_MMA(1, 1, At, B1); PG8_BAR;
            PG8_LDB(B0, 1, 0); PG8_SCHED; PG8_LDA(At, 1, 0); PG8_STAGE(PG8_SA(0, 1), a2 + hstep, voffA);
            PG8_WAIT_L(8); PG8_BAR; PG8_WAIT_L(0); PG8_MMA(0, 0, At, B0); PG8_BAR; PG8_SCHED;
            PG8_LDB(B1, 1, 1); PG8_STAGE(PG8_SB(1, 0), b3, voffB);
            PG8_BAR; PG8_WAIT_L(0); PG8_MMA(0, 1, At, B1); PG8_BAR;
            PG8_LDA(At, 1, 1); PG8_STAGE(PG8_SA(1, 0), a3, voffA);
            PG8_BAR; PG8_WAIT_L(0); PG8_MMA(1, 0, At, B0); PG8_BAR; PG8_SCHED;
            PG8_STAGE(PG8_SB(1, 1), b3 + hstep, voffB);
            PG8_WAIT_V(6); PG8_BAR; PG8_MMA(1, 1, At, B1); PG8_BAR;
            }
        }
        if constexpr (ALIGN_EPI) { if (wr == 0) PG8_BAR; }
        if constexpr (!Epi::AFTER_DRAIN) { E(acc, cur, wr, wc, fr, fq); S.done(cur); }
        if (!has_next) break;
#pragma unroll
        for (int a = 0; a < 2; ++a)
#pragma unroll
            for (int b = 0; b < 2; ++b)
#pragma unroll
                for (int m = 0; m < 4; ++m)
#pragma unroll
                    for (int n = 0; n < 2; ++n) acc[a][b][m][n] = (f32x4){0.f, 0.f, 0.f, 0.f};
        cur = nxt; cA = nA; cB = nB; ++ui;
        if constexpr (ALIGN_EPI) { if (wr == 1) PG8_BAR; }
    }
    PG8_WAIT_V(0);
    if constexpr (!ALIGN_EPI) { if (wr == 0) PG8_BAR; }
    PG8_BAR;
    if constexpr (Epi::AFTER_DRAIN) { E.fused(acc, cur, wr, wc, fr, fq, lds, wid, lane); S.done(cur); }
#undef PG8_SA
#undef PG8_SB
#undef PG8_STAGE
#undef PG8_LDA
#undef PG8_LDB
#undef PG8_MMA
#undef PG8_WAIT_V
#undef PG8_WAIT_L
#undef PG8_BAR
#undef PG8_SCHED
}
}

#ifndef PG8_SP2
#define PG8_SP2 true
#endif
#ifndef PG8_ALIGN
#define PG8_ALIGN true
#endif

constexpr int D = 1024, NB = 8, SEQ = 2048, CTXL = 256, NLAT = NB * SEQ, NCTX = NB * CTXL, NROWS = NLAT + NCTX;
constexpr int INC = 3624, INP = 3840, NE = 16, FF = 1536, SLOTS = 2304, MODW = 6144;
constexpr float EPS = 1e-6f;
constexpr int C_RET = 0, C_GLA = 1024, C_SSD = 1808, C_ML = 2584;
constexpr size_t MiB = 1u << 20;
constexpr size_t WS_CTL = 0, CTL_ZERO_BYTES = 1 * MiB;
constexpr size_t WS_MOD = 1 * MiB, WS_WTIN = 2 * MiB, WS_WTOUT = 18 * MiB, WS_WTGU = 22 * MiB, WS_WTDN = 214 * MiB, WS_H = 310 * MiB, WS_HN = 382 * MiB,
                 WS_U = 418 * MiB  , WS_O2 = 553 * MiB  , WS_Y = 625 * MiB  , WS_AFFT = 697 * MiB, WS_SLOT = 699 * MiB, WS_END = 701 * MiB;
constexpr int CW_BAR = 4096;
constexpr int RING_BYTES = 131072, LDSCTL_OFF = RING_BYTES, MISC_OFF = LDSCTL_OFF + 320, LDS_BYTES = 147456;
constexpr int NWAVES = 8, NPHASES = 20;

typedef unsigned short bf16;
typedef unsigned v4u __attribute__((ext_vector_type(4)));
typedef unsigned v2u __attribute__((ext_vector_type(2)));
typedef float f32x4 __attribute__((ext_vector_type(4)));
typedef GAS unsigned gu32;
#define LDS_WAIT() asm volatile("s_waitcnt lgkmcnt(0)" ::: "memory")
#define VM_WAIT() asm volatile("s_waitcnt vmcnt(0)" ::: "memory")

#define XB_TMO      128
#define XB_XCNT(j)  (256  + 64 * (j))
#define XB_XSUB(j)  (1280 + 64 * (j))
#define XB_XGEN(j)  (2304 + 64 * (j))
#define XB_TOP      3328
#define XB_TOPGEN   3392
#define XCD_BAR_WORDS 3456
#define XB_SPIN_CAP (1u << 18)

__device__ __forceinline__ unsigned xb_ld(unsigned* p)              { return __hip_atomic_load(p, __ATOMIC_RELAXED, __HIP_MEMORY_SCOPE_AGENT); }
__device__ __forceinline__ unsigned xb_add(unsigned* p, unsigned v) { return __hip_atomic_fetch_add(p, v, __ATOMIC_RELAXED, __HIP_MEMORY_SCOPE_AGENT); }
__device__ __forceinline__ unsigned xb_xcc_id() { return (unsigned)__builtin_amdgcn_s_getreg((3 << 11) | 20) & 0xFu; }
#define XB_SPIN(cond, bar) do { unsigned _sp = 0; while (cond) { __builtin_amdgcn_s_sleep(1); \
    if ((++_sp & 255u) == 0u) { if (xb_ld(&(bar)[XB_TMO])) break; if (_sp > XB_SPIN_CAP) { atomicAdd(&(bar)[XB_TMO], 1u); break; } } } } while (0)

struct XcdBarrier {
    unsigned* bar; unsigned x;
    volatile LAS unsigned* st;
};

__device__ __forceinline__ XcdBarrier xcd_barrier_post(unsigned* bar, volatile LAS unsigned* st) {
    XcdBarrier b; b.bar = bar; b.x = xb_xcc_id(); b.st = st;
    if (threadIdx.x == 0) (void)xb_add(&bar[XB_XCNT(b.x)], 1u);
    return b;
}
__device__ __forceinline__ void xcd_barrier_complete(unsigned* bar, unsigned x, unsigned& nloc, unsigned& nx) {
    const unsigned G = gridDim.x * gridDim.y * gridDim.z;
    unsigned sum, cnt, mine, sp = 0u;
    for (;;) {
        sum = 0u; cnt = 0u; mine = 0u;
#pragma unroll
        for (unsigned j = 0; j < 16; ++j) { const unsigned c = xb_ld(&bar[XB_XCNT(j)]); sum += c; cnt += (c > 0u) ? 1u : 0u; mine = (j == x) ? c : mine; }
        if (sum == G) break;
        __builtin_amdgcn_s_sleep(1);
        if ((++sp & 255u) == 0u) { if (xb_ld(&bar[XB_TMO])) break; if (sp > XB_SPIN_CAP) { atomicAdd(&bar[XB_TMO], 1u); break; } }
    }
    nloc = mine > 0u ? mine : 1u; nx = cnt > 0u ? cnt : 1u;
}

__device__ __forceinline__ void xcd_barrier(const XcdBarrier& b) {
    asm volatile("s_waitcnt vmcnt(0)" ::: "memory");
    __syncthreads();
    if (threadIdx.x == 0) {
        unsigned* bar = b.bar;
        __builtin_amdgcn_s_waitcnt(0);
        unsigned nloc = b.st[0], nx = b.st[1];
        if (nloc == 0u) { xcd_barrier_complete(bar, b.x, nloc, nx); b.st[0] = nloc; b.st[1] = nx; }
        const unsigned old = xb_add(&bar[XB_XSUB(b.x)], 1u);
        const unsigned gen = old / nloc;
        if (old + 1u == (gen + 1u) * nloc) {
            __builtin_amdgcn_fence(__ATOMIC_RELEASE, "agent");
            asm volatile("s_waitcnt vmcnt(0)" ::: "memory");
            const unsigned og = xb_add(&bar[XB_TOP], 1u);
            const unsigned tg = og / nx;
            if (og + 1u == (tg + 1u) * nx) xb_add(&bar[XB_TOPGEN], 1u);
            else XB_SPIN(xb_ld(&bar[XB_TOPGEN]) == tg, bar);
            __builtin_amdgcn_fence(__ATOMIC_ACQUIRE, "agent");
            xb_add(&bar[XB_XGEN(b.x)], 1u);
            asm volatile("s_waitcnt vmcnt(0)" ::: "memory");
        } else {
            XB_SPIN(xb_ld(&bar[XB_XGEN(b.x)]) == gen, bar);
            __builtin_amdgcn_fence(__ATOMIC_ACQUIRE, "agent");
            asm volatile("s_waitcnt vmcnt(0)" ::: "memory");
        }
    }
    __syncthreads();
}


struct Frame {
    LAS unsigned char* lds;
    int vcu, G;
    unsigned char* ws;
};
struct Ids { int tid, lane, wave; };
__device__ __forceinline__ const float* inp(const LAS unsigned char* lds, int i) {
    const LAS unsigned* t = (const LAS unsigned*)(lds + 131072) + 2 * i;
    const unsigned lo = __builtin_amdgcn_readfirstlane(t[0]), hi = __builtin_amdgcn_readfirstlane(t[1]);
    return (const float*)(((unsigned long long)hi << 32) | lo); }
__device__ __forceinline__ Ids fresh_ids() { int t = threadIdx.x; asm volatile("" : "+v"(t)); Ids I; I.tid = t; I.lane = t & 63; I.wave = __builtin_amdgcn_readfirstlane(t >> 6); return I; }
__device__ __forceinline__ float wave_sum(float v) {
#pragma unroll
    for (int o = 1; o < 64; o <<= 1) v += __shfl_xor(v, o);
    return v;
}
__device__ __forceinline__ float bf_lo(unsigned w) { return __uint_as_float(w << 16); }
__device__ __forceinline__ float bf_hi(unsigned w) { return __uint_as_float(w & 0xffff0000u); }
__device__ __forceinline__ f32x4 ld_bf4(const bf16* p) { const v2u w = *(const v2u*)p; return (f32x4){bf_lo(w.x), bf_hi(w.x), bf_lo(w.y), bf_hi(w.y)}; }
__device__ __forceinline__ void st_bf4(bf16* p, f32x4 v) { v2u w; w.x = pg8::cvt_pk_bf16(v.x, v.y); w.y = pg8::cvt_pk_bf16(v.z, v.w); *(v2u*)p = w; }
__device__ __forceinline__ float silu_f(float x) { return x / (1.0f + expf(-x)); }
__device__ __forceinline__ float sigmoid_f(float x) { return 1.0f / (1.0f + expf(-x)); }
__device__ __forceinline__ float log_sigmoid_f(float z) { return fminf(z, 0.f) - log1pf(expf(-fabsf(z))); }
__device__ __forceinline__ float softplus_f(float x) { return fmaxf(x, 0.f) + log1pf(expf(-fabsf(x))); }
__device__ __forceinline__ int row_sample(int r) { return r < NLAT ? (r >> 11) : 8; }

template <class RowMap>
__device__ __forceinline__ void transpose_item(const float* W, int ldw, int nvalid, int k0, int n0, bf16* WT, int ldt, const RowMap& f, LAS float* scr, int lane) {
    f32x4 t[8];
#pragma unroll
    for (int i = 0; i < 8; ++i) { const int idx = i * 64 + lane, kk = idx >> 3, c = n0 + 4 * (idx & 7);
        t[i] = c < nvalid ? __builtin_nontemporal_load((const f32x4*)(W + (size_t)(k0 + kk) * ldw + c)) : (f32x4){0.f, 0.f, 0.f, 0.f}; }
#pragma unroll
    for (int i = 0; i < 8; ++i) { const int idx = i * 64 + lane, kk = idx >> 3, c4 = 4 * (idx & 7); LAS float* d = scr + kk * 33 + c4; d[0] = t[i].x; d[1] = t[i].y; d[2] = t[i].z; d[3] = t[i].w; }
    LDS_WAIT(); asm volatile("" ::: "memory");
    const int c8 = lane & 7;
#pragma unroll
    for (int j = 0; j < 4; ++j) { const int n = (lane >> 3) + 8 * j, col = n0 + n; const LAS float* s = scr + (8 * c8) * 33 + n;
        if (col < nvalid) { v4u o; o.x = pg8::cvt_pk_bf16(s[0 * 33], s[1 * 33]); o.y = pg8::cvt_pk_bf16(s[2 * 33], s[3 * 33]); o.z = pg8::cvt_pk_bf16(s[4 * 33], s[5 * 33]); o.w = pg8::cvt_pk_bf16(s[6 * 33], s[7 * 33]);
            *(v4u*)(WT + (size_t)f(col) * ldt + k0 + 8 * c8) = o; } }
    LDS_WAIT(); asm volatile("" ::: "memory");
}
struct MapId { int off; __device__ __forceinline__ int operator()(int c) const { return off + c; } };
struct MapGU { int off, n; __device__ __forceinline__ int operator()(int h) const { const int hl = h & 127, q = hl >> 3, wc = q >> 2, fq = q & 3, rem = hl & 7, bj = rem >> 2, j = rem & 3;
    return off + 256 * (h >> 7) + 128 * bj + 32 * wc + 16 * n + 4 * fq + j; } };

__device__ __forceinline__ void p0_prologue(Frame& F) {
    const Ids I = fresh_ids();
    const float* cvec = inp(F.lds, 1); const float* cctx = inp(F.lds, 3); const float* w_mod = inp(F.lds, 4); const float* b_mod = inp(F.lds, 5);
    float* MOD = (float*)(F.ws + WS_MOD);
    {
        LAS float* sil = (LAS float*)F.lds;
        LAS float* part = (LAS float*)(F.lds + 40960);
        for (int i = I.tid; i < 9 * 1024; i += 512) { const int s = i >> 10, k = i & 1023; const float c = s < 8 ? cvec[s * 1024 + k] : cctx[k]; sil[i] = silu_f(c); }
        __syncthreads();
        for (int item = F.vcu; item < 192; item += F.G) {
            const int l = item / 96, col = (item % 96) * 64 + I.lane;
            float acc[9];
#pragma unroll
            for (int s = 0; s < 9; ++s) acc[s] = 0.f;
            const float* wp = w_mod + (size_t)l * 1024 * MODW + (size_t)(I.wave * 128) * MODW + col;
            for (int k = 0; k < 128; ++k) { const float wv = wp[(size_t)k * MODW];
#pragma unroll
                for (int s = 0; s < 9; ++s) acc[s] += sil[s * 1024 + I.wave * 128 + k] * wv; }
#pragma unroll
            for (int s = 0; s < 9; ++s) part[(I.wave * 9 + s) * 64 + I.lane] = acc[s];
            __syncthreads();
            for (int i = I.tid; i < 9 * 64; i += 512) { const int s = i >> 6, ln = i & 63; float t = 0.f;
#pragma unroll
                for (int w = 0; w < 8; ++w) t += part[(w * 9 + s) * 64 + ln];
                const int cc = (item % 96) * 64 + ln; MOD[((size_t)l * 9 + s) * MODW + cc] = t + b_mod[l * MODW + cc]; }
            __syncthreads();
        }
        __syncthreads();
    }
    {
        bf16* wtin = (bf16*)(F.ws + WS_WTIN);
        const int nchunk = 2 * (INP - INC) * 128;
        for (int i = F.vcu * 512 + I.tid; i < nchunk; i += F.G * 512) { const int l = i / ((INP - INC) * 128), r = i % ((INP - INC) * 128);
            *(v4u*)(wtin + ((size_t)l * INP + INC) * 1024 + (size_t)r * 8) = (v4u){0u, 0u, 0u, 0u}; }
    }
    {
        LAS float* scr = (LAS float*)(F.lds + I.wave * 16384);
        const int gw = F.vcu * NWAVES + I.wave, NGW = F.G * NWAVES;
        constexpr int I_IN = 16 * 114, I_OUT = 16 * 32, I_E = 768, PER_L = I_IN + I_OUT + 16 * 3 * I_E;
        for (int it = gw; it < 2 * PER_L; it += NGW) {
            const int l = it / PER_L; int r = it % PER_L;
            if (r < I_IN) { const int kb = r / 114, nb = r % 114;
                transpose_item(inp(F.lds, 8) + (size_t)l * 1024 * INC, INC, INC, 64 * kb, 32 * nb, (bf16*)(F.ws + WS_WTIN) + (size_t)l * INP * 1024, 1024, MapId{0}, scr, I.lane); continue; }
            r -= I_IN;
            if (r < I_OUT) { const int kb = r / 32, nb = r % 32;
                transpose_item(inp(F.lds, 9) + (size_t)l * 1024 * 1024, 1024, 1024, 64 * kb, 32 * nb, (bf16*)(F.ws + WS_WTOUT) + (size_t)l * 1024 * 1024, 1024, MapId{0}, scr, I.lane); continue; }
            r -= I_OUT;
            const int e = r / (3 * I_E), q = r % (3 * I_E), kind = q / I_E, t = q % I_E;
            if (kind < 2) { const int kb = t / 48, nb = t % 48;
                transpose_item((kind ? inp(F.lds, 25) : inp(F.lds, 24)) + ((size_t)l * NE + e) * 1024 * FF, FF, FF, 64 * kb, 32 * nb, (bf16*)(F.ws + WS_WTGU) + (size_t)l * NE * 3072 * 1024, 1024, MapGU{e * 3072, kind}, scr, I.lane); }
            else { const int kb = t / 32, nb = t % 32;
                transpose_item(inp(F.lds, 26) + ((size_t)l * NE + e) * FF * 1024, 1024, 1024, 64 * kb, 32 * nb, (bf16*)(F.ws + WS_WTDN) + (size_t)l * NE * 1024 * FF, FF, MapId{e * 1024}, scr, I.lane); }
        }
    }
}

__device__ __forceinline__ void load_row_f32(const float* p, int lane, f32x4 (&v)[4]) {
#pragma unroll
    for (int j = 0; j < 4; ++j) v[j] = *(const f32x4*)(p + 4 * lane + 256 * j);
}
__device__ __forceinline__ float row_sumsq(const f32x4 (&v)[4]) { float s = 0.f;
#pragma unroll
    for (int j = 0; j < 4; ++j) s += (v[j].x * v[j].x + v[j].y * v[j].y) + (v[j].z * v[j].z + v[j].w * v[j].w);
    return wave_sum(s); }
__device__ __forceinline__ void add_expert_out(f32x4 (&v)[4], int r, int lane, const int* slotmap, const float* afft, const bf16* EO, const float* g2) {
    f32x4 acc[4];
#pragma unroll
    for (int j = 0; j < 4; ++j) acc[j] = (f32x4){0.f, 0.f, 0.f, 0.f};
    for (int e = 0; e < NE; ++e) {
        const int slot = __builtin_amdgcn_readfirstlane(slotmap[r * 16 + e]);
        if (slot >= 0) { const float a = afft[(size_t)e * NROWS + r]; const bf16* er = EO + (size_t)slot * 1024;
#pragma unroll
            for (int j = 0; j < 4; ++j) acc[j] += a * ld_bf4(er + 4 * lane + 256 * j); }
    }
#pragma unroll
    for (int j = 0; j < 4; ++j) v[j] += *(const f32x4*)(g2 + 4 * lane + 256 * j) * acc[j];
}
__device__ __forceinline__ void p1_norm1(Frame& F, int l) {
    const Ids I = fresh_ids();
    const int gw = F.vcu * NWAVES + I.wave, NGW = F.G * NWAVES;
    float* H = (float*)(F.ws + WS_H); bf16* HN = (bf16*)(F.ws + WS_HN);
    const float* MOD = (const float*)(F.ws + WS_MOD); const float* nw = inp(F.lds, 6) + l * 1024;
    for (int r = gw; r < NROWS; r += NGW) {
        const int s = row_sample(r); f32x4 v[4];
        if (l == 0) load_row_f32(r < NLAT ? inp(F.lds, 0) + (size_t)r * D : inp(F.lds, 2) + (size_t)(r - NLAT) * D, I.lane, v);
        else { load_row_f32(H + (size_t)r * D, I.lane, v);
            add_expert_out(v, r, I.lane, (const int*)(F.ws + WS_SLOT), (const float*)(F.ws + WS_AFFT), (const bf16*)(F.ws + WS_O2), MOD + ((size_t)(l - 1) * 9 + s) * MODW + 5120); }
        const float rstd = 1.0f / sqrtf(row_sumsq(v) * (1.0f / D) + EPS);
        const float* m = MOD + ((size_t)l * 9 + s) * MODW;
#pragma unroll
        for (int j = 0; j < 4; ++j) { const int k = 4 * I.lane + 256 * j;
            *(f32x4*)(H + (size_t)r * D + k) = v[j];
            const f32x4 w = *(const f32x4*)(nw + k), sh = *(const f32x4*)(m + k), sc = *(const f32x4*)(m + 1024 + k);
            st_bf4(HN + (size_t)r * D + k, (v[j] * rstd * w) * (sc + 1.0f) + sh); }
    }
}
__device__ __forceinline__ void p_final(Frame& F, float* out) {
    const Ids I = fresh_ids();
    const int gw = F.vcu * NWAVES + I.wave, NGW = F.G * NWAVES;
    const float* H = (const float*)(F.ws + WS_H); const float* MOD = (const float*)(F.ws + WS_MOD); const float* nw = inp(F.lds, 27);
    for (int r = gw; r < NLAT; r += NGW) {
        const int s = row_sample(r); f32x4 v[4];
        load_row_f32(H + (size_t)r * D, I.lane, v);
        add_expert_out(v, r, I.lane, (const int*)(F.ws + WS_SLOT), (const float*)(F.ws + WS_AFFT), (const bf16*)(F.ws + WS_O2), MOD + ((size_t)1 * 9 + s) * MODW + 5120);
        const float rstd = 1.0f / sqrtf(row_sumsq(v) * (1.0f / D) + EPS);
#pragma unroll
        for (int j = 0; j < 4; ++j) { const int k = 4 * I.lane + 256 * j; *(f32x4*)(out + (size_t)r * D + k) = v[j] * rstd * *(const f32x4*)(nw + k); }
    }
}
__device__ __forceinline__ void p6_norm2_router(Frame& F, int l, int nrows) {
    const Ids I = fresh_ids();
    const int gw = F.vcu * NWAVES + I.wave, NGW = F.G * NWAVES;
    const float* H = (const float*)(F.ws + WS_H); bf16* HN = (bf16*)(F.ws + WS_HN); float* AFFT = (float*)(F.ws + WS_AFFT);
    const float* MOD = (const float*)(F.ws + WS_MOD); const float* nw = inp(F.lds, 7) + l * 1024; const float* rw = inp(F.lds, 23) + (size_t)l * 1024 * NE;
    LAS float* wt = (LAS float*)F.lds;
    for (int i = I.tid; i < 1024 * 4; i += 512) { const int k = i >> 2, q = i & 3; const f32x4 w = *(const f32x4*)(rw + k * 16 + 4 * q);
        wt[(4 * q + 0) * 1024 + k] = w.x; wt[(4 * q + 1) * 1024 + k] = w.y; wt[(4 * q + 2) * 1024 + k] = w.z; wt[(4 * q + 3) * 1024 + k] = w.w; }
    __syncthreads();
    for (int r = gw; r < nrows; r += NGW) {
        const int s = row_sample(r); f32x4 v[4];
        load_row_f32(H + (size_t)r * D, I.lane, v);
        const float rstd = 1.0f / sqrtf(row_sumsq(v) * (1.0f / D) + EPS);
        const float* m = MOD + ((size_t)l * 9 + s) * MODW;
#pragma unroll
        for (int j = 0; j < 4; ++j) { const int k = 4 * I.lane + 256 * j;
            const f32x4 w = *(const f32x4*)(nw + k), sh = *(const f32x4*)(m + 3072 + k), sc = *(const f32x4*)(m + 4096 + k);
            v[j] = (v[j] * rstd * w) * (sc + 1.0f) + sh;
            st_bf4(HN + (size_t)r * D + k, v[j]); }
        float lg[NE];
#pragma unroll
        for (int e = 0; e < NE; ++e) { float a = 0.f;
#pragma unroll
            for (int j = 0; j < 4; ++j) { const f32x4 w = *(const LAS f32x4*)(wt + e * 1024 + 4 * I.lane + 256 * j); a += (v[j].x * w.x + v[j].y * w.y) + (v[j].z * w.z + v[j].w * w.w); }
            lg[e] = wave_sum(a); }
        float mx = lg[0];
#pragma unroll
        for (int e = 1; e < NE; ++e) mx = fmaxf(mx, lg[e]);
        float den = 0.f;
#pragma unroll
        for (int e = 0; e < NE; ++e) { lg[e] = expf(lg[e] - mx); den += lg[e]; }
        const float inv = 1.0f / den; float mine = 0.f;
#pragma unroll
        for (int e = 0; e < NE; ++e) mine = (I.lane == e) ? lg[e] * inv : mine;
        if (I.lane < NE) AFFT[(size_t)I.lane * NROWS + r] = mine;
    }
    __syncthreads();
}
__device__ __forceinline__ void p4_combine(Frame& F, int l, int nrows) {
    const Ids I = fresh_ids();
    const int gw = F.vcu * NWAVES + I.wave, NGW = F.G * NWAVES;
    const bf16* O2 = (const bf16*)(F.ws + WS_O2); const bf16* U = (const bf16*)(F.ws + WS_U); bf16* Y = (bf16*)(F.ws + WS_Y);
    const int mixer = I.lane >> 4, c = (I.lane & 15) * 16;
    const float* nwp = (mixer == 0 ? inp(F.lds, 11) : mixer == 1 ? inp(F.lds, 14) : mixer == 2 ? inp(F.lds, 20) : inp(F.lds, 22)) + l * 256 + c;
    const int gcol = mixer == 0 ? C_RET + 768 + c : mixer == 1 ? C_GLA + 512 + c : mixer == 2 ? C_SSD + c : C_ML + 768 + c;
    float nw[16];
#pragma unroll
    for (int i = 0; i < 16; ++i) nw[i] = nwp[i];
    for (int r = gw; r < nrows; r += NGW) {
        float o[16], g[16];
        const bf16* p0 = O2 + (size_t)r * D + 16 * I.lane; const bf16* p1 = p0 + (size_t)NROWS * D; const bf16* pg = U + (size_t)r * INP + gcol;
#pragma unroll
        for (int q = 0; q < 4; ++q) { const f32x4 a = ld_bf4(p0 + 4 * q), b = ld_bf4(p1 + 4 * q), gg = ld_bf4(pg + 4 * q);
#pragma unroll
            for (int i = 0; i < 4; ++i) { o[4 * q + i] = a[i] + b[i]; g[4 * q + i] = gg[i]; } }
        if (mixer == 2) {
#pragma unroll
            for (int i = 0; i < 16; ++i) o[i] *= silu_f(g[i]);
        }
        float s1 = 0.f;
#pragma unroll
        for (int i = 0; i < 16; ++i) s1 += o[i];
        s1 += __shfl_xor(s1, 1); s1 += __shfl_xor(s1, 2);
        const float mean = mixer == 0 ? s1 * (1.0f / 64.0f) : 0.f;
        float s2 = 0.f;
#pragma unroll
        for (int i = 0; i < 16; ++i) { o[i] -= mean; s2 += o[i] * o[i]; }
        s2 += __shfl_xor(s2, 1); s2 += __shfl_xor(s2, 2);
        float s4 = s2 + __shfl_xor(s2, 4); s4 += __shfl_xor(s4, 8);
        const float rs = mixer == 2 ? 1.0f / sqrtf(s4 * (1.0f / 256.0f) + EPS) : 1.0f / sqrtf(s2 * (1.0f / 64.0f) + EPS);
        float y[16];
#pragma unroll
        for (int i = 0; i < 16; ++i) { const float gate = mixer == 2 ? 1.0f : (mixer == 3 ? sigmoid_f(g[i]) : silu_f(g[i])); y[i] = o[i] * rs * nw[i] * gate; }
        bf16* yp = Y + (size_t)r * D + 16 * I.lane;
        v4u w0, w1;
        w0.x = pg8::cvt_pk_bf16(y[0], y[1]); w0.y = pg8::cvt_pk_bf16(y[2], y[3]); w0.z = pg8::cvt_pk_bf16(y[4], y[5]); w0.w = pg8::cvt_pk_bf16(y[6], y[7]);
        w1.x = pg8::cvt_pk_bf16(y[8], y[9]); w1.y = pg8::cvt_pk_bf16(y[10], y[11]); w1.z = pg8::cvt_pk_bf16(y[12], y[13]); w1.w = pg8::cvt_pk_bf16(y[14], y[15]);
        *(v4u*)yp = w0; *(v4u*)(yp + 8) = w1;
    }
}

__device__ __forceinline__ int block_excl_scan(int v, LAS int* wsum, int lane, int wave, int& total) {
    int inc = v;
#pragma unroll
    for (int off = 1; off < 64; off <<= 1) { const int o = __shfl_up(inc, off); if (lane >= off) inc += o; }
    if (lane == 63) wsum[wave] = inc;
    __syncthreads();
    int base = 0, tot = 0;
#pragma unroll
    for (int w = 0; w < 8; ++w) { const int s = wsum[w]; base += (w < wave) ? s : 0; tot += s; }
    __syncthreads();
    total = tot; return base + inc - v;
}
__device__ __forceinline__ void p7_topk(Frame& F, int l) {
    const Ids I = fresh_ids();
    const float* AFFT = (const float*)(F.ws + WS_AFFT); int* SLOT = (int*)(F.ws + WS_SLOT);
    const bf16* HN = (const bf16*)(F.ws + WS_HN); bf16* XS = (bf16*)(F.ws + WS_Y);
    LAS unsigned* hist = (LAS unsigned*)F.lds;
    LAS unsigned* misc = hist + 256;
    LAS int* wsum = (LAS int*)(hist + 264);
    LAS int* selrow = (LAS int*)(hist + 272);
    const int nitems = (l == 0 ? 16 : 8) * NE;
    for (int item = F.vcu; item < nitems; item += F.G) {
        const int set = item >> 4, e = item & 15;
        const int n = set < 8 ? SEQ : CTXL, cap = n >> 3;
        const int row0 = set < 8 ? set * SEQ : NLAT + (set - 8) * CTXL, slotbase = set < 8 ? set * 256 : 2048 + (set - 8) * 32;
        unsigned key[4]; const int i0 = 4 * I.tid; const bool valid = i0 < n;
        { f32x4 a = (f32x4){0.f, 0.f, 0.f, 0.f}; if (valid) a = *(const f32x4*)(AFFT + (size_t)e * NROWS + row0 + i0);
          key[0] = __float_as_uint(a.x); key[1] = __float_as_uint(a.y); key[2] = __float_as_uint(a.z); key[3] = __float_as_uint(a.w); }
        unsigned prefix = 0u, kk = (unsigned)cap;
        for (int pass = 3; pass >= 0; --pass) {
            const int shift = 8 * pass;
            if (I.tid < 256) hist[I.tid] = 0u;
            __syncthreads();
            if (valid) {
#pragma unroll
                for (int j = 0; j < 4; ++j) { const bool match = pass == 3 || ((key[j] >> (shift + 8)) == (prefix >> (shift + 8)));
                    if (match) atomicAdd((unsigned*)&hist[(key[j] >> shift) & 255u], 1u); }
            }
            __syncthreads();
            if (I.wave == 0) {
                const unsigned h0 = hist[4 * I.lane], h1 = hist[4 * I.lane + 1], h2 = hist[4 * I.lane + 2], h3 = hist[4 * I.lane + 3];
                const unsigned s = h0 + h1 + h2 + h3; unsigned t = s;
#pragma unroll
                for (int off = 1; off < 64; off <<= 1) { const unsigned o = __shfl_down(t, off); if (I.lane + off < 64) t += o; }
                const unsigned above = t - s, c3 = above + h3, c2 = c3 + h2, c1 = c2 + h1, c0 = c1 + h0;
                int d = -1; unsigned nk = 0u;
                if (above < kk && c3 >= kk) { d = 3; nk = kk - above; }
                else if (c3 < kk && c2 >= kk) { d = 2; nk = kk - c3; }
                else if (c2 < kk && c1 >= kk) { d = 1; nk = kk - c2; }
                else if (c1 < kk && c0 >= kk) { d = 0; nk = kk - c1; }
                if (d >= 0) { misc[0] = prefix | ((unsigned)(4 * I.lane + d) << shift); misc[1] = nk; }
            }
            __syncthreads();
            prefix = misc[0]; kk = misc[1];
        }
        int ceq = 0; bool gt[4], eq[4];
#pragma unroll
        for (int j = 0; j < 4; ++j) { gt[j] = valid && key[j] > prefix; eq[j] = valid && key[j] == prefix; ceq += eq[j] ? 1 : 0; }
        int tot; int erank = block_excl_scan(ceq, wsum, I.lane, I.wave, tot);
        bool sel[4]; int csel = 0;
#pragma unroll
        for (int j = 0; j < 4; ++j) { sel[j] = gt[j] || (eq[j] && (unsigned)erank < kk); erank += eq[j] ? 1 : 0; csel += sel[j] ? 1 : 0; }
        int slot = block_excl_scan(csel, wsum, I.lane, I.wave, tot);
        if (valid) {
#pragma unroll
            for (int j = 0; j < 4; ++j) { const int r = row0 + i0 + j;
                if (sel[j]) { if (slot < cap) { selrow[slot] = r; SLOT[r * 16 + e] = e * SLOTS + slotbase + slot; } else SLOT[r * 16 + e] = -1; ++slot; }
                else SLOT[r * 16 + e] = -1; }
        }
        __syncthreads();
        for (int s0 = I.wave * 4; s0 < cap; s0 += NWAVES * 4) {
            v4u a[4], b[4];
#pragma unroll
            for (int q = 0; q < 4; ++q) { const bf16* src = HN + (size_t)selrow[s0 + q] * D; a[q] = *(const v4u*)(src + 8 * I.lane); b[q] = *(const v4u*)(src + 512 + 8 * I.lane); }
#pragma unroll
            for (int q = 0; q < 4; ++q) { bf16* dst = XS + (size_t)(e * SLOTS + slotbase + s0 + q) * D; *(v4u*)(dst + 8 * I.lane) = a[q]; *(v4u*)(dst + 512 + 8 * I.lane) = b[q]; }
        }
        __syncthreads();
    }
}

constexpr int SC_Q = 0, SC_K = 2048, SC_V = 4096, SC_A = 6144, SC_X = 8192, SC_OP = 10240, SC_DP = 26624;
__device__ __forceinline__ void p3_scan(Frame& F, int l, bool ctx_out, int mixmask) {
    const Ids I = fresh_ids();
    const bf16* U = (const bf16*)(F.ws + WS_U); bf16* O2 = (bf16*)(F.ws + WS_O2);
    LAS float* sm = (LAS float*)F.lds;
    const int tk = I.tid >> 4, d0 = (I.tid & 15) * 4;
    for (int item = F.vcu; item < 256; item += F.G) {
        const int dir = item & 1, h = (item >> 1) & 3, mixer = (item >> 3) & 3, b = item >> 5;
        if (!((mixmask >> mixer) & 1)) continue;
        float S[8], nst[8];
#pragma unroll
        for (int i = 0; i < 8; ++i) { S[i] = 0.f; nst[i] = 0.f; }
        const float ret_gamma = sigmoid_f(inp(F.lds, 10)[(l * 2 + dir) * 4 + h]);
        const float ssd_dtb = inp(F.lds, 17)[(l * 2 + dir) * 4 + h], ssd_aneg = -expf(inp(F.lds, 18)[(l * 2 + dir) * 4 + h]), ssd_dskip = inp(F.lds, 19)[l * 4 + h];
        const float ml_bi = inp(F.lds, 21)[((l * 2 + dir) * 2 + 0) * 4 + h], ml_bf = inp(F.lds, 21)[((l * 2 + dir) * 2 + 1) * 4 + h];
        for (int batch = 0; batch < 72; ++batch) {
            const bool isctx = batch < 8; const int len = isctx ? CTXL : SEQ, pos0 = (isctx ? batch : batch - 8) * 32, rowbase = isctx ? NLAT + b * CTXL : b * SEQ;
            {
                const int pos = pos0 + tk, t = dir ? len - 1 - pos : pos; const bf16* ur = U + (size_t)(rowbase + t) * INP;
                f32x4 q4, k4, v4, a4, x4 = (f32x4){0.f, 0.f, 0.f, 0.f};
                if (mixer == 0) {
                    q4 = ld_bf4(ur + C_RET + h * 64 + d0) * 0.125f; k4 = ld_bf4(ur + C_RET + 256 + h * 64 + d0); v4 = ld_bf4(ur + C_RET + 512 + h * 64 + d0);
                    a4 = (f32x4){ret_gamma, ret_gamma, ret_gamma, ret_gamma};
                    if (!isctx) {
                        const int dd = d0 & 31; const bool first = dd < 16; const int fi = dd & 15, poff = first ? 16 : -16;
                        const float posv = (d0 < 32) ? (float)(t >> 6) : (float)(t & 63);
                        const f32x4 qp = ld_bf4(ur + C_RET + h * 64 + d0 + poff) * 0.125f, kp = ld_bf4(ur + C_RET + 256 + h * 64 + d0 + poff);
#pragma unroll
                        for (int j = 0; j < 4; ++j) { const float ang = posv * exp2f(-(float)(fi + j) * (13.287712379549449f / 16.0f)); const float cs = __cosf(ang), sn = __sinf(ang);
                            q4[j] = first ? q4[j] * cs - qp[j] * sn : qp[j] * sn + q4[j] * cs; k4[j] = first ? k4[j] * cs - kp[j] * sn : kp[j] * sn + k4[j] * cs; }
                    }
                } else if (mixer == 1) {
                    v4 = ld_bf4(ur + C_GLA + 256 + h * 64 + d0);
                    if (d0 < 32) {
                        q4 = ld_bf4(ur + C_GLA + h * 32 + d0) * 0.17677669529663687f; k4 = ld_bf4(ur + C_GLA + 128 + h * 32 + d0);
                        const float* gw_ = inp(F.lds, 12) + (size_t)(l * 2 + dir) * 16 * 128 + h * 32 + d0; const float* gb_ = inp(F.lds, 13) + (l * 2 + dir) * 128 + h * 32 + d0;
                        f32x4 z = *(const f32x4*)gb_;
#pragma unroll
                        for (int q = 0; q < 4; ++q) { const f32x4 lr = ld_bf4(ur + C_GLA + 768 + 4 * q);
#pragma unroll
                            for (int i = 0; i < 4; ++i) z += lr[i] * *(const f32x4*)(gw_ + (4 * q + i) * 128); }
#pragma unroll
                        for (int j = 0; j < 4; ++j) a4[j] = expf(log_sigmoid_f(z[j]) * (1.0f / 16.0f));
                    } else { q4 = (f32x4){0.f, 0.f, 0.f, 0.f}; k4 = q4; a4 = (f32x4){1.f, 1.f, 1.f, 1.f}; }
                } else if (mixer == 2) {
                    const int g = h >> 1; const float* cw = inp(F.lds, 15) + (size_t)l * 5 * 512; const float* cb = inp(F.lds, 16) + l * 512;
                    const int chx = h * 64 + d0, chb = 256 + g * 64 + d0, chc = 384 + g * 64 + d0;
                    f32x4 ax = *(const f32x4*)(cb + chx), ab = *(const f32x4*)(cb + chb), ac = *(const f32x4*)(cb + chc);
#pragma unroll
                    for (int w = 0; w < 5; ++w) { const int tt = t + w - 2;
                        if (tt >= 0 && tt < len) { const bf16* up = U + (size_t)(rowbase + tt) * INP + C_SSD + 256;
                            ax += ld_bf4(up + chx) * *(const f32x4*)(cw + w * 512 + chx); ab += ld_bf4(up + chb) * *(const f32x4*)(cw + w * 512 + chb); ac += ld_bf4(up + chc) * *(const f32x4*)(cw + w * 512 + chc); } }
                    const float dtr = bf_lo((unsigned)ur[C_SSD + 768 + dir * 4 + h]);
                    const float dt = softplus_f(dtr + ssd_dtb), aa = expf(dt * ssd_aneg);
#pragma unroll
                    for (int j = 0; j < 4; ++j) { x4[j] = silu_f(ax[j]); k4[j] = silu_f(ab[j]); q4[j] = silu_f(ac[j]); v4[j] = x4[j] * dt; a4[j] = aa; }
                } else {
                    q4 = ld_bf4(ur + C_ML + h * 64 + d0); k4 = ld_bf4(ur + C_ML + 256 + h * 64 + d0) * 0.125f; v4 = ld_bf4(ur + C_ML + 512 + h * 64 + d0);
                    const float ip = bf_lo((unsigned)ur[C_ML + 1024 + dir * 8 + h]) + ml_bi, fp = bf_lo((unsigned)ur[C_ML + 1024 + dir * 8 + 4 + h]) + ml_bf;
                    const float wgt = expf(ip), aa = sigmoid_f(fp);
                    k4 = k4 * wgt; a4 = (f32x4){aa, aa, aa, aa};
                }
                *(LAS f32x4*)(sm + SC_Q + tk * 64 + d0) = q4; *(LAS f32x4*)(sm + SC_K + tk * 64 + d0) = k4; *(LAS f32x4*)(sm + SC_V + tk * 64 + d0) = v4;
                *(LAS f32x4*)(sm + SC_A + tk * 64 + d0) = a4; *(LAS f32x4*)(sm + SC_X + tk * 64 + d0) = x4;
            }
            __syncthreads();
            {
                const int k0 = I.wave * 8;
                for (int t = 0; t < 32; ++t) {
                    const float vv = sm[SC_V + t * 64 + I.lane];
                    const f32x4 a0 = *(const LAS f32x4*)(sm + SC_A + t * 64 + k0), a1 = *(const LAS f32x4*)(sm + SC_A + t * 64 + k0 + 4);
                    const f32x4 kq0 = *(const LAS f32x4*)(sm + SC_K + t * 64 + k0), kq1 = *(const LAS f32x4*)(sm + SC_K + t * 64 + k0 + 4);
                    const f32x4 q0 = *(const LAS f32x4*)(sm + SC_Q + t * 64 + k0), q1 = *(const LAS f32x4*)(sm + SC_Q + t * 64 + k0 + 4);
                    float acc = 0.f, dacc = 0.f;
#pragma unroll
                    for (int i = 0; i < 4; ++i) { S[i] = a0[i] * S[i] + kq0[i] * vv; acc += q0[i] * S[i]; S[4 + i] = a1[i] * S[4 + i] + kq1[i] * vv; acc += q1[i] * S[4 + i]; }
                    sm[SC_OP + (t * 8 + I.wave) * 64 + I.lane] = acc;
                    if (mixer == 3) {
#pragma unroll
                        for (int i = 0; i < 4; ++i) { nst[i] = a0[i] * nst[i] + kq0[i]; dacc += q0[i] * nst[i]; nst[4 + i] = a1[i] * nst[4 + i] + kq1[i]; dacc += q1[i] * nst[4 + i]; }
                        if (I.lane == 0) sm[SC_DP + t * 8 + I.wave] = dacc;
                    }
                }
            }
            __syncthreads();
            if (!isctx || ctx_out) {
                const int pos = pos0 + tk, t = dir ? len - 1 - pos : pos;
                f32x4 o = (f32x4){0.f, 0.f, 0.f, 0.f};
#pragma unroll
                for (int w = 0; w < 8; ++w) o += *(const LAS f32x4*)(sm + SC_OP + (tk * 8 + w) * 64 + d0);
                if (mixer == 3) { float den = 0.f;
#pragma unroll
                    for (int w = 0; w < 8; ++w) den += sm[SC_DP + tk * 8 + w];
                    o = o * (1.0f / fmaxf(fabsf(den), 1.0f)); }
                if (mixer == 2 && dir == 0) o += *(const LAS f32x4*)(sm + SC_X + tk * 64 + d0) * ssd_dskip;
                st_bf4(O2 + ((size_t)dir * NROWS + rowbase + t) * D + mixer * 256 + h * 64 + d0, o);
            }
        }
        __syncthreads();
    }
}

typedef short bf16x8s __attribute__((ext_vector_type(8)));
typedef short s16x4 __attribute__((ext_vector_type(4)));
constexpr int IMGB = 9216;
constexpr int CS_SET = 4 * IMGB + 1024;
constexpr int CS_P = 2 * CS_SET, CS_ST = CS_P + IMGB, CS_NS = CS_ST + 2 * IMGB, CS_GS = CS_NS + 256, CS_GM = CS_GS + 2048, CS_END = CS_GM + 8192;
static_assert(CS_END <= RING_BYTES, "scan LDS map");
__device__ __forceinline__ bf16x8s rowfrag(const LAS unsigned char* img, int row0, int ks, int fr, int fq) { return *(const LAS bf16x8s*)(img + (row0 + fr) * 144 + ks * 64 + fq * 16); }
__device__ __forceinline__ s16x4 tr_rd(const LAS unsigned char* p) { return __builtin_bit_cast(s16x4, __builtin_amdgcn_ds_read_tr16_b64_v4i16((LAS s16x4*)(LAS unsigned char*)p)); }
__device__ __forceinline__ bf16x8s trfrag(const LAS unsigned char* img, int tok0, int col0, int lane) {
    const LAS unsigned char* a = img + (tok0 + 8 * (lane >> 4) + ((lane >> 2) & 3)) * 144 + (col0 + 4 * (lane & 3)) * 2;
    const s16x4 lo = tr_rd(a), hi = tr_rd(a + 4 * 144);
    return (bf16x8s){lo[0], lo[1], lo[2], lo[3], hi[0], hi[1], hi[2], hi[3]};
}
__device__ __forceinline__ f32x4 mfma16(bf16x8s a, bf16x8s b, f32x4 c) { return __builtin_amdgcn_mfma_f32_16x16x32_bf16(a, b, c, 0, 0, 0); }
struct f32x8 { f32x4 a, b; };
__device__ __forceinline__ f32x8 cvt8(v4u w) { f32x8 r; r.a = (f32x4){bf_lo(w.x), bf_hi(w.x), bf_lo(w.y), bf_hi(w.y)}; r.b = (f32x4){bf_lo(w.z), bf_hi(w.z), bf_lo(w.w), bf_hi(w.w)}; return r; }
__device__ __forceinline__ v4u pack8(f32x4 a, f32x4 b) { v4u w; w.x = pg8::cvt_pk_safe(a.x, a.y); w.y = pg8::cvt_pk_safe(a.z, a.w); w.z = pg8::cvt_pk_safe(b.x, b.y); w.w = pg8::cvt_pk_safe(b.z, b.w); return w; }
__device__ __forceinline__ float wave_incl_scan(float v, int lane) {
#pragma unroll
    for (int off = 1; off < 64; off <<= 1) { const float o = __shfl_up(v, off); if (lane >= off) v += o; }
    return v;
}
struct ScanRaw { v4u r[15]; float s0, s1; };

template <int MIX>
__device__ __forceinline__ void scan_item(const Frame& F, const Ids& I, int l, bool ctx_out, int b, int h, int dir) {
    const bf16* U = (const bf16*)(F.ws + WS_U); bf16* O2 = (bf16*)(F.ws + WS_O2);
    LAS unsigned char* sm = F.lds;
    const int lane = I.lane, wave = I.wave, fr = lane & 15, fq = lane >> 4, rt = wave >> 1, cp = wave & 1;
    const int tk = I.tid >> 3, d0 = (I.tid & 7) * 8;
    float c_la = 0.f, c_b0 = 0.f, c_b1 = 0.f, c_dskip = 0.f;
    if (MIX == 0) c_la = log_sigmoid_f(inp(F.lds, 10)[(l * 2 + dir) * 4 + h]);
    if (MIX == 2) { c_b0 = inp(F.lds, 17)[(l * 2 + dir) * 4 + h]; c_b1 = -expf(inp(F.lds, 18)[(l * 2 + dir) * 4 + h]); c_dskip = inp(F.lds, 19)[l * 4 + h]; }
    if (MIX == 3) { c_b0 = inp(F.lds, 21)[((l * 2 + dir) * 2 + 0) * 4 + h]; c_b1 = inp(F.lds, 21)[((l * 2 + dir) * 2 + 1) * 4 + h]; }
    float gwr[16]; float gbr = 0.f;
    if (MIX == 1) { const float* gw_ = inp(F.lds, 12) + (size_t)(l * 2 + dir) * 16 * 128 + h * 32 + (I.tid & 31);
#pragma unroll
        for (int r = 0; r < 16; ++r) gwr[r] = gw_[r * 128];
        gbr = inp(F.lds, 13)[(l * 2 + dir) * 128 + h * 32 + (I.tid & 31)]; }
    if (MIX == 2) {
        LAS float* cwl = (LAS float*)(sm + CS_GM); const float* cw = inp(F.lds, 15) + (size_t)l * 5 * 512; const float* cb = inp(F.lds, 16) + l * 512; const int g = h >> 1;
        for (int i = I.tid; i < 6 * 192; i += 512) { const int w = i / 192, c = i % 192; const int ch = c < 64 ? h * 64 + c : (c < 128 ? 256 + g * 64 + (c - 64) : 384 + g * 64 + (c - 128));
            cwl[i] = w < 5 ? cw[w * 512 + ch] : cb[ch]; }
    }
    for (int i = I.tid; i < IMGB / 4; i += 512) ((LAS unsigned*)(sm + CS_ST))[i] = 0u;
    if (I.tid < 32) ((LAS unsigned*)(sm + CS_NS))[I.tid] = 0u;
    f32x4 S[2], nst; S[0] = (f32x4){0.f, 0.f, 0.f, 0.f}; S[1] = S[0]; nst = S[0];
    __syncthreads();

    auto chunk_rows = [&](int cc, int& rowbase, int& len, int& pos0) { const bool isctx = cc < 4; len = isctx ? CTXL : SEQ; pos0 = 64 * (isctx ? cc : cc - 4); rowbase = isctx ? NLAT + b * CTXL : b * SEQ; };
    auto tok_of = [&](int len, int pos) { return dir ? len - 1 - pos : pos; };

    auto issue = [&](int cc, ScanRaw& R) {
        int rowbase, len, pos0; chunk_rows(cc, rowbase, len, pos0);
        const int t = tok_of(len, pos0 + tk); const bf16* ur = U + (size_t)(rowbase + t) * INP;
        const int tl = tok_of(len, pos0 + lane); const bf16* ul = U + (size_t)(rowbase + tl) * INP;
        if (MIX == 0) {
            const int poff = ((d0 & 31) < 16) ? 16 : -16;
            R.r[0] = *(const v4u*)(ur + C_RET + h * 64 + d0); R.r[1] = *(const v4u*)(ur + C_RET + 256 + h * 64 + d0); R.r[2] = *(const v4u*)(ur + C_RET + 512 + h * 64 + d0);
            R.r[3] = *(const v4u*)(ur + C_RET + h * 64 + d0 + poff); R.r[4] = *(const v4u*)(ur + C_RET + 256 + h * 64 + d0 + poff);
        } else if (MIX == 1) {
            R.r[2] = *(const v4u*)(ur + C_GLA + 256 + h * 64 + d0);
            if (d0 < 32) { R.r[0] = *(const v4u*)(ur + C_GLA + h * 32 + d0); R.r[1] = *(const v4u*)(ur + C_GLA + 128 + h * 32 + d0); } else { R.r[0] = (v4u){0u, 0u, 0u, 0u}; R.r[1] = R.r[0]; }
            const int tq = I.tid >> 5;
#pragma unroll
            for (int u = 0; u < 4; ++u) { const int tu = tok_of(len, pos0 + 4 * tq + u); const bf16* uu = U + (size_t)(rowbase + tu) * INP + C_GLA + 768; R.r[3 + 2 * u] = *(const v4u*)uu; R.r[4 + 2 * u] = *(const v4u*)(uu + 8); }
        } else if (MIX == 2) {
            const int g = h >> 1;
#pragma unroll
            for (int w = 0; w < 5; ++w) { const int tt = t + w - 2; const bool ok = tt >= 0 && tt < len; const bf16* up = U + (size_t)(rowbase + (ok ? tt : t)) * INP + C_SSD + 256;
                const v4u z = (v4u){0u, 0u, 0u, 0u};
                const v4u x0 = *(const v4u*)(up + h * 64 + d0), x1 = *(const v4u*)(up + 256 + g * 64 + d0), x2 = *(const v4u*)(up + 384 + g * 64 + d0);
                R.r[3 * w] = ok ? x0 : z; R.r[3 * w + 1] = ok ? x1 : z; R.r[3 * w + 2] = ok ? x2 : z; }
            R.s0 = bf_lo((unsigned)ul[C_SSD + 768 + dir * 4 + h]);
        } else {
            R.r[0] = *(const v4u*)(ur + C_ML + h * 64 + d0); R.r[1] = *(const v4u*)(ur + C_ML + 256 + h * 64 + d0); R.r[2] = *(const v4u*)(ur + C_ML + 512 + h * 64 + d0);
            R.s0 = bf_lo((unsigned)ul[C_ML + 1024 + dir * 8 + h]); R.s1 = bf_lo((unsigned)ul[C_ML + 1024 + dir * 8 + 4 + h]);
        }
    };
    auto finish = [&](int cc, const ScanRaw& R) {
        int rowbase, len, pos0; chunk_rows(cc, rowbase, len, pos0);
        LAS unsigned char* set = sm + (cc & 1) * CS_SET;
        LAS float* Gs = (LAS float*)(set + 4 * IMGB); LAS float* Ws = Gs + 64; LAS float* ELs = Gs + 128; LAS float* DTs = Gs + 192;
        f32x8 q, k, kp, v;
        if (MIX != 1) {
            float la, w = 1.f, dt = 1.f;
            if (MIX == 0) la = c_la;
            else if (MIX == 2) { dt = softplus_f(R.s0 + c_b0); la = dt * c_b1; }
            else { w = expf(R.s0 + c_b0); la = log_sigmoid_f(R.s1 + c_b1); }
            const float g = wave_incl_scan(la, lane), gl = __shfl(g, 63);
            if (wave == 0) { Gs[lane] = g; Ws[lane] = w; ELs[lane] = expf(gl); DTs[lane] = dt; }
            const float g_tk = __shfl(g, tk), w_tk = __shfl(w, tk), dt_tk = __shfl(dt, tk);
            const float ck = expf(gl - g_tk) * w_tk;
            if (MIX == 0) {
                q = cvt8(R.r[0]); k = cvt8(R.r[1]); v = cvt8(R.r[2]);
                q.a = q.a * 0.125f; q.b = q.b * 0.125f;
                if (cc >= 4) {
                    f32x8 qp = cvt8(R.r[3]), kpp = cvt8(R.r[4]); qp.a = qp.a * 0.125f; qp.b = qp.b * 0.125f;
                    const int t = tok_of(len, pos0 + tk); const int dd = d0 & 31; const bool first = dd < 16; const int fi = dd & 15;
                    const float posv = (d0 < 32) ? (float)(t >> 6) : (float)(t & 63);
                    float qa[8], ka[8], qb[8], kb[8];
#pragma unroll
                    for (int j = 0; j < 4; ++j) { qa[j] = q.a[j]; qa[4 + j] = q.b[j]; ka[j] = k.a[j]; ka[4 + j] = k.b[j]; qb[j] = qp.a[j]; qb[4 + j] = qp.b[j]; kb[j] = kpp.a[j]; kb[4 + j] = kpp.b[j]; }
#pragma unroll
                    for (int j = 0; j < 8; ++j) { const float ang = posv * exp2f(-(float)(fi + j) * (13.287712379549449f / 16.0f)); const float cs = __cosf(ang), sn = __sinf(ang);
                        const float qn = first ? qa[j] * cs - qb[j] * sn : qb[j] * sn + qa[j] * cs, kn = first ? ka[j] * cs - kb[j] * sn : kb[j] * sn + ka[j] * cs; qa[j] = qn; ka[j] = kn; }
#pragma unroll
                    for (int j = 0; j < 4; ++j) { q.a[j] = qa[j]; q.b[j] = qa[4 + j]; k.a[j] = ka[j]; k.b[j] = ka[4 + j]; }
                }
            } else if (MIX == 2) {
                const LAS float* cwl = (const LAS float*)(sm + CS_GM);
                f32x8 ax, ab, ac;
                ax.a = *(const LAS f32x4*)(cwl + 5 * 192 + d0); ax.b = *(const LAS f32x4*)(cwl + 5 * 192 + d0 + 4);
                ab.a = *(const LAS f32x4*)(cwl + 5 * 192 + 64 + d0); ab.b = *(const LAS f32x4*)(cwl + 5 * 192 + 64 + d0 + 4);
                ac.a = *(const LAS f32x4*)(cwl + 5 * 192 + 128 + d0); ac.b = *(const LAS f32x4*)(cwl + 5 * 192 + 128 + d0 + 4);
#pragma unroll
                for (int w5 = 0; w5 < 5; ++w5) { const f32x8 x0 = cvt8(R.r[3 * w5]), x1 = cvt8(R.r[3 * w5 + 1]), x2 = cvt8(R.r[3 * w5 + 2]); const LAS float* cwr = cwl + w5 * 192 + d0;
                    ax.a += x0.a * *(const LAS f32x4*)(cwr); ax.b += x0.b * *(const LAS f32x4*)(cwr + 4);
                    ab.a += x1.a * *(const LAS f32x4*)(cwr + 64); ab.b += x1.b * *(const LAS f32x4*)(cwr + 68);
                    ac.a += x2.a * *(const LAS f32x4*)(cwr + 128); ac.b += x2.b * *(const LAS f32x4*)(cwr + 132); }
#pragma unroll
                for (int j = 0; j < 4; ++j) { v.a[j] = silu_f(ax.a[j]) * dt_tk; v.b[j] = silu_f(ax.b[j]) * dt_tk; k.a[j] = silu_f(ab.a[j]); k.b[j] = silu_f(ab.b[j]); q.a[j] = silu_f(ac.a[j]); q.b[j] = silu_f(ac.b[j]); }
            } else {
                q = cvt8(R.r[0]); k = cvt8(R.r[1]); v = cvt8(R.r[2]); k.a = k.a * 0.125f; k.b = k.b * 0.125f;
            }
            kp.a = k.a * ck; kp.b = k.b * ck;
        } else {
            LAS float* GS = (LAS float*)(sm + CS_GS); LAS float* GM = (LAS float*)(sm + CS_GM);
            const int d = I.tid & 31, tq = I.tid >> 5; float c[4]; float run = 0.f;
#pragma unroll
            for (int u = 0; u < 4; ++u) { const f32x8 l0 = cvt8(R.r[3 + 2 * u]), l1 = cvt8(R.r[4 + 2 * u]); float z = gbr;
#pragma unroll
                for (int r = 0; r < 4; ++r) { z += l0.a[r] * gwr[r] + l0.b[r] * gwr[4 + r] + l1.a[r] * gwr[8 + r] + l1.b[r] * gwr[12 + r]; }
                run += log_sigmoid_f(z) * (1.0f / 16.0f); c[u] = run; }
            GS[tq * 32 + d] = run;
            __syncthreads();
            float off = 0.f, tot = 0.f;
#pragma unroll
            for (int qq = 0; qq < 16; ++qq) { const float s = GS[qq * 32 + d]; off += (qq < tq) ? s : 0.f; tot += s; }
#pragma unroll
            for (int u = 0; u < 4; ++u) GM[(4 * tq + u) * 32 + d] = off + c[u];
            if (tq == 0) { ELs[d] = expf(tot); ELs[32 + d] = 1.0f; }
            if (I.tid < 64) { Gs[I.tid] = 0.f; Ws[I.tid] = 1.0f; DTs[I.tid] = 1.0f; }
            __syncthreads();
            q = cvt8(R.r[0]); k = cvt8(R.r[1]); v = cvt8(R.r[2]);
            if (d0 < 32) {
                const f32x4 g0 = *(const LAS f32x4*)(GM + tk * 32 + d0), g1 = *(const LAS f32x4*)(GM + tk * 32 + d0 + 4), e0 = *(const LAS f32x4*)(GM + 63 * 32 + d0), e1 = *(const LAS f32x4*)(GM + 63 * 32 + d0 + 4);
#pragma unroll
                for (int j = 0; j < 4; ++j) { kp.a[j] = k.a[j] * expf(e0[j] - g0[j]); kp.b[j] = k.b[j] * expf(e1[j] - g1[j]);
                    q.a[j] = q.a[j] * 0.17677669529663687f * expf(g0[j]); q.b[j] = q.b[j] * 0.17677669529663687f * expf(g1[j]); k.a[j] = k.a[j] * expf(-g0[j]); k.b[j] = k.b[j] * expf(-g1[j]); }
            } else { kp = k; }
        }
        const int ro = tk * 144 + d0 * 2;
        *(LAS v4u*)(set + ro) = pack8(q.a, q.b); *(LAS v4u*)(set + IMGB + ro) = pack8(k.a, k.b); *(LAS v4u*)(set + 2 * IMGB + ro) = pack8(kp.a, kp.b); *(LAS v4u*)(set + 3 * IMGB + ro) = pack8(v.a, v.b);
    };

    ScanRaw R;
    issue(0, R); finish(0, R);
    const bf16x8s ones = (bf16x8s){0x3F80, 0x3F80, 0x3F80, 0x3F80, 0x3F80, 0x3F80, 0x3F80, 0x3F80};
    for (int cc = 0; cc < 36; ++cc) {
        __syncthreads();
        if (cc + 1 < 36) issue(cc + 1, R);
        const LAS unsigned char* set = sm + (cc & 1) * CS_SET;
        const LAS unsigned char* Qs = set; const LAS unsigned char* Ks = set + IMGB; const LAS unsigned char* KPs = set + 2 * IMGB; const LAS unsigned char* Vs = set + 3 * IMGB;
        const LAS float* Gs = (const LAS float*)(set + 4 * IMGB); const LAS float* Ws = Gs + 64; const LAS float* ELs = Gs + 128; const LAS float* DTs = Gs + 192;
        const LAS unsigned char* STr = sm + CS_ST + (cc & 1) * IMGB; LAS unsigned char* STw = sm + CS_ST + ((cc + 1) & 1) * IMGB;
        const LAS unsigned char* NSr = sm + CS_NS + (cc & 1) * 128; LAS unsigned char* NSw = sm + CS_NS + ((cc + 1) & 1) * 128;
        LAS unsigned char* Ps = sm + CS_P;
        const int irow = 16 * rt + fr; const float gi = Gs[irow];
        const bf16x8s qf0 = rowfrag(Qs, 16 * rt, 0, fr, fq), qf1 = rowfrag(Qs, 16 * rt, 1, fr, fq);
#pragma unroll
        for (int u = 0; u < 2; ++u) { const int jt = 2 * cp + u; v2u pw = (v2u){0u, 0u};
            if (jt <= rt) {
                f32x4 sc = (f32x4){0.f, 0.f, 0.f, 0.f};
                sc = mfma16(rowfrag(Ks, 16 * jt, 0, fr, fq), qf0, sc); sc = mfma16(rowfrag(Ks, 16 * jt, 1, fr, fq), qf1, sc);
                const f32x4 gj = *(const LAS f32x4*)(Gs + 16 * jt + 4 * fq), wj = *(const LAS f32x4*)(Ws + 16 * jt + 4 * fq);
                float pv[4];
#pragma unroll
                for (int r = 0; r < 4; ++r) { const int j = 16 * jt + 4 * fq + r; pv[r] = (j <= irow) ? sc[r] * __expf(fminf(gi - gj[r], 0.f)) * wj[r] : 0.f; }
                pw.x = pg8::cvt_pk_safe(pv[0], pv[1]); pw.y = pg8::cvt_pk_safe(pv[2], pv[3]);
            }
            *(LAS v2u*)(Ps + irow * 144 + (16 * jt + 4 * fq) * 2) = pw; }
        f32x4 o2[2], e2 = (f32x4){0.f, 0.f, 0.f, 0.f};
#pragma unroll
        for (int u = 0; u < 2; ++u) { const int ct = 2 * cp + u; o2[u] = (f32x4){0.f, 0.f, 0.f, 0.f};
            o2[u] = mfma16(rowfrag(STr, 16 * ct, 0, fr, fq), qf0, o2[u]); o2[u] = mfma16(rowfrag(STr, 16 * ct, 1, fr, fq), qf1, o2[u]); }
        if (MIX == 3) { const bf16x8s n0 = *(const LAS bf16x8s*)(NSr + fq * 16), n1 = *(const LAS bf16x8s*)(NSr + 64 + fq * 16); e2 = mfma16(n0, qf0, e2); e2 = mfma16(n1, qf1, e2); }
        const bf16x8s kf0 = trfrag(KPs, 0, 16 * rt, lane), kf1 = trfrag(KPs, 32, 16 * rt, lane);
        bf16x8s vf[2][2];
#pragma unroll
        for (int u = 0; u < 2; ++u) { vf[u][0] = trfrag(Vs, 0, 16 * (2 * cp + u), lane); vf[u][1] = trfrag(Vs, 32, 16 * (2 * cp + u), lane); }
        const f32x4 el = *(const LAS f32x4*)(ELs + 16 * rt + 4 * fq);
#pragma unroll
        for (int u = 0; u < 2; ++u) { const int ct = 2 * cp + u; S[u] = S[u] * el; S[u] = mfma16(kf0, vf[u][0], S[u]); S[u] = mfma16(kf1, vf[u][1], S[u]);
            v2u sw; sw.x = pg8::cvt_pk_safe(S[u][0], S[u][1]); sw.y = pg8::cvt_pk_safe(S[u][2], S[u][3]);
            *(LAS v2u*)(STw + (16 * ct + fr) * 144 + (16 * rt + 4 * fq) * 2) = sw; }
        if (MIX == 3) { nst = nst * el; nst = mfma16(kf0, ones, nst); nst = mfma16(kf1, ones, nst);
            if (fr == 0 && cp == 0) { v2u nw; nw.x = pg8::cvt_pk_safe(nst[0], nst[1]); nw.y = pg8::cvt_pk_safe(nst[2], nst[3]); *(LAS v2u*)(NSw + (16 * rt + 4 * fq) * 2) = nw; } }
        __syncthreads();
        const bf16x8s pf0 = rowfrag(Ps, 16 * rt, 0, fr, fq), pf1 = rowfrag(Ps, 16 * rt, 1, fr, fq);
        const float egi = __expf(gi);
        float sden = 1.0f;
        if (MIX == 3) { f32x4 e1 = (f32x4){0.f, 0.f, 0.f, 0.f}; e1 = mfma16(ones, pf0, e1); e1 = mfma16(ones, pf1, e1); sden = 1.0f / fmaxf(fabsf(e1[0] + egi * e2[0]), 1.0f); }
        int rowbase, len, pos0; chunk_rows(cc, rowbase, len, pos0);
        const bool wr_out = cc >= 4 || ctx_out;
        const int trow = rowbase + tok_of(len, pos0 + irow);
#pragma unroll
        for (int u = 0; u < 2; ++u) { const int ct = 2 * cp + u; f32x4 o1 = (f32x4){0.f, 0.f, 0.f, 0.f};
            o1 = mfma16(vf[u][0], pf0, o1); o1 = mfma16(vf[u][1], pf1, o1);
            f32x4 o = (o1 + o2[u] * egi) * sden;
            if (MIX == 2) { if (dir == 0) { const v2u xw = *(const LAS v2u*)(Vs + irow * 144 + (16 * ct + 4 * fq) * 2); const float sk = c_dskip / DTs[irow];
                o += (f32x4){bf_lo(xw.x), bf_hi(xw.x), bf_lo(xw.y), bf_hi(xw.y)} * sk; } }
            if (wr_out) st_bf4(O2 + ((size_t)dir * NROWS + trow) * D + MIX * 256 + h * 64 + 16 * ct + 4 * fq, o); }
        if (cc + 1 < 36) finish(cc + 1, R);
    }
    __syncthreads();
}
__device__ __forceinline__ void p3_scan_mfma(Frame& F, int l, bool ctx_out, int mixmask) {
    const Ids I = fresh_ids();
    for (int item = F.vcu; item < 256; item += F.G) {
        const int dir = item & 1, h = (item >> 1) & 3, mixer = (item >> 3) & 3, b = item >> 5;
        if (!((mixmask >> mixer) & 1)) continue;
        if (mixer == 0) scan_item<0>(F, I, l, ctx_out, b, h, dir);
        else if (mixer == 1) scan_item<1>(F, I, l, ctx_out, b, h, dir);
        else if (mixer == 2) scan_item<2>(F, I, l, ctx_out, b, h, dir);
        else scan_item<3>(F, I, l, ctx_out, b, h, dir);
    }
}

struct Args { const float* in[28]; float* out; unsigned char* ws; int ph_lo, ph_hi, use_bar, never; };
__global__ void __launch_bounds__(NWAVES * 64, 2) fwd_kernel(Args args) {
    extern __shared__ __attribute__((aligned(16))) unsigned char lds[];
    Frame F;
    F.lds = (LAS unsigned char*)lds;
        F.G = gridDim.x; { const int bx = blockIdx.x; F.vcu = (F.G % 8 == 0) ? (bx % 8) * (F.G / 8) + bx / 8 : bx; }
    F.ws = args.ws;
    if (args.never) cooperative_groups::this_grid().sync();
    for (int u = threadIdx.x; u < (LDS_BYTES - LDSCTL_OFF) / 4; u += NWAVES * 64) ((LAS unsigned*)(F.lds + LDSCTL_OFF))[u] = 0u;
    __syncthreads();
    if (threadIdx.x == 0) { LAS unsigned long long* tab = (LAS unsigned long long*)(F.lds + LDSCTL_OFF);
#pragma unroll
        for (int i = 0; i < 28; ++i) tab[i] = (unsigned long long)args.in[i];
        tab[28] = (unsigned long long)args.out; }
    __syncthreads();
    XcdBarrier bar; bar.bar = (unsigned*)(F.ws + WS_CTL) + CW_BAR; bar.x = 0; bar.st = nullptr;
    if (args.use_bar) bar = xcd_barrier_post((unsigned*)(F.ws + WS_CTL) + CW_BAR, (volatile LAS unsigned*)(F.lds + MISC_OFF) + 8);
    const int lo = args.ph_lo, hi = args.ph_hi;
#define IN(k) (lo <= (k) && (k) < hi)
#define SEAM(k) do { if (IN(k) && IN((k) + 1)) xcd_barrier(bar); } while (0)
#ifndef PROBE_DUP
#define PROBE_DUP -1
#endif
#define PH_BEGIN(kind) for (int rep_ = 0; rep_ < ((PROBE_DUP) == (kind) ? 2 : 1); ++rep_) { if (rep_) xcd_barrier(bar);
#define PH_END }
    #ifndef NO_P0
    PH_BEGIN(0) if (IN(0)) { p0_prologue(F); } PH_END
#endif
    SEAM(0);
#pragma unroll
    for (int l = 0; l < 2; ++l) {
        const int pb = 1 + 9 * l;
        const bool ctx_out = l == 0;
        const int mrows = ctx_out ? NROWS : NLAT;
#ifndef NO_P1
        if (IN(pb + 0)) { p1_norm1(F, l); }
#endif
        SEAM(pb + 0);
        PH_BEGIN(2) if (IN(pb + 1)) {
            pg8::Gemm g{(const bf16*)(F.ws + WS_HN), (const bf16*)(F.ws + WS_WTIN) + (size_t)l * INP * 1024, NROWS, INP, D}; pg8::StaticOrder S; S.init(NROWS, INP, F.G, (int)blockIdx.x);
            pg8::EpiStoreBf16 E{(bf16*)(F.ws + WS_U), INP, 0, 0};
            pg8::gemm_phase<pg8::EpiStoreBf16, pg8::StaticOrder, PG8_ALIGN, PG8_SP2>(F.lds, g, S, E);
        }
        PH_END
        SEAM(pb + 1);
#ifndef NO_SCAN
        PH_BEGIN(3) if (IN(pb + 2)) {
#ifndef SCAN_MFMA_MASK
#define SCAN_MFMA_MASK 15
#endif
            if (SCAN_MFMA_MASK != 15) p3_scan(F, l, ctx_out, 15 ^ SCAN_MFMA_MASK);
            if (SCAN_MFMA_MASK != 0) p3_scan_mfma(F, l, ctx_out, SCAN_MFMA_MASK);
        } PH_END
#endif
        SEAM(pb + 2);
#ifndef NO_P4
        PH_BEGIN(4) if (IN(pb + 3)) { p4_combine(F, l, mrows); } PH_END
#endif
        SEAM(pb + 3);
        if (IN(pb + 4)) {
            pg8::Gemm g{(const bf16*)(F.ws + WS_Y), (const bf16*)(F.ws + WS_WTOUT) + (size_t)l * 1024 * 1024, mrows, D, D}; pg8::StaticOrder S; S.init(mrows, D, F.G, (int)blockIdx.x);
            pg8::EpiOutProj E{(float*)(F.ws + WS_H), (const float*)(F.ws + WS_MOD) + (size_t)l * 9 * MODW};
            pg8::gemm_phase<pg8::EpiOutProj, pg8::StaticOrder, PG8_ALIGN, PG8_SP2>(F.lds, g, S, E);
        }
        SEAM(pb + 4);
#ifndef NO_P6
        PH_BEGIN(6) if (IN(pb + 5)) { p6_norm2_router(F, l, mrows); } PH_END
#endif
        SEAM(pb + 5);
#ifndef NO_P7
        PH_BEGIN(7) if (IN(pb + 6)) { p7_topk(F, l); } PH_END
#endif
        SEAM(pb + 6);
        PH_BEGIN(8) if (IN(pb + 7)) {
            pg8::Gemm g{(const bf16*)(F.ws + WS_Y), (const bf16*)(F.ws + WS_WTGU) + (size_t)l * NE * 3072 * 1024, NE * SLOTS, NE * 3072, D};
            pg8::GroupedOrder S{ctx_out ? 9 : 8, 12, (int)blockIdx.x};
            pg8::EpiSwiGLU E{(bf16*)(F.ws + WS_U)};
            pg8::gemm_phase<pg8::EpiSwiGLU, pg8::GroupedOrder, PG8_ALIGN, PG8_SP2>(F.lds, g, S, E);
        }
        PH_END
        SEAM(pb + 7);
        PH_BEGIN(9) if (IN(pb + 8)) {
            pg8::Gemm g{(const bf16*)(F.ws + WS_U), (const bf16*)(F.ws + WS_WTDN) + (size_t)l * NE * 1024 * FF, NE * SLOTS, NE * 1024, FF};
            pg8::GroupedOrder S{ctx_out ? 9 : 8, 4, (int)blockIdx.x};
            pg8::EpiStoreBf16 E{(bf16*)(F.ws + WS_O2), D, 9, 4};
            pg8::gemm_phase<pg8::EpiStoreBf16, pg8::GroupedOrder, PG8_ALIGN, PG8_SP2>(F.lds, g, S, E);
        }
        PH_END
        SEAM(pb + 8);
    }
#ifndef NO_PF
    if (IN(19)) { p_final(F, (float*)inp(F.lds, 28)); }
#endif
#undef IN
#undef SEAM
}

#ifndef MK_ONE_LAUNCH
#define MK_ONE_LAUNCH 1
#endif
extern "C" void kernel_launch(void* const* d_in, const int* in_sizes, int n_in, void* d_out, int out_size, void* d_ws, size_t ws_size, hipStream_t stream) {
    static int grid = 0;
    if (grid == 0) {
        if (n_in != 28 || out_size != NLAT * D || ws_size < WS_END) { fprintf(stderr, "kernel_launch: unexpected problem (n_in %d, out %d, ws %zu < %zu)\n", n_in, out_size, ws_size, (size_t)WS_END); grid = -1; return; }
        int dev = 0, cus = 0, per_cu = 0;
        if (hipGetDevice(&dev) != hipSuccess || hipDeviceGetAttribute(&cus, hipDeviceAttributeMultiprocessorCount, dev) != hipSuccess) { grid = -1; return; }
        if (hipFuncSetAttribute((const void*)fwd_kernel, hipFuncAttributeMaxDynamicSharedMemorySize, LDS_BYTES) != hipSuccess) { fprintf(stderr, "kernel_launch: hipFuncSetAttribute failed\n"); grid = -1; return; }
        if (hipOccupancyMaxActiveBlocksPerMultiprocessor(&per_cu, (const void*)fwd_kernel, NWAVES * 64, LDS_BYTES) != hipSuccess || per_cu < 1) { fprintf(stderr, "kernel_launch: occupancy query says %d\n", per_cu); (void)hipGetLastError(); per_cu = 1; }
        grid = cus;
        if (grid != 256) { fprintf(stderr, "kernel_launch: built for 256 CUs, device has %d\n", cus); grid = -1; return; }
    }
    if (grid < 0) return;
    (void)hipMemsetAsync((char*)d_ws + WS_CTL, 0, CTL_ZERO_BYTES, stream);
    Args a{};
    for (int i = 0; i < 28; ++i) a.in[i] = (const float*)d_in[i];
    a.out = (float*)d_out; a.ws = (unsigned char*)d_ws; a.never = 0;
#if MK_ONE_LAUNCH
    a.ph_lo = 0; a.ph_hi = NPHASES; a.use_bar = 1;
    void* kargs[] = {&a};
    hipError_t e = hipLaunchCooperativeKernel((const void*)fwd_kernel, dim3(grid), dim3(NWAVES * 64), kargs, LDS_BYTES, stream);
    if (e != hipSuccess) fprintf(stderr, "kernel_launch: cooperative launch failed: %s\n", hipGetErrorString(e));
#else
    for (int ph = 0; ph < NPHASES; ++ph) { a.ph_lo = ph; a.ph_hi = ph + 1; a.use_bar = 0;
        hipLaunchKernelGGL(fwd_kernel, dim3(grid), dim3(NWAVES * 64), LDS_BYTES, stream, a); }
#endif
}
```

```cpp
#include <hip/hip_runtime.h>
#include <hip/hip_cooperative_groups.h>
#include <cstdio>
#include <cstdint>
#define GAS __attribute__((address_space(1)))
#define LAS __attribute__((address_space(3)))
namespace pg8 {
#define PG8_LAS __attribute__((address_space(3)))
typedef unsigned short bf16_t;
typedef short bf16x8 __attribute__((ext_vector_type(8)));
typedef float f32x4 __attribute__((ext_vector_type(4)));
typedef unsigned u32x4 __attribute__((ext_vector_type(4)));
constexpr int BM = 256, BK = 64, HALF = 128, HTB = HALF * BK * 2  , STAGE_BYTES = 8 * HTB, NXCD = 8, WGM = 8;

__host__ __device__ __forceinline__ int lds_byte(int r, int c) { const int st = (r >> 4) * 2 + (c >> 5), rr = r & 15, cc = c & 31, ob = rr * 64 + cc * 2; return st * 1024 + (ob ^ (((ob >> 9) & 1) << 5)); }
__host__ __device__ __forceinline__ void stage_rc(int b, int& R, int& C) { const int st = b / 1024, sb = b % 1024, swz = sb ^ (((sb >> 9) & 1) << 5); R = (st >> 1) * 16 + swz / 64; C = (st & 1) * 32 + (swz % 64) / 2; }
__host__ __device__ __forceinline__ int perm32(int rho) { const int n = rho >> 4, i = rho & 15; return 8 * (i >> 2) + 4 * n + (i & 3); }

struct Unit { int pm, pn; };
struct Gemm { const bf16_t* A; const bf16_t* Bt; int M, N, K; };

struct StaticOrder {
    int nM, nN, nwg, G, c;
    __host__ __device__ void init(int M, int N, int G_, int c_) { nM = M / BM; nN = N / BM; nwg = nM * nN; G = G_; c = c_; }
    __host__ __device__ bool next(int i, Unit& u) const {
        const long L = (long)i * G + c; if (L >= nwg) return false;
        int wgid = (int)L; { const int q = nwg / NXCD, r = nwg % NXCD, xcd = wgid % NXCD, off = wgid / NXCD; wgid = (xcd < r ? xcd * (q + 1) : r * (q + 1) + (xcd - r) * q) + off; }
        const int nig = WGM * nN, gid = wgid / nig, fm = gid * WGM, gsz = (nM - fm) < WGM ? (nM - fm) : WGM;
        u.pm = fm + ((wgid % nig) % gsz); u.pn = (wgid % nig) / gsz; return true;
    }
    __device__ __forceinline__ void a_ready(const Unit&) const {}
    __device__ __forceinline__ void done(const Unit&) const {}
};

__device__ __forceinline__ unsigned cvt_pk_bf16(float lo, float hi) { unsigned r; asm volatile("v_cvt_pk_bf16_f32 %0, %1, %2" : "=v"(r) : "v"(lo), "v"(hi)); return r; }
typedef float f32x2_t __attribute__((ext_vector_type(2))); typedef __bf16 bf16x2_t __attribute__((ext_vector_type(2)));
__device__ __forceinline__ unsigned cvt_pk_safe(float lo, float hi) { const f32x2_t v = {lo, hi}; const bf16x2_t b = __builtin_convertvector(v, bf16x2_t); return __builtin_bit_cast(unsigned, b); }

struct EpiStoreBf16 {
    static constexpr bool PERM = true, AFTER_DRAIN = false;
    bf16_t* O; int ldc; int pm_div, pn_per;
    __device__ __forceinline__ void operator()(const f32x4 (&acc)[2][2][4][2], const Unit& u, int wr, int wc, int fr, int fq) const {
        const int row0 = u.pm * BM + wr * 64 + fr; int pnl = u.pn; if (pm_div) pnl -= (u.pm / pm_div) * pn_per;
        const int col0 = pnl * BM + wc * 32 + 8 * fq;
#pragma unroll
        for (int ai = 0; ai < 2; ++ai)
#pragma unroll
            for (int m = 0; m < 4; ++m) { bf16_t* rowp = O + (size_t)(row0 + ai * HALF + m * 16) * ldc + col0;
#pragma unroll
                for (int bj = 0; bj < 2; ++bj) { const f32x4 v0 = acc[ai][bj][m][0], v1 = acc[ai][bj][m][1];
                    u32x4 w; w.x = cvt_pk_bf16(v0[0], v0[1]); w.y = cvt_pk_bf16(v0[2], v0[3]); w.z = cvt_pk_bf16(v1[0], v1[1]); w.w = cvt_pk_bf16(v1[2], v1[3]);
                    *(u32x4*)(rowp + bj * HALF) = w; } }
    }
};
struct EpiSwiGLU {
    static constexpr bool PERM = false, AFTER_DRAIN = false;
    bf16_t* O;
    __device__ __forceinline__ void operator()(const f32x4 (&acc)[2][2][4][2], const Unit& u, int wr, int wc, int fr, int fq) const {
        const int e = u.pm / 9, pnl = u.pn - e * 12;
        const int row0 = u.pm * BM + wr * 64 + fr, col0 = pnl * 128 + (4 * wc + fq) * 8;
#pragma unroll
        for (int ai = 0; ai < 2; ++ai)
#pragma unroll
            for (int m = 0; m < 4; ++m) {
                float h[8];
#pragma unroll
                for (int bj = 0; bj < 2; ++bj)
#pragma unroll
                    for (int j = 0; j < 4; ++j) { const float g = acc[ai][bj][m][0][j], up = acc[ai][bj][m][1][j]; h[bj * 4 + j] = g / (1.0f + __expf(-g)) * up; }
                u32x4 w; w.x = cvt_pk_bf16(h[0], h[1]); w.y = cvt_pk_bf16(h[2], h[3]); w.z = cvt_pk_bf16(h[4], h[5]); w.w = cvt_pk_bf16(h[6], h[7]);
                *(u32x4*)(O + (size_t)(row0 + ai * HALF + m * 16) * 1536 + col0) = w; }
    }
};
struct EpiOutProj {
    static constexpr bool PERM = false, AFTER_DRAIN = false;
    float* H; const float* mod;
    __device__ __forceinline__ void operator()(const f32x4 (&acc)[2][2][4][2], const Unit& u, int wr, int wc, int fr, int fq) const {
        const int s = u.pm < 64 ? (u.pm >> 3) : 8;
        const float* g1 = mod + s * 6144 + 2048;
        const int row0 = u.pm * BM + wr * 64 + fr, col0 = u.pn * BM + wc * 32 + 4 * fq;
#pragma unroll
        for (int bj = 0; bj < 2; ++bj)
#pragma unroll
            for (int n = 0; n < 2; ++n) { const f32x4 gv = *(const f32x4*)(g1 + col0 + bj * HALF + n * 16);
#pragma unroll
                for (int ai = 0; ai < 2; ++ai)
#pragma unroll
                    for (int m = 0; m < 4; ++m) { float* p = H + (size_t)(row0 + ai * HALF + m * 16) * 1024 + col0 + bj * HALF + n * 16;
                        const f32x4 old = *(const f32x4*)p; *(f32x4*)p = old + gv * acc[ai][bj][m][n]; } }
    }
};
struct GroupedOrder {
    int MT, NT, c;
    __device__ __forceinline__ bool next(int i, Unit& u) const {
        const int xcd = c & 7, j = i * 32 + (c >> 3), per = MT * NT;
        if (j >= 2 * per) return false;
        const int e = 2 * xcd + j / per, q = j % per;
        u.pm = e * 9 + q % MT; u.pn = e * NT + q / MT; return true;
    }
    __device__ __forceinline__ void a_ready(const Unit&) const {}
    __device__ __forceinline__ void done(const Unit&) const {}
};

template <class Epi, class Sched, bool ALIGN_EPI = false, bool SP2 = false>
__device__ __forceinline__ void gemm_phase(PG8_LAS unsigned char* lds, const Gemm g, const Sched& S, const Epi& E, const int wave_s) {
    unsigned m_ = ~0u; asm volatile("" : "+s"(m_)); const int tid_ = wave_s * 64 + (int)__builtin_amdgcn_mbcnt_hi(m_, __builtin_amdgcn_mbcnt_lo(m_, 0u));
    const int tid = tid_, wid = __builtin_amdgcn_readfirstlane(tid >> 6), lane = tid & 63, wr = wid >> 2, wc = wid & 3, fr = lane & 15, fq = lane >> 4;
    const int K = g.K, nt = K / BK;
    unsigned voffA[2], voffB[2];
#pragma unroll
    for (int i = 0; i < 2; ++i) { int R, C; stage_rc(tid * 16 + i * 8192, R, C); const int Rb = Epi::PERM ? ((R & ~31) + perm32(R & 31)) : R;
        voffA[i] = (unsigned)(R * K + C) * 2u; voffB[i] = (unsigned)(Rb * K + C) * 2u; }
    const size_t kstep = (size_t)(BK * 2);
    const size_t hstep = (size_t)HALF * K * 2;
    const size_t tstep = 2 * hstep;
    const unsigned ldsw = (unsigned)wid * 1024u;
    const int aoff = lds_byte(wr * 64 + fr, fq * 8), boff = lds_byte(wc * 32 + fr, fq * 8);
#define PG8_SA(b, h) (((b) * 2 + (h)) * HTB)
#define PG8_SB(b, h) ((4 + (b) * 2 + (h)) * HTB)
#define PG8_STAGE(bufoff, gbase, voff) do { _Pragma("unroll") for (int _i = 0; _i < 2; ++_i) \
        __builtin_amdgcn_global_load_lds((const unsigned*)((const char*)(gbase) + (voff)[_i]), (PG8_LAS unsigned*)(lds + (bufoff) + ldsw + _i * 8192), 16, 0, 0); } while (0)
#define PG8_LDA(dst, b, h) do { _Pragma("unroll") for (int m = 0; m < 4; ++m) _Pragma("unroll") for (int k = 0; k < 2; ++k) dst[m][k] = *(const PG8_LAS bf16x8*)(lds + PG8_SA(b, h) + aoff + m * 2048 + k * 1024); } while (0)
#define PG8_LDB(dst, b, h) do { _Pragma("unroll") for (int n = 0; n < 2; ++n) _Pragma("unroll") for (int k = 0; k < 2; ++k) dst[n][k] = *(const PG8_LAS bf16x8*)(lds + PG8_SB(b, h) + boff + n * 2048 + k * 1024); } while (0)
#define PG8_MMA(ai, bj, At, Bt) do { __builtin_amdgcn_s_setprio(1); _Pragma("unroll") for (int m = 0; m < 4; ++m) _Pragma("unroll") for (int n = 0; n < 2; ++n) _Pragma("unroll") for (int k = 0; k < 2; ++k) \
        acc[ai][bj][m][n] = __builtin_amdgcn_mfma_f32_16x16x32_bf16(Bt[n][k], At[m][k], acc[ai][bj][m][n], 0, 0, 0); __builtin_amdgcn_s_setprio(0); } while (0)
#define PG8_WAIT_V(n) asm volatile("s_waitcnt vmcnt(" #n ")" ::: "memory")
#define PG8_WAIT_L(n) asm volatile("s_waitcnt lgkmcnt(" #n ")" ::: "memory")
#define PG8_BAR __builtin_amdgcn_s_barrier()
#define PG8_SCHED __builtin_amdgcn_sched_barrier(0)
    Unit cur, nxt; int ui = 0;
    if (!S.next(0, cur)) return;
    f32x4 acc[2][2][4][2];
#pragma unroll
    for (int a = 0; a < 2; ++a)
#pragma unroll
        for (int b = 0; b < 2; ++b)
#pragma unroll
            for (int m = 0; m < 4; ++m)
#pragma unroll
                for (int n = 0; n < 2; ++n) acc[a][b][m][n] = (f32x4){0.f, 0.f, 0.f, 0.f};
    bf16x8 At[4][2], B0[2][2], B1[2][2];
    const char* cA = (const char*)g.A + (size_t)cur.pm * tstep; const char* cB = (const char*)g.Bt + (size_t)cur.pn * tstep;
    S.a_ready(cur);
    if constexpr (SP2) {
        PG8_STAGE(PG8_SB(0, 0), cB, voffB); PG8_STAGE(PG8_SB(0, 1), cB + hstep, voffB); PG8_STAGE(PG8_SA(0, 0), cA, voffA); PG8_STAGE(PG8_SA(0, 1), cA + hstep, voffA);
        if (wr == 1) PG8_BAR;
        PG8_WAIT_V(2); PG8_BAR;
        PG8_STAGE(PG8_SB(1, 0), cB + kstep, voffB); PG8_STAGE(PG8_SA(1, 0), cA + kstep, voffA); PG8_STAGE(PG8_SB(1, 1), cB + hstep + kstep, voffB);
        PG8_WAIT_V(6); PG8_BAR;
    } else {
        PG8_STAGE(PG8_SB(0, 0), cB, voffB); PG8_STAGE(PG8_SA(0, 0), cA, voffA); PG8_STAGE(PG8_SB(0, 1), cB + hstep, voffB); PG8_STAGE(PG8_SA(0, 1), cA + hstep, voffA);
        if (wr == 1) PG8_BAR;
        PG8_WAIT_V(4); PG8_BAR;
        PG8_STAGE(PG8_SB(1, 0), cB + kstep, voffB); PG8_STAGE(PG8_SA(1, 0), cA + kstep, voffA); PG8_STAGE(PG8_SB(1, 1), cB + hstep + kstep, voffB);
        PG8_WAIT_V(6); PG8_BAR;
    }
    for (;;) {
        const bool has_next = S.next(ui + 1, nxt);
        const char* nA = has_next ? (const char*)g.A + (size_t)nxt.pm * tstep : cA; const char* nB = has_next ? (const char*)g.Bt + (size_t)nxt.pn * tstep : cB;
        for (int t = 0; t < nt; t += 2) {
            const bool last = (t == nt - 2);
            const char* a1 = cA + (size_t)(t + 1) * kstep;
            const char* a2 = last ? nA : cA + (size_t)(t + 2) * kstep; const char* b2 = last ? nB : cB + (size_t)(t + 2) * kstep;
            const char* a3 = a2 + kstep; const char* b3 = b2 + kstep;
            if (last && has_next) S.a_ready(nxt);
            if constexpr (SP2) {
            PG8_LDB(B0, 0, 0); PG8_LDB(B1, 0, 1); PG8_SCHED; PG8_LDA(At, 0, 0); PG8_STAGE(PG8_SA(1, 1), a1 + hstep, voffA);
            PG8_WAIT_V(8); PG8_WAIT_L(0); PG8_BAR; PG8_MMA(0, 0, At, B0); PG8_MMA(0, 1, At, B1); PG8_BAR; PG8_SCHED;
            PG8_LDA(At, 0, 1); PG8_STAGE(PG8_SB(0, 0), b2, voffB); PG8_STAGE(PG8_SB(0, 1), b2 + hstep, voffB); PG8_STAGE(PG8_SA(0, 0), a2, voffA);
            PG8_WAIT_V(8); PG8_WAIT_L(0); PG8_BAR; PG8_MMA(1, 0, At, B0); PG8_MMA(1, 1, At, B1); PG8_BAR; PG8_SCHED;
            PG8_LDB(B0, 1, 0); PG8_LDB(B1, 1, 1); PG8_SCHED; PG8_LDA(At, 1, 0); PG8_STAGE(PG8_SA(0, 1), a2 + hstep, voffA);
            PG8_WAIT_V(8); PG8_WAIT_L(0); PG8_BAR; PG8_MMA(0, 0, At, B0); PG8_MMA(0, 1, At, B1); PG8_BAR; PG8_SCHED;
            PG8_LDA(At, 1, 1); PG8_STAGE(PG8_SB(1, 0), b3, voffB); PG8_STAGE(PG8_SB(1, 1), b3 + hstep, voffB); PG8_STAGE(PG8_SA(1, 0), a3, voffA);
            PG8_WAIT_V(8); PG8_WAIT_L(0); PG8_BAR; PG8_MMA(1, 0, At, B0); PG8_MMA(1, 1, At, B1); PG8_BAR; PG8_SCHED;
            } else {
            PG8_LDB(B0, 0, 0); PG8_SCHED; PG8_LDA(At, 0, 0); PG8_STAGE(PG8_SA(1, 1), a1 + hstep, voffA);
            PG8_WAIT_L(8); PG8_BAR; PG8_WAIT_L(0); PG8_MMA(0, 0, At, B0); PG8_BAR; PG8_SCHED;
            PG8_LDB(B1, 0, 1); PG8_STAGE(PG8_SB(0, 0), b2, voffB);
            PG8_BAR; PG8_WAIT_L(0); PG8_MMA(0, 1, At, B1); PG8_BAR;
            PG8_LDA(At, 0, 1); PG8_STAGE(PG8_SA(0, 0), a2, voffA);
            PG8_BAR; PG8_WAIT_L(0); PG8_MMA(1, 0, At, B0); PG8_BAR; PG8_SCHED;
            PG8_STAGE(PG8_SB(0, 1), b2 + hstep, voffB);
            PG8_WAIT_V(6); PG8_BAR; PG8_MMA(1, 1, At, B1); PG8_BAR;
            PG8_LDB(B0, 1, 0); PG8_SCHED; PG8_LDA(At, 1, 0); PG8_STAGE(PG8_SA(0, 1), a2 + hstep, voffA);
            PG8_WAIT_L(8); PG8_BAR; PG8_WAIT_L(0); PG8_MMA(0, 0, At, B0); PG8_BAR; PG8_SCHED;
            PG8_LDB(B1, 1, 1); PG8_STAGE(PG8_SB(1, 0), b3, voffB);
            PG8_BAR; PG8_WAIT_L(0); PG8_MMA(0, 1, At, B1); PG8_BAR;
            PG8_LDA(At, 1, 1); PG8_STAGE(PG8_SA(1, 0), a3, voffA);
            PG8_BAR; PG8_WAIT_L(0); PG8_MMA(1, 0, At, B0); PG8_BAR; PG8_SCHED;
            PG8_STAGE(PG8_SB(1, 1), b3 + hstep, voffB);
            PG8_WAIT_V(6); PG8_BAR; PG8_MMA(1, 1, At, B1); PG8_BAR;
            }
        }
        if constexpr (ALIGN_EPI) { if (wr == 0) PG8_BAR; }
        if constexpr (!Epi::AFTER_DRAIN) { E(acc, cur, wr, wc, fr, fq); S.done(cur); }
        if (!has_next) break;
#pragma unroll
        for (int a = 0; a < 2; ++a)
#pragma unroll
            for (int b = 0; b < 2; ++b)
#pragma unroll
                for (int m = 0; m < 4; ++m)
#pragma unroll
                    for (int n = 0; n < 2; ++n) acc[a][b][m][n] = (f32x4){0.f, 0.f, 0.f, 0.f};
        cur = nxt; cA = nA; cB = nB; ++ui;
        if constexpr (ALIGN_EPI) { if (wr == 1) PG8_BAR; }
    }
    PG8_WAIT_V(0);
    if constexpr (!ALIGN_EPI) { if (wr == 0) PG8_BAR; }
    PG8_BAR;
    if constexpr (Epi::AFTER_DRAIN) { E.fused(acc, cur, wr, wc, fr, fq, lds, wid, lane); S.done(cur); }
#undef PG8_SA
#undef PG8_SB
#undef PG8_STAGE
#undef PG8_LDA
#undef PG8_LDB
#undef PG8_MMA
#undef PG8_WAIT_V
#undef PG8_WAIT_L
#undef PG8_BAR
#undef PG8_SCHED
}
}

#ifndef PG8_SP2
#define PG8_SP2 true
#endif
#ifndef PG8_ALIGN
#define PG8_ALIGN true
#endif

constexpr int D = 1024, NB = 8, SEQ = 2048, CTXL = 256, NLAT = NB * SEQ, NCTX = NB * CTXL, NROWS = NLAT + NCTX;
constexpr int INC = 3624, INP = 3840, NE = 16, FF = 1536, SLOTS = 2304, MODW = 6144;
constexpr float EPS = 1e-6f;
constexpr int C_RET = 0, C_GLA = 1024, C_SSD = 1808, C_ML = 2584;
constexpr size_t MiB = 1u << 20;
constexpr size_t WS_CTL = 0, CTL_ZERO_BYTES = 1 * MiB;
constexpr size_t WS_MOD = 1 * MiB, WS_WTIN = 2 * MiB, WS_WTOUT = 18 * MiB, WS_WTGU = 22 * MiB, WS_WTDN = 214 * MiB, WS_H = 310 * MiB, WS_HN = 382 * MiB,
                 WS_U = 418 * MiB  , WS_O2 = 553 * MiB  , WS_Y = 625 * MiB  , WS_AFFT = 697 * MiB, WS_SLOT = 699 * MiB, WS_END = 701 * MiB;
constexpr int CW_BAR = 4096;
constexpr int RING_BYTES = 131072, LDSCTL_OFF = RING_BYTES, MISC_OFF = LDSCTL_OFF + 320, LDS_BYTES = 147456;
constexpr int NWAVES = 8, NPHASES = 20;

typedef unsigned short bf16;
typedef unsigned v4u __attribute__((ext_vector_type(4)));
typedef unsigned v2u __attribute__((ext_vector_type(2)));
typedef float f32x4 __attribute__((ext_vector_type(4)));
typedef GAS unsigned gu32;
#define LDS_WAIT() asm volatile("s_waitcnt lgkmcnt(0)" ::: "memory")
#define VM_WAIT() asm volatile("s_waitcnt vmcnt(0)" ::: "memory")

#define XB_TMO      128
#define XB_XCNT(j)  (256  + 64 * (j))
#define XB_XSUB(j)  (1280 + 64 * (j))
#define XB_XGEN(j)  (2304 + 64 * (j))
#define XB_TOP      3328
#define XB_TOPGEN   3392
#define XCD_BAR_WORDS 3456
#define XB_SPIN_CAP (1u << 18)

__device__ __forceinline__ unsigned xb_ld(unsigned* p)              { return __hip_atomic_load(p, __ATOMIC_RELAXED, __HIP_MEMORY_SCOPE_AGENT); }
__device__ __forceinline__ unsigned xb_add(unsigned* p, unsigned v) { return __hip_atomic_fetch_add(p, v, __ATOMIC_RELAXED, __HIP_MEMORY_SCOPE_AGENT); }
__device__ __forceinline__ unsigned xb_xcc_id() { return (unsigned)__builtin_amdgcn_s_getreg((3 << 11) | 20) & 0xFu; }
#define XB_SPIN(cond, bar) do { unsigned _sp = 0; while (cond) { __builtin_amdgcn_s_sleep(1); \
    if ((++_sp & 255u) == 0u) { if (xb_ld(&(bar)[XB_TMO])) break; if (_sp > XB_SPIN_CAP) { atomicAdd(&(bar)[XB_TMO], 1u); break; } } } } while (0)

__device__ __forceinline__ int xb_lane_id() { unsigned m = ~0u; asm volatile("" : "+s"(m)); return (int)__builtin_amdgcn_mbcnt_hi(m, __builtin_amdgcn_mbcnt_lo(m, 0u)); }
struct XcdBarrier {
    int wave_s;
    unsigned* bar; unsigned x;
    volatile LAS unsigned* st;
};

__device__ __forceinline__ XcdBarrier xcd_barrier_post(unsigned* bar, volatile LAS unsigned* st, int wave_s) {
    XcdBarrier b; b.bar = bar; b.x = xb_xcc_id(); b.st = st; b.wave_s = wave_s;
    if (wave_s == 0 && xb_lane_id() == 0) (void)xb_add(&bar[XB_XCNT(b.x)], 1u);
    return b;
}
__device__ __forceinline__ void xcd_barrier_complete(unsigned* bar, unsigned x, unsigned& nloc, unsigned& nx) {
    const unsigned G = gridDim.x * gridDim.y * gridDim.z;
    unsigned sum, cnt, mine, sp = 0u;
    for (;;) {
        sum = 0u; cnt = 0u; mine = 0u;
#pragma unroll
        for (unsigned j = 0; j < 16; ++j) { const unsigned c = xb_ld(&bar[XB_XCNT(j)]); sum += c; cnt += (c > 0u) ? 1u : 0u; }
        if (sum == G) { mine = xb_ld(&bar[XB_XCNT(x)]); break; }
        __builtin_amdgcn_s_sleep(1);
        if ((++sp & 255u) == 0u) { if (xb_ld(&bar[XB_TMO])) break; if (sp > XB_SPIN_CAP) { atomicAdd(&bar[XB_TMO], 1u); break; } }
    }
    nloc = mine > 0u ? mine : 1u; nx = cnt > 0u ? cnt : 1u;
}

__device__ __forceinline__ void xcd_barrier(const XcdBarrier& b) {
    asm volatile("s_waitcnt vmcnt(0)" ::: "memory");
    __syncthreads();
    if (b.wave_s == 0 && xb_lane_id() == 0) {
        unsigned* bar = b.bar; asm volatile("" : "+s"(bar));
        __builtin_amdgcn_s_waitcnt(0);
        unsigned nloc = b.st[0], nx = b.st[1];
        if (nloc == 0u) { xcd_barrier_complete(bar, b.x, nloc, nx); b.st[0] = nloc; b.st[1] = nx; }
        const unsigned old = xb_add(&bar[XB_XSUB(b.x)], 1u);
        const unsigned gen = old / nloc;
        if (old + 1u == (gen + 1u) * nloc) {
            __builtin_amdgcn_fence(__ATOMIC_RELEASE, "agent");
            asm volatile("s_waitcnt vmcnt(0)" ::: "memory");
            const unsigned og = xb_add(&bar[XB_TOP], 1u);
            const unsigned tg = og / nx;
            if (og + 1u == (tg + 1u) * nx) xb_add(&bar[XB_TOPGEN], 1u);
            else XB_SPIN(xb_ld(&bar[XB_TOPGEN]) == tg, bar);
            __builtin_amdgcn_fence(__ATOMIC_ACQUIRE, "agent");
            xb_add(&bar[XB_XGEN(b.x)], 1u);
            asm volatile("s_waitcnt vmcnt(0)" ::: "memory");
        } else {
            XB_SPIN(xb_ld(&bar[XB_XGEN(b.x)]) == gen, bar);
            __builtin_amdgcn_fence(__ATOMIC_ACQUIRE, "agent");
            asm volatile("s_waitcnt vmcnt(0)" ::: "memory");
        }
    }
    __syncthreads();
}


struct Frame {
    LAS unsigned char* lds;
    int vcu, G, wave_s;
    unsigned char* ws;
};
struct Ids { int tid, lane, wave; };
__device__ __forceinline__ const float* inp(const LAS unsigned char* lds, int i) {
    const LAS unsigned* t = (const LAS unsigned*)(lds + 131072) + 2 * i;
    const unsigned lo = __builtin_amdgcn_readfirstlane(t[0]), hi = __builtin_amdgcn_readfirstlane(t[1]);
    return (const float*)(GAS const float*)(((unsigned long long)hi << 32) | lo); }
__device__ __forceinline__ Frame fresh_frame(const Frame& F) { Frame G = F; GAS unsigned char* g = (GAS unsigned char*)F.ws; asm volatile("" : "+s"(g), "+s"(G.lds), "+s"(G.vcu), "+s"(G.G), "+s"(G.wave_s)); G.ws = (unsigned char*)g; return G; }
__device__ __forceinline__ int lane_id() { unsigned m = ~0u; asm volatile("" : "+s"(m)); return (int)__builtin_amdgcn_mbcnt_hi(m, __builtin_amdgcn_mbcnt_lo(m, 0u)); }
__device__ __forceinline__ Ids fresh_ids(int wave_s) { Ids I; I.lane = lane_id(); I.wave = wave_s; I.tid = wave_s * 64 + I.lane; return I; }
__device__ __forceinline__ float shx(float v, int mask, int lane) { return __int_as_float(__builtin_amdgcn_ds_bpermute((lane ^ mask) << 2, __float_as_int(v))); }
__device__ __forceinline__ float shidx(float v, int src) { return __int_as_float(__builtin_amdgcn_ds_bpermute(src << 2, __float_as_int(v))); }
__device__ __forceinline__ int shidx_i(int v, int src) { return __builtin_amdgcn_ds_bpermute(src << 2, v); }
__device__ __forceinline__ float wave_sum(float v, int lane) {
#pragma unroll
    for (int o = 1; o < 64; o <<= 1) v += shx(v, o, lane);
    return v;
}
__device__ __forceinline__ float bf_lo(unsigned w) { return __uint_as_float(w << 16); }
__device__ __forceinline__ float bf_hi(unsigned w) { return __uint_as_float(w & 0xffff0000u); }
__device__ __forceinline__ f32x4 ld_bf4(const bf16* p) { const v2u w = *(const v2u*)p; return (f32x4){bf_lo(w.x), bf_hi(w.x), bf_lo(w.y), bf_hi(w.y)}; }
__device__ __forceinline__ void st_bf4(bf16* p, f32x4 v) { v2u w; w.x = pg8::cvt_pk_bf16(v.x, v.y); w.y = pg8::cvt_pk_bf16(v.z, v.w); *(v2u*)p = w; }
__device__ __forceinline__ float silu_f(float x) { return x / (1.0f + expf(-x)); }
__device__ __forceinline__ float sigmoid_f(float x) { return 1.0f / (1.0f + expf(-x)); }
__device__ __forceinline__ float log_sigmoid_f(float z) { return fminf(z, 0.f) - log1pf(expf(-fabsf(z))); }
__device__ __forceinline__ float softplus_f(float x) { return fmaxf(x, 0.f) + log1pf(expf(-fabsf(x))); }
__device__ __forceinline__ int row_sample(int r) { return r < NLAT ? (r >> 11) : 8; }

template <class RowMap>
__device__ __forceinline__ void transpose_item(const float* W, int ldw, int nvalid, int k0, int n0, bf16* WT, int ldt, const RowMap& f, LAS float* scr, int lane) {
    f32x4 t[8];
#pragma unroll
    for (int i = 0; i < 8; ++i) { const int idx = i * 64 + lane, kk = idx >> 3, c = n0 + 4 * (idx & 7);
        t[i] = c < nvalid ? __builtin_nontemporal_load((const f32x4*)(W + (size_t)(k0 + kk) * ldw + c)) : (f32x4){0.f, 0.f, 0.f, 0.f}; }
#pragma unroll
    for (int i = 0; i < 8; ++i) { const int idx = i * 64 + lane, kk = idx >> 3, c4 = 4 * (idx & 7); LAS float* d = scr + kk * 33 + c4; d[0] = t[i].x; d[1] = t[i].y; d[2] = t[i].z; d[3] = t[i].w; }
    LDS_WAIT(); asm volatile("" ::: "memory");
    const int c8 = lane & 7;
#pragma unroll
    for (int j = 0; j < 4; ++j) { const int n = (lane >> 3) + 8 * j, col = n0 + n; const LAS float* s = scr + (8 * c8) * 33 + n;
        if (col < nvalid) { v4u o; o.x = pg8::cvt_pk_bf16(s[0 * 33], s[1 * 33]); o.y = pg8::cvt_pk_bf16(s[2 * 33], s[3 * 33]); o.z = pg8::cvt_pk_bf16(s[4 * 33], s[5 * 33]); o.w = pg8::cvt_pk_bf16(s[6 * 33], s[7 * 33]);
            *(v4u*)(WT + (size_t)f(col) * ldt + k0 + 8 * c8) = o; } }
    LDS_WAIT(); asm volatile("" ::: "memory");
}
struct MapId { int off; __device__ __forceinline__ int operator()(int c) const { return off + c; } };
struct MapGU { int off, n; __device__ __forceinline__ int operator()(int h) const { const int hl = h & 127, q = hl >> 3, wc = q >> 2, fq = q & 3, rem = hl & 7, bj = rem >> 2, j = rem & 3;
    return off + 256 * (h >> 7) + 128 * bj + 32 * wc + 16 * n + 4 * fq + j; } };

__device__ __forceinline__ void p0_prologue(const Frame& F_) {
    const Frame F = fresh_frame(F_); const Ids I = fresh_ids(F.wave_s);
    const float* cvec = inp(F.lds, 1); const float* cctx = inp(F.lds, 3); const float* w_mod = inp(F.lds, 4); const float* b_mod = inp(F.lds, 5);
    float* MOD = (float*)(F.ws + WS_MOD);
    {
        LAS float* sil = (LAS float*)F.lds;
        LAS float* part = (LAS float*)(F.lds + 40960);
        for (int i = I.tid; i < 9 * 1024; i += 512) { const int s = i >> 10, k = i & 1023; const float c = s < 8 ? cvec[s * 1024 + k] : cctx[k]; sil[i] = silu_f(c); }
        __syncthreads();
        for (int item = F.vcu; item < 192; item += F.G) {
            const int l = item / 96, col = (item % 96) * 64 + I.lane;
            float acc[9];
#pragma unroll
            for (int s = 0; s < 9; ++s) acc[s] = 0.f;
            const float* wp = w_mod + (size_t)l * 1024 * MODW + (size_t)(I.wave * 128) * MODW + col;
            for (int k = 0; k < 128; ++k) { const float wv = wp[(size_t)k * MODW];
#pragma unroll
                for (int s = 0; s < 9; ++s) acc[s] += sil[s * 1024 + I.wave * 128 + k] * wv; }
#pragma unroll
            for (int s = 0; s < 9; ++s) part[(I.wave * 9 + s) * 64 + I.lane] = acc[s];
            __syncthreads();
            for (int i = I.tid; i < 9 * 64; i += 512) { const int s = i >> 6, ln = i & 63; float t = 0.f;
#pragma unroll
                for (int w = 0; w < 8; ++w) t += part[(w * 9 + s) * 64 + ln];
                const int cc = (item % 96) * 64 + ln; MOD[((size_t)l * 9 + s) * MODW + cc] = t + b_mod[l * MODW + cc]; }
            __syncthreads();
        }
        __syncthreads();
    }
    {
        bf16* wtin = (bf16*)(F.ws + WS_WTIN);
        const int nchunk = 2 * (INP - INC) * 128;
        for (int i = F.vcu * 512 + I.tid; i < nchunk; i += F.G * 512) { const int l = i / ((INP - INC) * 128), r = i % ((INP - INC) * 128);
            *(v4u*)(wtin + ((size_t)l * INP + INC) * 1024 + (size_t)r * 8) = (v4u){0u, 0u, 0u, 0u}; }
    }
    {
        LAS float* scr = (LAS float*)(F.lds + I.wave * 16384);
        const int gw = F.vcu * NWAVES + I.wave, NGW = F.G * NWAVES;
        constexpr int I_IN = 16 * 114, I_OUT = 16 * 32, I_E = 768, PER_L = I_IN + I_OUT + 16 * 3 * I_E;
#ifndef CONV_IN_SCAN
#define CONV_IN_SCAN 1
#endif
        constexpr int PER_L0 = CONV_IN_SCAN ? (I_IN + I_OUT) : PER_L;
        for (int it = gw; it < 2 * PER_L0; it += NGW) {
            const int l = it / PER_L0; int r = it % PER_L0;
            if (r < I_IN) { const int kb = r / 114, nb = r % 114;
                transpose_item(inp(F.lds, 8) + (size_t)l * 1024 * INC, INC, INC, 64 * kb, 32 * nb, (bf16*)(F.ws + WS_WTIN) + (size_t)l * INP * 1024, 1024, MapId{0}, scr, I.lane); continue; }
            r -= I_IN;
            if (r < I_OUT) { const int kb = r / 32, nb = r % 32;
                transpose_item(inp(F.lds, 9) + (size_t)l * 1024 * 1024, 1024, 1024, 64 * kb, 32 * nb, (bf16*)(F.ws + WS_WTOUT) + (size_t)l * 1024 * 1024, 1024, MapId{0}, scr, I.lane); continue; }
            r -= I_OUT;
            const int e = r / (3 * I_E), q = r % (3 * I_E), kind = q / I_E, t = q % I_E;
            if (kind < 2) { const int kb = t / 48, nb = t % 48;
                transpose_item((kind ? inp(F.lds, 25) : inp(F.lds, 24)) + ((size_t)l * NE + e) * 1024 * FF, FF, FF, 64 * kb, 32 * nb, (bf16*)(F.ws + WS_WTGU) + (size_t)l * NE * 3072 * 1024, 1024, MapGU{e * 3072, kind}, scr, I.lane); }
            else { const int kb = t / 32, nb = t % 32;
                transpose_item(inp(F.lds, 26) + ((size_t)l * NE + e) * FF * 1024, 1024, 1024, 64 * kb, 32 * nb, (bf16*)(F.ws + WS_WTDN) + (size_t)l * NE * 1024 * FF, FF, MapId{e * 1024}, scr, I.lane); }
        }
    }
}

__device__ __forceinline__ void load_row_f32(const float* p, int lane, f32x4 (&v)[4]) {
#pragma unroll
    for (int j = 0; j < 4; ++j) v[j] = *(const f32x4*)(p + 4 * lane + 256 * j);
}
__device__ __forceinline__ float row_sumsq(const f32x4 (&v)[4], int lane) { float s = 0.f;
#pragma unroll
    for (int j = 0; j < 4; ++j) s += (v[j].x * v[j].x + v[j].y * v[j].y) + (v[j].z * v[j].z + v[j].w * v[j].w);
    return wave_sum(s, lane); }
__device__ __forceinline__ void add_expert_out(f32x4 (&v)[4], int r, int lane, const int* slotmap, const float* afft, const bf16* EO, const float* g2) {
    f32x4 acc[4];
#pragma unroll
    for (int j = 0; j < 4; ++j) acc[j] = (f32x4){0.f, 0.f, 0.f, 0.f};
    const int sl = lane < NE ? slotmap[r * 16 + lane] : -1;
    const float af = lane < NE ? afft[(size_t)lane * NROWS + r] : 0.f;
    unsigned mask = (unsigned)__ballot(sl >= 0);
    while (mask) {
        v2u w[4][4]; float a[4];
#pragma unroll
        for (int q = 0; q < 4; ++q) {
            const bool on = mask != 0u; const int e = on ? __builtin_ctz(mask) : 0; if (on) mask &= mask - 1u;
            const int slot = __builtin_amdgcn_readlane(sl, e); a[q] = on ? __int_as_float(__builtin_amdgcn_readlane(__float_as_int(af), e)) : 0.f;
            const bf16* er = EO + (size_t)(on ? slot : 0) * 1024;
#pragma unroll
            for (int j = 0; j < 4; ++j) w[q][j] = on ? *(const v2u*)(er + 4 * lane + 256 * j) : (v2u){0u, 0u};
        }
#pragma unroll
        for (int q = 0; q < 4; ++q)
#pragma unroll
            for (int j = 0; j < 4; ++j) acc[j] += a[q] * (f32x4){bf_lo(w[q][j].x), bf_hi(w[q][j].x), bf_lo(w[q][j].y), bf_hi(w[q][j].y)};
    }
#pragma unroll
    for (int j = 0; j < 4; ++j) v[j] += *(const f32x4*)(g2 + 4 * lane + 256 * j) * acc[j];
}
__device__ __forceinline__ void p1_norm1(const Frame& F_, int l) {
    const Frame F = fresh_frame(F_); const Ids I = fresh_ids(F.wave_s);
    const int gw = F.vcu * NWAVES + I.wave, NGW = F.G * NWAVES;
    float* H = (float*)(F.ws + WS_H); bf16* HN = (bf16*)(F.ws + WS_HN);
    const float* MOD = (const float*)(F.ws + WS_MOD); const float* nw = inp(F.lds, 6) + l * 1024;
    const float* xin = inp(F.lds, 0); const float* cin = inp(F.lds, 2);
    constexpr int RB = 3;
    for (int r0 = gw; r0 < NROWS; r0 += NGW * RB) {
        f32x4 v[RB][4];
#pragma unroll
        for (int q = 0; q < RB; ++q) { const int r = r0 + q * NGW; if (r < NROWS) {
            if (l == 0) load_row_f32(r < NLAT ? xin + (size_t)r * D : cin + (size_t)(r - NLAT) * D, I.lane, v[q]); else load_row_f32(H + (size_t)r * D, I.lane, v[q]); } }
#pragma unroll
        for (int q = 0; q < RB; ++q) { const int r = r0 + q * NGW; if (r < NROWS) {
            const int s = row_sample(r);
            if (l != 0) add_expert_out(v[q], r, I.lane, (const int*)(F.ws + WS_SLOT), (const float*)(F.ws + WS_AFFT), (const bf16*)(F.ws + WS_O2), MOD + ((size_t)(l - 1) * 9 + s) * MODW + 5120);
            const float rstd = 1.0f / sqrtf(row_sumsq(v[q], I.lane) * (1.0f / D) + EPS);
            const float* m = MOD + ((size_t)l * 9 + s) * MODW;
#pragma unroll
            for (int j = 0; j < 4; ++j) { const int k = 4 * I.lane + 256 * j;
                *(f32x4*)(H + (size_t)r * D + k) = v[q][j];
                const f32x4 w = *(const f32x4*)(nw + k), sh = *(const f32x4*)(m + k), sc = *(const f32x4*)(m + 1024 + k);
                st_bf4(HN + (size_t)r * D + k, (v[q][j] * rstd * w) * (sc + 1.0f) + sh); } } }
    }
}
__device__ __forceinline__ void p_final(const Frame& F_, float* out) {
    const Frame F = fresh_frame(F_); const Ids I = fresh_ids(F.wave_s);
    const int gw = F.vcu * NWAVES + I.wave, NGW = F.G * NWAVES;
    const float* H = (const float*)(F.ws + WS_H); const float* MOD = (const float*)(F.ws + WS_MOD); const float* nw = inp(F.lds, 27);
    constexpr int RB = 2;
    for (int r0 = gw; r0 < NLAT; r0 += NGW * RB) {
        f32x4 v[RB][4];
#pragma unroll
        for (int q = 0; q < RB; ++q) { const int r = r0 + q * NGW; if (r < NLAT) load_row_f32(H + (size_t)r * D, I.lane, v[q]); }
#pragma unroll
        for (int q = 0; q < RB; ++q) { const int r = r0 + q * NGW; if (r < NLAT) {
            const int s = row_sample(r);
            add_expert_out(v[q], r, I.lane, (const int*)(F.ws + WS_SLOT), (const float*)(F.ws + WS_AFFT), (const bf16*)(F.ws + WS_O2), MOD + ((size_t)1 * 9 + s) * MODW + 5120);
            const float rstd = 1.0f / sqrtf(row_sumsq(v[q], I.lane) * (1.0f / D) + EPS);
#pragma unroll
            for (int j = 0; j < 4; ++j) { const int k = 4 * I.lane + 256 * j; *(f32x4*)(out + (size_t)r * D + k) = v[q][j] * rstd * *(const f32x4*)(nw + k); } } }
    }
}
__device__ __forceinline__ void p6_norm2_router(const Frame& F_, int l, int nrows) {
    const Frame F = fresh_frame(F_); const Ids I = fresh_ids(F.wave_s);
    const int gw = F.vcu * NWAVES + I.wave, NGW = F.G * NWAVES;
    const float* H = (const float*)(F.ws + WS_H); bf16* HN = (bf16*)(F.ws + WS_HN); float* AFFT = (float*)(F.ws + WS_AFFT);
    const float* MOD = (const float*)(F.ws + WS_MOD); const float* nw = inp(F.lds, 7) + l * 1024; const float* rw = inp(F.lds, 23) + (size_t)l * 1024 * NE;
    LAS float* wt = (LAS float*)F.lds;
    for (int i = I.tid; i < 1024 * 4; i += 512) { const int k = i >> 2, q = i & 3; const f32x4 w = *(const f32x4*)(rw + k * 16 + 4 * q);
        wt[(4 * q + 0) * 1024 + k] = w.x; wt[(4 * q + 1) * 1024 + k] = w.y; wt[(4 * q + 2) * 1024 + k] = w.z; wt[(4 * q + 3) * 1024 + k] = w.w; }
    __syncthreads();
    const int lane = I.lane;
    const int myexp = ((lane >> 5) & 1) * 8 + ((lane >> 4) & 1) * 4 + ((lane >> 3) & 1) * 2 + ((lane >> 2) & 1);
    constexpr int RB = 2;
    for (int r0 = gw; r0 < nrows; r0 += NGW * RB) {
        f32x4 v[RB][4];
#pragma unroll
        for (int q = 0; q < RB; ++q) { const int r = r0 + q * NGW; if (r < nrows) load_row_f32(H + (size_t)r * D, lane, v[q]); }
#pragma unroll
        for (int q = 0; q < RB; ++q) { const int r = r0 + q * NGW; if (r < nrows) {
            const int s = row_sample(r);
            const float rstd = 1.0f / sqrtf(row_sumsq(v[q], I.lane) * (1.0f / D) + EPS);
            const float* m = MOD + ((size_t)l * 9 + s) * MODW;
#pragma unroll
            for (int j = 0; j < 4; ++j) { const int k = 4 * lane + 256 * j;
                const f32x4 w = *(const f32x4*)(nw + k), sh = *(const f32x4*)(m + 3072 + k), sc = *(const f32x4*)(m + 4096 + k);
                v[q][j] = (v[q][j] * rstd * w) * (sc + 1.0f) + sh;
                st_bf4(HN + (size_t)r * D + k, v[q][j]); }
            float p[NE];
#pragma unroll
            for (int e = 0; e < NE; ++e) { float a = 0.f;
#pragma unroll
                for (int j = 0; j < 4; ++j) { const f32x4 w = *(const LAS f32x4*)(wt + e * 1024 + 4 * lane + 256 * j); a += (v[q][j].x * w.x + v[q][j].y * w.y) + (v[q][j].z * w.z + v[q][j].w * w.w); }
                p[e] = a; }
            float a8[8], a4[4], a2[2], a1;
            { const bool hi = (lane & 32) != 0;
#pragma unroll
              for (int i = 0; i < 8; ++i) { const float send = hi ? p[i] : p[8 + i], keep = hi ? p[8 + i] : p[i]; a8[i] = keep + shx(send, 32, lane); } }
            { const bool hi = (lane & 16) != 0;
#pragma unroll
              for (int i = 0; i < 4; ++i) { const float send = hi ? a8[i] : a8[4 + i], keep = hi ? a8[4 + i] : a8[i]; a4[i] = keep + shx(send, 16, lane); } }
            { const bool hi = (lane & 8) != 0;
#pragma unroll
              for (int i = 0; i < 2; ++i) { const float send = hi ? a4[i] : a4[2 + i], keep = hi ? a4[2 + i] : a4[i]; a2[i] = keep + shx(send, 8, lane); } }
            { const bool hi = (lane & 4) != 0; const float send = hi ? a2[0] : a2[1], keep = hi ? a2[1] : a2[0]; a1 = keep + shx(send, 4, lane); }
            a1 += shx(a1, 2, lane); a1 += shx(a1, 1, lane);
            float mx = a1;
            mx = fmaxf(mx, shx(mx, 4, lane)); mx = fmaxf(mx, shx(mx, 8, lane)); mx = fmaxf(mx, shx(mx, 16, lane)); mx = fmaxf(mx, shx(mx, 32, lane));
            const float ex = expf(a1 - mx); float den = ex;
            den += shx(den, 4, lane); den += shx(den, 8, lane); den += shx(den, 16, lane); den += shx(den, 32, lane);
            if ((lane & 3) == 0) AFFT[(size_t)myexp * NROWS + r] = ex / den; } }
    }
    __syncthreads();
}
__device__ __forceinline__ void p4_combine(Frame& F, int l, int nrows) {
    const Ids I = fresh_ids(F.wave_s);
    const int gw = F.vcu * NWAVES + I.wave, NGW = F.G * NWAVES;
    const bf16* O2 = (const bf16*)(F.ws + WS_O2); const bf16* U = (const bf16*)(F.ws + WS_U); bf16* Y = (bf16*)(F.ws + WS_Y);
    const int mixer = I.lane >> 4, c = (I.lane & 15) * 16;
    const float* nwp = (mixer == 0 ? inp(F.lds, 11) : mixer == 1 ? inp(F.lds, 14) : mixer == 2 ? inp(F.lds, 20) : inp(F.lds, 22)) + l * 256 + c;
    const int gcol = mixer == 0 ? C_RET + 768 + c : mixer == 1 ? C_GLA + 512 + c : mixer == 2 ? C_SSD + c : C_ML + 768 + c;
    float nw[16];
#pragma unroll
    for (int i = 0; i < 16; ++i) nw[i] = nwp[i];
    constexpr int RB = 3;
    for (int r0 = gw; r0 < nrows; r0 += NGW * RB) {
        v4u ra[RB][2], rb[RB][2], rg[RB][2];
#pragma unroll
        for (int q = 0; q < RB; ++q) { const int r = r0 + q * NGW; if (r < nrows) {
            const bf16* p0 = O2 + (size_t)r * D + 16 * I.lane; const bf16* p1 = p0 + (size_t)NROWS * D; const bf16* pg = U + (size_t)r * INP + gcol;
            ra[q][0] = *(const v4u*)p0; ra[q][1] = *(const v4u*)(p0 + 8); rb[q][0] = *(const v4u*)p1; rb[q][1] = *(const v4u*)(p1 + 8); rg[q][0] = *(const v4u*)pg; rg[q][1] = *(const v4u*)(pg + 8); } }
#pragma unroll
        for (int q = 0; q < RB; ++q) { const int r = r0 + q * NGW; if (r < nrows) {
            float o[16], g[16];
#pragma unroll
            for (int hh = 0; hh < 2; ++hh) { const v4u a = ra[q][hh], b = rb[q][hh], gg = rg[q][hh];
                const unsigned aw[4] = {a.x, a.y, a.z, a.w}, bw[4] = {b.x, b.y, b.z, b.w}, gw4[4] = {gg.x, gg.y, gg.z, gg.w};
#pragma unroll
                for (int i = 0; i < 4; ++i) { o[8 * hh + 2 * i] = bf_lo(aw[i]) + bf_lo(bw[i]); o[8 * hh + 2 * i + 1] = bf_hi(aw[i]) + bf_hi(bw[i]); g[8 * hh + 2 * i] = bf_lo(gw4[i]); g[8 * hh + 2 * i + 1] = bf_hi(gw4[i]); } }
            if (mixer == 2) {
#pragma unroll
                for (int i = 0; i < 16; ++i) o[i] *= silu_f(g[i]);
            }
            float s1 = 0.f;
#pragma unroll
            for (int i = 0; i < 16; ++i) s1 += o[i];
            s1 += shx(s1, 1, I.lane); s1 += shx(s1, 2, I.lane);
            const float mean = mixer == 0 ? s1 * (1.0f / 64.0f) : 0.f;
            float s2 = 0.f;
#pragma unroll
            for (int i = 0; i < 16; ++i) { o[i] -= mean; s2 += o[i] * o[i]; }
            s2 += shx(s2, 1, I.lane); s2 += shx(s2, 2, I.lane);
            float s4 = s2 + shx(s2, 4, I.lane); s4 += shx(s4, 8, I.lane);
            const float rs = mixer == 2 ? 1.0f / sqrtf(s4 * (1.0f / 256.0f) + EPS) : 1.0f / sqrtf(s2 * (1.0f / 64.0f) + EPS);
            float y[16];
#pragma unroll
            for (int i = 0; i < 16; ++i) { const float gate = mixer == 2 ? 1.0f : (mixer == 3 ? sigmoid_f(g[i]) : silu_f(g[i])); y[i] = o[i] * rs * nw[i] * gate; }
            bf16* yp = Y + (size_t)r * D + 16 * I.lane;
            v4u w0, w1;
            w0.x = pg8::cvt_pk_bf16(y[0], y[1]); w0.y = pg8::cvt_pk_bf16(y[2], y[3]); w0.z = pg8::cvt_pk_bf16(y[4], y[5]); w0.w = pg8::cvt_pk_bf16(y[6], y[7]);
            w1.x = pg8::cvt_pk_bf16(y[8], y[9]); w1.y = pg8::cvt_pk_bf16(y[10], y[11]); w1.z = pg8::cvt_pk_bf16(y[12], y[13]); w1.w = pg8::cvt_pk_bf16(y[14], y[15]);
            *(v4u*)yp = w0; *(v4u*)(yp + 8) = w1; } }
    }
}

__device__ __forceinline__ int block_excl_scan(int v, LAS int* wsum, int lane, int wave, int& total) {
    int inc = v;
#pragma unroll
    for (int off = 1; off < 64; off <<= 1) { const int o = shidx_i(inc, (lane - off) & 63); if (lane >= off) inc += o; }
    if (lane == 63) wsum[wave] = inc;
    __syncthreads();
    int base = 0, tot = 0;
#pragma unroll
    for (int w = 0; w < 8; ++w) { const int s = wsum[w]; base += (w < wave) ? s : 0; tot += s; }
    __syncthreads();
    total = tot; return base + inc - v;
}
__device__ __forceinline__ void p7_topk(const Frame& F_, int l) {
    const Frame F = fresh_frame(F_); const Ids I = fresh_ids(F.wave_s);
    const float* AFFT = (const float*)(F.ws + WS_AFFT); int* SLOT = (int*)(F.ws + WS_SLOT);
    const bf16* HN = (const bf16*)(F.ws + WS_HN); bf16* XS = (bf16*)(F.ws + WS_Y);
    LAS unsigned* hist = (LAS unsigned*)F.lds;
    LAS unsigned* misc = hist + 256;
    LAS int* wsum = (LAS int*)(hist + 264);
    LAS int* selrow = (LAS int*)(hist + 272);
    const int nitems = (l == 0 ? 16 : 8) * NE;
    for (int item = F.vcu; item < nitems; item += F.G) {
        const int set = item >> 4, e = item & 15;
        const int n = set < 8 ? SEQ : CTXL, cap = n >> 3;
        const int row0 = set < 8 ? set * SEQ : NLAT + (set - 8) * CTXL, slotbase = set < 8 ? set * 256 : 2048 + (set - 8) * 32;
        unsigned key[4]; const int i0 = 4 * I.tid; const bool valid = i0 < n;
        { f32x4 a = (f32x4){0.f, 0.f, 0.f, 0.f}; if (valid) a = *(const f32x4*)(AFFT + (size_t)e * NROWS + row0 + i0);
          key[0] = __float_as_uint(a.x); key[1] = __float_as_uint(a.y); key[2] = __float_as_uint(a.z); key[3] = __float_as_uint(a.w); }
        unsigned prefix = 0u, kk = (unsigned)cap;
        for (int pass = 3; pass >= 0; --pass) {
            const int shift = 8 * pass;
            if (I.tid < 256) hist[I.tid] = 0u;
            __syncthreads();
            if (valid) {
#pragma unroll
                for (int j = 0; j < 4; ++j) { const bool match = pass == 3 || ((key[j] >> (shift + 8)) == (prefix >> (shift + 8)));
                    if (match) atomicAdd((unsigned*)&hist[(key[j] >> shift) & 255u], 1u); }
            }
            __syncthreads();
            if (I.wave == 0) {
                const unsigned h0 = hist[4 * I.lane], h1 = hist[4 * I.lane + 1], h2 = hist[4 * I.lane + 2], h3 = hist[4 * I.lane + 3];
                const unsigned s = h0 + h1 + h2 + h3; unsigned t = s;
#pragma unroll
                for (int off = 1; off < 64; off <<= 1) { const unsigned o = (unsigned)shidx_i((int)t, (I.lane + off) & 63); if (I.lane + off < 64) t += o; }
                const unsigned above = t - s, c3 = above + h3, c2 = c3 + h2, c1 = c2 + h1, c0 = c1 + h0;
                int d = -1; unsigned nk = 0u;
                if (above < kk && c3 >= kk) { d = 3; nk = kk - above; }
                else if (c3 < kk && c2 >= kk) { d = 2; nk = kk - c3; }
                else if (c2 < kk && c1 >= kk) { d = 1; nk = kk - c2; }
                else if (c1 < kk && c0 >= kk) { d = 0; nk = kk - c1; }
                if (d >= 0) { misc[0] = prefix | ((unsigned)(4 * I.lane + d) << shift); misc[1] = nk; }
            }
            __syncthreads();
            prefix = misc[0]; kk = misc[1];
        }
        int ceq = 0; bool gt[4], eq[4];
#pragma unroll
        for (int j = 0; j < 4; ++j) { gt[j] = valid && key[j] > prefix; eq[j] = valid && key[j] == prefix; ceq += eq[j] ? 1 : 0; }
        int tot; int erank = block_excl_scan(ceq, wsum, I.lane, I.wave, tot);
        bool sel[4]; int csel = 0;
#pragma unroll
        for (int j = 0; j < 4; ++j) { sel[j] = gt[j] || (eq[j] && (unsigned)erank < kk); erank += eq[j] ? 1 : 0; csel += sel[j] ? 1 : 0; }
        int slot = block_excl_scan(csel, wsum, I.lane, I.wave, tot);
        if (valid) {
#pragma unroll
            for (int j = 0; j < 4; ++j) { const int r = row0 + i0 + j;
                if (sel[j]) { if (slot < cap) { selrow[slot] = r; SLOT[r * 16 + e] = e * SLOTS + slotbase + slot; } else SLOT[r * 16 + e] = -1; ++slot; }
                else SLOT[r * 16 + e] = -1; }
        }
        __syncthreads();
        for (int s0 = I.wave * 4; s0 < cap; s0 += NWAVES * 4) {
            v4u a[4], b[4];
#pragma unroll
            for (int q = 0; q < 4; ++q) { const bf16* src = HN + (size_t)selrow[s0 + q] * D; a[q] = *(const v4u*)(src + 8 * I.lane); b[q] = *(const v4u*)(src + 512 + 8 * I.lane); }
#pragma unroll
            for (int q = 0; q < 4; ++q) { bf16* dst = XS + (size_t)(e * SLOTS + slotbase + s0 + q) * D; *(v4u*)(dst + 8 * I.lane) = a[q]; *(v4u*)(dst + 512 + 8 * I.lane) = b[q]; }
        }
        __syncthreads();
    }
}

constexpr int SC_Q = 0, SC_K = 2048, SC_V = 4096, SC_A = 6144, SC_X = 8192, SC_OP = 10240, SC_DP = 26624;
__device__ __forceinline__ void p3_scan(Frame& F, int l, bool ctx_out, int mixmask) {
    const Ids I = fresh_ids(F.wave_s);
    const bf16* U = (const bf16*)(F.ws + WS_U); bf16* O2 = (bf16*)(F.ws + WS_O2);
    LAS float* sm = (LAS float*)F.lds;
    const int tk = I.tid >> 4, d0 = (I.tid & 15) * 4;
    for (int item = F.vcu; item < 256; item += F.G) {
        const int dir = item & 1, h = (item >> 1) & 3, mixer = (item >> 3) & 3, b = item >> 5;
        if (!((mixmask >> mixer) & 1)) continue;
        float S[8], nst[8];
#pragma unroll
        for (int i = 0; i < 8; ++i) { S[i] = 0.f; nst[i] = 0.f; }
        const float ret_gamma = sigmoid_f(inp(F.lds, 10)[(l * 2 + dir) * 4 + h]);
        const float ssd_dtb = inp(F.lds, 17)[(l * 2 + dir) * 4 + h], ssd_aneg = -expf(inp(F.lds, 18)[(l * 2 + dir) * 4 + h]), ssd_dskip = inp(F.lds, 19)[l * 4 + h];
        const float ml_bi = inp(F.lds, 21)[((l * 2 + dir) * 2 + 0) * 4 + h], ml_bf = inp(F.lds, 21)[((l * 2 + dir) * 2 + 1) * 4 + h];
        for (int batch = 0; batch < 72; ++batch) {
            const bool isctx = batch < 8; const int len = isctx ? CTXL : SEQ, pos0 = (isctx ? batch : batch - 8) * 32, rowbase = isctx ? NLAT + b * CTXL : b * SEQ;
            {
                const int pos = pos0 + tk, t = dir ? len - 1 - pos : pos; const bf16* ur = U + (size_t)(rowbase + t) * INP;
                f32x4 q4, k4, v4, a4, x4 = (f32x4){0.f, 0.f, 0.f, 0.f};
                if (mixer == 0) {
                    q4 = ld_bf4(ur + C_RET + h * 64 + d0) * 0.125f; k4 = ld_bf4(ur + C_RET + 256 + h * 64 + d0); v4 = ld_bf4(ur + C_RET + 512 + h * 64 + d0);
                    a4 = (f32x4){ret_gamma, ret_gamma, ret_gamma, ret_gamma};
                    if (!isctx) {
                        const int dd = d0 & 31; const bool first = dd < 16; const int fi = dd & 15, poff = first ? 16 : -16;
                        const float posv = (d0 < 32) ? (float)(t >> 6) : (float)(t & 63);
                        const f32x4 qp = ld_bf4(ur + C_RET + h * 64 + d0 + poff) * 0.125f, kp = ld_bf4(ur + C_RET + 256 + h * 64 + d0 + poff);
#pragma unroll
                        for (int j = 0; j < 4; ++j) { const float ang = posv * exp2f(-(float)(fi + j) * (13.287712379549449f / 16.0f)); const float cs = __cosf(ang), sn = __sinf(ang);
                            q4[j] = first ? q4[j] * cs - qp[j] * sn : qp[j] * sn + q4[j] * cs; k4[j] = first ? k4[j] * cs - kp[j] * sn : kp[j] * sn + k4[j] * cs; }
                    }
                } else if (mixer == 1) {
                    v4 = ld_bf4(ur + C_GLA + 256 + h * 64 + d0);
                    if (d0 < 32) {
                        q4 = ld_bf4(ur + C_GLA + h * 32 + d0) * 0.17677669529663687f; k4 = ld_bf4(ur + C_GLA + 128 + h * 32 + d0);
                        const float* gw_ = inp(F.lds, 12) + (size_t)(l * 2 + dir) * 16 * 128 + h * 32 + d0; const float* gb_ = inp(F.lds, 13) + (l * 2 + dir) * 128 + h * 32 + d0;
                        f32x4 z = *(const f32x4*)gb_;
#pragma unroll
                        for (int q = 0; q < 4; ++q) { const f32x4 lr = ld_bf4(ur + C_GLA + 768 + 4 * q);
#pragma unroll
                            for (int i = 0; i < 4; ++i) z += lr[i] * *(const f32x4*)(gw_ + (4 * q + i) * 128); }
#pragma unroll
                        for (int j = 0; j < 4; ++j) a4[j] = expf(log_sigmoid_f(z[j]) * (1.0f / 16.0f));
                    } else { q4 = (f32x4){0.f, 0.f, 0.f, 0.f}; k4 = q4; a4 = (f32x4){1.f, 1.f, 1.f, 1.f}; }
                } else if (mixer == 2) {
                    const int g = h >> 1; const float* cw = inp(F.lds, 15) + (size_t)l * 5 * 512; const float* cb = inp(F.lds, 16) + l * 512;
                    const int chx = h * 64 + d0, chb = 256 + g * 64 + d0, chc = 384 + g * 64 + d0;
                    f32x4 ax = *(const f32x4*)(cb + chx), ab = *(const f32x4*)(cb + chb), ac = *(const f32x4*)(cb + chc);
#pragma unroll
                    for (int w = 0; w < 5; ++w) { const int tt = t + w - 2;
                        if (tt >= 0 && tt < len) { const bf16* up = U + (size_t)(rowbase + tt) * INP + C_SSD + 256;
                            ax += ld_bf4(up + chx) * *(const f32x4*)(cw + w * 512 + chx); ab += ld_bf4(up + chb) * *(const f32x4*)(cw + w * 512 + chb); ac += ld_bf4(up + chc) * *(const f32x4*)(cw + w * 512 + chc); } }
                    const float dtr = bf_lo((unsigned)ur[C_SSD + 768 + dir * 4 + h]);
                    const float dt = softplus_f(dtr + ssd_dtb), aa = expf(dt * ssd_aneg);
#pragma unroll
                    for (int j = 0; j < 4; ++j) { x4[j] = silu_f(ax[j]); k4[j] = silu_f(ab[j]); q4[j] = silu_f(ac[j]); v4[j] = x4[j] * dt; a4[j] = aa; }
                } else {
                    q4 = ld_bf4(ur + C_ML + h * 64 + d0); k4 = ld_bf4(ur + C_ML + 256 + h * 64 + d0) * 0.125f; v4 = ld_bf4(ur + C_ML + 512 + h * 64 + d0);
                    const float ip = bf_lo((unsigned)ur[C_ML + 1024 + dir * 8 + h]) + ml_bi, fp = bf_lo((unsigned)ur[C_ML + 1024 + dir * 8 + 4 + h]) + ml_bf;
                    const float wgt = expf(ip), aa = sigmoid_f(fp);
                    k4 = k4 * wgt; a4 = (f32x4){aa, aa, aa, aa};
                }
                *(LAS f32x4*)(sm + SC_Q + tk * 64 + d0) = q4; *(LAS f32x4*)(sm + SC_K + tk * 64 + d0) = k4; *(LAS f32x4*)(sm + SC_V + tk * 64 + d0) = v4;
                *(LAS f32x4*)(sm + SC_A + tk * 64 + d0) = a4; *(LAS f32x4*)(sm + SC_X + tk * 64 + d0) = x4;
            }
            __syncthreads();
            {
                const int k0 = I.wave * 8;
                for (int t = 0; t < 32; ++t) {
                    const float vv = sm[SC_V + t * 64 + I.lane];
                    const f32x4 a0 = *(const LAS f32x4*)(sm + SC_A + t * 64 + k0), a1 = *(const LAS f32x4*)(sm + SC_A + t * 64 + k0 + 4);
                    const f32x4 kq0 = *(const LAS f32x4*)(sm + SC_K + t * 64 + k0), kq1 = *(const LAS f32x4*)(sm + SC_K + t * 64 + k0 + 4);
                    const f32x4 q0 = *(const LAS f32x4*)(sm + SC_Q + t * 64 + k0), q1 = *(const LAS f32x4*)(sm + SC_Q + t * 64 + k0 + 4);
                    float acc = 0.f, dacc = 0.f;
#pragma unroll
                    for (int i = 0; i < 4; ++i) { S[i] = a0[i] * S[i] + kq0[i] * vv; acc += q0[i] * S[i]; S[4 + i] = a1[i] * S[4 + i] + kq1[i] * vv; acc += q1[i] * S[4 + i]; }
                    sm[SC_OP + (t * 8 + I.wave) * 64 + I.lane] = acc;
                    if (mixer == 3) {
#pragma unroll
                        for (int i = 0; i < 4; ++i) { nst[i] = a0[i] * nst[i] + kq0[i]; dacc += q0[i] * nst[i]; nst[4 + i] = a1[i] * nst[4 + i] + kq1[i]; dacc += q1[i] * nst[4 + i]; }
                        if (I.lane == 0) sm[SC_DP + t * 8 + I.wave] = dacc;
                    }
                }
            }
            __syncthreads();
            if (!isctx || ctx_out) {
                const int pos = pos0 + tk, t = dir ? len - 1 - pos : pos;
                f32x4 o = (f32x4){0.f, 0.f, 0.f, 0.f};
#pragma unroll
                for (int w = 0; w < 8; ++w) o += *(const LAS f32x4*)(sm + SC_OP + (tk * 8 + w) * 64 + d0);
                if (mixer == 3) { float den = 0.f;
#pragma unroll
                    for (int w = 0; w < 8; ++w) den += sm[SC_DP + tk * 8 + w];
                    o = o * (1.0f / fmaxf(fabsf(den), 1.0f)); }
                if (mixer == 2 && dir == 0) o += *(const LAS f32x4*)(sm + SC_X + tk * 64 + d0) * ssd_dskip;
                st_bf4(O2 + ((size_t)dir * NROWS + rowbase + t) * D + mixer * 256 + h * 64 + d0, o);
            }
        }
        __syncthreads();
    }
}

typedef short bf16x8s __attribute__((ext_vector_type(8)));
typedef short s16x4 __attribute__((ext_vector_type(4)));
constexpr int IMGB = 9216;
constexpr int CS_SET = 4 * IMGB + 1024;
constexpr int CS_P = 2 * CS_SET, CS_ST = CS_P + IMGB, CS_NS = CS_ST + 2 * IMGB, CS_GS = CS_NS + 256, CS_GM = CS_GS + 2048, CS_END = CS_GM + 8192;
static_assert(CS_END <= RING_BYTES, "scan LDS map");
__device__ __forceinline__ bf16x8s rowfrag(const LAS unsigned char* img, int row0, int ks, int fr, int fq) { return *(const LAS bf16x8s*)(img + (row0 + fr) * 144 + ks * 64 + fq * 16); }
__device__ __forceinline__ s16x4 tr_rd(const LAS unsigned char* p) { return __builtin_bit_cast(s16x4, __builtin_amdgcn_ds_read_tr16_b64_v4i16((LAS s16x4*)(LAS unsigned char*)p)); }
__device__ __forceinline__ bf16x8s trfrag(const LAS unsigned char* img, int tok0, int col0, int lane) {
    const LAS unsigned char* a = img + (tok0 + 8 * (lane >> 4) + ((lane >> 2) & 3)) * 144 + (col0 + 4 * (lane & 3)) * 2;
    const s16x4 lo = tr_rd(a), hi = tr_rd(a + 4 * 144);
    return (bf16x8s){lo[0], lo[1], lo[2], lo[3], hi[0], hi[1], hi[2], hi[3]};
}
__device__ __forceinline__ f32x4 mfma16(bf16x8s a, bf16x8s b, f32x4 c) { return __builtin_amdgcn_mfma_f32_16x16x32_bf16(a, b, c, 0, 0, 0); }
struct f32x8 { f32x4 a, b; };
__device__ __forceinline__ f32x8 cvt8(v4u w) { f32x8 r; r.a = (f32x4){bf_lo(w.x), bf_hi(w.x), bf_lo(w.y), bf_hi(w.y)}; r.b = (f32x4){bf_lo(w.z), bf_hi(w.z), bf_lo(w.w), bf_hi(w.w)}; return r; }
__device__ __forceinline__ v4u pack8(f32x4 a, f32x4 b) { v4u w; w.x = pg8::cvt_pk_safe(a.x, a.y); w.y = pg8::cvt_pk_safe(a.z, a.w); w.z = pg8::cvt_pk_safe(b.x, b.y); w.w = pg8::cvt_pk_safe(b.z, b.w); return w; }
__device__ __forceinline__ float silu_q(float x) { return x * __builtin_amdgcn_rcpf(1.0f + __expf(-x)); }
__device__ __forceinline__ float sigmoid_q(float x) { return __builtin_amdgcn_rcpf(1.0f + __expf(-x)); }
__device__ __forceinline__ float log_sigmoid_q(float z) { return fminf(z, 0.f) - __logf(1.0f + __expf(-fabsf(z))); }
__device__ __forceinline__ float softplus_q(float x) { return fmaxf(x, 0.f) + __logf(1.0f + __expf(-fabsf(x))); }
template <int N> __device__ __forceinline__ float dpp_row_shr(float v) { return __int_as_float(__builtin_amdgcn_update_dpp(0, __float_as_int(v), 0x110 + N, 0xf, 0xf, true)); }
__device__ __forceinline__ float rdlane(float v, int l) { return __int_as_float(__builtin_amdgcn_readlane(__float_as_int(v), l)); }
__device__ __forceinline__ float wave_incl_scan(float v, int lane) {
    v += dpp_row_shr<1>(v); v += dpp_row_shr<2>(v); v += dpp_row_shr<4>(v); v += dpp_row_shr<8>(v);
    const float t0 = rdlane(v, 15), t1 = rdlane(v, 31), t2 = rdlane(v, 47); const int row = lane >> 4;
    return v + ((row >= 1 ? t0 : 0.f) + (row >= 2 ? t1 : 0.f) + (row >= 3 ? t2 : 0.f));
}
struct ScanRaw { v4u r[15]; float s0, s1; };

template <int MIX>
__device__ __forceinline__ void scan_item(const Frame& F, const Ids& I, int l, bool ctx_out, int b, int h, int dir) {
    const bf16* U = (const bf16*)(F.ws + WS_U); bf16* O2 = (bf16*)(F.ws + WS_O2);
    LAS unsigned char* sm = F.lds;
    const int lane = I.lane, wave = I.wave, fr = lane & 15, fq = lane >> 4, rt = wave >> 1, cp = wave & 1;
    const int tk = I.tid >> 3, d0 = (I.tid & 7) * 8;
    float c_la = 0.f, c_b0 = 0.f, c_b1 = 0.f, c_dskip = 0.f;
    if (MIX == 0) c_la = log_sigmoid_f(inp(F.lds, 10)[(l * 2 + dir) * 4 + h]);
    if (MIX == 2) { c_b0 = inp(F.lds, 17)[(l * 2 + dir) * 4 + h]; c_b1 = -expf(inp(F.lds, 18)[(l * 2 + dir) * 4 + h]); c_dskip = inp(F.lds, 19)[l * 4 + h]; }
    if (MIX == 3) { c_b0 = inp(F.lds, 21)[((l * 2 + dir) * 2 + 0) * 4 + h]; c_b1 = inp(F.lds, 21)[((l * 2 + dir) * 2 + 1) * 4 + h]; }
    float invf[8];
#pragma unroll
    for (int j = 0; j < 8; ++j) invf[j] = MIX == 0 ? exp2f(-(float)((d0 & 15) + j) * (13.287712379549449f / 16.0f)) * 0.15915494309189535f : 0.f;
    float gwr[16]; float gbr = 0.f;
    if (MIX == 1) { const float* gw_ = inp(F.lds, 12) + (size_t)(l * 2 + dir) * 16 * 128 + h * 32 + (I.tid & 31);
#pragma unroll
        for (int r = 0; r < 16; ++r) gwr[r] = gw_[r * 128];
        gbr = inp(F.lds, 13)[(l * 2 + dir) * 128 + h * 32 + (I.tid & 31)]; }
    if (MIX == 2) {
        LAS float* cwl = (LAS float*)(sm + CS_GM); const float* cw = inp(F.lds, 15) + (size_t)l * 5 * 512; const float* cb = inp(F.lds, 16) + l * 512; const int g = h >> 1;
        for (int i = I.tid; i < 6 * 192; i += 512) { const int w = i / 192, c = i % 192; const int ch = c < 64 ? h * 64 + c : (c < 128 ? 256 + g * 64 + (c - 64) : 384 + g * 64 + (c - 128));
            cwl[i] = w < 5 ? cw[w * 512 + ch] : cb[ch]; }
    }
    for (int i = I.tid; i < IMGB / 4; i += 512) ((LAS unsigned*)(sm + CS_ST))[i] = 0u;
    if (I.tid < 32) ((LAS unsigned*)(sm + CS_NS))[I.tid] = 0u;
    f32x4 S[2], nst; S[0] = (f32x4){0.f, 0.f, 0.f, 0.f}; S[1] = S[0]; nst = S[0];
    __syncthreads();

    auto chunk_rows = [&](int cc, int& rowbase, int& len, int& pos0) { const bool isctx = cc < 4; len = isctx ? CTXL : SEQ; pos0 = 64 * (isctx ? cc : cc - 4); rowbase = isctx ? NLAT + b * CTXL : b * SEQ; };
    auto tok_of = [&](int len, int pos) { return dir ? len - 1 - pos : pos; };

    auto issue = [&](int cc, ScanRaw& R) {
        int rowbase, len, pos0; chunk_rows(cc, rowbase, len, pos0);
        const int t = tok_of(len, pos0 + tk); const bf16* ur = U + (size_t)(rowbase + t) * INP;
        const int tl = tok_of(len, pos0 + lane); const bf16* ul = U + (size_t)(rowbase + tl) * INP;
        if (MIX == 0) {
            const int poff = ((d0 & 31) < 16) ? 16 : -16;
            R.r[0] = *(const v4u*)(ur + C_RET + h * 64 + d0); R.r[1] = *(const v4u*)(ur + C_RET + 256 + h * 64 + d0); R.r[2] = *(const v4u*)(ur + C_RET + 512 + h * 64 + d0);
            R.r[3] = *(const v4u*)(ur + C_RET + h * 64 + d0 + poff); R.r[4] = *(const v4u*)(ur + C_RET + 256 + h * 64 + d0 + poff);
        } else if (MIX == 1) {
            R.r[2] = *(const v4u*)(ur + C_GLA + 256 + h * 64 + d0);
            if (d0 < 32) { R.r[0] = *(const v4u*)(ur + C_GLA + h * 32 + d0); R.r[1] = *(const v4u*)(ur + C_GLA + 128 + h * 32 + d0); } else { R.r[0] = (v4u){0u, 0u, 0u, 0u}; R.r[1] = R.r[0]; }
            const int tq = I.tid >> 5;
#pragma unroll
            for (int u = 0; u < 4; ++u) { const int tu = tok_of(len, pos0 + 4 * tq + u); const bf16* uu = U + (size_t)(rowbase + tu) * INP + C_GLA + 768; R.r[3 + 2 * u] = *(const v4u*)uu; R.r[4 + 2 * u] = *(const v4u*)(uu + 8); }
        } else if (MIX == 2) {
            const int g = h >> 1;
#pragma unroll
            for (int w = 0; w < 5; ++w) { const int tt = t + w - 2; const bool ok = tt >= 0 && tt < len; const bf16* up = U + (size_t)(rowbase + (ok ? tt : t)) * INP + C_SSD + 256;
                const v4u z = (v4u){0u, 0u, 0u, 0u};
                const v4u x0 = *(const v4u*)(up + h * 64 + d0), x1 = *(const v4u*)(up + 256 + g * 64 + d0), x2 = *(const v4u*)(up + 384 + g * 64 + d0);
                R.r[3 * w] = ok ? x0 : z; R.r[3 * w + 1] = ok ? x1 : z; R.r[3 * w + 2] = ok ? x2 : z; }
            R.s0 = bf_lo((unsigned)ul[C_SSD + 768 + dir * 4 + h]);
        } else {
            R.r[0] = *(const v4u*)(ur + C_ML + h * 64 + d0); R.r[1] = *(const v4u*)(ur + C_ML + 256 + h * 64 + d0); R.r[2] = *(const v4u*)(ur + C_ML + 512 + h * 64 + d0);
            R.s0 = bf_lo((unsigned)ul[C_ML + 1024 + dir * 8 + h]); R.s1 = bf_lo((unsigned)ul[C_ML + 1024 + dir * 8 + 4 + h]);
        }
    };
    auto finish = [&](int cc, const ScanRaw& R) {
        int rowbase, len, pos0; chunk_rows(cc, rowbase, len, pos0);
        LAS unsigned char* set = sm + (cc & 1) * CS_SET;
        LAS float* Gs = (LAS float*)(set + 4 * IMGB); LAS float* Ws = Gs + 64; LAS float* ELs = Gs + 128; LAS float* DTs = Gs + 192;
        f32x8 q, k, kp, v;
        if (MIX != 1) {
            float la, w = 1.f, dt = 1.f;
            if (MIX == 0) la = c_la;
            else if (MIX == 2) { dt = softplus_q(R.s0 + c_b0); la = dt * c_b1; }
            else { w = __expf(R.s0 + c_b0); la = log_sigmoid_q(R.s1 + c_b1); }
            const float g = wave_incl_scan(la, lane), gl = rdlane(g, 63);
            if (wave == 0) { Gs[lane] = g; Ws[lane] = w; ELs[lane] = __expf(gl); DTs[lane] = dt; }
            const float g_tk = shidx(g, tk), w_tk = shidx(w, tk), dt_tk = shidx(dt, tk);
            const float ck = __expf(gl - g_tk) * w_tk;
            if (MIX == 0) {
                q = cvt8(R.r[0]); k = cvt8(R.r[1]); v = cvt8(R.r[2]);
                q.a = q.a * 0.125f; q.b = q.b * 0.125f;
                if (cc >= 4) {
                    f32x8 qp = cvt8(R.r[3]), kpp = cvt8(R.r[4]); qp.a = qp.a * 0.125f; qp.b = qp.b * 0.125f;
                    const int t = tok_of(len, pos0 + tk); const int dd = d0 & 31; const bool first = dd < 16;
                    const float posv = (d0 < 32) ? (float)(t >> 6) : (float)(t & 63);
                    float qa[8], ka[8], qb[8], kb[8];
#pragma unroll
                    for (int j = 0; j < 4; ++j) { qa[j] = q.a[j]; qa[4 + j] = q.b[j]; ka[j] = k.a[j]; ka[4 + j] = k.b[j]; qb[j] = qp.a[j]; qb[4 + j] = qp.b[j]; kb[j] = kpp.a[j]; kb[4 + j] = kpp.b[j]; }
#pragma unroll
                    for (int j = 0; j < 8; ++j) { const float rev = posv * invf[j]; const float cs = __builtin_amdgcn_cosf(rev), sn = __builtin_amdgcn_sinf(rev);
                        const float qn = first ? qa[j] * cs - qb[j] * sn : qb[j] * sn + qa[j] * cs, kn = first ? ka[j] * cs - kb[j] * sn : kb[j] * sn + ka[j] * cs; qa[j] = qn; ka[j] = kn; }
#pragma unroll
                    for (int j = 0; j < 4; ++j) { q.a[j] = qa[j]; q.b[j] = qa[4 + j]; k.a[j] = ka[j]; k.b[j] = ka[4 + j]; }
                }
            } else if (MIX == 2) {
                const LAS float* cwl = (const LAS float*)(sm + CS_GM);
                f32x8 ax, ab, ac;
                ax.a = *(const LAS f32x4*)(cwl + 5 * 192 + d0); ax.b = *(const LAS f32x4*)(cwl + 5 * 192 + d0 + 4);
                ab.a = *(const LAS f32x4*)(cwl + 5 * 192 + 64 + d0); ab.b = *(const LAS f32x4*)(cwl + 5 * 192 + 64 + d0 + 4);
                ac.a = *(const LAS f32x4*)(cwl + 5 * 192 + 128 + d0); ac.b = *(const LAS f32x4*)(cwl + 5 * 192 + 128 + d0 + 4);
#pragma unroll
                for (int w5 = 0; w5 < 5; ++w5) { const f32x8 x0 = cvt8(R.r[3 * w5]), x1 = cvt8(R.r[3 * w5 + 1]), x2 = cvt8(R.r[3 * w5 + 2]); const LAS float* cwr = cwl + w5 * 192 + d0;
                    ax.a += x0.a * *(const LAS f32x4*)(cwr); ax.b += x0.b * *(const LAS f32x4*)(cwr + 4);
                    ab.a += x1.a * *(const LAS f32x4*)(cwr + 64); ab.b += x1.b * *(const LAS f32x4*)(cwr + 68);
                    ac.a += x2.a * *(const LAS f32x4*)(cwr + 128); ac.b += x2.b * *(const LAS f32x4*)(cwr + 132); }
#pragma unroll
                for (int j = 0; j < 4; ++j) { v.a[j] = silu_q(ax.a[j]) * dt_tk; v.b[j] = silu_q(ax.b[j]) * dt_tk; k.a[j] = silu_q(ab.a[j]); k.b[j] = silu_q(ab.b[j]); q.a[j] = silu_q(ac.a[j]); q.b[j] = silu_q(ac.b[j]); }
            } else {
                q = cvt8(R.r[0]); k = cvt8(R.r[1]); v = cvt8(R.r[2]); k.a = k.a * 0.125f; k.b = k.b * 0.125f;
            }
            kp.a = k.a * ck; kp.b = k.b * ck;
        } else {
            LAS float* GS = (LAS float*)(sm + CS_GS); LAS float* GM = (LAS float*)(sm + CS_GM);
            const int d = I.tid & 31, tq = I.tid >> 5; float c[4]; float run = 0.f;
#pragma unroll
            for (int u = 0; u < 4; ++u) { const f32x8 l0 = cvt8(R.r[3 + 2 * u]), l1 = cvt8(R.r[4 + 2 * u]); float z = gbr;
#pragma unroll
                for (int r = 0; r < 4; ++r) { z += l0.a[r] * gwr[r] + l0.b[r] * gwr[4 + r] + l1.a[r] * gwr[8 + r] + l1.b[r] * gwr[12 + r]; }
                run += log_sigmoid_q(z) * (1.0f / 16.0f); c[u] = run; }
            GS[tq * 32 + d] = run;
            __syncthreads();
            float off = 0.f, tot = 0.f;
#pragma unroll
            for (int qq = 0; qq < 16; ++qq) { const float s = GS[qq * 32 + d]; off += (qq < tq) ? s : 0.f; tot += s; }
#pragma unroll
            for (int u = 0; u < 4; ++u) GM[(4 * tq + u) * 32 + d] = off + c[u];
            if (tq == 0) { ELs[d] = __expf(tot); ELs[32 + d] = 1.0f; }
            if (I.tid < 64) { Gs[I.tid] = 0.f; Ws[I.tid] = 1.0f; DTs[I.tid] = 1.0f; }
            __syncthreads();
            q = cvt8(R.r[0]); k = cvt8(R.r[1]); v = cvt8(R.r[2]);
            if (d0 < 32) {
                const f32x4 g0 = *(const LAS f32x4*)(GM + tk * 32 + d0), g1 = *(const LAS f32x4*)(GM + tk * 32 + d0 + 4), e0 = *(const LAS f32x4*)(GM + 63 * 32 + d0), e1 = *(const LAS f32x4*)(GM + 63 * 32 + d0 + 4);
#pragma unroll
                for (int j = 0; j < 4; ++j) { kp.a[j] = k.a[j] * __expf(e0[j] - g0[j]); kp.b[j] = k.b[j] * __expf(e1[j] - g1[j]);
                    q.a[j] = q.a[j] * 0.17677669529663687f * __expf(g0[j]); q.b[j] = q.b[j] * 0.17677669529663687f * __expf(g1[j]); k.a[j] = k.a[j] * __expf(-g0[j]); k.b[j] = k.b[j] * __expf(-g1[j]); }
            } else { kp = k; }
        }
        const int ro = tk * 144 + d0 * 2;
        *(LAS v4u*)(set + ro) = pack8(q.a, q.b); *(LAS v4u*)(set + IMGB + ro) = pack8(k.a, k.b); *(LAS v4u*)(set + 2 * IMGB + ro) = pack8(kp.a, kp.b); *(LAS v4u*)(set + 3 * IMGB + ro) = pack8(v.a, v.b);
    };

    ScanRaw R;
    issue(0, R); finish(0, R);
    const bf16x8s ones = (bf16x8s){0x3F80, 0x3F80, 0x3F80, 0x3F80, 0x3F80, 0x3F80, 0x3F80, 0x3F80};
    for (int cc = 0; cc < 36; ++cc) {
        __syncthreads();
        if (cc + 1 < 36) issue(cc + 1, R);
        const LAS unsigned char* set = sm + (cc & 1) * CS_SET;
        const LAS unsigned char* Qs = set; const LAS unsigned char* Ks = set + IMGB; const LAS unsigned char* KPs = set + 2 * IMGB; const LAS unsigned char* Vs = set + 3 * IMGB;
        const LAS float* Gs = (const LAS float*)(set + 4 * IMGB); const LAS float* Ws = Gs + 64; const LAS float* ELs = Gs + 128; const LAS float* DTs = Gs + 192;
        const LAS unsigned char* STr = sm + CS_ST + (cc & 1) * IMGB; LAS unsigned char* STw = sm + CS_ST + ((cc + 1) & 1) * IMGB;
        const LAS unsigned char* NSr = sm + CS_NS + (cc & 1) * 128; LAS unsigned char* NSw = sm + CS_NS + ((cc + 1) & 1) * 128;
        LAS unsigned char* Ps = sm + CS_P;
        const int irow = 16 * rt + fr; const float gi = Gs[irow];
        const bf16x8s qf0 = rowfrag(Qs, 16 * rt, 0, fr, fq), qf1 = rowfrag(Qs, 16 * rt, 1, fr, fq);
#pragma unroll
        for (int u = 0; u < 2; ++u) { const int jt = 2 * cp + u; v2u pw = (v2u){0u, 0u};
            if (jt <= rt) {
                f32x4 sc = (f32x4){0.f, 0.f, 0.f, 0.f};
                sc = mfma16(rowfrag(Ks, 16 * jt, 0, fr, fq), qf0, sc); sc = mfma16(rowfrag(Ks, 16 * jt, 1, fr, fq), qf1, sc);
                const f32x4 gj = *(const LAS f32x4*)(Gs + 16 * jt + 4 * fq), wj = *(const LAS f32x4*)(Ws + 16 * jt + 4 * fq);
                float pv[4];
#pragma unroll
                for (int r = 0; r < 4; ++r) { const int j = 16 * jt + 4 * fq + r; pv[r] = (j <= irow) ? sc[r] * __expf(fminf(gi - gj[r], 0.f)) * wj[r] : 0.f; }
                pw.x = pg8::cvt_pk_safe(pv[0], pv[1]); pw.y = pg8::cvt_pk_safe(pv[2], pv[3]);
            }
            *(LAS v2u*)(Ps + irow * 144 + (16 * jt + 4 * fq) * 2) = pw; }
        f32x4 o2[2], e2 = (f32x4){0.f, 0.f, 0.f, 0.f};
#pragma unroll
        for (int u = 0; u < 2; ++u) { const int ct = 2 * cp + u; o2[u] = (f32x4){0.f, 0.f, 0.f, 0.f};
            o2[u] = mfma16(rowfrag(STr, 16 * ct, 0, fr, fq), qf0, o2[u]); o2[u] = mfma16(rowfrag(STr, 16 * ct, 1, fr, fq), qf1, o2[u]); }
        if (MIX == 3) { const bf16x8s n0 = *(const LAS bf16x8s*)(NSr + fq * 16), n1 = *(const LAS bf16x8s*)(NSr + 64 + fq * 16); e2 = mfma16(n0, qf0, e2); e2 = mfma16(n1, qf1, e2); }
        const bf16x8s kf0 = trfrag(KPs, 0, 16 * rt, lane), kf1 = trfrag(KPs, 32, 16 * rt, lane);
        bf16x8s vf[2][2];
#pragma unroll
        for (int u = 0; u < 2; ++u) { vf[u][0] = trfrag(Vs, 0, 16 * (2 * cp + u), lane); vf[u][1] = trfrag(Vs, 32, 16 * (2 * cp + u), lane); }
        const f32x4 el = *(const LAS f32x4*)(ELs + 16 * rt + 4 * fq);
#pragma unroll
        for (int u = 0; u < 2; ++u) { const int ct = 2 * cp + u; S[u] = S[u] * el; S[u] = mfma16(kf0, vf[u][0], S[u]); S[u] = mfma16(kf1, vf[u][1], S[u]);
            v2u sw; sw.x = pg8::cvt_pk_safe(S[u][0], S[u][1]); sw.y = pg8::cvt_pk_safe(S[u][2], S[u][3]);
            *(LAS v2u*)(STw + (16 * ct + fr) * 144 + (16 * rt + 4 * fq) * 2) = sw; }
        if (MIX == 3) { nst = nst * el; nst = mfma16(kf0, ones, nst); nst = mfma16(kf1, ones, nst);
            if (fr == 0 && cp == 0) { v2u nw; nw.x = pg8::cvt_pk_safe(nst[0], nst[1]); nw.y = pg8::cvt_pk_safe(nst[2], nst[3]); *(LAS v2u*)(NSw + (16 * rt + 4 * fq) * 2) = nw; } }
        __syncthreads();
        const bf16x8s pf0 = rowfrag(Ps, 16 * rt, 0, fr, fq), pf1 = rowfrag(Ps, 16 * rt, 1, fr, fq);
        const float egi = __expf(gi);
        float sden = 1.0f;
        if (MIX == 3) { f32x4 e1 = (f32x4){0.f, 0.f, 0.f, 0.f}; e1 = mfma16(ones, pf0, e1); e1 = mfma16(ones, pf1, e1); sden = 1.0f / fmaxf(fabsf(e1[0] + egi * e2[0]), 1.0f); }
        int rowbase, len, pos0; chunk_rows(cc, rowbase, len, pos0);
        const bool wr_out = cc >= 4 || ctx_out;
        const int trow = rowbase + tok_of(len, pos0 + irow);
#pragma unroll
        for (int u = 0; u < 2; ++u) { const int ct = 2 * cp + u; f32x4 o1 = (f32x4){0.f, 0.f, 0.f, 0.f};
            o1 = mfma16(vf[u][0], pf0, o1); o1 = mfma16(vf[u][1], pf1, o1);
            f32x4 o = (o1 + o2[u] * egi) * sden;
            if (MIX == 2) { if (dir == 0) { const v2u xw = *(const LAS v2u*)(Vs + irow * 144 + (16 * ct + 4 * fq) * 2); const float sk = c_dskip / DTs[irow];
                o += (f32x4){bf_lo(xw.x), bf_hi(xw.x), bf_lo(xw.y), bf_hi(xw.y)} * sk; } }
            if (wr_out) st_bf4(O2 + ((size_t)dir * NROWS + trow) * D + MIX * 256 + h * 64 + 16 * ct + 4 * fq, o); }
        if (cc + 1 < 36) finish(cc + 1, R);
    }
    __syncthreads();
}
__device__ __forceinline__ void p3_scan_mfma(Frame& F, int l, bool ctx_out, int mixmask) {
    const Ids I = fresh_ids(F.wave_s);
    for (int item = F.vcu; item < 256; item += F.G) {
        const int dir = item & 1, h = (item >> 1) & 3, mixer = (item >> 3) & 3, b = item >> 5;
        if (!((mixmask >> mixer) & 1)) continue;
        if (mixer == 0) scan_item<0>(F, I, l, ctx_out, b, h, dir);
        else if (mixer == 1) scan_item<1>(F, I, l, ctx_out, b, h, dir);
        else if (mixer == 2) scan_item<2>(F, I, l, ctx_out, b, h, dir);
        else scan_item<3>(F, I, l, ctx_out, b, h, dir);
    }
}

struct ConvRaw { float t[32]; bf16* dp; };
__device__ __forceinline__ void conv_issue(const LAS unsigned char* lds, unsigned char* ws, int l, int idx, int lane, ConvRaw& C) {
    const int e = idx / 2304, q = idx % 2304, kind = q / 768, t = q % 768;
    const float* sp; size_t ldw;
    if (kind < 2) { const int kb = t / 24, nb = t % 24, n = 64 * nb + lane; ldw = FF;
        sp = (kind ? inp(lds, 25) : inp(lds, 24)) + ((size_t)l * NE + e) * 1024 * FF + (size_t)(32 * kb) * FF + n;
        C.dp = (bf16*)(ws + WS_WTGU) + (size_t)l * NE * 3072 * 1024 + (size_t)MapGU{e * 3072, kind}(n) * 1024 + 32 * kb; }
    else { const int kb = t / 16, nb = t % 16, n = 64 * nb + lane; ldw = 1024;
        sp = inp(lds, 26) + ((size_t)l * NE + e) * FF * 1024 + (size_t)(32 * kb) * 1024 + n;
        C.dp = (bf16*)(ws + WS_WTDN) + (size_t)l * NE * 1024 * FF + (size_t)(e * 1024 + n) * FF + 32 * kb; }
#pragma unroll
    for (int i = 0; i < 32; ++i) C.t[i] = __builtin_nontemporal_load(sp + (size_t)i * ldw);
}
__device__ __forceinline__ void conv_finish(const ConvRaw& C) {
#pragma unroll
    for (int q = 0; q < 4; ++q) { v4u o; o.x = pg8::cvt_pk_bf16(C.t[8 * q], C.t[8 * q + 1]); o.y = pg8::cvt_pk_bf16(C.t[8 * q + 2], C.t[8 * q + 3]); o.z = pg8::cvt_pk_bf16(C.t[8 * q + 4], C.t[8 * q + 5]); o.w = pg8::cvt_pk_bf16(C.t[8 * q + 6], C.t[8 * q + 7]);
        *(v4u*)(C.dp + 8 * q) = o; }
}
constexpr size_t WS_NIN = WS_AFFT + 1179648;
constexpr int S1_SET = 2 * IMGB + 256, S1_GS = 2 * S1_SET, S1_GM = S1_GS + 2048, S1_END = S1_GM + 8192;
struct StRaw { v4u r[10]; float s0, s1; };
__device__ __forceinline__ int nat_chunk(int cc, int dir) { return cc < 4 ? (dir ? 3 - cc : cc) : (dir ? 35 - cc : cc - 4); }

template <int MIX>
__device__ __forceinline__ void state_item(const Frame& F, const Ids& I, int l, int b, int h, int dir, int item) {
    const bf16* U = (const bf16*)(F.ws + WS_U); bf16* SIN = (bf16*)(F.ws + WS_O2) + (size_t)item * 36 * 4096;
    float* NIN = (float*)(F.ws + WS_NIN) + (size_t)((b * 4 + h) * 2 + dir) * 36 * 64;
    LAS unsigned char* sm = F.lds;
    const int lane = I.lane, wave = I.wave, fr = lane & 15, fq = lane >> 4, rt = wave >> 1, cp = wave & 1;
    const int tk = I.tid >> 3, d0 = (I.tid & 7) * 8;
    float c_la = 0.f, c_b0 = 0.f, c_b1 = 0.f;
    if (MIX == 0) c_la = log_sigmoid_f(inp(F.lds, 10)[(l * 2 + dir) * 4 + h]);
    if (MIX == 2) { c_b0 = inp(F.lds, 17)[(l * 2 + dir) * 4 + h]; c_b1 = -expf(inp(F.lds, 18)[(l * 2 + dir) * 4 + h]); }
    if (MIX == 3) { c_b0 = inp(F.lds, 21)[((l * 2 + dir) * 2 + 0) * 4 + h]; c_b1 = inp(F.lds, 21)[((l * 2 + dir) * 2 + 1) * 4 + h]; }
    float invf[8];
#pragma unroll
    for (int j = 0; j < 8; ++j) invf[j] = MIX == 0 ? exp2f(-(float)((d0 & 15) + j) * (13.287712379549449f / 16.0f)) * 0.15915494309189535f : 0.f;
    float gwr[16]; float gbr = 0.f;
    if (MIX == 1) { const float* gw_ = inp(F.lds, 12) + (size_t)(l * 2 + dir) * 16 * 128 + h * 32 + (I.tid & 31);
#pragma unroll
        for (int r = 0; r < 16; ++r) gwr[r] = gw_[r * 128];
        gbr = inp(F.lds, 13)[(l * 2 + dir) * 128 + h * 32 + (I.tid & 31)]; }
    if (MIX == 2) {
        LAS float* cwl = (LAS float*)(sm + S1_GM); const float* cw = inp(F.lds, 15) + (size_t)l * 5 * 512; const float* cb = inp(F.lds, 16) + l * 512; const int g = h >> 1;
        for (int i = I.tid; i < 6 * 128; i += 512) { const int w = i >> 7, c = i & 127; const int ch = c < 64 ? h * 64 + c : 256 + g * 64 + (c - 64); cwl[i] = w < 5 ? cw[w * 512 + ch] : cb[ch]; }
    }
    f32x4 S[2], nst; S[0] = (f32x4){0.f, 0.f, 0.f, 0.f}; S[1] = S[0]; nst = S[0];
    __syncthreads();

    auto issue = [&](int cc, StRaw& R) {
        const bool isctx = cc < 4; const int len = isctx ? CTXL : SEQ, rowbase = isctx ? NLAT + b * CTXL : b * SEQ, t0 = 64 * nat_chunk(cc, dir);
        const int t = t0 + tk; const bf16* ur = U + (size_t)(rowbase + t) * INP; const bf16* ul = U + (size_t)(rowbase + t0 + lane) * INP;
        if (MIX == 0) { const int poff = ((d0 & 31) < 16) ? 16 : -16;
            R.r[0] = *(const v4u*)(ur + C_RET + 256 + h * 64 + d0); R.r[1] = *(const v4u*)(ur + C_RET + 512 + h * 64 + d0); R.r[2] = *(const v4u*)(ur + C_RET + 256 + h * 64 + d0 + poff);
        } else if (MIX == 1) {
            R.r[1] = *(const v4u*)(ur + C_GLA + 256 + h * 64 + d0);
            R.r[0] = d0 < 32 ? *(const v4u*)(ur + C_GLA + 128 + h * 32 + d0) : (v4u){0u, 0u, 0u, 0u};
            const int tq = I.tid >> 5;
#pragma unroll
            for (int u = 0; u < 4; ++u) { const bf16* uu = U + (size_t)(rowbase + t0 + 4 * tq + u) * INP + C_GLA + 768; R.r[2 + 2 * u] = *(const v4u*)uu; R.r[3 + 2 * u] = *(const v4u*)(uu + 8); }
        } else if (MIX == 2) { const int g = h >> 1;
#pragma unroll
            for (int w = 0; w < 5; ++w) { const int tt = t + w - 2; const bool ok = tt >= 0 && tt < len; const bf16* up = U + (size_t)(rowbase + (ok ? tt : t)) * INP + C_SSD + 256;
                const v4u z = (v4u){0u, 0u, 0u, 0u}; const v4u x0 = *(const v4u*)(up + h * 64 + d0), x1 = *(const v4u*)(up + 256 + g * 64 + d0);
                R.r[2 * w] = ok ? x0 : z; R.r[2 * w + 1] = ok ? x1 : z; }
            R.s0 = bf_lo((unsigned)ul[C_SSD + 768 + dir * 4 + h]);
        } else {
            R.r[0] = *(const v4u*)(ur + C_ML + 256 + h * 64 + d0); R.r[1] = *(const v4u*)(ur + C_ML + 512 + h * 64 + d0);
            R.s0 = bf_lo((unsigned)ul[C_ML + 1024 + dir * 8 + h]); R.s1 = bf_lo((unsigned)ul[C_ML + 1024 + dir * 8 + 4 + h]);
        }
    };
    auto finish = [&](int cc, const StRaw& R) {
        LAS unsigned char* set = sm + (cc & 1) * S1_SET; LAS float* ELs = (LAS float*)(set + 2 * IMGB);
        f32x8 k, kp, v;
        if (MIX != 1) {
            float la, w = 1.f;
            if (MIX == 0) la = c_la;
            else if (MIX == 2) { w = softplus_q(R.s0 + c_b0); la = w * c_b1; }
            else { w = __expf(R.s0 + c_b0); la = log_sigmoid_q(R.s1 + c_b1); }
            const float G = wave_incl_scan(la, lane), T = rdlane(G, 63);
            if (wave == 0) ELs[lane] = __expf(T);
            const float e_l = (dir ? __expf(G - la) : __expf(T - G)) * w;
            const float ck = shidx(e_l, tk);
            if (MIX == 0) { k = cvt8(R.r[0]); v = cvt8(R.r[1]);
                if (cc >= 4) { const f32x8 kq = cvt8(R.r[2]); const int t = 64 * nat_chunk(cc, dir) + tk; const bool first = (d0 & 31) < 16;
                    const float posv = (d0 < 32) ? (float)(t >> 6) : (float)(t & 63);
#pragma unroll
                    for (int j = 0; j < 8; ++j) { const float rev = posv * invf[j]; const float cs = __builtin_amdgcn_cosf(rev), sn = __builtin_amdgcn_sinf(rev);
                        const float own = j < 4 ? k.a[j & 3] : k.b[j & 3], par = j < 4 ? kq.a[j & 3] : kq.b[j & 3]; const float kn = first ? own * cs - par * sn : par * sn + own * cs;
                        if (j < 4) k.a[j & 3] = kn; else k.b[j & 3] = kn; } }
            } else if (MIX == 2) { const LAS float* cwl = (const LAS float*)(sm + S1_GM);
                f32x8 ax, ab; ax.a = *(const LAS f32x4*)(cwl + 5 * 128 + d0); ax.b = *(const LAS f32x4*)(cwl + 5 * 128 + d0 + 4); ab.a = *(const LAS f32x4*)(cwl + 5 * 128 + 64 + d0); ab.b = *(const LAS f32x4*)(cwl + 5 * 128 + 64 + d0 + 4);
#pragma unroll
                for (int w5 = 0; w5 < 5; ++w5) { const f32x8 x0 = cvt8(R.r[2 * w5]), x1 = cvt8(R.r[2 * w5 + 1]); const LAS float* cwr = cwl + w5 * 128 + d0;
                    ax.a += x0.a * *(const LAS f32x4*)(cwr); ax.b += x0.b * *(const LAS f32x4*)(cwr + 4); ab.a += x1.a * *(const LAS f32x4*)(cwr + 64); ab.b += x1.b * *(const LAS f32x4*)(cwr + 68); }
#pragma unroll
                for (int j = 0; j < 4; ++j) { v.a[j] = silu_q(ax.a[j]); v.b[j] = silu_q(ax.b[j]); k.a[j] = silu_q(ab.a[j]); k.b[j] = silu_q(ab.b[j]); }
            } else { k = cvt8(R.r[0]); v = cvt8(R.r[1]); k.a = k.a * 0.125f; k.b = k.b * 0.125f; }
            kp.a = k.a * ck; kp.b = k.b * ck;
        } else {
            LAS float* GS = (LAS float*)(sm + S1_GS); LAS float* GM = (LAS float*)(sm + S1_GM);
            const int d = I.tid & 31, tq = I.tid >> 5; float c[4], la4[4]; float run = 0.f;
#pragma unroll
            for (int u = 0; u < 4; ++u) { const f32x8 l0 = cvt8(R.r[2 + 2 * u]), l1 = cvt8(R.r[3 + 2 * u]); float z = gbr;
#pragma unroll
                for (int r = 0; r < 4; ++r) z += l0.a[r] * gwr[r] + l0.b[r] * gwr[4 + r] + l1.a[r] * gwr[8 + r] + l1.b[r] * gwr[12 + r];
                la4[u] = log_sigmoid_q(z) * (1.0f / 16.0f); run += la4[u]; c[u] = run; }
            GS[tq * 32 + d] = run;
            __syncthreads();
            float off = 0.f, tot = 0.f;
#pragma unroll
            for (int qq = 0; qq < 16; ++qq) { const float s = GS[qq * 32 + d]; off += (qq < tq) ? s : 0.f; tot += s; }
#pragma unroll
            for (int u = 0; u < 4; ++u) GM[(4 * tq + u) * 32 + d] = dir ? (off + c[u] - la4[u]) : (tot - (off + c[u]));
            if (tq == 0) { ELs[d] = __expf(tot); ELs[32 + d] = 1.0f; }
            __syncthreads();
            k = cvt8(R.r[0]); v = cvt8(R.r[1]);
            if (d0 < 32) { const f32x4 g0 = *(const LAS f32x4*)(GM + tk * 32 + d0), g1 = *(const LAS f32x4*)(GM + tk * 32 + d0 + 4);
#pragma unroll
                for (int j = 0; j < 4; ++j) { kp.a[j] = k.a[j] * __expf(g0[j]); kp.b[j] = k.b[j] * __expf(g1[j]); } }
            else kp = k;
        }
        const int ro = tk * 144 + d0 * 2;
        *(LAS v4u*)(set + ro) = pack8(kp.a, kp.b); *(LAS v4u*)(set + IMGB + ro) = pack8(v.a, v.b);
    };

    StRaw Ra, Rb; ConvRaw CR;
    issue(0, Ra); issue(1, Rb); finish(0, Ra);
    const bf16x8s ones = (bf16x8s){0x3F80, 0x3F80, 0x3F80, 0x3F80, 0x3F80, 0x3F80, 0x3F80, 0x3F80};
    auto chunk_body = [&](const int cc, const int cmode, StRaw& Rfar, const StRaw& Rnext) {
        __syncthreads();
        if (cc + 2 < 36) issue(cc + 2, Rfar);
        if (cmode == 1) conv_issue(F.lds, F.ws, l, (F.vcu * NWAVES + wave) * 18 + (cc >> 1), lane, CR);
        const LAS unsigned char* set = sm + (cc & 1) * S1_SET; const LAS unsigned char* KPs = set; const LAS unsigned char* Vs = set + IMGB; const LAS float* ELs = (const LAS float*)(set + 2 * IMGB);
#pragma unroll
        for (int u = 0; u < 2; ++u) { const int ct = 2 * cp + u; v2u sw; sw.x = pg8::cvt_pk_safe(S[u][0], S[u][1]); sw.y = pg8::cvt_pk_safe(S[u][2], S[u][3]);
            *(v2u*)(SIN + (size_t)cc * 4096 + (16 * ct + fr) * 64 + 16 * rt + 4 * fq) = sw; }
        if (MIX == 3) { if (fr == 0 && cp == 0) *(f32x4*)(NIN + cc * 64 + 16 * rt + 4 * fq) = nst; }
        const bf16x8s kf0 = trfrag(KPs, 0, 16 * rt, lane), kf1 = trfrag(KPs, 32, 16 * rt, lane);
        const f32x4 el = *(const LAS f32x4*)(ELs + 16 * rt + 4 * fq);
#pragma unroll
        for (int u = 0; u < 2; ++u) { const int ct = 2 * cp + u; const bf16x8s v0 = trfrag(Vs, 0, 16 * ct, lane), v1 = trfrag(Vs, 32, 16 * ct, lane);
            S[u] = S[u] * el; S[u] = mfma16(kf0, v0, S[u]); S[u] = mfma16(kf1, v1, S[u]); }
        if (MIX == 3) { nst = nst * el; nst = mfma16(kf0, ones, nst); nst = mfma16(kf1, ones, nst); }
        if (cc + 1 < 36) finish(cc + 1, Rnext);
        if (cmode == 2) conv_finish(CR);
    };
    for (int cc = 0; cc < 36; cc += 2) { chunk_body(cc, 1, Ra, Rb); chunk_body(cc + 1, 2, Rb, Ra); }
    __syncthreads();
}
__device__ __forceinline__ void p3a_state(const Frame& F_, int l) {
    const Frame F = fresh_frame(F_); const Ids I = fresh_ids(F.wave_s);
    for (int item = F.vcu; item < 256; item += F.G) {
        const int dir = item & 1, h = (item >> 1) & 3, mixer = (item >> 3) & 3, b = item >> 5;
        if (mixer == 0) state_item<0>(F, I, l, b, h, dir, item);
        else if (mixer == 1) state_item<1>(F, I, l, b, h, dir, item);
        else if (mixer == 2) state_item<2>(F, I, l, b, h, dir, item);
        else state_item<3>(F, I, l, b, h, dir, item);
    }
}

constexpr int S2_Q = 0, S2_K = IMGB, S2_V = 2 * IMGB, S2_P = 3 * IMGB, S2_P2 = 4 * IMGB, S2_STF = 5 * IMGB, S2_STB = 6 * IMGB, S2_ARR = 7 * IMGB, S2_NV = S2_ARR + 1024, S2_STAT = S2_NV + 256,
              S2_GS = S2_STAT + 1024, S2_GM = S2_GS + 4096, S2_END = S2_GM + 16384;
constexpr int S2_CST = S2_END, S2_CST_END = S2_CST + 5440 * 4;
static_assert(S2_CST_END <= RING_BYTES && S1_END <= RING_BYTES, "mixer LDS maps");
struct OutAcc { f32x4 y[2]; };
struct HRaw { v4u r[17]; v2u g[2]; float s[4]; };
struct HItem { int mix, b, h, nc; bool isctx, last; };

template <int MIX>
__device__ __forceinline__ void s2_issue(const Frame& F, const Ids&, int l, const HItem& it, HRaw& R) {
    const Ids I = fresh_ids(F.wave_s);
    const bf16* U = (const bf16*)(F.ws + WS_U); const bf16* SINB = (const bf16*)(F.ws + WS_O2); const float* NINB = (const float*)(F.ws + WS_NIN);
    const int lane = I.lane, wave = I.wave, fr = lane & 15, fq = lane >> 4, rt = wave >> 1, cp = wave & 1, tk = I.tid >> 3, d0 = (I.tid & 7) * 8;
    const int b = it.b, h = it.h, nc = it.nc; const bool isctx = it.isctx;
    const int len = isctx ? CTXL : SEQ, rowbase = isctx ? NLAT + b * CTXL : b * SEQ, t0 = 64 * nc, t = t0 + tk;
    const int item_f = b * 32 + MIX * 8 + h * 2, cc_f = isctx ? nc : 4 + nc, cc_b = isctx ? 3 - nc : 35 - nc;
    const bf16* ur = U + (size_t)(rowbase + t) * INP; const bf16* ul = U + (size_t)(rowbase + t0 + lane) * INP;
    const int row = I.tid >> 3, pc = I.tid & 7;
    const int orow = rowbase + t0 + 16 * rt + fr;
    if (MIX == 0) { const int poff = ((d0 & 31) < 16) ? 16 : -16;
        R.r[0] = *(const v4u*)(ur + C_RET + h * 64 + d0); R.r[1] = *(const v4u*)(ur + C_RET + 256 + h * 64 + d0); R.r[2] = *(const v4u*)(ur + C_RET + 512 + h * 64 + d0);
        R.r[3] = *(const v4u*)(ur + C_RET + h * 64 + d0 + poff); R.r[4] = *(const v4u*)(ur + C_RET + 256 + h * 64 + d0 + poff);
        R.r[5] = *(const v4u*)(SINB + ((size_t)item_f * 36 + cc_f) * 4096 + row * 64 + 8 * pc); R.r[6] = *(const v4u*)(SINB + ((size_t)(item_f + 1) * 36 + cc_b) * 4096 + row * 64 + 8 * pc);
#pragma unroll
        for (int u = 0; u < 2; ++u) R.g[u] = *(const v2u*)(U + (size_t)orow * INP + C_RET + 768 + h * 64 + 16 * (2 * cp + u) + 4 * fq);
    } else if (MIX == 1) {
        R.r[2] = *(const v4u*)(ur + C_GLA + 256 + h * 64 + d0);
        if (d0 < 32) { R.r[0] = *(const v4u*)(ur + C_GLA + h * 32 + d0); R.r[1] = *(const v4u*)(ur + C_GLA + 128 + h * 32 + d0); } else { R.r[0] = (v4u){0u, 0u, 0u, 0u}; R.r[1] = R.r[0]; }
        R.r[3] = *(const v4u*)(SINB + ((size_t)(item_f + (pc >> 2)) * 36 + (pc < 4 ? cc_f : cc_b)) * 4096 + row * 64 + 8 * (pc & 3));
        const int tq = I.tid >> 5;
#pragma unroll
        for (int u = 0; u < 4; ++u) { const bf16* uu = U + (size_t)(rowbase + t0 + 4 * tq + u) * INP + C_GLA + 768; R.r[4 + 2 * u] = *(const v4u*)uu; R.r[5 + 2 * u] = *(const v4u*)(uu + 8); }
#pragma unroll
        for (int u = 0; u < 2; ++u) R.g[u] = *(const v2u*)(U + (size_t)orow * INP + C_GLA + 512 + h * 64 + 16 * (2 * cp + u) + 4 * fq);
    } else if (MIX == 2) { const int g = h >> 1;
#pragma unroll
        for (int w = 0; w < 5; ++w) { const int tt = t + w - 2; const bool ok = tt >= 0 && tt < len; const bf16* up = U + (size_t)(rowbase + (ok ? tt : t)) * INP + C_SSD + 256; const v4u z = (v4u){0u, 0u, 0u, 0u};
            const v4u x0 = *(const v4u*)(up + h * 64 + d0), x1 = *(const v4u*)(up + 256 + g * 64 + d0), x2 = *(const v4u*)(up + 384 + g * 64 + d0);
            R.r[3 * w] = ok ? x0 : z; R.r[3 * w + 1] = ok ? x1 : z; R.r[3 * w + 2] = ok ? x2 : z; }
        R.r[15] = *(const v4u*)(SINB + ((size_t)item_f * 36 + cc_f) * 4096 + row * 64 + 8 * pc); R.r[16] = *(const v4u*)(SINB + ((size_t)(item_f + 1) * 36 + cc_b) * 4096 + row * 64 + 8 * pc);
        R.s[0] = bf_lo((unsigned)ul[C_SSD + 768 + h]); R.s[1] = bf_lo((unsigned)ul[C_SSD + 768 + 4 + h]);
#pragma unroll
        for (int u = 0; u < 2; ++u) R.g[u] = *(const v2u*)(U + (size_t)orow * INP + C_SSD + h * 64 + 16 * (2 * cp + u) + 4 * fq);
    } else {
        R.r[0] = *(const v4u*)(ur + C_ML + h * 64 + d0); R.r[1] = *(const v4u*)(ur + C_ML + 256 + h * 64 + d0); R.r[2] = *(const v4u*)(ur + C_ML + 512 + h * 64 + d0);
        R.r[3] = *(const v4u*)(SINB + ((size_t)item_f * 36 + cc_f) * 4096 + row * 64 + 8 * pc); R.r[4] = *(const v4u*)(SINB + ((size_t)(item_f + 1) * 36 + cc_b) * 4096 + row * 64 + 8 * pc);
        if (I.tid < 32) R.r[5] = *(const v4u*)(NINB + ((size_t)((b * 4 + h) * 2 + (I.tid >> 4)) * 36 + ((I.tid >> 4) ? cc_b : cc_f)) * 64 + 4 * (I.tid & 15));
        R.s[0] = bf_lo((unsigned)ul[C_ML + 1024 + h]); R.s[1] = bf_lo((unsigned)ul[C_ML + 1024 + 4 + h]); R.s[2] = bf_lo((unsigned)ul[C_ML + 1024 + 8 + h]); R.s[3] = bf_lo((unsigned)ul[C_ML + 1024 + 12 + h]);
#pragma unroll
        for (int u = 0; u < 2; ++u) R.g[u] = *(const v2u*)(U + (size_t)orow * INP + C_ML + 768 + h * 64 + 16 * (2 * cp + u) + 4 * fq);
    }
}
template <int MIX>
__device__ __forceinline__ void s2_transform(const Frame& F, const Ids&, int l, const HItem& it, const HRaw& R) {
    const Ids I = fresh_ids(F.wave_s);
    LAS unsigned char* sm = F.lds;
    const int lane = I.lane, wave = I.wave, tk = I.tid >> 3, d0 = (I.tid & 7) * 8; const int h = it.h; const bool isctx = it.isctx; const int t = 64 * it.nc + tk;
    LAS float* GF = (LAS float*)(sm + S2_ARR); LAS float* HB = GF + 64; LAS float* WF = GF + 128; LAS float* WB = GF + 192;
    const int row = I.tid >> 3, pc = I.tid & 7;
    f32x8 q, k, v;
    if (MIX != 1) {
        const v4u sf = MIX == 0 ? R.r[5] : (MIX == 2 ? R.r[15] : R.r[3]), sb = MIX == 0 ? R.r[6] : (MIX == 2 ? R.r[16] : R.r[4]);
        *(LAS v4u*)(sm + S2_STF + row * 144 + pc * 16) = sf; *(LAS v4u*)(sm + S2_STB + row * 144 + pc * 16) = sb;
        if (MIX == 3 && I.tid < 32) { const f32x4 nv = __builtin_bit_cast(f32x4, R.r[5]); v2u w; w.x = pg8::cvt_pk_safe(nv[0], nv[1]); w.y = pg8::cvt_pk_safe(nv[2], nv[3]); *(LAS v2u*)(sm + S2_NV + (I.tid >> 4) * 128 + 8 * (I.tid & 15)) = w; }
        float laf, lab, wf = 1.f, wb = 1.f;
        const LAS float* cst = (const LAS float*)(sm + S2_CST);
        if (MIX == 0) { laf = cst[h]; lab = cst[4 + h]; }
        else if (MIX == 2) { wf = softplus_q(R.s[0] + cst[8 + h]); wb = softplus_q(R.s[1] + cst[12 + h]); laf = wf * cst[16 + h]; lab = wb * cst[20 + h]; }
        else { const LAS float* gb = cst + 32; wf = __expf(R.s[0] + gb[h]); laf = log_sigmoid_q(R.s[1] + gb[4 + h]); wb = __expf(R.s[2] + gb[8 + h]); lab = log_sigmoid_q(R.s[3] + gb[12 + h]); }
        const float Gf = wave_incl_scan(laf, lane), Gb = wave_incl_scan(lab, lane), Tb = rdlane(Gb, 63);
        if (wave == 0) { GF[lane] = Gf; HB[lane] = Tb - Gb + lab; WF[lane] = wf; WB[lane] = wb; }
        if (MIX == 0) { q = cvt8(R.r[0]); k = cvt8(R.r[1]); v = cvt8(R.r[2]); q.a = q.a * 0.125f; q.b = q.b * 0.125f;
            if (!isctx) { f32x8 qp = cvt8(R.r[3]); const f32x8 kq = cvt8(R.r[4]); qp.a = qp.a * 0.125f; qp.b = qp.b * 0.125f; const bool first = (d0 & 31) < 16; const float posv = (d0 < 32) ? (float)(t >> 6) : (float)(t & 63);
#pragma unroll
                for (int j = 0; j < 8; ++j) { const float rev = posv * exp2f(-(float)((d0 & 15) + j) * (13.287712379549449f / 16.0f)) * 0.15915494309189535f; const float cs = __builtin_amdgcn_cosf(rev), sn = __builtin_amdgcn_sinf(rev);
                    const float qo = j < 4 ? q.a[j & 3] : q.b[j & 3], qq = j < 4 ? qp.a[j & 3] : qp.b[j & 3], ko = j < 4 ? k.a[j & 3] : k.b[j & 3], kk = j < 4 ? kq.a[j & 3] : kq.b[j & 3];
                    const float qn = first ? qo * cs - qq * sn : qq * sn + qo * cs, kn = first ? ko * cs - kk * sn : kk * sn + ko * cs;
                    if (j < 4) { q.a[j & 3] = qn; k.a[j & 3] = kn; } else { q.b[j & 3] = qn; k.b[j & 3] = kn; } } }
        } else if (MIX == 2) { const LAS float* cwl = (const LAS float*)(sm + S2_GM);
            const int g = h >> 1, chx = h * 64 + d0, chb = 256 + g * 64 + d0, chc = 384 + g * 64 + d0;
            f32x8 ax, ab, ac; ax.a = *(const LAS f32x4*)(cwl + 2560 + chx); ax.b = *(const LAS f32x4*)(cwl + 2560 + chx + 4); ab.a = *(const LAS f32x4*)(cwl + 2560 + chb); ab.b = *(const LAS f32x4*)(cwl + 2560 + chb + 4);
            ac.a = *(const LAS f32x4*)(cwl + 2560 + chc); ac.b = *(const LAS f32x4*)(cwl + 2560 + chc + 4);
#pragma unroll
            for (int w5 = 0; w5 < 5; ++w5) { const f32x8 x0 = cvt8(R.r[3 * w5]), x1 = cvt8(R.r[3 * w5 + 1]), x2 = cvt8(R.r[3 * w5 + 2]); const LAS float* cwr = cwl + w5 * 512;
                ax.a += x0.a * *(const LAS f32x4*)(cwr + chx); ax.b += x0.b * *(const LAS f32x4*)(cwr + chx + 4); ab.a += x1.a * *(const LAS f32x4*)(cwr + chb); ab.b += x1.b * *(const LAS f32x4*)(cwr + chb + 4);
                ac.a += x2.a * *(const LAS f32x4*)(cwr + chc); ac.b += x2.b * *(const LAS f32x4*)(cwr + chc + 4); }
#pragma unroll
            for (int j = 0; j < 4; ++j) { v.a[j] = silu_q(ax.a[j]); v.b[j] = silu_q(ax.b[j]); k.a[j] = silu_q(ab.a[j]); k.b[j] = silu_q(ab.b[j]); q.a[j] = silu_q(ac.a[j]); q.b[j] = silu_q(ac.b[j]); }
        } else { q = cvt8(R.r[0]); k = cvt8(R.r[1]); v = cvt8(R.r[2]); k.a = k.a * 0.125f; k.b = k.b * 0.125f; }
        const int ro = tk * 144 + d0 * 2;
        *(LAS v4u*)(sm + S2_Q + ro) = pack8(q.a, q.b); *(LAS v4u*)(sm + S2_K + ro) = pack8(k.a, k.b); *(LAS v4u*)(sm + S2_V + ro) = pack8(v.a, v.b);
    } else {
        *(LAS v4u*)(sm + S2_STF + row * 144 + pc * 16) = R.r[3];
        LAS float* GS = (LAS float*)(sm + S2_GS); LAS float* GM = (LAS float*)(sm + S2_GM);
        const int d = I.tid & 31, tq = I.tid >> 5; float cfw[4], cbw[4], lbw[4]; float runf = 0.f, runb = 0.f;
        const LAS float* gwf = (const LAS float*)(sm + S2_CST) + 1088 + h * 32 + d; const LAS float* gbp = (const LAS float*)(sm + S2_CST) + 5184 + h * 32 + d;
        float wfr[16], wbr[16];
#pragma unroll
        for (int r = 0; r < 16; ++r) { wfr[r] = gwf[r * 128]; wbr[r] = gwf[16 * 128 + r * 128]; }
        const float bfv = gbp[0], bbv = gbp[128];
#pragma unroll
        for (int u = 0; u < 4; ++u) { const f32x8 l0 = cvt8(R.r[4 + 2 * u]), l1 = cvt8(R.r[5 + 2 * u]); float zf = bfv, zb = bbv;
#pragma unroll
            for (int r = 0; r < 4; ++r) { zf += l0.a[r] * wfr[r] + l0.b[r] * wfr[4 + r] + l1.a[r] * wfr[8 + r] + l1.b[r] * wfr[12 + r]; zb += l0.a[r] * wbr[r] + l0.b[r] * wbr[4 + r] + l1.a[r] * wbr[8 + r] + l1.b[r] * wbr[12 + r]; }
            runf += log_sigmoid_q(zf) * (1.0f / 16.0f); cfw[u] = runf; lbw[u] = log_sigmoid_q(zb) * (1.0f / 16.0f); runb += lbw[u]; cbw[u] = runb; }
        GS[tq * 32 + d] = runf; GS[512 + tq * 32 + d] = runb;
        __syncthreads();
        float offf = 0.f, offb = 0.f, totb = 0.f;
#pragma unroll
        for (int qq = 0; qq < 16; ++qq) { const float sf = GS[qq * 32 + d], sb = GS[512 + qq * 32 + d]; offf += (qq < tq) ? sf : 0.f; offb += (qq < tq) ? sb : 0.f; totb += sb; }
#pragma unroll
        for (int u = 0; u < 4; ++u) { GM[(4 * tq + u) * 32 + d] = offf + cfw[u]; GM[2048 + (4 * tq + u) * 32 + d] = totb - (offb + cbw[u]) + lbw[u]; }
        if (I.tid < 64) { GF[I.tid] = 0.f; HB[I.tid] = 0.f; WF[I.tid] = 1.f; WB[I.tid] = 1.f; }
        __syncthreads();
        v = cvt8(R.r[2]);
        *(LAS v4u*)(sm + S2_V + tk * 144 + d0 * 2) = pack8(v.a, v.b);
        if (d0 < 32) { q = cvt8(R.r[0]); k = cvt8(R.r[1]);
            const f32x4 gf0 = *(const LAS f32x4*)(GM + tk * 32 + d0), gf1 = *(const LAS f32x4*)(GM + tk * 32 + d0 + 4), gb0 = *(const LAS f32x4*)(GM + 2048 + tk * 32 + d0), gb1 = *(const LAS f32x4*)(GM + 2048 + tk * 32 + d0 + 4);
            f32x8 qf, kf, qb, kb;
#pragma unroll
            for (int j = 0; j < 4; ++j) { qf.a[j] = q.a[j] * 0.17677669529663687f * __expf(gf0[j]); qf.b[j] = q.b[j] * 0.17677669529663687f * __expf(gf1[j]); kf.a[j] = k.a[j] * __expf(-gf0[j]); kf.b[j] = k.b[j] * __expf(-gf1[j]);
                qb.a[j] = q.a[j] * 0.17677669529663687f * __expf(gb0[j]); qb.b[j] = q.b[j] * 0.17677669529663687f * __expf(gb1[j]); kb.a[j] = k.a[j] * __expf(-gb0[j]); kb.b[j] = k.b[j] * __expf(-gb1[j]); }
            const int ro = tk * 144 + d0 * 2;
            *(LAS v4u*)(sm + S2_Q + ro) = pack8(qf.a, qf.b); *(LAS v4u*)(sm + S2_Q + ro + 64) = pack8(qb.a, qb.b); *(LAS v4u*)(sm + S2_K + ro) = pack8(kf.a, kf.b); *(LAS v4u*)(sm + S2_K + ro + 64) = pack8(kb.a, kb.b); }
    }
}
template <int MIX>
__device__ __forceinline__ OutAcc s2_compute(const Frame& F, const Ids&, int l, const HItem& it, const v2u (&zg)[2]) {
    const Ids I = fresh_ids(F.wave_s);
    LAS unsigned char* sm = F.lds;
    const int lane = I.lane, wave = I.wave, fr = lane & 15, fq = lane >> 4, rt = wave >> 1, cp = wave & 1; const int h = it.h;
    const LAS float* GF = (const LAS float*)(sm + S2_ARR); const LAS float* HB = GF + 64; const LAS float* WF = GF + 128; const LAS float* WB = GF + 192;
    const int irow = 16 * rt + fr;
    const float gfi = GF[irow], hbi = HB[irow];
    const bf16x8s qf0 = rowfrag(sm + S2_Q, 16 * rt, 0, fr, fq), qf1 = rowfrag(sm + S2_Q, 16 * rt, 1, fr, fq);
#pragma unroll
    for (int u = 0; u < 2; ++u) { const int jt = 2 * cp + u;
        f32x4 sc = (f32x4){0.f, 0.f, 0.f, 0.f}, sc2 = sc;
        sc = mfma16(rowfrag(sm + S2_K, 16 * jt, 0, fr, fq), qf0, sc);
        if (MIX == 1) sc2 = mfma16(rowfrag(sm + S2_K, 16 * jt, 1, fr, fq), qf1, sc2); else sc = mfma16(rowfrag(sm + S2_K, 16 * jt, 1, fr, fq), qf1, sc);
        const f32x4 gj = *(const LAS f32x4*)(GF + 16 * jt + 4 * fq), hj = *(const LAS f32x4*)(HB + 16 * jt + 4 * fq), wfj = *(const LAS f32x4*)(WF + 16 * jt + 4 * fq), wbj = *(const LAS f32x4*)(WB + 16 * jt + 4 * fq);
        float pa[4], pb[4];
#pragma unroll
        for (int r = 0; r < 4; ++r) { const int j = 16 * jt + 4 * fq + r;
            const float ef = (j <= irow) ? __expf(fminf(gfi - gj[r], 0.f)) * wfj[r] : 0.f, eb = (j >= irow) ? __expf(fminf(hbi - hj[r], 0.f)) * wbj[r] : 0.f;
            if (MIX == 1) { pa[r] = sc[r] * ef + sc2[r] * eb; pb[r] = 0.f; } else if (MIX == 3) { pa[r] = sc[r] * ef; pb[r] = sc[r] * eb; } else { pa[r] = sc[r] * (ef + eb); pb[r] = 0.f; } }
        v2u pw; pw.x = pg8::cvt_pk_safe(pa[0], pa[1]); pw.y = pg8::cvt_pk_safe(pa[2], pa[3]); *(LAS v2u*)(sm + S2_P + irow * 144 + (16 * jt + 4 * fq) * 2) = pw;
        if (MIX == 3) { v2u pw2; pw2.x = pg8::cvt_pk_safe(pb[0], pb[1]); pw2.y = pg8::cvt_pk_safe(pb[2], pb[3]); *(LAS v2u*)(sm + S2_P2 + irow * 144 + (16 * jt + 4 * fq) * 2) = pw2; } }
    f32x4 o2f[2], o2b[2], e2f = (f32x4){0.f, 0.f, 0.f, 0.f}, e2b = e2f;
#pragma unroll
    for (int u = 0; u < 2; ++u) { const int ct = 2 * cp + u; o2f[u] = (f32x4){0.f, 0.f, 0.f, 0.f}; o2b[u] = o2f[u];
        o2f[u] = mfma16(rowfrag(sm + S2_STF, 16 * ct, 0, fr, fq), qf0, o2f[u]); o2f[u] = mfma16(rowfrag(sm + S2_STF, 16 * ct, 1, fr, fq), qf1, o2f[u]);
        if (MIX != 1) { o2b[u] = mfma16(rowfrag(sm + S2_STB, 16 * ct, 0, fr, fq), qf0, o2b[u]); o2b[u] = mfma16(rowfrag(sm + S2_STB, 16 * ct, 1, fr, fq), qf1, o2b[u]); } }
    if (MIX == 3) { const LAS unsigned char* nv = sm + S2_NV;
        e2f = mfma16(*(const LAS bf16x8s*)(nv + fq * 16), qf0, e2f); e2f = mfma16(*(const LAS bf16x8s*)(nv + 64 + fq * 16), qf1, e2f);
        e2b = mfma16(*(const LAS bf16x8s*)(nv + 128 + fq * 16), qf0, e2b); e2b = mfma16(*(const LAS bf16x8s*)(nv + 192 + fq * 16), qf1, e2b); }
    bf16x8s vf[2][2];
#pragma unroll
    for (int u = 0; u < 2; ++u) { vf[u][0] = trfrag(sm + S2_V, 0, 16 * (2 * cp + u), lane); vf[u][1] = trfrag(sm + S2_V, 32, 16 * (2 * cp + u), lane); }
    __syncthreads();
    const bf16x8s pf0 = rowfrag(sm + S2_P, 16 * rt, 0, fr, fq), pf1 = rowfrag(sm + S2_P, 16 * rt, 1, fr, fq);
    const float egf = __expf(gfi), egb = __expf(hbi);
    const bf16x8s ones = (bf16x8s){0x3F80, 0x3F80, 0x3F80, 0x3F80, 0x3F80, 0x3F80, 0x3F80, 0x3F80};
    OutAcc A;
    if (MIX == 3) {
        const bf16x8s pb0 = rowfrag(sm + S2_P2, 16 * rt, 0, fr, fq), pb1 = rowfrag(sm + S2_P2, 16 * rt, 1, fr, fq);
        f32x4 e1f = (f32x4){0.f, 0.f, 0.f, 0.f}, e1b = e1f; e1f = mfma16(ones, pf0, e1f); e1f = mfma16(ones, pf1, e1f); e1b = mfma16(ones, pb0, e1b); e1b = mfma16(ones, pb1, e1b);
        const float sf = 1.0f / fmaxf(fabsf(e1f[0] + egf * e2f[0]), 1.0f), sb = 1.0f / fmaxf(fabsf(e1b[0] + egb * e2b[0]), 1.0f);
#pragma unroll
        for (int u = 0; u < 2; ++u) { f32x4 of = (f32x4){0.f, 0.f, 0.f, 0.f}, ob = of; of = mfma16(vf[u][0], pf0, of); of = mfma16(vf[u][1], pf1, of); ob = mfma16(vf[u][0], pb0, ob); ob = mfma16(vf[u][1], pb1, ob);
            A.y[u] = (of + o2f[u] * egf) * sf + (ob + o2b[u] * egb) * sb; }
    } else {
#pragma unroll
        for (int u = 0; u < 2; ++u) { f32x4 o1 = (f32x4){0.f, 0.f, 0.f, 0.f}; o1 = mfma16(vf[u][0], pf0, o1); o1 = mfma16(vf[u][1], pf1, o1);
            A.y[u] = MIX == 1 ? (o1 + o2f[u]) : (o1 + o2f[u] * egf + o2b[u] * egb); }
    }
    if (MIX == 2) { const float dsk = ((const LAS float*)(sm + S2_CST))[24 + h];
#pragma unroll
        for (int u = 0; u < 2; ++u) { const int c0 = 16 * (2 * cp + u) + 4 * fq; const v2u xw = *(const LAS v2u*)(sm + S2_V + irow * 144 + c0 * 2);
            const f32x4 xs = (f32x4){bf_lo(xw.x), bf_hi(xw.x), bf_lo(xw.y), bf_hi(xw.y)}, z = (f32x4){bf_lo(zg[u].x), bf_hi(zg[u].x), bf_lo(zg[u].y), bf_hi(zg[u].y)};
#pragma unroll
            for (int r = 0; r < 4; ++r) A.y[u][r] = (A.y[u][r] + dsk * xs[r]) * silu_q(z[r]); }
    }
    return A;
}
__device__ __forceinline__ void token_stats(LAS unsigned char* sm, int rt, int cp, int fr, int fq, int lane, float& s1, float& s2) {
    s1 += shx(s1, 16, lane); s1 += shx(s1, 32, lane); s2 += shx(s2, 16, lane); s2 += shx(s2, 32, lane);
    LAS float* ST = (LAS float*)(sm + S2_STAT);
    if (fq == 0) { ST[((16 * rt + fr) * 2 + cp) * 2] = s1; ST[((16 * rt + fr) * 2 + cp) * 2 + 1] = s2; }
    __syncthreads();
    const f32x4 a = *(const LAS f32x4*)(ST + (16 * rt + fr) * 4); s1 = a[0] + a[2]; s2 = a[1] + a[3];
}
__device__ __forceinline__ HItem s2_item(int j, int blk, int G, int NCH, bool ctx_out, int nsu, int u0) {
    HItem it; int c;
    if (j < 4 * nsu) { const int u = blk + (j >> 2) * G; it.mix = 2; it.b = u / NCH; c = u % NCH; it.h = j & 3; it.last = (j & 3) == 3; }
    else { const int u = u0 + (j - 4 * nsu), mh = u % 12, bc = u / 12; it.b = bc / NCH; c = bc % NCH; const int m3 = mh >> 2; it.mix = m3 == 0 ? 0 : (m3 == 1 ? 1 : 3); it.h = mh & 3; it.last = true; }
    it.isctx = ctx_out && c < 4; it.nc = ctx_out ? (it.isctx ? c : c - 4) : c; return it;
}
__device__ __forceinline__ void p3b_output(const Frame& F_, int l, bool ctx_out) {
    const Frame F = fresh_frame(F_); const Ids I = fresh_ids(F.wave_s);
    bf16* Y = (bf16*)(F.ws + WS_Y);
    const int lane = I.lane, wave = I.wave, fr = lane & 15, fq = lane >> 4, rt = wave >> 1, cp = wave & 1;
    const int NCH = ctx_out ? 36 : 32, nssd = 8 * NCH, blk = F.vcu, G = F.G;
    const int extra = nssd - G, nsu = 1 + (blk < extra ? 1 : 0);
    const int per_lo = (16 * NCH * 8) / G - 8, per_hi = per_lo + 4;
    const int u0 = blk < extra ? blk * per_lo : extra * per_lo + (blk - extra) * per_hi, cnt = blk < extra ? per_lo : per_hi, nitems = 4 * nsu + cnt;
    {
        LAS float* cwl = (LAS float*)(F.lds + S2_GM); const float* cw = inp(F.lds, 15) + (size_t)l * 5 * 512; const float* cb = inp(F.lds, 16) + l * 512;
        for (int i = I.tid; i < 6 * 512; i += 512) cwl[i] = i < 2560 ? cw[i] : cb[i - 2560];
        LAS float* cst = (LAS float*)(F.lds + S2_CST);
        if (I.tid < 8) { cst[I.tid] = log_sigmoid_f(inp(F.lds, 10)[l * 8 + I.tid]); cst[8 + I.tid] = inp(F.lds, 17)[l * 8 + I.tid]; cst[16 + I.tid] = -expf(inp(F.lds, 18)[l * 8 + I.tid]); }
        if (I.tid < 4) cst[24 + I.tid] = inp(F.lds, 19)[l * 4 + I.tid];
        if (I.tid < 16) cst[32 + I.tid] = inp(F.lds, 21)[l * 16 + I.tid];
        if (I.tid < 256) { cst[64 + I.tid] = inp(F.lds, 11)[l * 256 + I.tid]; cst[320 + I.tid] = inp(F.lds, 14)[l * 256 + I.tid]; cst[576 + I.tid] = inp(F.lds, 20)[l * 256 + I.tid]; cst[832 + I.tid] = inp(F.lds, 22)[l * 256 + I.tid];
            cst[5184 + I.tid] = inp(F.lds, 13)[l * 256 + I.tid]; }
        for (int i = I.tid; i < 4096; i += 512) cst[1088 + i] = inp(F.lds, 12)[(size_t)l * 4096 + i];
    }
    __syncthreads();
    HRaw R; HItem cur = s2_item(0, blk, G, NCH, ctx_out, nsu, u0);
    s2_issue<2>(F, I, l, cur, R);
    unsigned ssdy[3][2][2]; float ssd_s2 = 0.f;
    for (int j = 0; j < nitems; ++j) {
        if (cur.mix == 0) s2_transform<0>(F, I, l, cur, R); else if (cur.mix == 1) s2_transform<1>(F, I, l, cur, R); else if (cur.mix == 2) s2_transform<2>(F, I, l, cur, R); else s2_transform<3>(F, I, l, cur, R);
        const v2u zg[2] = {R.g[0], R.g[1]};
        __syncthreads();
        HItem nxt = cur;
        if (j + 1 < nitems) { nxt = s2_item(j + 1, blk, G, NCH, ctx_out, nsu, u0);
            if (nxt.mix == 0) s2_issue<0>(F, I, l, nxt, R); else if (nxt.mix == 1) s2_issue<1>(F, I, l, nxt, R); else if (nxt.mix == 2) s2_issue<2>(F, I, l, nxt, R); else s2_issue<3>(F, I, l, nxt, R); }
        OutAcc A;
        if (cur.mix == 0) A = s2_compute<0>(F, I, l, cur, zg); else if (cur.mix == 1) A = s2_compute<1>(F, I, l, cur, zg); else if (cur.mix == 2) A = s2_compute<2>(F, I, l, cur, zg); else A = s2_compute<3>(F, I, l, cur, zg);
        const int row = (cur.isctx ? NLAT + cur.b * CTXL : cur.b * SEQ) + 64 * cur.nc + 16 * rt + fr;
        if (cur.mix == 2) {
#pragma unroll
            for (int u = 0; u < 2; ++u)
#pragma unroll
                for (int r = 0; r < 4; ++r) ssd_s2 += A.y[u][r] * A.y[u][r];
            if (!cur.last) {
#pragma unroll
                for (int hh = 0; hh < 3; ++hh) if (cur.h == hh) {
#pragma unroll
                    for (int u = 0; u < 2; ++u) { ssdy[hh][u][0] = pg8::cvt_pk_safe(A.y[u][0], A.y[u][1]); ssdy[hh][u][1] = pg8::cvt_pk_safe(A.y[u][2], A.y[u][3]); } }
                __syncthreads();
            } else {
                float s1 = 0.f, s2 = ssd_s2; token_stats(F.lds, rt, cp, fr, fq, lane, s1, s2); ssd_s2 = 0.f;
                const float rs = 1.0f / sqrtf(s2 * (1.0f / 256.0f) + EPS); const LAS float* nw = (const LAS float*)(F.lds + S2_CST) + 576;
#pragma unroll
                for (int hh = 0; hh < 4; ++hh)
#pragma unroll
                    for (int u = 0; u < 2; ++u) { const int c0 = hh * 64 + 16 * (2 * cp + u) + 4 * fq;
                        const f32x4 yv = hh < 3 ? (f32x4){bf_lo(ssdy[hh < 3 ? hh : 0][u][0]), bf_hi(ssdy[hh < 3 ? hh : 0][u][0]), bf_lo(ssdy[hh < 3 ? hh : 0][u][1]), bf_hi(ssdy[hh < 3 ? hh : 0][u][1])} : A.y[u];
                        st_bf4(Y + (size_t)row * D + 512 + c0, yv * rs * *(const LAS f32x4*)(nw + c0)); }
                __syncthreads();
            }
        } else {
            float s1 = 0.f, s2 = 0.f;
#pragma unroll
            for (int u = 0; u < 2; ++u)
#pragma unroll
                for (int r = 0; r < 4; ++r) { s1 += A.y[u][r]; s2 += A.y[u][r] * A.y[u][r]; }
            token_stats(F.lds, rt, cp, fr, fq, lane, s1, s2);
            const float mean = cur.mix == 0 ? s1 * (1.0f / 64.0f) : 0.f;
            const float rs = 1.0f / sqrtf(fmaxf(s2 * (1.0f / 64.0f) - mean * mean, 0.f) + EPS);
            const LAS float* nw = (const LAS float*)(F.lds + S2_CST) + 64 + (cur.mix == 0 ? 0 : cur.mix == 1 ? 256 : 768) + cur.h * 64;
#pragma unroll
            for (int u = 0; u < 2; ++u) { const int c0 = 16 * (2 * cp + u) + 4 * fq; const f32x4 w = *(const LAS f32x4*)(nw + c0); f32x4 y;
                const f32x4 g = (f32x4){bf_lo(zg[u].x), bf_hi(zg[u].x), bf_lo(zg[u].y), bf_hi(zg[u].y)};
#pragma unroll
                for (int r = 0; r < 4; ++r) y[r] = (A.y[u][r] - mean) * rs * w[r] * (cur.mix == 3 ? sigmoid_q(g[r]) : silu_q(g[r]));
                st_bf4(Y + (size_t)row * D + cur.mix * 256 + cur.h * 64 + c0, y); }
            __syncthreads();
        }
        cur = nxt;
    }
}

struct Args { const float* in[28]; float* out; unsigned char* ws; int ph_lo, ph_hi, use_bar, never; };
__global__ void __launch_bounds__(NWAVES * 64, 2) fwd_kernel(Args args) {
    extern __shared__ __attribute__((aligned(16))) unsigned char lds[];
    Frame F;
    F.lds = (LAS unsigned char*)lds;
        F.wave_s = __builtin_amdgcn_readfirstlane((int)threadIdx.x >> 6);
    F.G = gridDim.x; { const int bx = blockIdx.x; F.vcu = (F.G % 8 == 0) ? (bx % 8) * (F.G / 8) + bx / 8 : bx; }
    F.ws = args.ws;
    if (args.never) cooperative_groups::this_grid().sync();
    for (int u = F.wave_s * 64 + lane_id(); u < (LDS_BYTES - LDSCTL_OFF) / 4; u += NWAVES * 64) ((LAS unsigned*)(F.lds + LDSCTL_OFF))[u] = 0u;
    __syncthreads();
    if (F.wave_s == 0 && lane_id() == 0) { LAS unsigned long long* tab = (LAS unsigned long long*)(F.lds + LDSCTL_OFF);
#pragma unroll
        for (int i = 0; i < 28; ++i) tab[i] = (unsigned long long)args.in[i];
        tab[28] = (unsigned long long)args.out; }
    __syncthreads();
    XcdBarrier bar; bar.bar = (unsigned*)(F.ws + WS_CTL) + CW_BAR; bar.x = 0; bar.st = nullptr; bar.wave_s = F.wave_s;
    if (args.use_bar) bar = xcd_barrier_post((unsigned*)(F.ws + WS_CTL) + CW_BAR, (volatile LAS unsigned*)(F.lds + MISC_OFF) + 8, F.wave_s);
    const int lo = args.ph_lo, hi = args.ph_hi;
#define IN(k) (lo <= (k) && (k) < hi)
#define SEAM(k) do { if (IN(k) && IN((k) + 1)) xcd_barrier(bar); } while (0)
#ifndef PROBE_DUP
#define PROBE_DUP -1
#endif
#define PH_BEGIN(kind) for (int rep_ = 0; rep_ < ((PROBE_DUP) == (kind) ? 2 : 1); ++rep_) { if (rep_) xcd_barrier(bar);
#define PH_END }
    #ifndef NO_P0
    PH_BEGIN(0) if (IN(0)) { p0_prologue(F); } PH_END
#endif
    SEAM(0);
#pragma unroll
    for (int l = 0; l < 2; ++l) {
        const int pb = 1 + 9 * l;
        const bool ctx_out = l == 0;
        const int mrows = ctx_out ? NROWS : NLAT;
#ifndef NO_P1
        if (IN(pb + 0)) { p1_norm1(F, l); }
#endif
        SEAM(pb + 0);
        PH_BEGIN(2) if (IN(pb + 1)) {
            const Frame Fg = fresh_frame(F);
            pg8::Gemm g{(const bf16*)(Fg.ws + WS_HN), (const bf16*)(Fg.ws + WS_WTIN) + (size_t)l * INP * 1024, NROWS, INP, D}; pg8::StaticOrder S; S.init(NROWS, INP, F.G, (int)blockIdx.x);
            pg8::EpiStoreBf16 E{(bf16*)(Fg.ws + WS_U), INP, 0, 0};
            pg8::gemm_phase<pg8::EpiStoreBf16, pg8::StaticOrder, PG8_ALIGN, PG8_SP2>(Fg.lds, g, S, E, F.wave_s);
        }
        PH_END
        SEAM(pb + 1);
        PH_BEGIN(3) if (IN(pb + 2)) { p3a_state(F, l); } PH_END
        SEAM(pb + 2);
        PH_BEGIN(4) if (IN(pb + 3)) { p3b_output(F, l, ctx_out); } PH_END
        SEAM(pb + 3);
        if (IN(pb + 4)) {
            const Frame Fg = fresh_frame(F);
            pg8::Gemm g{(const bf16*)(Fg.ws + WS_Y), (const bf16*)(Fg.ws + WS_WTOUT) + (size_t)l * 1024 * 1024, mrows, D, D}; pg8::StaticOrder S; S.init(mrows, D, F.G, (int)blockIdx.x);
            pg8::EpiOutProj E{(float*)(Fg.ws + WS_H), (const float*)(Fg.ws + WS_MOD) + (size_t)l * 9 * MODW};
            pg8::gemm_phase<pg8::EpiOutProj, pg8::StaticOrder, PG8_ALIGN, PG8_SP2>(Fg.lds, g, S, E, F.wave_s);
        }
        SEAM(pb + 4);
#ifndef NO_P6
        PH_BEGIN(6) if (IN(pb + 5)) { p6_norm2_router(F, l, mrows); } PH_END
#endif
        SEAM(pb + 5);
#ifndef NO_P7
        PH_BEGIN(7) if (IN(pb + 6)) { p7_topk(F, l); } PH_END
#endif
        SEAM(pb + 6);
        PH_BEGIN(8) if (IN(pb + 7)) {
            const Frame Fg = fresh_frame(F);
            pg8::Gemm g{(const bf16*)(Fg.ws + WS_Y), (const bf16*)(Fg.ws + WS_WTGU) + (size_t)l * NE * 3072 * 1024, NE * SLOTS, NE * 3072, D};
            pg8::GroupedOrder S{ctx_out ? 9 : 8, 12, (int)blockIdx.x};
            pg8::EpiSwiGLU E{(bf16*)(Fg.ws + WS_U)};
            pg8::gemm_phase<pg8::EpiSwiGLU, pg8::GroupedOrder, PG8_ALIGN, PG8_SP2>(Fg.lds, g, S, E, F.wave_s);
        }
        PH_END
        SEAM(pb + 7);
        PH_BEGIN(9) if (IN(pb + 8)) {
            const Frame Fg = fresh_frame(F);
            pg8::Gemm g{(const bf16*)(Fg.ws + WS_U), (const bf16*)(Fg.ws + WS_WTDN) + (size_t)l * NE * 1024 * FF, NE * SLOTS, NE * 1024, FF};
            pg8::GroupedOrder S{ctx_out ? 9 : 8, 4, (int)blockIdx.x};
            pg8::EpiStoreBf16 E{(bf16*)(Fg.ws + WS_O2), D, 9, 4};
            pg8::gemm_phase<pg8::EpiStoreBf16, pg8::GroupedOrder, PG8_ALIGN, PG8_SP2>(Fg.lds, g, S, E, F.wave_s);
        }
        PH_END
        SEAM(pb + 8);
    }
#ifndef NO_PF
    if (IN(19)) { p_final(F, (float*)inp(F.lds, 28)); }
#endif
#undef IN
#undef SEAM
}

#ifndef MK_ONE_LAUNCH
#define MK_ONE_LAUNCH 1
#endif
extern "C" void kernel_launch(void* const* d_in, const int* in_sizes, int n_in, void* d_out, int out_size, void* d_ws, size_t ws_size, hipStream_t stream) {
    static int grid = 0;
    if (grid == 0) {
        if (n_in != 28 || out_size != NLAT * D || ws_size < WS_END) { fprintf(stderr, "kernel_launch: unexpected problem (n_in %d, out %d, ws %zu < %zu)\n", n_in, out_size, ws_size, (size_t)WS_END); grid = -1; return; }
        int dev = 0, cus = 0, per_cu = 0;
        if (hipGetDevice(&dev) != hipSuccess || hipDeviceGetAttribute(&cus, hipDeviceAttributeMultiprocessorCount, dev) != hipSuccess) { grid = -1; return; }
        if (hipFuncSetAttribute((const void*)fwd_kernel, hipFuncAttributeMaxDynamicSharedMemorySize, LDS_BYTES) != hipSuccess) { fprintf(stderr, "kernel_launch: hipFuncSetAttribute failed\n"); grid = -1; return; }
        if (hipOccupancyMaxActiveBlocksPerMultiprocessor(&per_cu, (const void*)fwd_kernel, NWAVES * 64, LDS_BYTES) != hipSuccess || per_cu < 1) { fprintf(stderr, "kernel_launch: occupancy query says %d\n", per_cu); (void)hipGetLastError(); per_cu = 1; }
        grid = cus;
        if (grid != 256) { fprintf(stderr, "kernel_launch: built for 256 CUs, device has %d\n", cus); grid = -1; return; }
    }
    if (grid < 0) return;
    (void)hipMemsetAsync((char*)d_ws + WS_CTL, 0, CTL_ZERO_BYTES, stream);
    Args a{};
    for (int i = 0; i < 28; ++i) a.in[i] = (const float*)d_in[i];
    a.out = (float*)d_out; a.ws = (unsigned char*)d_ws; a.never = 0;
#if MK_ONE_LAUNCH
    a.ph_lo = 0; a.ph_hi = NPHASES; a.use_bar = 1;
    void* kargs[] = {&a};
    hipError_t e = hipLaunchCooperativeKernel((const void*)fwd_kernel, dim3(grid), dim3(NWAVES * 64), kargs, LDS_BYTES, stream);
    if (e != hipSuccess) fprintf(stderr, "kernel_launch: cooperative launch failed: %s\n", hipGetErrorString(e));
#else
    for (int ph = 0; ph < NPHASES; ++ph) { a.ph_lo = ph; a.ph_hi = ph + 1; a.use_bar = 0;
        hipLaunchKernelGGL(fwd_kernel, dim3(grid), dim3(NWAVES * 64), LDS_BYTES, stream, a); }
#endif
}
```

```cpp
#include <hip/hip_runtime.h>
#include <hip/hip_cooperative_groups.h>
#include <cstdio>
#include <cstdint>
#define GAS __attribute__((address_space(1)))
#define LAS __attribute__((address_space(3)))
namespace pg8 {
#define PG8_LAS __attribute__((address_space(3)))
typedef unsigned short bf16_t;
typedef short bf16x8 __attribute__((ext_vector_type(8)));
typedef float f32x4 __attribute__((ext_vector_type(4)));
typedef unsigned u32x4 __attribute__((ext_vector_type(4)));
constexpr int BM = 256, BK = 64, HALF = 128, HTB = HALF * BK * 2  , STAGE_BYTES = 8 * HTB, NXCD = 8, WGM = 8;

__host__ __device__ __forceinline__ int lds_byte(int r, int c) { const int st = (r >> 4) * 2 + (c >> 5), rr = r & 15, cc = c & 31, ob = rr * 64 + cc * 2; return st * 1024 + (ob ^ (((ob >> 9) & 1) << 5)); }
__host__ __device__ __forceinline__ void stage_rc(int b, int& R, int& C) { const int st = b / 1024, sb = b % 1024, swz = sb ^ (((sb >> 9) & 1) << 5); R = (st >> 1) * 16 + swz / 64; C = (st & 1) * 32 + (swz % 64) / 2; }
__host__ __device__ __forceinline__ int perm32(int rho) { const int n = rho >> 4, i = rho & 15; return 8 * (i >> 2) + 4 * n + (i & 3); }

struct Unit { int pm, pn; };
struct Gemm { const bf16_t* A; const bf16_t* Bt; int M, N, K; };

struct StaticOrder {
    int nM, nN, nwg, G, c;
    __host__ __device__ void init(int M, int N, int G_, int c_) { nM = M / BM; nN = N / BM; nwg = nM * nN; G = G_; c = c_; }
    __host__ __device__ bool next(int i, Unit& u) const {
        const long L = (long)i * G + c; if (L >= nwg) return false;
        int wgid = (int)L; { const int q = nwg / NXCD, r = nwg % NXCD, xcd = wgid % NXCD, off = wgid / NXCD; wgid = (xcd < r ? xcd * (q + 1) : r * (q + 1) + (xcd - r) * q) + off; }
        const int nig = WGM * nN, gid = wgid / nig, fm = gid * WGM, gsz = (nM - fm) < WGM ? (nM - fm) : WGM;
        u.pm = fm + ((wgid % nig) % gsz); u.pn = (wgid % nig) / gsz; return true;
    }
    __device__ __forceinline__ void a_ready(const Unit&) const {}
    __device__ __forceinline__ void done(const Unit&) const {}
};

__device__ __forceinline__ unsigned cvt_pk_bf16(float lo, float hi) { unsigned r; asm volatile("v_cvt_pk_bf16_f32 %0, %1, %2" : "=v"(r) : "v"(lo), "v"(hi)); return r; }
typedef float f32x2_t __attribute__((ext_vector_type(2))); typedef __bf16 bf16x2_t __attribute__((ext_vector_type(2)));
__device__ __forceinline__ unsigned cvt_pk_safe(float lo, float hi) { const f32x2_t v = {lo, hi}; const bf16x2_t b = __builtin_convertvector(v, bf16x2_t); return __builtin_bit_cast(unsigned, b); }

struct EpiStoreBf16 {
    static constexpr bool PERM = true, AFTER_DRAIN = false;
    bf16_t* O; int ldc; int pm_div, pn_per;
    __device__ __forceinline__ void operator()(const f32x4 (&acc)[2][2][4][2], const Unit& u, int wr, int wc, int fr, int fq) const {
        const int row0 = u.pm * BM + wr * 64 + fr; int pnl = u.pn; if (pm_div) pnl -= (u.pm / pm_div) * pn_per;
        const int col0 = pnl * BM + wc * 32 + 8 * fq;
#pragma unroll
        for (int ai = 0; ai < 2; ++ai)
#pragma unroll
            for (int m = 0; m < 4; ++m) { bf16_t* rowp = O + (size_t)(row0 + ai * HALF + m * 16) * ldc + col0;
#pragma unroll
                for (int bj = 0; bj < 2; ++bj) { const f32x4 v0 = acc[ai][bj][m][0], v1 = acc[ai][bj][m][1];
                    u32x4 w; w.x = cvt_pk_bf16(v0[0], v0[1]); w.y = cvt_pk_bf16(v0[2], v0[3]); w.z = cvt_pk_bf16(v1[0], v1[1]); w.w = cvt_pk_bf16(v1[2], v1[3]);
                    *(u32x4*)(rowp + bj * HALF) = w; } }
    }
};
struct EpiSwiGLU {
    static constexpr bool PERM = false, AFTER_DRAIN = false;
    bf16_t* O;
    __device__ __forceinline__ void operator()(const f32x4 (&acc)[2][2][4][2], const Unit& u, int wr, int wc, int fr, int fq) const {
        const int e = u.pm / 9, pnl = u.pn - e * 12;
        const int row0 = u.pm * BM + wr * 64 + fr, col0 = pnl * 128 + (4 * wc + fq) * 8;
#pragma unroll
        for (int ai = 0; ai < 2; ++ai)
#pragma unroll
            for (int m = 0; m < 4; ++m) {
                float h[8];
#pragma unroll
                for (int bj = 0; bj < 2; ++bj)
#pragma unroll
                    for (int j = 0; j < 4; ++j) { const float g = acc[ai][bj][m][0][j], up = acc[ai][bj][m][1][j]; h[bj * 4 + j] = g * __builtin_amdgcn_rcpf(1.0f + __expf(-g)) * up; }
                u32x4 w; w.x = cvt_pk_bf16(h[0], h[1]); w.y = cvt_pk_bf16(h[2], h[3]); w.z = cvt_pk_bf16(h[4], h[5]); w.w = cvt_pk_bf16(h[6], h[7]);
                *(u32x4*)(O + (size_t)(row0 + ai * HALF + m * 16) * 1536 + col0) = w; }
    }
};
struct EpiOutProj {
    static constexpr bool PERM = false, AFTER_DRAIN = false;
    float* H; const float* mod;
    __device__ __forceinline__ void operator()(const f32x4 (&acc)[2][2][4][2], const Unit& u, int wr, int wc, int fr, int fq) const {
        const int s = u.pm < 64 ? (u.pm >> 3) : 8;
        const float* g1 = mod + s * 6144 + 2048;
        const int row0 = u.pm * BM + wr * 64 + fr, col0 = u.pn * BM + wc * 32 + 4 * fq;
#pragma unroll
        for (int bj = 0; bj < 2; ++bj)
#pragma unroll
            for (int n = 0; n < 2; ++n) { const f32x4 gv = *(const f32x4*)(g1 + col0 + bj * HALF + n * 16);
#pragma unroll
                for (int ai = 0; ai < 2; ++ai)
#pragma unroll
                    for (int m = 0; m < 4; ++m) { float* p = H + (size_t)(row0 + ai * HALF + m * 16) * 1024 + col0 + bj * HALF + n * 16;
                        const f32x4 old = *(const f32x4*)p; *(f32x4*)p = old + gv * acc[ai][bj][m][n]; } }
    }
};
struct GroupedOrder {
    int MT, NT, c;
    __device__ __forceinline__ bool next(int i, Unit& u) const {
        const int xcd = c & 7, j = i * 32 + (c >> 3), per = MT * NT;
        if (j >= 2 * per) return false;
        const int e = 2 * xcd + j / per, q = j % per;
        u.pm = e * 9 + q % MT; u.pn = e * NT + q / MT; return true;
    }
    __device__ __forceinline__ void a_ready(const Unit&) const {}
    __device__ __forceinline__ void done(const Unit&) const {}
};

template <class Epi, class Sched, bool ALIGN_EPI = false, bool SP2 = false>
__device__ __forceinline__ void gemm_phase(PG8_LAS unsigned char* lds, const Gemm g, const Sched& S, const Epi& E, const int wave_s) {
    unsigned m_ = ~0u; asm volatile("" : "+s"(m_)); const int tid_ = wave_s * 64 + (int)__builtin_amdgcn_mbcnt_hi(m_, __builtin_amdgcn_mbcnt_lo(m_, 0u));
    const int tid = tid_, wid = __builtin_amdgcn_readfirstlane(tid >> 6), lane = tid & 63, wr = wid >> 2, wc = wid & 3, fr = lane & 15, fq = lane >> 4;
    const int K = g.K, nt = K / BK;
    unsigned voffA[2], voffB[2];
#pragma unroll
    for (int i = 0; i < 2; ++i) { int R, C; stage_rc(tid * 16 + i * 8192, R, C); const int Rb = Epi::PERM ? ((R & ~31) + perm32(R & 31)) : R;
        voffA[i] = (unsigned)(R * K + C) * 2u; voffB[i] = (unsigned)(Rb * K + C) * 2u; }
    const size_t kstep = (size_t)(BK * 2);
    const size_t hstep = (size_t)HALF * K * 2;
    const size_t tstep = 2 * hstep;
    const unsigned ldsw = (unsigned)wid * 1024u;
    const int aoff = lds_byte(wr * 64 + fr, fq * 8), boff = lds_byte(wc * 32 + fr, fq * 8);
#define PG8_SA(b, h) (((b) * 2 + (h)) * HTB)
#define PG8_SB(b, h) ((4 + (b) * 2 + (h)) * HTB)
#define PG8_STAGE(bufoff, gbase, voff) do { _Pragma("unroll") for (int _i = 0; _i < 2; ++_i) \
        __builtin_amdgcn_global_load_lds((const unsigned*)((const char*)(gbase) + (voff)[_i]), (PG8_LAS unsigned*)(lds + (bufoff) + ldsw + _i * 8192), 16, 0, 0); } while (0)
#define PG8_LDA(dst, b, h) do { _Pragma("unroll") for (int m = 0; m < 4; ++m) _Pragma("unroll") for (int k = 0; k < 2; ++k) dst[m][k] = *(const PG8_LAS bf16x8*)(lds + PG8_SA(b, h) + aoff + m * 2048 + k * 1024); } while (0)
#define PG8_LDB(dst, b, h) do { _Pragma("unroll") for (int n = 0; n < 2; ++n) _Pragma("unroll") for (int k = 0; k < 2; ++k) dst[n][k] = *(const PG8_LAS bf16x8*)(lds + PG8_SB(b, h) + boff + n * 2048 + k * 1024); } while (0)
#define PG8_MMA(ai, bj, At, Bt) do { __builtin_amdgcn_s_setprio(1); _Pragma("unroll") for (int m = 0; m < 4; ++m) _Pragma("unroll") for (int n = 0; n < 2; ++n) _Pragma("unroll") for (int k = 0; k < 2; ++k) \
        acc[ai][bj][m][n] = __builtin_amdgcn_mfma_f32_16x16x32_bf16(Bt[n][k], At[m][k], acc[ai][bj][m][n], 0, 0, 0); __builtin_amdgcn_s_setprio(0); } while (0)
#define PG8_WAIT_V(n) asm volatile("s_waitcnt vmcnt(" #n ")" ::: "memory")
#define PG8_WAIT_L(n) asm volatile("s_waitcnt lgkmcnt(" #n ")" ::: "memory")
#define PG8_BAR __builtin_amdgcn_s_barrier()
#define PG8_SCHED __builtin_amdgcn_sched_barrier(0)
    Unit cur, nxt; int ui = 0;
    if (!S.next(0, cur)) return;
    f32x4 acc[2][2][4][2];
#pragma unroll
    for (int a = 0; a < 2; ++a)
#pragma unroll
        for (int b = 0; b < 2; ++b)
#pragma unroll
            for (int m = 0; m < 4; ++m)
#pragma unroll
                for (int n = 0; n < 2; ++n) acc[a][b][m][n] = (f32x4){0.f, 0.f, 0.f, 0.f};
    bf16x8 At[4][2], B0[2][2], B1[2][2];
    const char* cA = (const char*)g.A + (size_t)cur.pm * tstep; const char* cB = (const char*)g.Bt + (size_t)cur.pn * tstep;
    S.a_ready(cur);
    if constexpr (SP2) {
        PG8_STAGE(PG8_SB(0, 0), cB, voffB); PG8_STAGE(PG8_SB(0, 1), cB + hstep, voffB); PG8_STAGE(PG8_SA(0, 0), cA, voffA); PG8_STAGE(PG8_SA(0, 1), cA + hstep, voffA);
        if (wr == 1) PG8_BAR;
        PG8_WAIT_V(2); PG8_BAR;
        PG8_STAGE(PG8_SB(1, 0), cB + kstep, voffB); PG8_STAGE(PG8_SA(1, 0), cA + kstep, voffA); PG8_STAGE(PG8_SB(1, 1), cB + hstep + kstep, voffB);
        PG8_WAIT_V(6); PG8_BAR;
    } else {
        PG8_STAGE(PG8_SB(0, 0), cB, voffB); PG8_STAGE(PG8_SA(0, 0), cA, voffA); PG8_STAGE(PG8_SB(0, 1), cB + hstep, voffB); PG8_STAGE(PG8_SA(0, 1), cA + hstep, voffA);
        if (wr == 1) PG8_BAR;
        PG8_WAIT_V(4); PG8_BAR;
        PG8_STAGE(PG8_SB(1, 0), cB + kstep, voffB); PG8_STAGE(PG8_SA(1, 0), cA + kstep, voffA); PG8_STAGE(PG8_SB(1, 1), cB + hstep + kstep, voffB);
        PG8_WAIT_V(6); PG8_BAR;
    }
    for (;;) {
        const bool has_next = S.next(ui + 1, nxt);
        const char* nA = has_next ? (const char*)g.A + (size_t)nxt.pm * tstep : cA; const char* nB = has_next ? (const char*)g.Bt + (size_t)nxt.pn * tstep : cB;
        for (int t = 0; t < nt; t += 2) {
            const bool last = (t == nt - 2);
            const char* a1 = cA + (size_t)(t + 1) * kstep;
            const char* a2 = last ? nA : cA + (size_t)(t + 2) * kstep; const char* b2 = last ? nB : cB + (size_t)(t + 2) * kstep;
            const char* a3 = a2 + kstep; const char* b3 = b2 + kstep;
            if (last && has_next) S.a_ready(nxt);
            if constexpr (SP2) {
            PG8_LDB(B0, 0, 0); PG8_LDB(B1, 0, 1); PG8_SCHED; PG8_LDA(At, 0, 0); PG8_STAGE(PG8_SA(1, 1), a1 + hstep, voffA);
            PG8_WAIT_V(8); PG8_WAIT_L(0); PG8_BAR; PG8_MMA(0, 0, At, B0); PG8_MMA(0, 1, At, B1); PG8_BAR; PG8_SCHED;
            PG8_LDA(At, 0, 1); PG8_STAGE(PG8_SB(0, 0), b2, voffB); PG8_STAGE(PG8_SB(0, 1), b2 + hstep, voffB); PG8_STAGE(PG8_SA(0, 0), a2, voffA);
            PG8_WAIT_V(8); PG8_WAIT_L(0); PG8_BAR; PG8_MMA(1, 0, At, B0); PG8_MMA(1, 1, At, B1); PG8_BAR; PG8_SCHED;
            PG8_LDB(B0, 1, 0); PG8_LDB(B1, 1, 1); PG8_SCHED; PG8_LDA(At, 1, 0); PG8_STAGE(PG8_SA(0, 1), a2 + hstep, voffA);
            PG8_WAIT_V(8); PG8_WAIT_L(0); PG8_BAR; PG8_MMA(0, 0, At, B0); PG8_MMA(0, 1, At, B1); PG8_BAR; PG8_SCHED;
            PG8_LDA(At, 1, 1); PG8_STAGE(PG8_SB(1, 0), b3, voffB); PG8_STAGE(PG8_SB(1, 1), b3 + hstep, voffB); PG8_STAGE(PG8_SA(1, 0), a3, voffA);
            PG8_WAIT_V(8); PG8_WAIT_L(0); PG8_BAR; PG8_MMA(1, 0, At, B0); PG8_MMA(1, 1, At, B1); PG8_BAR; PG8_SCHED;
            } else {
            PG8_LDB(B0, 0, 0); PG8_SCHED; PG8_LDA(At, 0, 0); PG8_STAGE(PG8_SA(1, 1), a1 + hstep, voffA);
            PG8_WAIT_L(8); PG8_BAR; PG8_WAIT_L(0); PG8_MMA(0, 0, At, B0); PG8_BAR; PG8_SCHED;
            PG8_LDB(B1, 0, 1); PG8_STAGE(PG8_SB(0, 0), b2, voffB);
            PG8_BAR; PG8_WAIT_L(0); PG8_MMA(0, 1, At, B1); PG8_BAR;
            PG8_LDA(At, 0, 1); PG8_STAGE(PG8_SA(0, 0), a2, voffA);
            PG8_BAR; PG8_WAIT_L(0); PG8_MMA(1, 0, At, B0); PG8_BAR; PG8_SCHED;
            PG8_STAGE(PG8_SB(0, 1), b2 + hstep, voffB);
            PG8_WAIT_V(6); PG8_BAR; PG8_MMA(1, 1, At, B1); PG8_BAR;
            PG8_LDB(B0, 1, 0); PG8_SCHED; PG8_LDA(At, 1, 0); PG8_STAGE(PG8_SA(0, 1), a2 + hstep, voffA);
            PG8_WAIT_L(8); PG8_BAR; PG8_WAIT_L(0); PG8_MMA(0, 0, At, B0); PG8_BAR; PG8_SCHED;
            PG8_LDB(B1, 1, 1); PG8_STAGE(PG8_SB(1, 0), b3, voffB);
            PG8_BAR; PG8_WAIT_L(0); PG8_MMA(0, 1, At, B1); PG8_BAR;
            PG8_LDA(At, 1, 1); PG8_STAGE(PG8_SA(1, 0), a3, voffA);
            PG8_BAR; PG8_WAIT_L(0); PG8_MMA(1, 0, At, B0); PG8_BAR; PG8_SCHED;
            PG8_STAGE(PG8_SB(1, 1), b3 + hstep, voffB);
            PG8_WAIT_V(6); PG8_BAR; PG8_MMA(1, 1, At, B1); PG8_BAR;
            }
        }
        if constexpr (ALIGN_EPI) { if (wr == 0) PG8_BAR; }
        if constexpr (!Epi::AFTER_DRAIN) { E(acc, cur, wr, wc, fr, fq); S.done(cur); }
        if (!has_next) break;
#pragma unroll
        for (int a = 0; a < 2; ++a)
#pragma unroll
            for (int b = 0; b < 2; ++b)
#pragma unroll
                for (int m = 0; m < 4; ++m)
#pragma unroll
                    for (int n = 0; n < 2; ++n) acc[a][b][m][n] = (f32x4){0.f, 0.f, 0.f, 0.f};
        cur = nxt; cA = nA; cB = nB; ++ui;
        if constexpr (ALIGN_EPI) { if (wr == 1) PG8_BAR; }
    }
    PG8_WAIT_V(0);
    if constexpr (!ALIGN_EPI) { if (wr == 0) PG8_BAR; }
    PG8_BAR;
    if constexpr (Epi::AFTER_DRAIN) { E.fused(acc, cur, wr, wc, fr, fq, lds, wid, lane); S.done(cur); }
#undef PG8_SA
#undef PG8_SB
#undef PG8_STAGE
#undef PG8_LDA
#undef PG8_LDB
#undef PG8_MMA
#undef PG8_WAIT_V
#undef PG8_WAIT_L
#undef PG8_BAR
#undef PG8_SCHED
}
}

#ifndef PG8_SP2
#define PG8_SP2 true
#endif
#ifndef PG8_ALIGN
#define PG8_ALIGN true
#endif

constexpr int D = 1024, NB = 8, SEQ = 2048, CTXL = 256, NLAT = NB * SEQ, NCTX = NB * CTXL, NROWS = NLAT + NCTX;
constexpr int INC = 3624, INP = 3840, NE = 16, FF = 1536, SLOTS = 2304, MODW = 6144;
constexpr float EPS = 1e-6f;
constexpr int C_RET = 0, C_GLA = 1024, C_SSD = 1808, C_ML = 2584;
constexpr size_t MiB = 1u << 20;
constexpr size_t WS_CTL = 0, CTL_ZERO_BYTES = 1 * MiB;
constexpr size_t WS_MOD = 1 * MiB, WS_WTIN = 2 * MiB, WS_WTOUT = 18 * MiB, WS_WTGU = 22 * MiB, WS_WTDN = 214 * MiB, WS_H = 310 * MiB, WS_HN = 382 * MiB,
                 WS_U = 418 * MiB  , WS_O2 = 553 * MiB  , WS_Y = 625 * MiB  , WS_AFFT = 697 * MiB, WS_SLOT = 699 * MiB, WS_END = 701 * MiB;
constexpr int CW_BAR = 4096;
constexpr int RING_BYTES = 131072, LDSCTL_OFF = RING_BYTES, MISC_OFF = LDSCTL_OFF + 320, LDS_BYTES = 147456;
constexpr int NWAVES = 8, NPHASES = 22;

typedef unsigned short bf16;
typedef unsigned v4u __attribute__((ext_vector_type(4)));
typedef unsigned v2u __attribute__((ext_vector_type(2)));
typedef float f32x4 __attribute__((ext_vector_type(4)));
typedef GAS unsigned gu32;
#define LDS_WAIT() asm volatile("s_waitcnt lgkmcnt(0)" ::: "memory")
#define VM_WAIT() asm volatile("s_waitcnt vmcnt(0)" ::: "memory")

#define XB_TMO      128
#define XB_XCNT(j)  (256  + 64 * (j))
#define XB_XSUB(j)  (1280 + 64 * (j))
#define XB_XGEN(j)  (2304 + 64 * (j))
#define XB_TOP      3328
#define XB_TOPGEN   3392
#define XCD_BAR_WORDS 3456
#define XB_SPIN_CAP (1u << 18)

__device__ __forceinline__ unsigned xb_ld(unsigned* p)              { return __hip_atomic_load(p, __ATOMIC_RELAXED, __HIP_MEMORY_SCOPE_AGENT); }
__device__ __forceinline__ unsigned xb_add(unsigned* p, unsigned v) { return __hip_atomic_fetch_add(p, v, __ATOMIC_RELAXED, __HIP_MEMORY_SCOPE_AGENT); }
__device__ __forceinline__ unsigned xb_xcc_id() { return (unsigned)__builtin_amdgcn_s_getreg((3 << 11) | 20) & 0xFu; }
#define XB_SPIN(cond, bar) do { unsigned _sp = 0; while (cond) { __builtin_amdgcn_s_sleep(1); \
    if ((++_sp & 255u) == 0u) { if (xb_ld(&(bar)[XB_TMO])) break; if (_sp > XB_SPIN_CAP) { atomicAdd(&(bar)[XB_TMO], 1u); break; } } } } while (0)

__device__ __forceinline__ int xb_lane_id() { unsigned m = ~0u; asm volatile("" : "+s"(m)); return (int)__builtin_amdgcn_mbcnt_hi(m, __builtin_amdgcn_mbcnt_lo(m, 0u)); }
struct XcdBarrier {
    int wave_s;
    unsigned* bar; unsigned x;
    volatile LAS unsigned* st;
};

__device__ __forceinline__ XcdBarrier xcd_barrier_post(unsigned* bar, volatile LAS unsigned* st, int wave_s) {
    XcdBarrier b; b.bar = bar; b.x = xb_xcc_id(); b.st = st; b.wave_s = wave_s;
    if (wave_s == 0 && xb_lane_id() == 0) (void)xb_add(&bar[XB_XCNT(b.x)], 1u);
    return b;
}
__device__ __forceinline__ void xcd_barrier_complete(unsigned* bar, unsigned x, unsigned& nloc, unsigned& nx) {
    const unsigned G = gridDim.x * gridDim.y * gridDim.z;
    unsigned sum, cnt, mine, sp = 0u;
    for (;;) {
        sum = 0u; cnt = 0u; mine = 0u;
#pragma unroll
        for (unsigned j = 0; j < 16; ++j) { const unsigned c = xb_ld(&bar[XB_XCNT(j)]); sum += c; cnt += (c > 0u) ? 1u : 0u; }
        if (sum == G) { mine = xb_ld(&bar[XB_XCNT(x)]); break; }
        __builtin_amdgcn_s_sleep(1);
        if ((++sp & 255u) == 0u) { if (xb_ld(&bar[XB_TMO])) break; if (sp > XB_SPIN_CAP) { atomicAdd(&bar[XB_TMO], 1u); break; } }
    }
    nloc = mine > 0u ? mine : 1u; nx = cnt > 0u ? cnt : 1u;
}

__device__ __forceinline__ void xcd_barrier(const XcdBarrier& b) {
    asm volatile("s_waitcnt vmcnt(0)" ::: "memory");
    __syncthreads();
    if (b.wave_s == 0 && xb_lane_id() == 0) {
        unsigned* bar = b.bar; asm volatile("" : "+s"(bar));
        __builtin_amdgcn_s_waitcnt(0);
        unsigned nloc = b.st[0], nx = b.st[1];
        if (nloc == 0u) { xcd_barrier_complete(bar, b.x, nloc, nx); b.st[0] = nloc; b.st[1] = nx; }
        const unsigned old = xb_add(&bar[XB_XSUB(b.x)], 1u);
        const unsigned gen = old / nloc;
        if (old + 1u == (gen + 1u) * nloc) {
            __builtin_amdgcn_fence(__ATOMIC_RELEASE, "agent");
            asm volatile("s_waitcnt vmcnt(0)" ::: "memory");
            const unsigned og = xb_add(&bar[XB_TOP], 1u);
            const unsigned tg = og / nx;
            if (og + 1u == (tg + 1u) * nx) xb_add(&bar[XB_TOPGEN], 1u);
            else XB_SPIN(xb_ld(&bar[XB_TOPGEN]) == tg, bar);
            __builtin_amdgcn_fence(__ATOMIC_ACQUIRE, "agent");
            xb_add(&bar[XB_XGEN(b.x)], 1u);
            asm volatile("s_waitcnt vmcnt(0)" ::: "memory");
        } else {
            XB_SPIN(xb_ld(&bar[XB_XGEN(b.x)]) == gen, bar);
            __builtin_amdgcn_fence(__ATOMIC_ACQUIRE, "agent");
            asm volatile("s_waitcnt vmcnt(0)" ::: "memory");
        }
    }
    __syncthreads();
}


struct Frame {
    LAS unsigned char* lds;
    int vcu, G, wave_s;
    unsigned char* ws;
};
struct Ids { int tid, lane, wave; };
__device__ __forceinline__ const float* inp(const LAS unsigned char* lds, int i) {
    const LAS unsigned* t = (const LAS unsigned*)(lds + 131072) + 2 * i;
    const unsigned lo = __builtin_amdgcn_readfirstlane(t[0]), hi = __builtin_amdgcn_readfirstlane(t[1]);
    return (const float*)(GAS const float*)(((unsigned long long)hi << 32) | lo); }
__device__ __forceinline__ Frame fresh_frame(const Frame& F) { Frame G = F; GAS unsigned char* g = (GAS unsigned char*)F.ws; asm volatile("" : "+s"(g), "+s"(G.lds), "+s"(G.vcu), "+s"(G.G), "+s"(G.wave_s)); G.ws = (unsigned char*)g; return G; }
__device__ __forceinline__ int lane_id() { unsigned m = ~0u; asm volatile("" : "+s"(m)); return (int)__builtin_amdgcn_mbcnt_hi(m, __builtin_amdgcn_mbcnt_lo(m, 0u)); }
__device__ __forceinline__ Ids fresh_ids(int wave_s) { Ids I; I.lane = lane_id(); I.wave = wave_s; I.tid = wave_s * 64 + I.lane; return I; }
__device__ __forceinline__ float shx(float v, int mask, int lane) { return __int_as_float(__builtin_amdgcn_ds_bpermute((lane ^ mask) << 2, __float_as_int(v))); }
__device__ __forceinline__ float shidx(float v, int src) { return __int_as_float(__builtin_amdgcn_ds_bpermute(src << 2, __float_as_int(v))); }
__device__ __forceinline__ int shidx_i(int v, int src) { return __builtin_amdgcn_ds_bpermute(src << 2, v); }
__device__ __forceinline__ float wave_sum(float v, int lane) {
#pragma unroll
    for (int o = 1; o < 64; o <<= 1) v += shx(v, o, lane);
    return v;
}
__device__ __forceinline__ float bf_lo(unsigned w) { return __uint_as_float(w << 16); }
__device__ __forceinline__ float bf_hi(unsigned w) { return __uint_as_float(w & 0xffff0000u); }
__device__ __forceinline__ f32x4 ld_bf4(const bf16* p) { const v2u w = *(const v2u*)p; return (f32x4){bf_lo(w.x), bf_hi(w.x), bf_lo(w.y), bf_hi(w.y)}; }
__device__ __forceinline__ void st_bf4(bf16* p, f32x4 v) { v2u w; w.x = pg8::cvt_pk_bf16(v.x, v.y); w.y = pg8::cvt_pk_bf16(v.z, v.w); *(v2u*)p = w; }
__device__ __forceinline__ float silu_f(float x) { return x / (1.0f + expf(-x)); }
__device__ __forceinline__ float sigmoid_f(float x) { return 1.0f / (1.0f + expf(-x)); }
__device__ __forceinline__ float log_sigmoid_f(float z) { return fminf(z, 0.f) - log1pf(expf(-fabsf(z))); }
__device__ __forceinline__ float softplus_f(float x) { return fmaxf(x, 0.f) + log1pf(expf(-fabsf(x))); }
__device__ __forceinline__ int row_sample(int r) { return r < NLAT ? (r >> 11) : 8; }

template <class RowMap>
__device__ __forceinline__ void transpose_item(const float* W, int ldw, int nvalid, int k0, int n0, bf16* WT, int ldt, const RowMap& f, LAS float* scr, int lane) {
    f32x4 t[8];
#pragma unroll
    for (int i = 0; i < 8; ++i) { const int idx = i * 64 + lane, kk = idx >> 3, c = n0 + 4 * (idx & 7);
        t[i] = c < nvalid ? __builtin_nontemporal_load((const f32x4*)(W + (size_t)(k0 + kk) * ldw + c)) : (f32x4){0.f, 0.f, 0.f, 0.f}; }
#pragma unroll
    for (int i = 0; i < 8; ++i) { const int idx = i * 64 + lane, kk = idx >> 3, c4 = 4 * (idx & 7); LAS float* d = scr + kk * 33 + c4; d[0] = t[i].x; d[1] = t[i].y; d[2] = t[i].z; d[3] = t[i].w; }
    LDS_WAIT(); asm volatile("" ::: "memory");
    const int c8 = lane & 7;
#pragma unroll
    for (int j = 0; j < 4; ++j) { const int n = (lane >> 3) + 8 * j, col = n0 + n; const LAS float* s = scr + (8 * c8) * 33 + n;
        if (col < nvalid) { v4u o; o.x = pg8::cvt_pk_bf16(s[0 * 33], s[1 * 33]); o.y = pg8::cvt_pk_bf16(s[2 * 33], s[3 * 33]); o.z = pg8::cvt_pk_bf16(s[4 * 33], s[5 * 33]); o.w = pg8::cvt_pk_bf16(s[6 * 33], s[7 * 33]);
            *(v4u*)(WT + (size_t)f(col) * ldt + k0 + 8 * c8) = o; } }
    LDS_WAIT(); asm volatile("" ::: "memory");
}
struct MapId { int off; __device__ __forceinline__ int operator()(int c) const { return off + c; } };
struct MapGU { int off, n; __device__ __forceinline__ int operator()(int h) const { const int hl = h & 127, q = hl >> 3, wc = q >> 2, fq = q & 3, rem = hl & 7, bj = rem >> 2, j = rem & 3;
    return off + 256 * (h >> 7) + 128 * bj + 32 * wc + 16 * n + 4 * fq + j; } };

__device__ __forceinline__ void p0_prologue(const Frame& F_) {
    const Frame F = fresh_frame(F_); const Ids I = fresh_ids(F.wave_s);
    const float* cvec = inp(F.lds, 1); const float* cctx = inp(F.lds, 3); const float* w_mod = inp(F.lds, 4); const float* b_mod = inp(F.lds, 5);
    float* MOD = (float*)(F.ws + WS_MOD);
    {
        LAS float* sil = (LAS float*)F.lds;
        LAS float* part = (LAS float*)(F.lds + 40960);
        for (int i = I.tid; i < 9 * 1024; i += 512) { const int s = i >> 10, k = i & 1023; const float c = s < 8 ? cvec[s * 1024 + k] : cctx[k]; sil[i] = silu_f(c); }
        __syncthreads();
        for (int item = F.vcu; item < 192; item += F.G) {
            const int l = item / 96, col = (item % 96) * 64 + I.lane;
            float acc[9];
#pragma unroll
            for (int s = 0; s < 9; ++s) acc[s] = 0.f;
            const float* wp = w_mod + (size_t)l * 1024 * MODW + (size_t)(I.wave * 128) * MODW + col;
            for (int k = 0; k < 128; ++k) { const float wv = wp[(size_t)k * MODW];
#pragma unroll
                for (int s = 0; s < 9; ++s) acc[s] += sil[s * 1024 + I.wave * 128 + k] * wv; }
#pragma unroll
            for (int s = 0; s < 9; ++s) part[(I.wave * 9 + s) * 64 + I.lane] = acc[s];
            __syncthreads();
            for (int i = I.tid; i < 9 * 64; i += 512) { const int s = i >> 6, ln = i & 63; float t = 0.f;
#pragma unroll
                for (int w = 0; w < 8; ++w) t += part[(w * 9 + s) * 64 + ln];
                const int cc = (item % 96) * 64 + ln; MOD[((size_t)l * 9 + s) * MODW + cc] = t + b_mod[l * MODW + cc]; }
            __syncthreads();
        }
        __syncthreads();
    }
    {
        bf16* wtin = (bf16*)(F.ws + WS_WTIN);
        const int nchunk = 2 * (INP - INC) * 128;
        for (int i = F.vcu * 512 + I.tid; i < nchunk; i += F.G * 512) { const int l = i / ((INP - INC) * 128), r = i % ((INP - INC) * 128);
            *(v4u*)(wtin + ((size_t)l * INP + INC) * 1024 + (size_t)r * 8) = (v4u){0u, 0u, 0u, 0u}; }
    }
    {
        LAS float* scr = (LAS float*)(F.lds + I.wave * 16384);
        const int gw = F.vcu * NWAVES + I.wave, NGW = F.G * NWAVES;
        constexpr int I_IN = 16 * 114, I_OUT = 16 * 32, I_E = 768, PER_L = I_IN + I_OUT + 16 * 3 * I_E;
#ifndef CONV_IN_SCAN
#define CONV_IN_SCAN 1
#endif
        constexpr int PER_L0 = CONV_IN_SCAN ? (I_IN + I_OUT) : PER_L;
        for (int it = gw; it < 2 * PER_L0; it += NGW) {
            const int l = it / PER_L0; int r = it % PER_L0;
            if (r < I_IN) { const int kb = r / 114, nb = r % 114;
                transpose_item(inp(F.lds, 8) + (size_t)l * 1024 * INC, INC, INC, 64 * kb, 32 * nb, (bf16*)(F.ws + WS_WTIN) + (size_t)l * INP * 1024, 1024, MapId{0}, scr, I.lane); continue; }
            r -= I_IN;
            if (r < I_OUT) { const int kb = r / 32, nb = r % 32;
                transpose_item(inp(F.lds, 9) + (size_t)l * 1024 * 1024, 1024, 1024, 64 * kb, 32 * nb, (bf16*)(F.ws + WS_WTOUT) + (size_t)l * 1024 * 1024, 1024, MapId{0}, scr, I.lane); continue; }
            r -= I_OUT;
            const int e = r / (3 * I_E), q = r % (3 * I_E), kind = q / I_E, t = q % I_E;
            if (kind < 2) { const int kb = t / 48, nb = t % 48;
                transpose_item((kind ? inp(F.lds, 25) : inp(F.lds, 24)) + ((size_t)l * NE + e) * 1024 * FF, FF, FF, 64 * kb, 32 * nb, (bf16*)(F.ws + WS_WTGU) + (size_t)l * NE * 3072 * 1024, 1024, MapGU{e * 3072, kind}, scr, I.lane); }
            else { const int kb = t / 32, nb = t % 32;
                transpose_item(inp(F.lds, 26) + ((size_t)l * NE + e) * FF * 1024, 1024, 1024, 64 * kb, 32 * nb, (bf16*)(F.ws + WS_WTDN) + (size_t)l * NE * 1024 * FF, FF, MapId{e * 1024}, scr, I.lane); }
        }
    }
}

__device__ __forceinline__ void load_row_f32(const float* p, int lane, f32x4 (&v)[4]) {
#pragma unroll
    for (int j = 0; j < 4; ++j) v[j] = *(const f32x4*)(p + 4 * lane + 256 * j);
}
__device__ __forceinline__ float row_sumsq(const f32x4 (&v)[4], int lane) { float s = 0.f;
#pragma unroll
    for (int j = 0; j < 4; ++j) s += (v[j].x * v[j].x + v[j].y * v[j].y) + (v[j].z * v[j].z + v[j].w * v[j].w);
    return wave_sum(s, lane); }
__device__ __forceinline__ void add_expert_out(f32x4 (&v)[4], int r, int lane, const int* slotmap, const float* afft, const bf16* EO, const float* g2) {
    f32x4 acc[4];
#pragma unroll
    for (int j = 0; j < 4; ++j) acc[j] = (f32x4){0.f, 0.f, 0.f, 0.f};
    const int sl = lane < NE ? slotmap[r * 16 + lane] : -1;
    const float af = lane < NE ? afft[(size_t)lane * NROWS + r] : 0.f;
    unsigned mask = (unsigned)__ballot(sl >= 0);
    while (mask) {
        v2u w[4][4]; float a[4];
#pragma unroll
        for (int q = 0; q < 4; ++q) {
            const bool on = mask != 0u; const int e = on ? __builtin_ctz(mask) : 0; if (on) mask &= mask - 1u;
            const int slot = __builtin_amdgcn_readlane(sl, e); a[q] = on ? __int_as_float(__builtin_amdgcn_readlane(__float_as_int(af), e)) : 0.f;
            const bf16* er = EO + (size_t)(on ? slot : 0) * 1024;
#pragma unroll
            for (int j = 0; j < 4; ++j) w[q][j] = on ? *(const v2u*)(er + 4 * lane + 256 * j) : (v2u){0u, 0u};
        }
#pragma unroll
        for (int q = 0; q < 4; ++q)
#pragma unroll
            for (int j = 0; j < 4; ++j) acc[j] += a[q] * (f32x4){bf_lo(w[q][j].x), bf_hi(w[q][j].x), bf_lo(w[q][j].y), bf_hi(w[q][j].y)};
    }
#pragma unroll
    for (int j = 0; j < 4; ++j) v[j] += *(const f32x4*)(g2 + 4 * lane + 256 * j) * acc[j];
}
__device__ __forceinline__ void p1_norm1(const Frame& F_, int l) {
    const Frame F = fresh_frame(F_); const Ids I = fresh_ids(F.wave_s);
    const int gw = F.vcu * NWAVES + I.wave, NGW = F.G * NWAVES;
    float* H = (float*)(F.ws + WS_H); bf16* HN = (bf16*)(F.ws + WS_HN);
    const float* MOD = (const float*)(F.ws + WS_MOD); const float* nw = inp(F.lds, 6) + l * 1024;
    const float* xin = inp(F.lds, 0); const float* cin = inp(F.lds, 2);
    constexpr int RB = 3;
    for (int r0 = gw; r0 < NROWS; r0 += NGW * RB) {
        f32x4 v[RB][4];
#pragma unroll
        for (int q = 0; q < RB; ++q) { const int r = r0 + q * NGW; if (r < NROWS) {
            if (l == 0) load_row_f32(r < NLAT ? xin + (size_t)r * D : cin + (size_t)(r - NLAT) * D, I.lane, v[q]); else load_row_f32(H + (size_t)r * D, I.lane, v[q]); } }
#pragma unroll
        for (int q = 0; q < RB; ++q) { const int r = r0 + q * NGW; if (r < NROWS) {
            const int s = row_sample(r);
            if (l != 0) add_expert_out(v[q], r, I.lane, (const int*)(F.ws + WS_SLOT), (const float*)(F.ws + WS_AFFT), (const bf16*)(F.ws + WS_O2), MOD + ((size_t)(l - 1) * 9 + s) * MODW + 5120);
            const float rstd = 1.0f / sqrtf(row_sumsq(v[q], I.lane) * (1.0f / D) + EPS);
            const float* m = MOD + ((size_t)l * 9 + s) * MODW;
#pragma unroll
            for (int j = 0; j < 4; ++j) { const int k = 4 * I.lane + 256 * j;
                *(f32x4*)(H + (size_t)r * D + k) = v[q][j];
                const f32x4 w = *(const f32x4*)(nw + k), sh = *(const f32x4*)(m + k), sc = *(const f32x4*)(m + 1024 + k);
                st_bf4(HN + (size_t)r * D + k, (v[q][j] * rstd * w) * (sc + 1.0f) + sh); } } }
    }
}
__device__ __forceinline__ void p_final(const Frame& F_, float* out) {
    const Frame F = fresh_frame(F_); const Ids I = fresh_ids(F.wave_s);
    const int gw = F.vcu * NWAVES + I.wave, NGW = F.G * NWAVES;
    const float* H = (const float*)(F.ws + WS_H); const float* MOD = (const float*)(F.ws + WS_MOD); const float* nw = inp(F.lds, 27);
    constexpr int RB = 2;
    for (int r0 = gw; r0 < NLAT; r0 += NGW * RB) {
        f32x4 v[RB][4];
#pragma unroll
        for (int q = 0; q < RB; ++q) { const int r = r0 + q * NGW; if (r < NLAT) load_row_f32(H + (size_t)r * D, I.lane, v[q]); }
#pragma unroll
        for (int q = 0; q < RB; ++q) { const int r = r0 + q * NGW; if (r < NLAT) {
            const int s = row_sample(r);
            add_expert_out(v[q], r, I.lane, (const int*)(F.ws + WS_SLOT), (const float*)(F.ws + WS_AFFT), (const bf16*)(F.ws + WS_O2), MOD + ((size_t)1 * 9 + s) * MODW + 5120);
            const float rstd = 1.0f / sqrtf(row_sumsq(v[q], I.lane) * (1.0f / D) + EPS);
#pragma unroll
            for (int j = 0; j < 4; ++j) { const int k = 4 * I.lane + 256 * j; *(f32x4*)(out + (size_t)r * D + k) = v[q][j] * rstd * *(const f32x4*)(nw + k); } } }
    }
}
__device__ __forceinline__ void p6_norm2_router(const Frame& F_, int l, int nrows) {
    const Frame F = fresh_frame(F_); const Ids I = fresh_ids(F.wave_s);
    const int gw = F.vcu * NWAVES + I.wave, NGW = F.G * NWAVES;
    const float* H = (const float*)(F.ws + WS_H); bf16* HN = (bf16*)(F.ws + WS_HN); float* AFFT = (float*)(F.ws + WS_AFFT);
    const float* MOD = (const float*)(F.ws + WS_MOD); const float* nw = inp(F.lds, 7) + l * 1024; const float* rw = inp(F.lds, 23) + (size_t)l * 1024 * NE;
    LAS float* wt = (LAS float*)F.lds;
    for (int i = I.tid; i < 1024 * 4; i += 512) { const int k = i >> 2, q = i & 3; const f32x4 w = *(const f32x4*)(rw + k * 16 + 4 * q);
        wt[(4 * q + 0) * 1024 + k] = w.x; wt[(4 * q + 1) * 1024 + k] = w.y; wt[(4 * q + 2) * 1024 + k] = w.z; wt[(4 * q + 3) * 1024 + k] = w.w; }
    __syncthreads();
    const int lane = I.lane;
    const int myexp = ((lane >> 5) & 1) * 8 + ((lane >> 4) & 1) * 4 + ((lane >> 3) & 1) * 2 + ((lane >> 2) & 1);
    constexpr int RB = 2;
    for (int r0 = gw; r0 < nrows; r0 += NGW * RB) {
        f32x4 v[RB][4];
#pragma unroll
        for (int q = 0; q < RB; ++q) { const int r = r0 + q * NGW; if (r < nrows) load_row_f32(H + (size_t)r * D, lane, v[q]); }
#pragma unroll
        for (int q = 0; q < RB; ++q) { const int r = r0 + q * NGW; if (r < nrows) {
            const int s = row_sample(r);
            const float rstd = 1.0f / sqrtf(row_sumsq(v[q], I.lane) * (1.0f / D) + EPS);
            const float* m = MOD + ((size_t)l * 9 + s) * MODW;
#pragma unroll
            for (int j = 0; j < 4; ++j) { const int k = 4 * lane + 256 * j;
                const f32x4 w = *(const f32x4*)(nw + k), sh = *(const f32x4*)(m + 3072 + k), sc = *(const f32x4*)(m + 4096 + k);
                v[q][j] = (v[q][j] * rstd * w) * (sc + 1.0f) + sh;
                st_bf4(HN + (size_t)r * D + k, v[q][j]); }
            float p[NE];
#pragma unroll
            for (int e = 0; e < NE; ++e) { float a = 0.f;
#pragma unroll
                for (int j = 0; j < 4; ++j) { const f32x4 w = *(const LAS f32x4*)(wt + e * 1024 + 4 * lane + 256 * j); a += (v[q][j].x * w.x + v[q][j].y * w.y) + (v[q][j].z * w.z + v[q][j].w * w.w); }
                p[e] = a; }
            float a8[8], a4[4], a2[2], a1;
            { const bool hi = (lane & 32) != 0;
#pragma unroll
              for (int i = 0; i < 8; ++i) { const float send = hi ? p[i] : p[8 + i], keep = hi ? p[8 + i] : p[i]; a8[i] = keep + shx(send, 32, lane); } }
            { const bool hi = (lane & 16) != 0;
#pragma unroll
              for (int i = 0; i < 4; ++i) { const float send = hi ? a8[i] : a8[4 + i], keep = hi ? a8[4 + i] : a8[i]; a4[i] = keep + shx(send, 16, lane); } }
            { const bool hi = (lane & 8) != 0;
#pragma unroll
              for (int i = 0; i < 2; ++i) { const float send = hi ? a4[i] : a4[2 + i], keep = hi ? a4[2 + i] : a4[i]; a2[i] = keep + shx(send, 8, lane); } }
            { const bool hi = (lane & 4) != 0; const float send = hi ? a2[0] : a2[1], keep = hi ? a2[1] : a2[0]; a1 = keep + shx(send, 4, lane); }
            a1 += shx(a1, 2, lane); a1 += shx(a1, 1, lane);
            float mx = a1;
            mx = fmaxf(mx, shx(mx, 4, lane)); mx = fmaxf(mx, shx(mx, 8, lane)); mx = fmaxf(mx, shx(mx, 16, lane)); mx = fmaxf(mx, shx(mx, 32, lane));
            const float ex = expf(a1 - mx); float den = ex;
            den += shx(den, 4, lane); den += shx(den, 8, lane); den += shx(den, 16, lane); den += shx(den, 32, lane);
            if ((lane & 3) == 0) AFFT[(size_t)myexp * NROWS + r] = ex / den; } }
    }
    __syncthreads();
}
__device__ __forceinline__ int block_excl_scan(int v, LAS int* wsum, int lane, int wave, int& total) {
    int inc = v;
#pragma unroll
    for (int off = 1; off < 64; off <<= 1) { const int o = shidx_i(inc, (lane - off) & 63); if (lane >= off) inc += o; }
    if (lane == 63) wsum[wave] = inc;
    __syncthreads();
    int base = 0, tot = 0;
#pragma unroll
    for (int w = 0; w < 8; ++w) { const int s = wsum[w]; base += (w < wave) ? s : 0; tot += s; }
    __syncthreads();
    total = tot; return base + inc - v;
}
__device__ __forceinline__ void p7_topk(const Frame& F_, int l) {
    const Frame F = fresh_frame(F_); const Ids I = fresh_ids(F.wave_s);
    const float* AFFT = (const float*)(F.ws + WS_AFFT); int* SLOT = (int*)(F.ws + WS_SLOT);
    const bf16* HN = (const bf16*)(F.ws + WS_HN); bf16* XS = (bf16*)(F.ws + WS_Y);
    LAS unsigned* hist = (LAS unsigned*)F.lds;
    LAS unsigned* misc = hist + 256;
    LAS int* wsum = (LAS int*)(hist + 264);
    LAS int* selrow = (LAS int*)(hist + 272);
    const int nitems = (l == 0 ? 16 : 8) * NE;
    for (int item = F.vcu; item < nitems; item += F.G) {
        const int set = item >> 4, e = item & 15;
        const int n = set < 8 ? SEQ : CTXL, cap = n >> 3;
        const int row0 = set < 8 ? set * SEQ : NLAT + (set - 8) * CTXL, slotbase = set < 8 ? set * 256 : 2048 + (set - 8) * 32;
        unsigned key[4]; const int i0 = 4 * I.tid; const bool valid = i0 < n;
        { f32x4 a = (f32x4){0.f, 0.f, 0.f, 0.f}; if (valid) a = *(const f32x4*)(AFFT + (size_t)e * NROWS + row0 + i0);
          key[0] = __float_as_uint(a.x); key[1] = __float_as_uint(a.y); key[2] = __float_as_uint(a.z); key[3] = __float_as_uint(a.w); }
        unsigned prefix = 0u, kk = (unsigned)cap;
        for (int pass = 3; pass >= 0; --pass) {
            const int shift = 8 * pass;
            if (I.tid < 256) hist[I.tid] = 0u;
            __syncthreads();
            if (valid) {
#pragma unroll
                for (int j = 0; j < 4; ++j) { const bool match = pass == 3 || ((key[j] >> (shift + 8)) == (prefix >> (shift + 8)));
                    if (match) atomicAdd((unsigned*)&hist[(key[j] >> shift) & 255u], 1u); }
            }
            __syncthreads();
            if (I.wave == 0) {
                const unsigned h0 = hist[4 * I.lane], h1 = hist[4 * I.lane + 1], h2 = hist[4 * I.lane + 2], h3 = hist[4 * I.lane + 3];
                const unsigned s = h0 + h1 + h2 + h3; unsigned t = s;
#pragma unroll
                for (int off = 1; off < 64; off <<= 1) { const unsigned o = (unsigned)shidx_i((int)t, (I.lane + off) & 63); if (I.lane + off < 64) t += o; }
                const unsigned above = t - s, c3 = above + h3, c2 = c3 + h2, c1 = c2 + h1, c0 = c1 + h0;
                int d = -1; unsigned nk = 0u;
                if (above < kk && c3 >= kk) { d = 3; nk = kk - above; }
                else if (c3 < kk && c2 >= kk) { d = 2; nk = kk - c3; }
                else if (c2 < kk && c1 >= kk) { d = 1; nk = kk - c2; }
                else if (c1 < kk && c0 >= kk) { d = 0; nk = kk - c1; }
                if (d >= 0) { misc[0] = prefix | ((unsigned)(4 * I.lane + d) << shift); misc[1] = nk; }
            }
            __syncthreads();
            prefix = misc[0]; kk = misc[1];
        }
        int ceq = 0; bool gt[4], eq[4];
#pragma unroll
        for (int j = 0; j < 4; ++j) { gt[j] = valid && key[j] > prefix; eq[j] = valid && key[j] == prefix; ceq += eq[j] ? 1 : 0; }
        int tot; int erank = block_excl_scan(ceq, wsum, I.lane, I.wave, tot);
        bool sel[4]; int csel = 0;
#pragma unroll
        for (int j = 0; j < 4; ++j) { sel[j] = gt[j] || (eq[j] && (unsigned)erank < kk); erank += eq[j] ? 1 : 0; csel += sel[j] ? 1 : 0; }
        int slot = block_excl_scan(csel, wsum, I.lane, I.wave, tot);
        if (valid) {
#pragma unroll
            for (int j = 0; j < 4; ++j) { const int r = row0 + i0 + j;
                if (sel[j]) { if (slot < cap) { selrow[slot] = r; SLOT[r * 16 + e] = e * SLOTS + slotbase + slot; } else SLOT[r * 16 + e] = -1; ++slot; }
                else SLOT[r * 16 + e] = -1; }
        }
        __syncthreads();
        for (int s0 = I.wave * 4; s0 < cap; s0 += NWAVES * 4) {
            v4u a[4], b[4];
#pragma unroll
            for (int q = 0; q < 4; ++q) { const bf16* src = HN + (size_t)selrow[s0 + q] * D; a[q] = *(const v4u*)(src + 8 * I.lane); b[q] = *(const v4u*)(src + 512 + 8 * I.lane); }
#pragma unroll
            for (int q = 0; q < 4; ++q) { bf16* dst = XS + (size_t)(e * SLOTS + slotbase + s0 + q) * D; *(v4u*)(dst + 8 * I.lane) = a[q]; *(v4u*)(dst + 512 + 8 * I.lane) = b[q]; }
        }
        __syncthreads();
    }
}

typedef short bf16x8s __attribute__((ext_vector_type(8)));
typedef short s16x4 __attribute__((ext_vector_type(4)));
constexpr int IMGB = 9216;
constexpr int CS_SET = 4 * IMGB + 1024;
constexpr int CS_P = 2 * CS_SET, CS_ST = CS_P + IMGB, CS_NS = CS_ST + 2 * IMGB, CS_GS = CS_NS + 256, CS_GM = CS_GS + 2048, CS_END = CS_GM + 8192;
static_assert(CS_END <= RING_BYTES, "scan LDS map");
__device__ __forceinline__ bf16x8s rowfrag(const LAS unsigned char* img, int row0, int ks, int fr, int fq) { return *(const LAS bf16x8s*)(img + (row0 + fr) * 144 + ks * 64 + fq * 16); }
__device__ __forceinline__ s16x4 tr_rd(const LAS unsigned char* p) { return __builtin_bit_cast(s16x4, __builtin_amdgcn_ds_read_tr16_b64_v4i16((LAS s16x4*)(LAS unsigned char*)p)); }
__device__ __forceinline__ bf16x8s trfrag(const LAS unsigned char* img, int tok0, int col0, int lane) {
    const LAS unsigned char* a = img + (tok0 + 8 * (lane >> 4) + ((lane >> 2) & 3)) * 144 + (col0 + 4 * (lane & 3)) * 2;
    const s16x4 lo = tr_rd(a), hi = tr_rd(a + 4 * 144);
    return (bf16x8s){lo[0], lo[1], lo[2], lo[3], hi[0], hi[1], hi[2], hi[3]};
}
__device__ __forceinline__ f32x4 mfma16(bf16x8s a, bf16x8s b, f32x4 c) { return __builtin_amdgcn_mfma_f32_16x16x32_bf16(a, b, c, 0, 0, 0); }
struct f32x8 { f32x4 a, b; };
__device__ __forceinline__ f32x8 cvt8(v4u w) { f32x8 r; r.a = (f32x4){bf_lo(w.x), bf_hi(w.x), bf_lo(w.y), bf_hi(w.y)}; r.b = (f32x4){bf_lo(w.z), bf_hi(w.z), bf_lo(w.w), bf_hi(w.w)}; return r; }
__device__ __forceinline__ v4u pack8(f32x4 a, f32x4 b) { v4u w; w.x = pg8::cvt_pk_safe(a.x, a.y); w.y = pg8::cvt_pk_safe(a.z, a.w); w.z = pg8::cvt_pk_safe(b.x, b.y); w.w = pg8::cvt_pk_safe(b.z, b.w); return w; }
__device__ __forceinline__ float silu_q(float x) { return x * __builtin_amdgcn_rcpf(1.0f + __expf(-x)); }
__device__ __forceinline__ float sigmoid_q(float x) { return __builtin_amdgcn_rcpf(1.0f + __expf(-x)); }
__device__ __forceinline__ float log_sigmoid_q(float z) { return fminf(z, 0.f) - __logf(1.0f + __expf(-fabsf(z))); }
__device__ __forceinline__ float softplus_q(float x) { return fmaxf(x, 0.f) + __logf(1.0f + __expf(-fabsf(x))); }
template <int N> __device__ __forceinline__ float dpp_row_shr(float v) { return __int_as_float(__builtin_amdgcn_update_dpp(0, __float_as_int(v), 0x110 + N, 0xf, 0xf, true)); }
__device__ __forceinline__ float rdlane(float v, int l) { return __int_as_float(__builtin_amdgcn_readlane(__float_as_int(v), l)); }
__device__ __forceinline__ float wave_incl_scan(float v, int lane) {
    v += dpp_row_shr<1>(v); v += dpp_row_shr<2>(v); v += dpp_row_shr<4>(v); v += dpp_row_shr<8>(v);
    const float t0 = rdlane(v, 15), t1 = rdlane(v, 31), t2 = rdlane(v, 47); const int row = lane >> 4;
    return v + ((row >= 1 ? t0 : 0.f) + (row >= 2 ? t1 : 0.f) + (row >= 3 ? t2 : 0.f));
}
struct ConvRaw { float t[32]; bf16* dp; };
__device__ __forceinline__ void conv_issue(const LAS unsigned char* lds, unsigned char* ws, int l, int idx, int lane, ConvRaw& C) {
    const int e = idx / 2304, q = idx % 2304, kind = q / 768, t = q % 768;
    const float* sp; size_t ldw;
    if (kind < 2) { const int kb = t / 24, nb = t % 24, n = 64 * nb + lane; ldw = FF;
        sp = (kind ? inp(lds, 25) : inp(lds, 24)) + ((size_t)l * NE + e) * 1024 * FF + (size_t)(32 * kb) * FF + n;
        C.dp = (bf16*)(ws + WS_WTGU) + (size_t)l * NE * 3072 * 1024 + (size_t)MapGU{e * 3072, kind}(n) * 1024 + 32 * kb; }
    else { const int kb = t / 16, nb = t % 16, n = 64 * nb + lane; ldw = 1024;
        sp = inp(lds, 26) + ((size_t)l * NE + e) * FF * 1024 + (size_t)(32 * kb) * 1024 + n;
        C.dp = (bf16*)(ws + WS_WTDN) + (size_t)l * NE * 1024 * FF + (size_t)(e * 1024 + n) * FF + 32 * kb; }
#pragma unroll
    for (int i = 0; i < 32; ++i) C.t[i] = __builtin_nontemporal_load(sp + (size_t)i * ldw);
}
__device__ __forceinline__ void conv_finish(const ConvRaw& C) {
#pragma unroll
    for (int q = 0; q < 4; ++q) { v4u o; o.x = pg8::cvt_pk_bf16(C.t[8 * q], C.t[8 * q + 1]); o.y = pg8::cvt_pk_bf16(C.t[8 * q + 2], C.t[8 * q + 3]); o.z = pg8::cvt_pk_bf16(C.t[8 * q + 4], C.t[8 * q + 5]); o.w = pg8::cvt_pk_bf16(C.t[8 * q + 6], C.t[8 * q + 7]);
        *(v4u*)(C.dp + 8 * q) = o; }
}
constexpr size_t WS_UC = 701 * MiB, WS_LA = 719 * MiB, WS_END3 = 737 * MiB;
__device__ __forceinline__ void p2t_pretransform(const Frame& F_, int l) {
    const Frame F = fresh_frame(F_); const Ids I = fresh_ids(F.wave_s);
    const int gw = F.vcu * NWAVES + I.wave, NGW = F.G * NWAVES, lane = I.lane;
    bf16* U = (bf16*)(F.ws + WS_U); bf16* UC = (bf16*)(F.ws + WS_UC); float* LA = (float*)(F.ws + WS_LA);
    f32x4 cwa[5], cwb[5], cba, cbb;
    { const float* cw = inp(F.lds, 15) + (size_t)l * 5 * 512 + 8 * lane; const float* cb = inp(F.lds, 16) + l * 512 + 8 * lane;
#pragma unroll
      for (int w = 0; w < 5; ++w) { cwa[w] = *(const f32x4*)(cw + w * 512); cwb[w] = *(const f32x4*)(cw + w * 512 + 4); }
      cba = *(const f32x4*)cb; cbb = *(const f32x4*)(cb + 4); }
    f32x4 gwv[16], gbv;
    { const float* gwp = inp(F.lds, 12) + (size_t)l * 4096 + (lane >> 5) * 2048 + ((4 * lane) & 127);
#pragma unroll
      for (int r = 0; r < 16; ++r) gwv[r] = *(const f32x4*)(gwp + r * 128);
      gbv = *(const f32x4*)(inp(F.lds, 13) + l * 256 + 4 * lane); }
    const int rc = (8 * lane) & 255, rd0 = rc & 63; const bool isq = lane < 32, first = (rd0 & 31) < 16; const int plane = first ? lane + 2 : lane - 2;
    float invf[8];
#pragma unroll
    for (int j = 0; j < 8; ++j) invf[j] = exp2f(-(float)((rd0 & 15) + j) * (13.287712379549449f / 16.0f)) * 0.15915494309189535f;
    constexpr int RB = 2;
    for (int r0 = gw; r0 < NROWS; r0 += NGW * RB) {
        v4u qk[RB], tap[RB][5], lr0[RB], lr1[RB], mk[RB];
#pragma unroll
        for (int q = 0; q < RB; ++q) { const int r = r0 + q * NGW; if (r < NROWS) {
            const bool isctx = r >= NLAT; const int t = isctx ? ((r - NLAT) & (CTXL - 1)) : (r & (SEQ - 1)), len = isctx ? CTXL : SEQ; const size_t rb = (size_t)(r - t);
            const bf16* ur = U + (size_t)r * INP;
            qk[q] = *(const v4u*)(ur + 8 * lane);
#pragma unroll
            for (int w = 0; w < 5; ++w) { const int tt = t + w - 2; const bool ok = tt >= 0 && tt < len; const v4u x = *(const v4u*)(U + (rb + (ok ? tt : t)) * INP + C_SSD + 256 + 8 * lane); tap[q][w] = ok ? x : (v4u){0u, 0u, 0u, 0u}; }
            lr0[q] = *(const v4u*)(ur + C_GLA + 768); lr1[q] = *(const v4u*)(ur + C_GLA + 776);
            mk[q] = (v4u){0u, 0u, 0u, 0u}; if (lane < 32) mk[q] = *(const v4u*)(ur + C_ML + 256 + 8 * lane); } }
#pragma unroll
        for (int q = 0; q < RB; ++q) { const int r = r0 + q * NGW; if (r < NROWS) {
            const bool isctx = r >= NLAT; const int t = isctx ? ((r - NLAT) & (CTXL - 1)) : (r & (SEQ - 1));
            bf16* ur = U + (size_t)r * INP;
            { f32x8 own = cvt8(qk[q]); v4u pq; pq.x = (unsigned)shidx_i((int)qk[q].x, plane); pq.y = (unsigned)shidx_i((int)qk[q].y, plane); pq.z = (unsigned)shidx_i((int)qk[q].z, plane); pq.w = (unsigned)shidx_i((int)qk[q].w, plane);
              const f32x8 par = cvt8(pq); const float sc = isq ? 0.125f : 1.0f;
              if (!isctx) { const float posv = (rd0 < 32) ? (float)(t >> 6) : (float)(t & 63);
#pragma unroll
                  for (int j = 0; j < 8; ++j) { const float rev = posv * invf[j]; const float cs = __builtin_amdgcn_cosf(rev), sn = __builtin_amdgcn_sinf(rev);
                      const float o = j < 4 ? own.a[j & 3] : own.b[j & 3], p = j < 4 ? par.a[j & 3] : par.b[j & 3]; const float n = (first ? o * cs - p * sn : p * sn + o * cs) * sc;
                      if (j < 4) own.a[j & 3] = n; else own.b[j & 3] = n; } }
              else { own.a = own.a * sc; own.b = own.b * sc; }
              *(v4u*)(ur + 8 * lane) = pack8(own.a, own.b); }
            { f32x4 a0 = cba, a1 = cbb;
#pragma unroll
              for (int w = 0; w < 5; ++w) { const f32x8 x = cvt8(tap[q][w]); a0 += x.a * cwa[w]; a1 += x.b * cwb[w]; }
#pragma unroll
              for (int j = 0; j < 4; ++j) { a0[j] = silu_q(a0[j]); a1[j] = silu_q(a1[j]); }
              *(v4u*)(UC + (size_t)r * 512 + 8 * lane) = pack8(a0, a1); }
            { const f32x8 l0 = cvt8(lr0[q]), l1 = cvt8(lr1[q]); f32x4 z = gbv;
#pragma unroll
              for (int qq = 0; qq < 4; ++qq) { z += gwv[qq] * l0.a[qq] + gwv[4 + qq] * l0.b[qq] + gwv[8 + qq] * l1.a[qq] + gwv[12 + qq] * l1.b[qq]; }
              f32x4 o;
#pragma unroll
              for (int j = 0; j < 4; ++j) o[j] = log_sigmoid_q(z[j]) * (1.0f / 16.0f);
              *(f32x4*)(LA + (size_t)r * 256 + 4 * lane) = o; }
            if (lane < 32) { f32x8 kk = cvt8(mk[q]); kk.a = kk.a * 0.125f; kk.b = kk.b * 0.125f; *(v4u*)(ur + C_ML + 256 + 8 * lane) = pack8(kk.a, kk.b); } } }
    }
}

constexpr size_t WS_NIN = WS_AFFT + 1179648;
constexpr int S1_SET = 2 * IMGB + 256, S1_GS = 2 * S1_SET, S1_GM = S1_GS + 2048, S1_END = S1_GM + 8192;
struct StRaw { v4u r[10]; float s0, s1; };
__device__ __forceinline__ int nat_chunk(int cc, int dir) { return cc < 4 ? (dir ? 3 - cc : cc) : (dir ? 35 - cc : cc - 4); }

template <int MIX>
__device__ __forceinline__ void state_item(const Frame& F, const Ids& I, int l, int b, int h, int dir, int item) {
    const bf16* U = (const bf16*)(F.ws + WS_U); bf16* SIN = (bf16*)(F.ws + WS_O2) + (size_t)item * 36 * 4096;
    float* NIN = (float*)(F.ws + WS_NIN) + (size_t)((b * 4 + h) * 2 + dir) * 36 * 64;
    LAS unsigned char* sm = F.lds;
    const int lane = I.lane, wave = I.wave, fr = lane & 15, fq = lane >> 4, rt = wave >> 1, cp = wave & 1;
    const int tk = I.tid >> 3, d0 = (I.tid & 7) * 8;
    float c_la = 0.f, c_b0 = 0.f, c_b1 = 0.f;
    if (MIX == 0) c_la = log_sigmoid_f(inp(F.lds, 10)[(l * 2 + dir) * 4 + h]);
    if (MIX == 2) { c_b0 = inp(F.lds, 17)[(l * 2 + dir) * 4 + h]; c_b1 = -expf(inp(F.lds, 18)[(l * 2 + dir) * 4 + h]); }
    if (MIX == 3) { c_b0 = inp(F.lds, 21)[((l * 2 + dir) * 2 + 0) * 4 + h]; c_b1 = inp(F.lds, 21)[((l * 2 + dir) * 2 + 1) * 4 + h]; }
    float invf[8];
#pragma unroll
    for (int j = 0; j < 8; ++j) invf[j] = MIX == 0 ? exp2f(-(float)((d0 & 15) + j) * (13.287712379549449f / 16.0f)) * 0.15915494309189535f : 0.f;
    float gwr[16]; float gbr = 0.f;
    if (MIX == 1) { const float* gw_ = inp(F.lds, 12) + (size_t)(l * 2 + dir) * 16 * 128 + h * 32 + (I.tid & 31);
#pragma unroll
        for (int r = 0; r < 16; ++r) gwr[r] = gw_[r * 128];
        gbr = inp(F.lds, 13)[(l * 2 + dir) * 128 + h * 32 + (I.tid & 31)]; }
    if (MIX == 2) {
        LAS float* cwl = (LAS float*)(sm + S1_GM); const float* cw = inp(F.lds, 15) + (size_t)l * 5 * 512; const float* cb = inp(F.lds, 16) + l * 512; const int g = h >> 1;
        for (int i = I.tid; i < 6 * 128; i += 512) { const int w = i >> 7, c = i & 127; const int ch = c < 64 ? h * 64 + c : 256 + g * 64 + (c - 64); cwl[i] = w < 5 ? cw[w * 512 + ch] : cb[ch]; }
    }
    f32x4 S[2], nst; S[0] = (f32x4){0.f, 0.f, 0.f, 0.f}; S[1] = S[0]; nst = S[0];
    __syncthreads();

    const bf16* UC = (const bf16*)(F.ws + WS_UC); const float* LA = (const float*)(F.ws + WS_LA);
    auto issue = [&](int cc, StRaw& R) {
        const bool isctx = cc < 4; const int rowbase = isctx ? NLAT + b * CTXL : b * SEQ, t0 = 64 * nat_chunk(cc, dir);
        const int t = t0 + tk; const bf16* ur = U + (size_t)(rowbase + t) * INP; const bf16* ul = U + (size_t)(rowbase + t0 + lane) * INP;
        if (MIX == 0) { R.r[0] = *(const v4u*)(ur + C_RET + 256 + h * 64 + d0); R.r[1] = *(const v4u*)(ur + C_RET + 512 + h * 64 + d0); }
        else if (MIX == 1) {
            R.r[1] = *(const v4u*)(ur + C_GLA + 256 + h * 64 + d0); R.r[0] = d0 < 32 ? *(const v4u*)(ur + C_GLA + 128 + h * 32 + d0) : (v4u){0u, 0u, 0u, 0u};
            const int tq = I.tid >> 5, d = I.tid & 31; v4u lf;
            lf.x = __float_as_uint(LA[(size_t)(rowbase + t0 + 4 * tq + 0) * 256 + dir * 128 + h * 32 + d]); lf.y = __float_as_uint(LA[(size_t)(rowbase + t0 + 4 * tq + 1) * 256 + dir * 128 + h * 32 + d]);
            lf.z = __float_as_uint(LA[(size_t)(rowbase + t0 + 4 * tq + 2) * 256 + dir * 128 + h * 32 + d]); lf.w = __float_as_uint(LA[(size_t)(rowbase + t0 + 4 * tq + 3) * 256 + dir * 128 + h * 32 + d]); R.r[2] = lf;
        } else if (MIX == 2) { const int g = h >> 1; const bf16* uc = UC + (size_t)(rowbase + t) * 512;
            R.r[0] = *(const v4u*)(uc + 256 + g * 64 + d0); R.r[1] = *(const v4u*)(uc + h * 64 + d0);
            R.s0 = bf_lo((unsigned)ul[C_SSD + 768 + dir * 4 + h]);
        } else {
            R.r[0] = *(const v4u*)(ur + C_ML + 256 + h * 64 + d0); R.r[1] = *(const v4u*)(ur + C_ML + 512 + h * 64 + d0);
            R.s0 = bf_lo((unsigned)ul[C_ML + 1024 + dir * 8 + h]); R.s1 = bf_lo((unsigned)ul[C_ML + 1024 + dir * 8 + 4 + h]);
        }
    };
    auto finish = [&](int cc, const StRaw& R) {
        LAS unsigned char* set = sm + (cc & 1) * S1_SET; LAS float* ELs = (LAS float*)(set + 2 * IMGB);
        f32x8 k, kp;
        if (MIX != 1) {
            float la, w = 1.f;
            if (MIX == 0) la = c_la;
            else if (MIX == 2) { w = softplus_q(R.s0 + c_b0); la = w * c_b1; }
            else { w = __expf(R.s0 + c_b0); la = log_sigmoid_q(R.s1 + c_b1); }
            const float G = wave_incl_scan(la, lane), T = rdlane(G, 63);
            if (wave == 0) ELs[lane] = __expf(T);
            const float e_l = (dir ? __expf(G - la) : __expf(T - G)) * w;
            const float ck = shidx(e_l, tk);
            k = cvt8(R.r[0]);
            kp.a = k.a * ck; kp.b = k.b * ck;
        } else {
            LAS float* GS = (LAS float*)(sm + S1_GS); LAS float* GM = (LAS float*)(sm + S1_GM);
            const int d = I.tid & 31, tq = I.tid >> 5; float c[4], la4[4]; float run = 0.f;
            la4[0] = __uint_as_float(R.r[2].x); la4[1] = __uint_as_float(R.r[2].y); la4[2] = __uint_as_float(R.r[2].z); la4[3] = __uint_as_float(R.r[2].w);
#pragma unroll
            for (int u = 0; u < 4; ++u) { run += la4[u]; c[u] = run; }
            GS[tq * 32 + d] = run;
            __syncthreads();
            float off = 0.f, tot = 0.f;
#pragma unroll
            for (int qq = 0; qq < 16; ++qq) { const float s = GS[qq * 32 + d]; off += (qq < tq) ? s : 0.f; tot += s; }
#pragma unroll
            for (int u = 0; u < 4; ++u) GM[(4 * tq + u) * 32 + d] = dir ? (off + c[u] - la4[u]) : (tot - (off + c[u]));
            if (tq == 0) { ELs[d] = __expf(tot); ELs[32 + d] = 1.0f; }
            __syncthreads();
            k = cvt8(R.r[0]);
            if (d0 < 32) { const f32x4 g0 = *(const LAS f32x4*)(GM + tk * 32 + d0), g1 = *(const LAS f32x4*)(GM + tk * 32 + d0 + 4);
#pragma unroll
                for (int j = 0; j < 4; ++j) { kp.a[j] = k.a[j] * __expf(g0[j]); kp.b[j] = k.b[j] * __expf(g1[j]); } }
            else kp = k;
        }
        const int ro = tk * 144 + d0 * 2;
        *(LAS v4u*)(set + ro) = pack8(kp.a, kp.b); *(LAS v4u*)(set + IMGB + ro) = R.r[1];
    };

    StRaw Ra, Rb; ConvRaw CR;
    issue(0, Ra); issue(1, Rb); finish(0, Ra);
    const bf16x8s ones = (bf16x8s){0x3F80, 0x3F80, 0x3F80, 0x3F80, 0x3F80, 0x3F80, 0x3F80, 0x3F80};
    auto chunk_body = [&](const int cc, const int cmode, StRaw& Rfar, const StRaw& Rnext) {
        __syncthreads();
        if (cc + 2 < 36) issue(cc + 2, Rfar);
        if (cmode == 1) conv_issue(F.lds, F.ws, l, (F.vcu * NWAVES + wave) * 18 + (cc >> 1), lane, CR);
        const LAS unsigned char* set = sm + (cc & 1) * S1_SET; const LAS unsigned char* KPs = set; const LAS unsigned char* Vs = set + IMGB; const LAS float* ELs = (const LAS float*)(set + 2 * IMGB);
#pragma unroll
        for (int u = 0; u < 2; ++u) { const int ct = 2 * cp + u; v2u sw; sw.x = pg8::cvt_pk_safe(S[u][0], S[u][1]); sw.y = pg8::cvt_pk_safe(S[u][2], S[u][3]);
            *(v2u*)(SIN + (size_t)cc * 4096 + (16 * ct + fr) * 64 + 16 * rt + 4 * fq) = sw; }
        if (MIX == 3) { if (fr == 0 && cp == 0) *(f32x4*)(NIN + cc * 64 + 16 * rt + 4 * fq) = nst; }
        const bf16x8s kf0 = trfrag(KPs, 0, 16 * rt, lane), kf1 = trfrag(KPs, 32, 16 * rt, lane);
        const f32x4 el = *(const LAS f32x4*)(ELs + 16 * rt + 4 * fq);
#pragma unroll
        for (int u = 0; u < 2; ++u) { const int ct = 2 * cp + u; const bf16x8s v0 = trfrag(Vs, 0, 16 * ct, lane), v1 = trfrag(Vs, 32, 16 * ct, lane);
            S[u] = S[u] * el; S[u] = mfma16(kf0, v0, S[u]); S[u] = mfma16(kf1, v1, S[u]); }
        if (MIX == 3) { nst = nst * el; nst = mfma16(kf0, ones, nst); nst = mfma16(kf1, ones, nst); }
        if (cc + 1 < 36) finish(cc + 1, Rnext);
        if (cmode == 2) conv_finish(CR);
    };
    for (int cc = 0; cc < 36; cc += 2) { chunk_body(cc, 1, Ra, Rb); chunk_body(cc + 1, 2, Rb, Ra); }
    __syncthreads();
}
__device__ __forceinline__ void p3a_state(const Frame& F_, int l) {
    const Frame F = fresh_frame(F_); const Ids I = fresh_ids(F.wave_s);
    for (int item = F.vcu; item < 256; item += F.G) {
        const int dir = item & 1, h = (item >> 1) & 3, mixer = (item >> 3) & 3, b = item >> 5;
        if (mixer == 0) state_item<0>(F, I, l, b, h, dir, item);
        else if (mixer == 1) state_item<1>(F, I, l, b, h, dir, item);
        else if (mixer == 2) state_item<2>(F, I, l, b, h, dir, item);
        else state_item<3>(F, I, l, b, h, dir, item);
    }
}

constexpr int S2_Q = 0, S2_K = IMGB, S2_V = 2 * IMGB, S2_P = 3 * IMGB, S2_P2 = 4 * IMGB, S2_STF = 5 * IMGB, S2_STB = 6 * IMGB, S2_ARR = 7 * IMGB, S2_NV = S2_ARR + 1024, S2_STAT = S2_NV + 256,
              S2_GS = S2_STAT + 1024, S2_GM = S2_GS + 4096, S2_END = S2_GM + 16384;
constexpr int S2_CST = S2_END, S2_CST_END = S2_CST + 5440 * 4;
static_assert(S2_CST_END <= RING_BYTES && S1_END <= RING_BYTES, "mixer LDS maps");
struct OutAcc { f32x4 y[2]; };
struct HRaw { v4u r[17]; v2u g[2]; float s[4]; };
struct HItem { int mix, b, h, nc, isctx, last; };

template <int MIX>
__device__ __forceinline__ void s2_issue(const Frame& F, const Ids&, int l, const HItem& it, HRaw& R) {
    const Ids I = fresh_ids(F.wave_s);
    const bf16* U = (const bf16*)(F.ws + WS_U); const bf16* SINB = (const bf16*)(F.ws + WS_O2); const float* NINB = (const float*)(F.ws + WS_NIN);
    const int lane = I.lane, wave = I.wave, fr = lane & 15, fq = lane >> 4, rt = wave >> 1, cp = wave & 1, tk = I.tid >> 3, d0 = (I.tid & 7) * 8;
    const int b = it.b, h = it.h, nc = it.nc; const bool isctx = it.isctx;
    const int len = isctx ? CTXL : SEQ, rowbase = isctx ? NLAT + b * CTXL : b * SEQ, t0 = 64 * nc, t = t0 + tk;
    const int item_f = b * 32 + MIX * 8 + h * 2, cc_f = isctx ? nc : 4 + nc, cc_b = isctx ? 3 - nc : 35 - nc;
    const bf16* ur = U + (size_t)(rowbase + t) * INP; const bf16* ul = U + (size_t)(rowbase + t0 + lane) * INP;
    const int row = I.tid >> 3, pc = I.tid & 7;
    const int orow = rowbase + t0 + 16 * rt + fr;
    if (MIX == 0) {
        R.r[0] = *(const v4u*)(ur + C_RET + h * 64 + d0); R.r[1] = *(const v4u*)(ur + C_RET + 256 + h * 64 + d0); R.r[2] = *(const v4u*)(ur + C_RET + 512 + h * 64 + d0);
        R.r[5] = *(const v4u*)(SINB + ((size_t)item_f * 36 + cc_f) * 4096 + row * 64 + 8 * pc); R.r[6] = *(const v4u*)(SINB + ((size_t)(item_f + 1) * 36 + cc_b) * 4096 + row * 64 + 8 * pc);
#pragma unroll
        for (int u = 0; u < 2; ++u) R.g[u] = *(const v2u*)(U + (size_t)orow * INP + C_RET + 768 + h * 64 + 16 * (2 * cp + u) + 4 * fq);
    } else if (MIX == 1) {
        R.r[2] = *(const v4u*)(ur + C_GLA + 256 + h * 64 + d0);
        if (d0 < 32) { R.r[0] = *(const v4u*)(ur + C_GLA + h * 32 + d0); R.r[1] = *(const v4u*)(ur + C_GLA + 128 + h * 32 + d0); } else { R.r[0] = (v4u){0u, 0u, 0u, 0u}; R.r[1] = R.r[0]; }
        R.r[3] = *(const v4u*)(SINB + ((size_t)(item_f + (pc >> 2)) * 36 + (pc < 4 ? cc_f : cc_b)) * 4096 + row * 64 + 8 * (pc & 3));
        { const int tq = I.tid >> 5, d = I.tid & 31; const float* la = (const float*)(F.ws + WS_LA) + (size_t)(rowbase + t0 + 4 * tq) * 256 + h * 32 + d; v4u lf, lb;
          lf.x = __float_as_uint(la[0]); lf.y = __float_as_uint(la[256]); lf.z = __float_as_uint(la[512]); lf.w = __float_as_uint(la[768]);
          lb.x = __float_as_uint(la[128]); lb.y = __float_as_uint(la[128 + 256]); lb.z = __float_as_uint(la[128 + 512]); lb.w = __float_as_uint(la[128 + 768]); R.r[4] = lf; R.r[5] = lb; }
#pragma unroll
        for (int u = 0; u < 2; ++u) R.g[u] = *(const v2u*)(U + (size_t)orow * INP + C_GLA + 512 + h * 64 + 16 * (2 * cp + u) + 4 * fq);
    } else if (MIX == 2) { const int g = h >> 1; const bf16* uc = (const bf16*)(F.ws + WS_UC) + (size_t)(rowbase + t) * 512;
        R.r[0] = *(const v4u*)(uc + h * 64 + d0); R.r[1] = *(const v4u*)(uc + 256 + g * 64 + d0); R.r[2] = *(const v4u*)(uc + 384 + g * 64 + d0);
        R.r[15] = *(const v4u*)(SINB + ((size_t)item_f * 36 + cc_f) * 4096 + row * 64 + 8 * pc); R.r[16] = *(const v4u*)(SINB + ((size_t)(item_f + 1) * 36 + cc_b) * 4096 + row * 64 + 8 * pc);
        R.s[0] = bf_lo((unsigned)ul[C_SSD + 768 + h]); R.s[1] = bf_lo((unsigned)ul[C_SSD + 768 + 4 + h]);
#pragma unroll
        for (int u = 0; u < 2; ++u) R.g[u] = *(const v2u*)(U + (size_t)orow * INP + C_SSD + h * 64 + 16 * (2 * cp + u) + 4 * fq);
    } else {
        R.r[0] = *(const v4u*)(ur + C_ML + h * 64 + d0); R.r[1] = *(const v4u*)(ur + C_ML + 256 + h * 64 + d0); R.r[2] = *(const v4u*)(ur + C_ML + 512 + h * 64 + d0);
        R.r[3] = *(const v4u*)(SINB + ((size_t)item_f * 36 + cc_f) * 4096 + row * 64 + 8 * pc); R.r[4] = *(const v4u*)(SINB + ((size_t)(item_f + 1) * 36 + cc_b) * 4096 + row * 64 + 8 * pc);
        if (I.tid < 32) R.r[5] = *(const v4u*)(NINB + ((size_t)((b * 4 + h) * 2 + (I.tid >> 4)) * 36 + ((I.tid >> 4) ? cc_b : cc_f)) * 64 + 4 * (I.tid & 15));
        R.s[0] = bf_lo((unsigned)ul[C_ML + 1024 + h]); R.s[1] = bf_lo((unsigned)ul[C_ML + 1024 + 4 + h]); R.s[2] = bf_lo((unsigned)ul[C_ML + 1024 + 8 + h]); R.s[3] = bf_lo((unsigned)ul[C_ML + 1024 + 12 + h]);
#pragma unroll
        for (int u = 0; u < 2; ++u) R.g[u] = *(const v2u*)(U + (size_t)orow * INP + C_ML + 768 + h * 64 + 16 * (2 * cp + u) + 4 * fq);
    }
}
template <int MIX>
__device__ __forceinline__ void s2_transform(const Frame& F, const Ids&, int l, const HItem& it, const HRaw& R) {
    const Ids I = fresh_ids(F.wave_s);
    LAS unsigned char* sm = F.lds;
    const int lane = I.lane, wave = I.wave, tk = I.tid >> 3, d0 = (I.tid & 7) * 8; const int h = it.h; const bool isctx = it.isctx; const int t = 64 * it.nc + tk;
    LAS float* GF = (LAS float*)(sm + S2_ARR); LAS float* HB = GF + 64; LAS float* WF = GF + 128; LAS float* WB = GF + 192;
    const int row = I.tid >> 3, pc = I.tid & 7;
    f32x8 q, k, v;
    if (MIX != 1) {
        const v4u sf = MIX == 0 ? R.r[5] : (MIX == 2 ? R.r[15] : R.r[3]), sb = MIX == 0 ? R.r[6] : (MIX == 2 ? R.r[16] : R.r[4]);
        *(LAS v4u*)(sm + S2_STF + row * 144 + pc * 16) = sf; *(LAS v4u*)(sm + S2_STB + row * 144 + pc * 16) = sb;
        if (MIX == 3 && I.tid < 32) { const f32x4 nv = __builtin_bit_cast(f32x4, R.r[5]); v2u w; w.x = pg8::cvt_pk_safe(nv[0], nv[1]); w.y = pg8::cvt_pk_safe(nv[2], nv[3]); *(LAS v2u*)(sm + S2_NV + (I.tid >> 4) * 128 + 8 * (I.tid & 15)) = w; }
        float laf, lab, wf = 1.f, wb = 1.f;
        const LAS float* cst = (const LAS float*)(sm + S2_CST);
        if (MIX == 0) { laf = cst[h]; lab = cst[4 + h]; }
        else if (MIX == 2) { wf = softplus_q(R.s[0] + cst[8 + h]); wb = softplus_q(R.s[1] + cst[12 + h]); laf = wf * cst[16 + h]; lab = wb * cst[20 + h]; }
        else { const LAS float* gb = cst + 32; wf = __expf(R.s[0] + gb[h]); laf = log_sigmoid_q(R.s[1] + gb[4 + h]); wb = __expf(R.s[2] + gb[8 + h]); lab = log_sigmoid_q(R.s[3] + gb[12 + h]); }
        const float Gf = wave_incl_scan(laf, lane), Gb = wave_incl_scan(lab, lane), Tb = rdlane(Gb, 63);
        if (wave == 0) { GF[lane] = Gf; HB[lane] = Tb - Gb + lab; WF[lane] = wf; WB[lane] = wb; }
        const int ro = tk * 144 + d0 * 2;
        *(LAS v4u*)(sm + S2_Q + ro) = MIX == 2 ? R.r[2] : R.r[0]; *(LAS v4u*)(sm + S2_K + ro) = R.r[1]; *(LAS v4u*)(sm + S2_V + ro) = MIX == 2 ? R.r[0] : R.r[2];
    } else {
        *(LAS v4u*)(sm + S2_STF + row * 144 + pc * 16) = R.r[3];
        LAS float* GS = (LAS float*)(sm + S2_GS); LAS float* GM = (LAS float*)(sm + S2_GM);
        const int d = I.tid & 31, tq = I.tid >> 5; float cfw[4], cbw[4], lbw[4]; float runf = 0.f, runb = 0.f;
        const float lfw[4] = {__uint_as_float(R.r[4].x), __uint_as_float(R.r[4].y), __uint_as_float(R.r[4].z), __uint_as_float(R.r[4].w)};
        lbw[0] = __uint_as_float(R.r[5].x); lbw[1] = __uint_as_float(R.r[5].y); lbw[2] = __uint_as_float(R.r[5].z); lbw[3] = __uint_as_float(R.r[5].w);
#pragma unroll
        for (int u = 0; u < 4; ++u) { runf += lfw[u]; cfw[u] = runf; runb += lbw[u]; cbw[u] = runb; }
        GS[tq * 32 + d] = runf; GS[512 + tq * 32 + d] = runb;
        __syncthreads();
        float offf = 0.f, offb = 0.f, totb = 0.f;
#pragma unroll
        for (int qq = 0; qq < 16; ++qq) { const float sf = GS[qq * 32 + d], sb = GS[512 + qq * 32 + d]; offf += (qq < tq) ? sf : 0.f; offb += (qq < tq) ? sb : 0.f; totb += sb; }
#pragma unroll
        for (int u = 0; u < 4; ++u) { GM[(4 * tq + u) * 32 + d] = offf + cfw[u]; GM[2048 + (4 * tq + u) * 32 + d] = totb - (offb + cbw[u]) + lbw[u]; }
        if (I.tid < 64) { GF[I.tid] = 0.f; HB[I.tid] = 0.f; WF[I.tid] = 1.f; WB[I.tid] = 1.f; }
        __syncthreads();
        *(LAS v4u*)(sm + S2_V + tk * 144 + d0 * 2) = R.r[2];
        if (d0 < 32) { q = cvt8(R.r[0]); k = cvt8(R.r[1]);
            const f32x4 gf0 = *(const LAS f32x4*)(GM + tk * 32 + d0), gf1 = *(const LAS f32x4*)(GM + tk * 32 + d0 + 4), gb0 = *(const LAS f32x4*)(GM + 2048 + tk * 32 + d0), gb1 = *(const LAS f32x4*)(GM + 2048 + tk * 32 + d0 + 4);
            f32x8 qf, kf, qb, kb;
#pragma unroll
            for (int j = 0; j < 4; ++j) { qf.a[j] = q.a[j] * 0.17677669529663687f * __expf(gf0[j]); qf.b[j] = q.b[j] * 0.17677669529663687f * __expf(gf1[j]); kf.a[j] = k.a[j] * __expf(-gf0[j]); kf.b[j] = k.b[j] * __expf(-gf1[j]);
                qb.a[j] = q.a[j] * 0.17677669529663687f * __expf(gb0[j]); qb.b[j] = q.b[j] * 0.17677669529663687f * __expf(gb1[j]); kb.a[j] = k.a[j] * __expf(-gb0[j]); kb.b[j] = k.b[j] * __expf(-gb1[j]); }
            const int ro = tk * 144 + d0 * 2;
            *(LAS v4u*)(sm + S2_Q + ro) = pack8(qf.a, qf.b); *(LAS v4u*)(sm + S2_Q + ro + 64) = pack8(qb.a, qb.b); *(LAS v4u*)(sm + S2_K + ro) = pack8(kf.a, kf.b); *(LAS v4u*)(sm + S2_K + ro + 64) = pack8(kb.a, kb.b); }
    }
}
template <int MIX>
__device__ __forceinline__ OutAcc s2_compute(const Frame& F, const Ids&, int l, const HItem& it, const v2u (&zg)[2]) {
    const Ids I = fresh_ids(F.wave_s);
    LAS unsigned char* sm = F.lds;
    const int lane = I.lane, wave = I.wave, fr = lane & 15, fq = lane >> 4, rt = wave >> 1, cp = wave & 1; const int h = it.h;
    const LAS float* GF = (const LAS float*)(sm + S2_ARR); const LAS float* HB = GF + 64; const LAS float* WF = GF + 128; const LAS float* WB = GF + 192;
    const int irow = 16 * rt + fr;
    const float gfi = GF[irow], hbi = HB[irow];
    const bf16x8s qf0 = rowfrag(sm + S2_Q, 16 * rt, 0, fr, fq), qf1 = rowfrag(sm + S2_Q, 16 * rt, 1, fr, fq);
#pragma unroll
    for (int u = 0; u < 2; ++u) { const int jt = 2 * cp + u;
        f32x4 sc = (f32x4){0.f, 0.f, 0.f, 0.f}, sc2 = sc;
        sc = mfma16(rowfrag(sm + S2_K, 16 * jt, 0, fr, fq), qf0, sc);
        if (MIX == 1) sc2 = mfma16(rowfrag(sm + S2_K, 16 * jt, 1, fr, fq), qf1, sc2); else sc = mfma16(rowfrag(sm + S2_K, 16 * jt, 1, fr, fq), qf1, sc);
        const f32x4 gj = *(const LAS f32x4*)(GF + 16 * jt + 4 * fq), hj = *(const LAS f32x4*)(HB + 16 * jt + 4 * fq), wfj = *(const LAS f32x4*)(WF + 16 * jt + 4 * fq), wbj = *(const LAS f32x4*)(WB + 16 * jt + 4 * fq);
        float pa[4], pb[4];
#pragma unroll
        for (int r = 0; r < 4; ++r) { const int j = 16 * jt + 4 * fq + r;
            const float ef = (j <= irow) ? __expf(fminf(gfi - gj[r], 0.f)) * wfj[r] : 0.f, eb = (j >= irow) ? __expf(fminf(hbi - hj[r], 0.f)) * wbj[r] : 0.f;
            if (MIX == 1) { pa[r] = sc[r] * ef + sc2[r] * eb; pb[r] = 0.f; } else if (MIX == 3) { pa[r] = sc[r] * ef; pb[r] = sc[r] * eb; } else { pa[r] = sc[r] * (ef + eb); pb[r] = 0.f; } }
        v2u pw; pw.x = pg8::cvt_pk_safe(pa[0], pa[1]); pw.y = pg8::cvt_pk_safe(pa[2], pa[3]); *(LAS v2u*)(sm + S2_P + irow * 144 + (16 * jt + 4 * fq) * 2) = pw;
        if (MIX == 3) { v2u pw2; pw2.x = pg8::cvt_pk_safe(pb[0], pb[1]); pw2.y = pg8::cvt_pk_safe(pb[2], pb[3]); *(LAS v2u*)(sm + S2_P2 + irow * 144 + (16 * jt + 4 * fq) * 2) = pw2; } }
    f32x4 o2f[2], o2b[2], e2f = (f32x4){0.f, 0.f, 0.f, 0.f}, e2b = e2f;
#pragma unroll
    for (int u = 0; u < 2; ++u) { const int ct = 2 * cp + u; o2f[u] = (f32x4){0.f, 0.f, 0.f, 0.f}; o2b[u] = o2f[u];
        o2f[u] = mfma16(rowfrag(sm + S2_STF, 16 * ct, 0, fr, fq), qf0, o2f[u]); o2f[u] = mfma16(rowfrag(sm + S2_STF, 16 * ct, 1, fr, fq), qf1, o2f[u]);
        if (MIX != 1) { o2b[u] = mfma16(rowfrag(sm + S2_STB, 16 * ct, 0, fr, fq), qf0, o2b[u]); o2b[u] = mfma16(rowfrag(sm + S2_STB, 16 * ct, 1, fr, fq), qf1, o2b[u]); } }
    if (MIX == 3) { const LAS unsigned char* nv = sm + S2_NV;
        e2f = mfma16(*(const LAS bf16x8s*)(nv + fq * 16), qf0, e2f); e2f = mfma16(*(const LAS bf16x8s*)(nv + 64 + fq * 16), qf1, e2f);
        e2b = mfma16(*(const LAS bf16x8s*)(nv + 128 + fq * 16), qf0, e2b); e2b = mfma16(*(const LAS bf16x8s*)(nv + 192 + fq * 16), qf1, e2b); }
    bf16x8s vf[2][2];
#pragma unroll
    for (int u = 0; u < 2; ++u) { vf[u][0] = trfrag(sm + S2_V, 0, 16 * (2 * cp + u), lane); vf[u][1] = trfrag(sm + S2_V, 32, 16 * (2 * cp + u), lane); }
    __syncthreads();
    const bf16x8s pf0 = rowfrag(sm + S2_P, 16 * rt, 0, fr, fq), pf1 = rowfrag(sm + S2_P, 16 * rt, 1, fr, fq);
    const float egf = __expf(gfi), egb = __expf(hbi);
    const bf16x8s ones = (bf16x8s){0x3F80, 0x3F80, 0x3F80, 0x3F80, 0x3F80, 0x3F80, 0x3F80, 0x3F80};
    OutAcc A;
    if (MIX == 3) {
        const bf16x8s pb0 = rowfrag(sm + S2_P2, 16 * rt, 0, fr, fq), pb1 = rowfrag(sm + S2_P2, 16 * rt, 1, fr, fq);
        f32x4 e1f = (f32x4){0.f, 0.f, 0.f, 0.f}, e1b = e1f; e1f = mfma16(ones, pf0, e1f); e1f = mfma16(ones, pf1, e1f); e1b = mfma16(ones, pb0, e1b); e1b = mfma16(ones, pb1, e1b);
        const float sf = 1.0f / fmaxf(fabsf(e1f[0] + egf * e2f[0]), 1.0f), sb = 1.0f / fmaxf(fabsf(e1b[0] + egb * e2b[0]), 1.0f);
#pragma unroll
        for (int u = 0; u < 2; ++u) { f32x4 of = (f32x4){0.f, 0.f, 0.f, 0.f}, ob = of; of = mfma16(vf[u][0], pf0, of); of = mfma16(vf[u][1], pf1, of); ob = mfma16(vf[u][0], pb0, ob); ob = mfma16(vf[u][1], pb1, ob);
            A.y[u] = (of + o2f[u] * egf) * sf + (ob + o2b[u] * egb) * sb; }
    } else {
#pragma unroll
        for (int u = 0; u < 2; ++u) { f32x4 o1 = (f32x4){0.f, 0.f, 0.f, 0.f}; o1 = mfma16(vf[u][0], pf0, o1); o1 = mfma16(vf[u][1], pf1, o1);
            A.y[u] = MIX == 1 ? (o1 + o2f[u]) : (o1 + o2f[u] * egf + o2b[u] * egb); }
    }
    if (MIX == 2) { const float dsk = ((const LAS float*)(sm + S2_CST))[24 + h];
#pragma unroll
        for (int u = 0; u < 2; ++u) { const int c0 = 16 * (2 * cp + u) + 4 * fq; const v2u xw = *(const LAS v2u*)(sm + S2_V + irow * 144 + c0 * 2);
            const f32x4 xs = (f32x4){bf_lo(xw.x), bf_hi(xw.x), bf_lo(xw.y), bf_hi(xw.y)}, z = (f32x4){bf_lo(zg[u].x), bf_hi(zg[u].x), bf_lo(zg[u].y), bf_hi(zg[u].y)};
#pragma unroll
            for (int r = 0; r < 4; ++r) A.y[u][r] = (A.y[u][r] + dsk * xs[r]) * silu_q(z[r]); }
    }
    return A;
}
__device__ __forceinline__ void token_stats(LAS unsigned char* sm, int rt, int cp, int fr, int fq, int lane, float& s1, float& s2) {
    s1 += shx(s1, 16, lane); s1 += shx(s1, 32, lane); s2 += shx(s2, 16, lane); s2 += shx(s2, 32, lane);
    LAS float* ST = (LAS float*)(sm + S2_STAT);
    if (fq == 0) { ST[((16 * rt + fr) * 2 + cp) * 2] = s1; ST[((16 * rt + fr) * 2 + cp) * 2 + 1] = s2; }
    __syncthreads();
    const f32x4 a = *(const LAS f32x4*)(ST + (16 * rt + fr) * 4); s1 = a[0] + a[2]; s2 = a[1] + a[3];
}
__device__ __forceinline__ HItem s2_item(int j, int blk, int G, int NCH, bool ctx_out, int nsu, int u0) {
    HItem it; int c;
    if (j < 4 * nsu) { const int u = blk + (j >> 2) * G; it.mix = 2; it.b = u / NCH; c = u % NCH; it.h = j & 3; it.last = (j & 3) == 3; }
    else { const int u = u0 + (j - 4 * nsu), mh = u % 12, bc = u / 12; it.b = bc / NCH; c = bc % NCH; const int m3 = mh >> 2; it.mix = m3 == 0 ? 0 : (m3 == 1 ? 1 : 3); it.h = mh & 3; it.last = true; }
    it.isctx = ctx_out && c < 4; it.nc = ctx_out ? (it.isctx ? c : c - 4) : c; return it;
}
__device__ __forceinline__ void p3b_output(const Frame& F_, int l, bool ctx_out) {
    const Frame F = fresh_frame(F_); const Ids I = fresh_ids(F.wave_s);
    bf16* Y = (bf16*)(F.ws + WS_Y);
    const int lane = I.lane, wave = I.wave, fr = lane & 15, fq = lane >> 4, rt = wave >> 1, cp = wave & 1;
    const int NCH = ctx_out ? 36 : 32, nssd = 8 * NCH, blk = F.vcu, G = F.G;
    const int extra = nssd - G, nsu = 1 + (blk < extra ? 1 : 0);
    const int per_lo = (16 * NCH * 8) / G - 8, per_hi = per_lo + 4;
    const int u0 = blk < extra ? blk * per_lo : extra * per_lo + (blk - extra) * per_hi, cnt = blk < extra ? per_lo : per_hi, nitems = 4 * nsu + cnt;
    {
        LAS float* cwl = (LAS float*)(F.lds + S2_GM); const float* cw = inp(F.lds, 15) + (size_t)l * 5 * 512; const float* cb = inp(F.lds, 16) + l * 512;
        for (int i = I.tid; i < 6 * 512; i += 512) cwl[i] = i < 2560 ? cw[i] : cb[i - 2560];
        LAS float* cst = (LAS float*)(F.lds + S2_CST);
        if (I.tid < 8) { cst[I.tid] = log_sigmoid_f(inp(F.lds, 10)[l * 8 + I.tid]); cst[8 + I.tid] = inp(F.lds, 17)[l * 8 + I.tid]; cst[16 + I.tid] = -expf(inp(F.lds, 18)[l * 8 + I.tid]); }
        if (I.tid < 4) cst[24 + I.tid] = inp(F.lds, 19)[l * 4 + I.tid];
        if (I.tid < 16) cst[32 + I.tid] = inp(F.lds, 21)[l * 16 + I.tid];
        if (I.tid < 256) { cst[64 + I.tid] = inp(F.lds, 11)[l * 256 + I.tid]; cst[320 + I.tid] = inp(F.lds, 14)[l * 256 + I.tid]; cst[576 + I.tid] = inp(F.lds, 20)[l * 256 + I.tid]; cst[832 + I.tid] = inp(F.lds, 22)[l * 256 + I.tid];
            cst[5184 + I.tid] = inp(F.lds, 13)[l * 256 + I.tid]; }
        for (int i = I.tid; i < 4096; i += 512) cst[1088 + i] = inp(F.lds, 12)[(size_t)l * 4096 + i];
    }
    __syncthreads();
    HRaw Ra, Rb;
    { const HItem i0 = s2_item(0, blk, G, NCH, ctx_out, nsu, u0), i1 = s2_item(1, blk, G, NCH, ctx_out, nsu, u0);
      s2_issue<2>(F, I, l, i0, Ra); s2_issue<2>(F, I, l, i1, Rb); }
    unsigned ssdy[3][2][2] = {}; float ssd_s2 = 0.f;
    auto item_body = [&](const int j, HRaw& R) {
        const HItem cur = s2_item(j, blk, G, NCH, ctx_out, nsu, u0);
        if (cur.mix == 0) s2_transform<0>(F, I, l, cur, R); else if (cur.mix == 1) s2_transform<1>(F, I, l, cur, R); else if (cur.mix == 2) s2_transform<2>(F, I, l, cur, R); else s2_transform<3>(F, I, l, cur, R);
        const v2u zg[2] = {R.g[0], R.g[1]};
        __syncthreads();
        if (j + 2 < nitems) { const HItem nxt = s2_item(j + 2, blk, G, NCH, ctx_out, nsu, u0);
            if (nxt.mix == 0) s2_issue<0>(F, I, l, nxt, R); else if (nxt.mix == 1) s2_issue<1>(F, I, l, nxt, R); else if (nxt.mix == 2) s2_issue<2>(F, I, l, nxt, R); else s2_issue<3>(F, I, l, nxt, R); }
        OutAcc A;
        if (cur.mix == 0) A = s2_compute<0>(F, I, l, cur, zg); else if (cur.mix == 1) A = s2_compute<1>(F, I, l, cur, zg); else if (cur.mix == 2) A = s2_compute<2>(F, I, l, cur, zg); else A = s2_compute<3>(F, I, l, cur, zg);
        const int row = (cur.isctx ? NLAT + cur.b * CTXL : cur.b * SEQ) + 64 * cur.nc + 16 * rt + fr;
        if (cur.mix == 2) {
#pragma unroll
            for (int u = 0; u < 2; ++u)
#pragma unroll
                for (int r = 0; r < 4; ++r) ssd_s2 += A.y[u][r] * A.y[u][r];
            if (!cur.last) {
#pragma unroll
                for (int hh = 0; hh < 3; ++hh) {
#pragma unroll
                    for (int u = 0; u < 2; ++u) { const unsigned p0 = pg8::cvt_pk_safe(A.y[u][0], A.y[u][1]), p1 = pg8::cvt_pk_safe(A.y[u][2], A.y[u][3]);
                        ssdy[hh][u][0] = cur.h == hh ? p0 : ssdy[hh][u][0]; ssdy[hh][u][1] = cur.h == hh ? p1 : ssdy[hh][u][1]; } }
                __syncthreads();
            } else {
                float s1 = 0.f, s2 = ssd_s2; token_stats(F.lds, rt, cp, fr, fq, lane, s1, s2); ssd_s2 = 0.f;
                const float rs = 1.0f / sqrtf(s2 * (1.0f / 256.0f) + EPS); const LAS float* nw = (const LAS float*)(F.lds + S2_CST) + 576;
#pragma unroll
                for (int hh = 0; hh < 4; ++hh)
#pragma unroll
                    for (int u = 0; u < 2; ++u) { const int c0 = hh * 64 + 16 * (2 * cp + u) + 4 * fq;
                        const f32x4 yv = hh < 3 ? (f32x4){bf_lo(ssdy[hh < 3 ? hh : 0][u][0]), bf_hi(ssdy[hh < 3 ? hh : 0][u][0]), bf_lo(ssdy[hh < 3 ? hh : 0][u][1]), bf_hi(ssdy[hh < 3 ? hh : 0][u][1])} : A.y[u];
                        st_bf4(Y + (size_t)row * D + 512 + c0, yv * rs * *(const LAS f32x4*)(nw + c0)); }
                __syncthreads();
            }
        } else {
            float s1 = 0.f, s2 = 0.f;
#pragma unroll
            for (int u = 0; u < 2; ++u)
#pragma unroll
                for (int r = 0; r < 4; ++r) { s1 += A.y[u][r]; s2 += A.y[u][r] * A.y[u][r]; }
            token_stats(F.lds, rt, cp, fr, fq, lane, s1, s2);
            const float mean = cur.mix == 0 ? s1 * (1.0f / 64.0f) : 0.f;
            const float rs = 1.0f / sqrtf(fmaxf(s2 * (1.0f / 64.0f) - mean * mean, 0.f) + EPS);
            const LAS float* nw = (const LAS float*)(F.lds + S2_CST) + 64 + (cur.mix == 0 ? 0 : cur.mix == 1 ? 256 : 768) + cur.h * 64;
#pragma unroll
            for (int u = 0; u < 2; ++u) { const int c0 = 16 * (2 * cp + u) + 4 * fq; const f32x4 w = *(const LAS f32x4*)(nw + c0); f32x4 y;
                const f32x4 g = (f32x4){bf_lo(zg[u].x), bf_hi(zg[u].x), bf_lo(zg[u].y), bf_hi(zg[u].y)};
#pragma unroll
                for (int r = 0; r < 4; ++r) y[r] = (A.y[u][r] - mean) * rs * w[r] * (cur.mix == 3 ? sigmoid_q(g[r]) : silu_q(g[r]));
                st_bf4(Y + (size_t)row * D + cur.mix * 256 + cur.h * 64 + c0, y); }
            __syncthreads();
        }
    };
    for (int j = 0; j < nitems; j += 2) { item_body(j, Ra); if (j + 1 < nitems) item_body(j + 1, Rb); }
}

struct Args { const float* in[28]; float* out; unsigned char* ws; int ph_lo, ph_hi, use_bar, never; };
__global__ void __launch_bounds__(NWAVES * 64, 2) fwd_kernel(Args args) {
    extern __shared__ __attribute__((aligned(16))) unsigned char lds[];
    Frame F;
    F.lds = (LAS unsigned char*)lds;
        F.wave_s = __builtin_amdgcn_readfirstlane((int)threadIdx.x >> 6);
    F.G = gridDim.x; { const int bx = blockIdx.x; F.vcu = (F.G % 8 == 0) ? (bx % 8) * (F.G / 8) + bx / 8 : bx; }
    F.ws = args.ws;
    if (args.never) cooperative_groups::this_grid().sync();
    for (int u = F.wave_s * 64 + lane_id(); u < (LDS_BYTES - LDSCTL_OFF) / 4; u += NWAVES * 64) ((LAS unsigned*)(F.lds + LDSCTL_OFF))[u] = 0u;
    __syncthreads();
    if (F.wave_s == 0 && lane_id() == 0) { LAS unsigned long long* tab = (LAS unsigned long long*)(F.lds + LDSCTL_OFF);
#pragma unroll
        for (int i = 0; i < 28; ++i) tab[i] = (unsigned long long)args.in[i];
        tab[28] = (unsigned long long)args.out; }
    __syncthreads();
    XcdBarrier bar; bar.bar = (unsigned*)(F.ws + WS_CTL) + CW_BAR; bar.x = 0; bar.st = nullptr; bar.wave_s = F.wave_s;
    if (args.use_bar) bar = xcd_barrier_post((unsigned*)(F.ws + WS_CTL) + CW_BAR, (volatile LAS unsigned*)(F.lds + MISC_OFF) + 8, F.wave_s);
    const int lo = args.ph_lo, hi = args.ph_hi;
#define IN(k) (lo <= (k) && (k) < hi)
#define SEAM(k) do { if (IN(k) && IN((k) + 1)) xcd_barrier(bar); } while (0)
#ifndef PROBE_DUP
#define PROBE_DUP -1
#endif
#define PH_BEGIN(kind) for (int rep_ = 0; rep_ < ((PROBE_DUP) == (kind) ? 2 : 1); ++rep_) { if (rep_) xcd_barrier(bar);
#define PH_END }
    #ifndef NO_P0
    PH_BEGIN(0) if (IN(0)) { p0_prologue(F); } PH_END
#endif
    SEAM(0);
#pragma unroll
    for (int l = 0; l < 2; ++l) {
        const int pb = 1 + 10 * l;
        const bool ctx_out = l == 0;
        const int mrows = ctx_out ? NROWS : NLAT;
#ifndef NO_P1
        if (IN(pb + 0)) { p1_norm1(F, l); }
#endif
        SEAM(pb + 0);
        PH_BEGIN(2) if (IN(pb + 1)) {
            const Frame Fg = fresh_frame(F);
            pg8::Gemm g{(const bf16*)(Fg.ws + WS_HN), (const bf16*)(Fg.ws + WS_WTIN) + (size_t)l * INP * 1024, NROWS, INP, D}; pg8::StaticOrder S; S.init(NROWS, INP, F.G, (int)blockIdx.x);
            pg8::EpiStoreBf16 E{(bf16*)(Fg.ws + WS_U), INP, 0, 0};
            pg8::gemm_phase<pg8::EpiStoreBf16, pg8::StaticOrder, PG8_ALIGN, PG8_SP2>(Fg.lds, g, S, E, F.wave_s);
        }
        PH_END
        SEAM(pb + 1);
        if (IN(pb + 2)) { p2t_pretransform(F, l); }
        SEAM(pb + 2);
        PH_BEGIN(3) if (IN(pb + 3)) { p3a_state(F, l); } PH_END
        SEAM(pb + 3);
        PH_BEGIN(4) if (IN(pb + 4)) { p3b_output(F, l, ctx_out); } PH_END
        SEAM(pb + 4);
        if (IN(pb + 5)) {
            const Frame Fg = fresh_frame(F);
            pg8::Gemm g{(const bf16*)(Fg.ws + WS_Y), (const bf16*)(Fg.ws + WS_WTOUT) + (size_t)l * 1024 * 1024, mrows, D, D}; pg8::StaticOrder S; S.init(mrows, D, F.G, (int)blockIdx.x);
            pg8::EpiOutProj E{(float*)(Fg.ws + WS_H), (const float*)(Fg.ws + WS_MOD) + (size_t)l * 9 * MODW};
            pg8::gemm_phase<pg8::EpiOutProj, pg8::StaticOrder, PG8_ALIGN, PG8_SP2>(Fg.lds, g, S, E, F.wave_s);
        }
        SEAM(pb + 5);
#ifndef NO_P6
        PH_BEGIN(6) if (IN(pb + 6)) { p6_norm2_router(F, l, mrows); } PH_END
#endif
        SEAM(pb + 6);
#ifndef NO_P7
        PH_BEGIN(7) if (IN(pb + 7)) { p7_topk(F, l); } PH_END
#endif
        SEAM(pb + 7);
        PH_BEGIN(8) if (IN(pb + 8)) {
            const Frame Fg = fresh_frame(F);
            pg8::Gemm g{(const bf16*)(Fg.ws + WS_Y), (const bf16*)(Fg.ws + WS_WTGU) + (size_t)l * NE * 3072 * 1024, NE * SLOTS, NE * 3072, D};
            pg8::GroupedOrder S{ctx_out ? 9 : 8, 12, (int)blockIdx.x};
            pg8::EpiSwiGLU E{(bf16*)(Fg.ws + WS_U)};
            pg8::gemm_phase<pg8::EpiSwiGLU, pg8::GroupedOrder, PG8_ALIGN, PG8_SP2>(Fg.lds, g, S, E, F.wave_s);
        }
        PH_END
        SEAM(pb + 8);
        PH_BEGIN(9) if (IN(pb + 9)) {
            const Frame Fg = fresh_frame(F);
            pg8::Gemm g{(const bf16*)(Fg.ws + WS_U), (const bf16*)(Fg.ws + WS_WTDN) + (size_t)l * NE * 1024 * FF, NE * SLOTS, NE * 1024, FF};
            pg8::GroupedOrder S{ctx_out ? 9 : 8, 4, (int)blockIdx.x};
            pg8::EpiStoreBf16 E{(bf16*)(Fg.ws + WS_O2), D, 9, 4};
            pg8::gemm_phase<pg8::EpiStoreBf16, pg8::GroupedOrder, PG8_ALIGN, PG8_SP2>(Fg.lds, g, S, E, F.wave_s);
        }
        PH_END
        SEAM(pb + 9);
    }
#ifndef NO_PF
    if (IN(21)) { p_final(F, (float*)inp(F.lds, 28)); }
#endif
#undef IN
#undef SEAM
}

#ifndef MK_ONE_LAUNCH
#define MK_ONE_LAUNCH 1
#endif
extern "C" void kernel_launch(void* const* d_in, const int* in_sizes, int n_in, void* d_out, int out_size, void* d_ws, size_t ws_size, hipStream_t stream) {
    static int grid = 0;
    if (grid == 0) {
        if (n_in != 28 || out_size != NLAT * D || ws_size < WS_END3) { fprintf(stderr, "kernel_launch: unexpected problem (n_in %d, out %d, ws %zu < %zu)\n", n_in, out_size, ws_size, (size_t)WS_END); grid = -1; return; }
        int dev = 0, cus = 0, per_cu = 0;
        if (hipGetDevice(&dev) != hipSuccess || hipDeviceGetAttribute(&cus, hipDeviceAttributeMultiprocessorCount, dev) != hipSuccess) { grid = -1; return; }
        if (hipFuncSetAttribute((const void*)fwd_kernel, hipFuncAttributeMaxDynamicSharedMemorySize, LDS_BYTES) != hipSuccess) { fprintf(stderr, "kernel_launch: hipFuncSetAttribute failed\n"); grid = -1; return; }
        if (hipOccupancyMaxActiveBlocksPerMultiprocessor(&per_cu, (const void*)fwd_kernel, NWAVES * 64, LDS_BYTES) != hipSuccess || per_cu < 1) { fprintf(stderr, "kernel_launch: occupancy query says %d\n", per_cu); (void)hipGetLastError(); per_cu = 1; }
        grid = cus;
        if (grid != 256) { fprintf(stderr, "kernel_launch: built for 256 CUs, device has %d\n", cus); grid = -1; return; }
    }
    if (grid < 0) return;
    (void)hipMemsetAsync((char*)d_ws + WS_CTL, 0, CTL_ZERO_BYTES, stream);
    Args a{};
    for (int i = 0; i < 28; ++i) a.in[i] = (const float*)d_in[i];
    a.out = (float*)d_out; a.ws = (unsigned char*)d_ws; a.never = 0;
#if MK_ONE_LAUNCH
    a.ph_lo = 0; a.ph_hi = NPHASES; a.use_bar = 1;
    void* kargs[] = {&a};
    hipError_t e = hipLaunchCooperativeKernel((const void*)fwd_kernel, dim3(grid), dim3(NWAVES * 64), kargs, LDS_BYTES, stream);
    if (e != hipSuccess) fprintf(stderr, "kernel_launch: cooperative launch failed: %s\n", hipGetErrorString(e));
#else
    for (int ph = 0; ph < NPHASES; ++ph) { a.ph_lo = ph; a.ph_hi = ph + 1; a.use_bar = 0;
        hipLaunchKernelGGL(fwd_kernel, dim3(grid), dim3(NWAVES * 64), LDS_BYTES, stream, a); }
#endif
}
```

```cpp
#include <hip/hip_runtime.h>
#include <hip/hip_cooperative_groups.h>
#include <cstdio>
#include <cstdint>
#define GAS __attribute__((address_space(1)))
#define LAS __attribute__((address_space(3)))
namespace pg8 {
#define PG8_LAS __attribute__((address_space(3)))
typedef unsigned short bf16_t;
typedef short bf16x8 __attribute__((ext_vector_type(8)));
typedef float f32x4 __attribute__((ext_vector_type(4)));
typedef unsigned u32x4 __attribute__((ext_vector_type(4)));
constexpr int BM = 256, BK = 64, HALF = 128, HTB = HALF * BK * 2  , STAGE_BYTES = 8 * HTB, NXCD = 8, WGM = 8;

__host__ __device__ __forceinline__ int lds_byte(int r, int c) { const int st = (r >> 4) * 2 + (c >> 5), rr = r & 15, cc = c & 31, ob = rr * 64 + cc * 2; return st * 1024 + (ob ^ (((ob >> 9) & 1) << 5)); }
__host__ __device__ __forceinline__ void stage_rc(int b, int& R, int& C) { const int st = b / 1024, sb = b % 1024, swz = sb ^ (((sb >> 9) & 1) << 5); R = (st >> 1) * 16 + swz / 64; C = (st & 1) * 32 + (swz % 64) / 2; }
__host__ __device__ __forceinline__ int perm32(int rho) { const int n = rho >> 4, i = rho & 15; return 8 * (i >> 2) + 4 * n + (i & 3); }

struct Unit { int pm, pn; };
struct Gemm { const bf16_t* A; const bf16_t* Bt; int M, N, K; };

struct StaticOrder {
    int nM, nN, nwg, G, c;
    __host__ __device__ void init(int M, int N, int G_, int c_) { nM = M / BM; nN = N / BM; nwg = nM * nN; G = G_; c = c_; }
    __host__ __device__ bool next(int i, Unit& u) const {
        const long L = (long)i * G + c; if (L >= nwg) return false;
        int wgid = (int)L; { const int q = nwg / NXCD, r = nwg % NXCD, xcd = wgid % NXCD, off = wgid / NXCD; wgid = (xcd < r ? xcd * (q + 1) : r * (q + 1) + (xcd - r) * q) + off; }
        const int nig = WGM * nN, gid = wgid / nig, fm = gid * WGM, gsz = (nM - fm) < WGM ? (nM - fm) : WGM;
        u.pm = fm + ((wgid % nig) % gsz); u.pn = (wgid % nig) / gsz; return true;
    }
    __device__ __forceinline__ void a_ready(const Unit&) const {}
    __device__ __forceinline__ void done(const Unit&) const {}
};

__device__ __forceinline__ unsigned cvt_pk_bf16(float lo, float hi) { unsigned r; asm volatile("v_cvt_pk_bf16_f32 %0, %1, %2" : "=v"(r) : "v"(lo), "v"(hi)); return r; }
typedef float f32x2_t __attribute__((ext_vector_type(2))); typedef __bf16 bf16x2_t __attribute__((ext_vector_type(2)));
__device__ __forceinline__ unsigned cvt_pk_safe(float lo, float hi) { const f32x2_t v = {lo, hi}; const bf16x2_t b = __builtin_convertvector(v, bf16x2_t); return __builtin_bit_cast(unsigned, b); }

struct EpiStoreBf16 {
    static constexpr bool PERM = true, AFTER_DRAIN = false;
    bf16_t* O; int ldc; int pm_div, pn_per;
    __device__ __forceinline__ void operator()(const f32x4 (&acc)[2][2][4][2], const Unit& u, int wr, int wc, int fr, int fq) const {
        const int row0 = u.pm * BM + wr * 64 + fr; int pnl = u.pn; if (pm_div) pnl -= (u.pm / pm_div) * pn_per;
        const int col0 = pnl * BM + wc * 32 + 8 * fq;
#pragma unroll
        for (int ai = 0; ai < 2; ++ai)
#pragma unroll
            for (int m = 0; m < 4; ++m) { bf16_t* rowp = O + (size_t)(row0 + ai * HALF + m * 16) * ldc + col0;
#pragma unroll
                for (int bj = 0; bj < 2; ++bj) { const f32x4 v0 = acc[ai][bj][m][0], v1 = acc[ai][bj][m][1];
                    u32x4 w; w.x = cvt_pk_bf16(v0[0], v0[1]); w.y = cvt_pk_bf16(v0[2], v0[3]); w.z = cvt_pk_bf16(v1[0], v1[1]); w.w = cvt_pk_bf16(v1[2], v1[3]);
                    *(u32x4*)(rowp + bj * HALF) = w; } }
    }
};
struct EpiSwiGLU {
    static constexpr bool PERM = false, AFTER_DRAIN = false;
    bf16_t* O;
    __device__ __forceinline__ void operator()(const f32x4 (&acc)[2][2][4][2], const Unit& u, int wr, int wc, int fr, int fq) const {
        const int e = u.pm / 9, pnl = u.pn - e * 12;
        const int row0 = u.pm * BM + wr * 64 + fr, col0 = pnl * 128 + (4 * wc + fq) * 8;
#pragma unroll
        for (int ai = 0; ai < 2; ++ai)
#pragma unroll
            for (int m = 0; m < 4; ++m) {
                float h[8];
#pragma unroll
                for (int bj = 0; bj < 2; ++bj)
#pragma unroll
                    for (int j = 0; j < 4; ++j) { const float g = acc[ai][bj][m][0][j], up = acc[ai][bj][m][1][j]; h[bj * 4 + j] = g * __builtin_amdgcn_rcpf(1.0f + __expf(-g)) * up; }
                u32x4 w; w.x = cvt_pk_bf16(h[0], h[1]); w.y = cvt_pk_bf16(h[2], h[3]); w.z = cvt_pk_bf16(h[4], h[5]); w.w = cvt_pk_bf16(h[6], h[7]);
                *(u32x4*)(O + (size_t)(row0 + ai * HALF + m * 16) * 1536 + col0) = w; }
    }
};
struct EpiOutProj {
    static constexpr bool PERM = false, AFTER_DRAIN = false;
    float* H; const float* mod;
    const float* xin; const float* cin;
    float gsc;
    __device__ __forceinline__ void operator()(const f32x4 (&acc)[2][2][4][2], const Unit& u, int wr, int wc, int fr, int fq) const {
        const int s = u.pm < 64 ? (u.pm >> 3) : 8;
        const float* g1 = mod + s * 6144 + 2048;
        const int row0 = u.pm * BM + wr * 64 + fr, col0 = u.pn * BM + wc * 32 + 4 * fq;
#pragma unroll
        for (int bj = 0; bj < 2; ++bj)
#pragma unroll
            for (int n = 0; n < 2; ++n) { const f32x4 gv = *(const f32x4*)(g1 + col0 + bj * HALF + n * 16);
#pragma unroll
                for (int ai = 0; ai < 2; ++ai)
#pragma unroll
                    for (int m = 0; m < 4; ++m) { const size_t off = (size_t)(row0 + ai * HALF + m * 16) * 1024 + col0 + bj * HALF + n * 16; float* p = H + off;
                        const float* bp = xin ? (u.pm < 64 ? xin + off : cin + (off - (size_t)16384 * 1024)) : p;
                        const f32x4 old = *(const f32x4*)bp; *(f32x4*)p = old + gv * gsc * acc[ai][bj][m][n]; } }
    }
};
struct GroupedOrder {
    int MT, NT, c;
    __device__ __forceinline__ bool next(int i, Unit& u) const {
        const int xcd = c & 7, j = i * 32 + (c >> 3), per = MT * NT;
        if (j >= 2 * per) return false;
        const int e = 2 * xcd + j / per, q = j % per;
        u.pm = e * 9 + q % MT; u.pn = e * NT + q / MT; return true;
    }
    __device__ __forceinline__ void a_ready(const Unit&) const {}
    __device__ __forceinline__ void done(const Unit&) const {}
};

template <class Epi, class Sched, bool ALIGN_EPI = false, bool SP2 = false, bool GATHER = false>
__device__ __forceinline__ void gemm_phase(PG8_LAS unsigned char* lds, const Gemm g, const Sched& S, const Epi& E, const int wave_s, const PG8_LAS int* idxl = nullptr) {
    unsigned m_ = ~0u; asm volatile("" : "+s"(m_)); const int tid_ = wave_s * 64 + (int)__builtin_amdgcn_mbcnt_hi(m_, __builtin_amdgcn_mbcnt_lo(m_, 0u));
    const int tid = tid_, wid = __builtin_amdgcn_readfirstlane(tid >> 6), lane = tid & 63, wr = wid >> 2, wc = wid & 3, fr = lane & 15, fq = lane >> 4;
    const int K = g.K, nt = K / BK;
    unsigned voffA[2], voffB[2]; int gR[2], gC2[2];
#pragma unroll
    for (int i = 0; i < 2; ++i) { int R, C; stage_rc(tid * 16 + i * 8192, R, C); const int Rb = Epi::PERM ? ((R & ~31) + perm32(R & 31)) : R;
        voffA[i] = (unsigned)(R * K + C) * 2u; voffB[i] = (unsigned)(Rb * K + C) * 2u; gR[i] = R; gC2[i] = 2 * C; }
    const size_t kstep = (size_t)(BK * 2);
    const size_t hstep = (size_t)HALF * K * 2;
    const size_t tstep = 2 * hstep;
    const unsigned ldsw = (unsigned)wid * 1024u;
    const int aoff = lds_byte(wr * 64 + fr, fq * 8), boff = lds_byte(wc * 32 + fr, fq * 8);
#define PG8_SA(b, h) (((b) * 2 + (h)) * HTB)
#define PG8_SB(b, h) ((4 + (b) * 2 + (h)) * HTB)
#define PG8_STAGE(bufoff, gbase, voff) do { _Pragma("unroll") for (int _i = 0; _i < 2; ++_i) \
        __builtin_amdgcn_global_load_lds((const unsigned*)((const char*)(gbase) + (voff)[_i]), (PG8_LAS unsigned*)(lds + (bufoff) + ldsw + _i * 8192), 16, 0, 0); } while (0)
#define PG8_STAGE_A(bufoff, gbase, h, usenext) do { if constexpr (GATHER) { _Pragma("unroll") for (int _i = 0; _i < 2; ++_i) { const unsigned _o = (usenext) ? vn[h][_i] : vo[h][_i]; \
        __builtin_amdgcn_global_load_lds((const unsigned*)((const char*)(gbase) + _o), (PG8_LAS unsigned*)(lds + (bufoff) + ldsw + _i * 8192), 16, 0, 0); } } \
        else { PG8_STAGE(bufoff, (const char*)(gbase) + ((h) ? hstep : (size_t)0), voffA); } } while (0)
#define PG8_LDA(dst, b, h) do { _Pragma("unroll") for (int m = 0; m < 4; ++m) _Pragma("unroll") for (int k = 0; k < 2; ++k) dst[m][k] = *(const PG8_LAS bf16x8*)(lds + PG8_SA(b, h) + aoff + m * 2048 + k * 1024); } while (0)
#define PG8_LDB(dst, b, h) do { _Pragma("unroll") for (int n = 0; n < 2; ++n) _Pragma("unroll") for (int k = 0; k < 2; ++k) dst[n][k] = *(const PG8_LAS bf16x8*)(lds + PG8_SB(b, h) + boff + n * 2048 + k * 1024); } while (0)
#define PG8_MMA(ai, bj, At, Bt) do { __builtin_amdgcn_s_setprio(1); _Pragma("unroll") for (int m = 0; m < 4; ++m) _Pragma("unroll") for (int n = 0; n < 2; ++n) _Pragma("unroll") for (int k = 0; k < 2; ++k) \
        acc[ai][bj][m][n] = __builtin_amdgcn_mfma_f32_16x16x32_bf16(Bt[n][k], At[m][k], acc[ai][bj][m][n], 0, 0, 0); __builtin_amdgcn_s_setprio(0); } while (0)
#define PG8_WAIT_V(n) asm volatile("s_waitcnt vmcnt(" #n ")" ::: "memory")
#define PG8_WAIT_L(n) asm volatile("s_waitcnt lgkmcnt(" #n ")" ::: "memory")
#define PG8_BAR __builtin_amdgcn_s_barrier()
#define PG8_SCHED __builtin_amdgcn_sched_barrier(0)
    Unit cur, nxt; int ui = 0;
    if (!S.next(0, cur)) return;
    f32x4 acc[2][2][4][2];
#pragma unroll
    for (int a = 0; a < 2; ++a)
#pragma unroll
        for (int b = 0; b < 2; ++b)
#pragma unroll
            for (int m = 0; m < 4; ++m)
#pragma unroll
                for (int n = 0; n < 2; ++n) acc[a][b][m][n] = (f32x4){0.f, 0.f, 0.f, 0.f};
    bf16x8 At[4][2], B0[2][2], B1[2][2];
    const char* cA = (const char*)g.A + (GATHER ? (size_t)0 : (size_t)cur.pm * tstep); const char* cB = (const char*)g.Bt + (size_t)cur.pn * tstep;
    unsigned vo[2][2], vn[2][2];
    if constexpr (GATHER) {
#pragma unroll
        for (int h = 0; h < 2; ++h)
#pragma unroll
            for (int i = 0; i < 2; ++i) { vo[h][i] = (unsigned)idxl[h * 128 + gR[i]] * (unsigned)(2 * K) + (unsigned)gC2[i]; vn[h][i] = vo[h][i]; } }
    S.a_ready(cur);
    if constexpr (SP2) {
        PG8_STAGE(PG8_SB(0, 0), cB, voffB); PG8_STAGE(PG8_SB(0, 1), cB + hstep, voffB); PG8_STAGE_A(PG8_SA(0, 0), cA, 0, false); PG8_STAGE_A(PG8_SA(0, 1), cA, 1, false);
        if (wr == 1) PG8_BAR;
        PG8_WAIT_V(2); PG8_BAR;
        PG8_STAGE(PG8_SB(1, 0), cB + kstep, voffB); PG8_STAGE_A(PG8_SA(1, 0), cA + kstep, 0, false); PG8_STAGE(PG8_SB(1, 1), cB + hstep + kstep, voffB);
        PG8_WAIT_V(6); PG8_BAR;
    } else {
        PG8_STAGE(PG8_SB(0, 0), cB, voffB); PG8_STAGE(PG8_SA(0, 0), cA, voffA); PG8_STAGE(PG8_SB(0, 1), cB + hstep, voffB); PG8_STAGE(PG8_SA(0, 1), cA + hstep, voffA);
        if (wr == 1) PG8_BAR;
        PG8_WAIT_V(4); PG8_BAR;
        PG8_STAGE(PG8_SB(1, 0), cB + kstep, voffB); PG8_STAGE(PG8_SA(1, 0), cA + kstep, voffA); PG8_STAGE(PG8_SB(1, 1), cB + hstep + kstep, voffB);
        PG8_WAIT_V(6); PG8_BAR;
    }
    for (;;) {
        const bool has_next = S.next(ui + 1, nxt);
        const char* nA = (has_next && !GATHER) ? (const char*)g.A + (size_t)nxt.pm * tstep : cA; const char* nB = has_next ? (const char*)g.Bt + (size_t)nxt.pn * tstep : cB;
        if constexpr (GATHER) {
#pragma unroll
            for (int h = 0; h < 2; ++h)
#pragma unroll
                for (int i = 0; i < 2; ++i) vn[h][i] = has_next ? (unsigned)idxl[(ui + 1) * 256 + h * 128 + gR[i]] * (unsigned)(2 * K) + (unsigned)gC2[i] : vo[h][i]; }
        for (int t = 0; t < nt; t += 2) {
            const bool last = (t == nt - 2);
            const char* a1 = cA + (size_t)(t + 1) * kstep;
            const char* a2 = last ? nA : cA + (size_t)(t + 2) * kstep; const char* b2 = last ? nB : cB + (size_t)(t + 2) * kstep;
            const char* a3 = a2 + kstep; const char* b3 = b2 + kstep;
            if (last && has_next) S.a_ready(nxt);
            if constexpr (SP2) {
            PG8_LDB(B0, 0, 0); PG8_LDB(B1, 0, 1); PG8_SCHED; PG8_LDA(At, 0, 0); PG8_STAGE_A(PG8_SA(1, 1), a1, 1, false);
            PG8_WAIT_V(8); PG8_WAIT_L(0); PG8_BAR; PG8_MMA(0, 0, At, B0); PG8_MMA(0, 1, At, B1); PG8_BAR; PG8_SCHED;
            PG8_LDA(At, 0, 1); PG8_STAGE(PG8_SB(0, 0), b2, voffB); PG8_STAGE(PG8_SB(0, 1), b2 + hstep, voffB); PG8_STAGE_A(PG8_SA(0, 0), a2, 0, last);
            PG8_WAIT_V(8); PG8_WAIT_L(0); PG8_BAR; PG8_MMA(1, 0, At, B0); PG8_MMA(1, 1, At, B1); PG8_BAR; PG8_SCHED;
            PG8_LDB(B0, 1, 0); PG8_LDB(B1, 1, 1); PG8_SCHED; PG8_LDA(At, 1, 0); PG8_STAGE_A(PG8_SA(0, 1), a2, 1, last);
            PG8_WAIT_V(8); PG8_WAIT_L(0); PG8_BAR; PG8_MMA(0, 0, At, B0); PG8_MMA(0, 1, At, B1); PG8_BAR; PG8_SCHED;
            PG8_LDA(At, 1, 1); PG8_STAGE(PG8_SB(1, 0), b3, voffB); PG8_STAGE(PG8_SB(1, 1), b3 + hstep, voffB); PG8_STAGE_A(PG8_SA(1, 0), a3, 0, last);
            PG8_WAIT_V(8); PG8_WAIT_L(0); PG8_BAR; PG8_MMA(1, 0, At, B0); PG8_MMA(1, 1, At, B1); PG8_BAR; PG8_SCHED;
            } else {
            PG8_LDB(B0, 0, 0); PG8_SCHED; PG8_LDA(At, 0, 0); PG8_STAGE(PG8_SA(1, 1), a1 + hstep, voffA);
            PG8_WAIT_L(8); PG8_BAR; PG8_WAIT_L(0); PG8_MMA(0, 0, At, B0); PG8_BAR; PG8_SCHED;
            PG8_LDB(B1, 0, 1); PG8_STAGE(PG8_SB(0, 0), b2, voffB);
            PG8_BAR; PG8_WAIT_L(0); PG8_MMA(0, 1, At, B1); PG8_BAR;
            PG8_LDA(At, 0, 1); PG8_STAGE(PG8_SA(0, 0), a2, voffA);
            PG8_BAR; PG8_WAIT_L(0); PG8_MMA(1, 0, At, B0); PG8_BAR; PG8_SCHED;
            PG8_STAGE(PG8_SB(0, 1), b2 + hstep, voffB);
            PG8_WAIT_V(6); PG8_BAR; PG8_MMA(1, 1, At, B1); PG8_BAR;
            PG8_LDB(B0, 1, 0); PG8_SCHED; PG8_LDA(At, 1, 0); PG8_STAGE(PG8_SA(0, 1), a2 + hstep, voffA);
            PG8_WAIT_L(8); PG8_BAR; PG8_WAIT_L(0); PG8_MMA(0, 0, At, B0); PG8_BAR; PG8_SCHED;
            PG8_LDB(B1, 1, 1); PG8_STAGE(PG8_SB(1, 0), b3, voffB);
            PG8_BAR; PG8_WAIT_L(0); PG8_MMA(0, 1, At, B1); PG8_BAR;
            PG8_LDA(At, 1, 1); PG8_STAGE(PG8_SA(1, 0), a3, voffA);
            PG8_BAR; PG8_WAIT_L(0); PG8_MMA(1, 0, At, B0); PG8_BAR; PG8_SCHED;
            PG8_STAGE(PG8_SB(1, 1), b3 + hstep, voffB);
            PG8_WAIT_V(6); PG8_BAR; PG8_MMA(1, 1, At, B1); PG8_BAR;
            }
        }
        if constexpr (ALIGN_EPI) { if (wr == 0) PG8_BAR; }
        if constexpr (!Epi::AFTER_DRAIN) { E(acc, cur, wr, wc, fr, fq); S.done(cur); }
        if (!has_next) break;
#pragma unroll
        for (int a = 0; a < 2; ++a)
#pragma unroll
            for (int b = 0; b < 2; ++b)
#pragma unroll
                for (int m = 0; m < 4; ++m)
#pragma unroll
                    for (int n = 0; n < 2; ++n) acc[a][b][m][n] = (f32x4){0.f, 0.f, 0.f, 0.f};
        cur = nxt; cA = nA; cB = nB; ++ui;
        if constexpr (GATHER) {
#pragma unroll
            for (int h = 0; h < 2; ++h)
#pragma unroll
                for (int i = 0; i < 2; ++i) vo[h][i] = vn[h][i]; }
        if constexpr (ALIGN_EPI) { if (wr == 1) PG8_BAR; }
    }
    PG8_WAIT_V(0);
    if constexpr (!ALIGN_EPI) { if (wr == 0) PG8_BAR; }
    PG8_BAR;
    if constexpr (Epi::AFTER_DRAIN) { E.fused(acc, cur, wr, wc, fr, fq, lds, wid, lane); S.done(cur); }
#undef PG8_SA
#undef PG8_SB
#undef PG8_STAGE
#undef PG8_STAGE_A
#undef PG8_LDA
#undef PG8_LDB
#undef PG8_MMA
#undef PG8_WAIT_V
#undef PG8_WAIT_L
#undef PG8_BAR
#undef PG8_SCHED
}
}

#ifndef PG8_SP2
#define PG8_SP2 true
#endif
#ifndef PG8_ALIGN
#define PG8_ALIGN true
#endif

constexpr int D = 1024, NB = 8, SEQ = 2048, CTXL = 256, NLAT = NB * SEQ, NCTX = NB * CTXL, NROWS = NLAT + NCTX;
constexpr int INC = 3624, INP = 3840, NE = 16, FF = 1536, SLOTS = 2304, MODW = 6144;
constexpr float EPS = 1e-6f;
constexpr int C_RET = 0, C_GLA = 1024, C_SSD = 1808, C_ML = 2584;
constexpr size_t MiB = 1u << 20;
constexpr size_t WS_CTL = 0, CTL_ZERO_BYTES = 1 * MiB;
constexpr size_t WS_MOD = 1 * MiB, WS_WTIN = 2 * MiB, WS_WTOUT = 18 * MiB, WS_WTGU = 22 * MiB, WS_WTDN = 214 * MiB, WS_H = 310 * MiB, WS_HN = 382 * MiB,
                 WS_U = 418 * MiB  , WS_O2 = 553 * MiB  , WS_Y = 625 * MiB  , WS_AFFT = 697 * MiB, WS_SLOT = 699 * MiB, WS_END = 701 * MiB;
constexpr int CW_BAR = 4096;
constexpr int RING_BYTES = 131072, LDSCTL_OFF = RING_BYTES, MISC_OFF = LDSCTL_OFF + 320, LDS_BYTES = 147456;
constexpr int NWAVES = 8, NPHASES = 22;

typedef unsigned short bf16;
typedef unsigned v4u __attribute__((ext_vector_type(4)));
typedef unsigned v2u __attribute__((ext_vector_type(2)));
typedef float f32x4 __attribute__((ext_vector_type(4)));
typedef GAS unsigned gu32;
#define LDS_WAIT() asm volatile("s_waitcnt lgkmcnt(0)" ::: "memory")
#define VM_WAIT() asm volatile("s_waitcnt vmcnt(0)" ::: "memory")

#define XB_TMO      128
#define XB_XCNT(j)  (256  + 64 * (j))
#define XB_XSUB(j)  (1280 + 64 * (j))
#define XB_XGEN(j)  (2304 + 64 * (j))
#define XB_TOP      3328
#define XB_TOPGEN   3392
#define XCD_BAR_WORDS 3456
#define XB_SPIN_CAP (1u << 18)

__device__ __forceinline__ unsigned xb_ld(unsigned* p)              { return __hip_atomic_load(p, __ATOMIC_RELAXED, __HIP_MEMORY_SCOPE_AGENT); }
__device__ __forceinline__ unsigned xb_add(unsigned* p, unsigned v) { return __hip_atomic_fetch_add(p, v, __ATOMIC_RELAXED, __HIP_MEMORY_SCOPE_AGENT); }
__device__ __forceinline__ unsigned xb_xcc_id() { return (unsigned)__builtin_amdgcn_s_getreg((3 << 11) | 20) & 0xFu; }
#define XB_SPIN(cond, bar) do { unsigned _sp = 0; while (cond) { __builtin_amdgcn_s_sleep(1); \
    if ((++_sp & 255u) == 0u) { if (xb_ld(&(bar)[XB_TMO])) break; if (_sp > XB_SPIN_CAP) { atomicAdd(&(bar)[XB_TMO], 1u); break; } } } } while (0)

__device__ __forceinline__ int xb_lane_id() { unsigned m = ~0u; asm volatile("" : "+s"(m)); return (int)__builtin_amdgcn_mbcnt_hi(m, __builtin_amdgcn_mbcnt_lo(m, 0u)); }
struct XcdBarrier {
    int wave_s;
    unsigned* bar; unsigned x;
    volatile LAS unsigned* st;
};

__device__ __forceinline__ XcdBarrier xcd_barrier_post(unsigned* bar, volatile LAS unsigned* st, int wave_s) {
    XcdBarrier b; b.bar = bar; b.x = xb_xcc_id(); b.st = st; b.wave_s = wave_s;
    if (wave_s == 0 && xb_lane_id() == 0) (void)xb_add(&bar[XB_XCNT(b.x)], 1u);
    return b;
}
__device__ __forceinline__ void xcd_barrier_complete(unsigned* bar, unsigned x, unsigned& nloc, unsigned& nx) {
    const unsigned G = gridDim.x * gridDim.y * gridDim.z;
    unsigned sum, cnt, mine, sp = 0u;
    for (;;) {
        sum = 0u; cnt = 0u; mine = 0u;
#pragma unroll
        for (unsigned j = 0; j < 16; ++j) { const unsigned c = xb_ld(&bar[XB_XCNT(j)]); sum += c; cnt += (c > 0u) ? 1u : 0u; }
        if (sum == G) { mine = xb_ld(&bar[XB_XCNT(x)]); break; }
        __builtin_amdgcn_s_sleep(1);
        if ((++sp & 255u) == 0u) { if (xb_ld(&bar[XB_TMO])) break; if (sp > XB_SPIN_CAP) { atomicAdd(&bar[XB_TMO], 1u); break; } }
    }
    nloc = mine > 0u ? mine : 1u; nx = cnt > 0u ? cnt : 1u;
}

__device__ __forceinline__ void xcd_barrier(const XcdBarrier& b) {
    asm volatile("s_waitcnt vmcnt(0)" ::: "memory");
    __syncthreads();
    if (b.wave_s == 0 && xb_lane_id() == 0) {
        unsigned* bar = b.bar; asm volatile("" : "+s"(bar));
        __builtin_amdgcn_s_waitcnt(0);
        unsigned nloc = b.st[0], nx = b.st[1];
        if (nloc == 0u) { xcd_barrier_complete(bar, b.x, nloc, nx); b.st[0] = nloc; b.st[1] = nx; }
        const unsigned old = xb_add(&bar[XB_XSUB(b.x)], 1u);
        const unsigned gen = old / nloc;
        if (old + 1u == (gen + 1u) * nloc) {
            __builtin_amdgcn_fence(__ATOMIC_RELEASE, "agent");
            asm volatile("s_waitcnt vmcnt(0)" ::: "memory");
            const unsigned og = xb_add(&bar[XB_TOP], 1u);
            const unsigned tg = og / nx;
            if (og + 1u == (tg + 1u) * nx) xb_add(&bar[XB_TOPGEN], 1u);
            else XB_SPIN(xb_ld(&bar[XB_TOPGEN]) == tg, bar);
            __builtin_amdgcn_fence(__ATOMIC_ACQUIRE, "agent");
            xb_add(&bar[XB_XGEN(b.x)], 1u);
            asm volatile("s_waitcnt vmcnt(0)" ::: "memory");
        } else {
            XB_SPIN(xb_ld(&bar[XB_XGEN(b.x)]) == gen, bar);
            __builtin_amdgcn_fence(__ATOMIC_ACQUIRE, "agent");
            asm volatile("s_waitcnt vmcnt(0)" ::: "memory");
        }
    }
    __syncthreads();
}


struct Frame {
    LAS unsigned char* lds;
    int vcu, G, wave_s;
    unsigned char* ws;
};
struct Ids { int tid, lane, wave; };
__device__ __forceinline__ const float* inp(const LAS unsigned char* lds, int i) {
    const LAS unsigned* t = (const LAS unsigned*)(lds + 131072) + 2 * i;
    const unsigned lo = __builtin_amdgcn_readfirstlane(t[0]), hi = __builtin_amdgcn_readfirstlane(t[1]);
    return (const float*)(GAS const float*)(((unsigned long long)hi << 32) | lo); }
__device__ __forceinline__ Frame fresh_frame(const Frame& F) { Frame G = F; GAS unsigned char* g = (GAS unsigned char*)F.ws; asm volatile("" : "+s"(g), "+s"(G.lds), "+s"(G.vcu), "+s"(G.G), "+s"(G.wave_s)); G.ws = (unsigned char*)g; return G; }
__device__ __forceinline__ int lane_id() { unsigned m = ~0u; asm volatile("" : "+s"(m)); return (int)__builtin_amdgcn_mbcnt_hi(m, __builtin_amdgcn_mbcnt_lo(m, 0u)); }
__device__ __forceinline__ Ids fresh_ids(int wave_s) { Ids I; I.lane = lane_id(); I.wave = wave_s; I.tid = wave_s * 64 + I.lane; return I; }
__device__ __forceinline__ float shx(float v, int mask, int lane) { return __int_as_float(__builtin_amdgcn_ds_bpermute((lane ^ mask) << 2, __float_as_int(v))); }
__device__ __forceinline__ float shidx(float v, int src) { return __int_as_float(__builtin_amdgcn_ds_bpermute(src << 2, __float_as_int(v))); }
__device__ __forceinline__ int shidx_i(int v, int src) { return __builtin_amdgcn_ds_bpermute(src << 2, v); }
__device__ __forceinline__ float wave_sum(float v, int lane) {
#pragma unroll
    for (int o = 1; o < 64; o <<= 1) v += shx(v, o, lane);
    return v;
}
__device__ __forceinline__ float bf_lo(unsigned w) { return __uint_as_float(w << 16); }
__device__ __forceinline__ float bf_hi(unsigned w) { return __uint_as_float(w & 0xffff0000u); }
__device__ __forceinline__ f32x4 ld_bf4(const bf16* p) { const v2u w = *(const v2u*)p; return (f32x4){bf_lo(w.x), bf_hi(w.x), bf_lo(w.y), bf_hi(w.y)}; }
__device__ __forceinline__ void st_bf4(bf16* p, f32x4 v) { v2u w; w.x = pg8::cvt_pk_bf16(v.x, v.y); w.y = pg8::cvt_pk_bf16(v.z, v.w); *(v2u*)p = w; }
__device__ __forceinline__ float silu_f(float x) { return x / (1.0f + expf(-x)); }
__device__ __forceinline__ float sigmoid_f(float x) { return 1.0f / (1.0f + expf(-x)); }
__device__ __forceinline__ float log_sigmoid_f(float z) { return fminf(z, 0.f) - log1pf(expf(-fabsf(z))); }
__device__ __forceinline__ float softplus_f(float x) { return fmaxf(x, 0.f) + log1pf(expf(-fabsf(x))); }
__device__ __forceinline__ int row_sample(int r) { return r < NLAT ? (r >> 11) : 8; }

template <class RowMap>
__device__ __forceinline__ void transpose_item(const float* W, int ldw, int nvalid, int k0, int n0, bf16* WT, int ldt, const RowMap& f, LAS float* scr, int lane) {
    f32x4 t[8];
#pragma unroll
    for (int i = 0; i < 8; ++i) { const int idx = i * 64 + lane, kk = idx >> 3, c = n0 + 4 * (idx & 7);
        t[i] = c < nvalid ? __builtin_nontemporal_load((const f32x4*)(W + (size_t)(k0 + kk) * ldw + c)) : (f32x4){0.f, 0.f, 0.f, 0.f}; }
#pragma unroll
    for (int i = 0; i < 8; ++i) { const int idx = i * 64 + lane, kk = idx >> 3, c4 = 4 * (idx & 7); LAS float* d = scr + kk * 33 + c4; d[0] = t[i].x; d[1] = t[i].y; d[2] = t[i].z; d[3] = t[i].w; }
    LDS_WAIT(); asm volatile("" ::: "memory");
    const int c8 = lane & 7;
#pragma unroll
    for (int j = 0; j < 4; ++j) { const int n = (lane >> 3) + 8 * j, col = n0 + n; const LAS float* s = scr + (8 * c8) * 33 + n;
        if (col < nvalid) { v4u o; o.x = pg8::cvt_pk_bf16(s[0 * 33], s[1 * 33]); o.y = pg8::cvt_pk_bf16(s[2 * 33], s[3 * 33]); o.z = pg8::cvt_pk_bf16(s[4 * 33], s[5 * 33]); o.w = pg8::cvt_pk_bf16(s[6 * 33], s[7 * 33]);
            *(v4u*)(WT + (size_t)f(col) * ldt + k0 + 8 * c8) = o; } }
    LDS_WAIT(); asm volatile("" ::: "memory");
}
struct MapId { int off; __device__ __forceinline__ int operator()(int c) const { return off + c; } };
struct MapGU { int off, n; __device__ __forceinline__ int operator()(int h) const { const int hl = h & 127, q = hl >> 3, wc = q >> 2, fq = q & 3, rem = hl & 7, bj = rem >> 2, j = rem & 3;
    return off + 256 * (h >> 7) + 128 * bj + 32 * wc + 16 * n + 4 * fq + j; } };

__device__ __forceinline__ void p0_prologue(const Frame& F_) {
    const Frame F = fresh_frame(F_); const Ids I = fresh_ids(F.wave_s);
    const float* cvec = inp(F.lds, 1); const float* cctx = inp(F.lds, 3); const float* w_mod = inp(F.lds, 4); const float* b_mod = inp(F.lds, 5);
    float* MOD = (float*)(F.ws + WS_MOD);
    {
        LAS float* sil = (LAS float*)F.lds;
        LAS float* part = (LAS float*)(F.lds + 40960);
        for (int i = I.tid; i < 9 * 1024; i += 512) { const int s = i >> 10, k = i & 1023; const float c = s < 8 ? cvec[s * 1024 + k] : cctx[k]; sil[i] = silu_f(c); }
        __syncthreads();
        for (int item = F.vcu; item < 192; item += F.G) {
            const int l = item / 96, col = (item % 96) * 64 + I.lane;
            float acc[9];
#pragma unroll
            for (int s = 0; s < 9; ++s) acc[s] = 0.f;
            const float* wp = w_mod + (size_t)l * 1024 * MODW + (size_t)(I.wave * 128) * MODW + col;
            for (int k = 0; k < 128; ++k) { const float wv = wp[(size_t)k * MODW];
#pragma unroll
                for (int s = 0; s < 9; ++s) acc[s] += sil[s * 1024 + I.wave * 128 + k] * wv; }
#pragma unroll
            for (int s = 0; s < 9; ++s) part[(I.wave * 9 + s) * 64 + I.lane] = acc[s];
            __syncthreads();
            for (int i = I.tid; i < 9 * 64; i += 512) { const int s = i >> 6, ln = i & 63; float t = 0.f;
#pragma unroll
                for (int w = 0; w < 8; ++w) t += part[(w * 9 + s) * 64 + ln];
                const int cc = (item % 96) * 64 + ln; MOD[((size_t)l * 9 + s) * MODW + cc] = t + b_mod[l * MODW + cc]; }
            __syncthreads();
        }
        __syncthreads();
    }
    {
        bf16* wtin = (bf16*)(F.ws + WS_WTIN);
        const int nchunk = 2 * (INP - INC) * 128;
        for (int i = F.vcu * 512 + I.tid; i < nchunk; i += F.G * 512) { const int l = i / ((INP - INC) * 128), r = i % ((INP - INC) * 128);
            *(v4u*)(wtin + ((size_t)l * INP + INC) * 1024 + (size_t)r * 8) = (v4u){0u, 0u, 0u, 0u}; }
    }
    {
        LAS float* scr = (LAS float*)(F.lds + I.wave * 16384);
        const int gw = F.vcu * NWAVES + I.wave, NGW = F.G * NWAVES;
        constexpr int I_IN = 16 * 114, I_OUT = 16 * 32, I_E = 768, PER_L = I_IN + I_OUT + 16 * 3 * I_E;
#ifndef CONV_IN_SCAN
#define CONV_IN_SCAN 1
#endif
        constexpr int PER_L0 = CONV_IN_SCAN ? (I_IN + I_OUT) : PER_L;
        for (int it = gw; it < 2 * PER_L0; it += NGW) {
            const int l = it / PER_L0; int r = it % PER_L0;
            if (r < I_IN) { const int kb = r / 114, nb = r % 114;
                transpose_item(inp(F.lds, 8) + (size_t)l * 1024 * INC, INC, INC, 64 * kb, 32 * nb, (bf16*)(F.ws + WS_WTIN) + (size_t)l * INP * 1024, 1024, MapId{0}, scr, I.lane); continue; }
            r -= I_IN;
            if (r < I_OUT) { const int kb = r / 32, nb = r % 32;
                transpose_item(inp(F.lds, 9) + (size_t)l * 1024 * 1024, 1024, 1024, 64 * kb, 32 * nb, (bf16*)(F.ws + WS_WTOUT) + (size_t)l * 1024 * 1024, 1024, MapId{0}, scr, I.lane); continue; }
            r -= I_OUT;
            const int e = r / (3 * I_E), q = r % (3 * I_E), kind = q / I_E, t = q % I_E;
            if (kind < 2) { const int kb = t / 48, nb = t % 48;
                transpose_item((kind ? inp(F.lds, 25) : inp(F.lds, 24)) + ((size_t)l * NE + e) * 1024 * FF, FF, FF, 64 * kb, 32 * nb, (bf16*)(F.ws + WS_WTGU) + (size_t)l * NE * 3072 * 1024, 1024, MapGU{e * 3072, kind}, scr, I.lane); }
            else { const int kb = t / 32, nb = t % 32;
                transpose_item(inp(F.lds, 26) + ((size_t)l * NE + e) * FF * 1024, 1024, 1024, 64 * kb, 32 * nb, (bf16*)(F.ws + WS_WTDN) + (size_t)l * NE * 1024 * FF, FF, MapId{e * 1024}, scr, I.lane); }
        }
    }
}

struct ConvRaw { float t[32]; bf16* dp; };
__device__ __forceinline__ void conv_issue(const LAS unsigned char* lds, unsigned char* ws, int l, int idx, int lane, ConvRaw& C) {
    const int e = idx / 2304, q = idx % 2304, kind = q / 768, t = q % 768;
    const float* sp; size_t ldw;
    if (kind < 2) { const int kb = t / 24, nb = t % 24, n = 64 * nb + lane; ldw = FF;
        sp = (kind ? inp(lds, 25) : inp(lds, 24)) + ((size_t)l * NE + e) * 1024 * FF + (size_t)(32 * kb) * FF + n;
        C.dp = (bf16*)(ws + WS_WTGU) + (size_t)l * NE * 3072 * 1024 + (size_t)MapGU{e * 3072, kind}(n) * 1024 + 32 * kb; }
    else { const int kb = t / 16, nb = t % 16, n = 64 * nb + lane; ldw = 1024;
        sp = inp(lds, 26) + ((size_t)l * NE + e) * FF * 1024 + (size_t)(32 * kb) * 1024 + n;
        C.dp = (bf16*)(ws + WS_WTDN) + (size_t)l * NE * 1024 * FF + (size_t)(e * 1024 + n) * FF + 32 * kb; }
#pragma unroll
    for (int i = 0; i < 32; ++i) C.t[i] = __builtin_nontemporal_load(sp + (size_t)i * ldw);
}
__device__ __forceinline__ void conv_finish(const ConvRaw& C) {
#pragma unroll
    for (int q = 0; q < 4; ++q) { v4u o; o.x = pg8::cvt_pk_bf16(C.t[8 * q], C.t[8 * q + 1]); o.y = pg8::cvt_pk_bf16(C.t[8 * q + 2], C.t[8 * q + 3]); o.z = pg8::cvt_pk_bf16(C.t[8 * q + 4], C.t[8 * q + 5]); o.w = pg8::cvt_pk_bf16(C.t[8 * q + 6], C.t[8 * q + 7]);
        *(v4u*)(C.dp + 8 * q) = o; }
}
__device__ __forceinline__ void load_row_f32(const float* p, int lane, f32x4 (&v)[4]) {
#pragma unroll
    for (int j = 0; j < 4; ++j) v[j] = *(const f32x4*)(p + 4 * lane + 256 * j);
}
__device__ __forceinline__ float row_sumsq(const f32x4 (&v)[4], int lane) { float s = 0.f;
#pragma unroll
    for (int j = 0; j < 4; ++j) s += (v[j].x * v[j].x + v[j].y * v[j].y) + (v[j].z * v[j].z + v[j].w * v[j].w);
    return wave_sum(s, lane); }
__device__ __forceinline__ void add_expert_out(f32x4 (&v)[4], int r, int lane, const int* slotmap, const float* afft, const bf16* EO, const float* g2, float esc = 1.0f) {
    f32x4 acc[4];
#pragma unroll
    for (int j = 0; j < 4; ++j) acc[j] = (f32x4){0.f, 0.f, 0.f, 0.f};
    const int sl = lane < NE ? slotmap[r * 16 + lane] : -1;
    const float af = lane < NE ? afft[(size_t)lane * NROWS + r] : 0.f;
    unsigned mask = (unsigned)__ballot(sl >= 0);
    while (mask) {
        v2u w[4][4]; float a[4];
#pragma unroll
        for (int q = 0; q < 4; ++q) {
            const bool on = mask != 0u; const int e = on ? __builtin_ctz(mask) : 0; if (on) mask &= mask - 1u;
            const int slot = __builtin_amdgcn_readlane(sl, e); a[q] = on ? __int_as_float(__builtin_amdgcn_readlane(__float_as_int(af), e)) : 0.f;
            const bf16* er = EO + (size_t)(on ? slot : 0) * 1024;
#pragma unroll
            for (int j = 0; j < 4; ++j) w[q][j] = on ? *(const v2u*)(er + 4 * lane + 256 * j) : (v2u){0u, 0u};
        }
#pragma unroll
        for (int q = 0; q < 4; ++q)
#pragma unroll
            for (int j = 0; j < 4; ++j) acc[j] += a[q] * (f32x4){bf_lo(w[q][j].x), bf_hi(w[q][j].x), bf_lo(w[q][j].y), bf_hi(w[q][j].y)};
    }
#pragma unroll
    for (int j = 0; j < 4; ++j) v[j] += *(const f32x4*)(g2 + 4 * lane + 256 * j) * esc * acc[j];
}
__device__ __forceinline__ void p1_norm1(const Frame& F_, int l, float esc) {
    const Frame F = fresh_frame(F_); const Ids I = fresh_ids(F.wave_s);
    const int gw = F.vcu * NWAVES + I.wave, NGW = F.G * NWAVES;
    float* H = (float*)(F.ws + WS_H); bf16* HN = (bf16*)(F.ws + WS_HN);
    const float* MOD = (const float*)(F.ws + WS_MOD); const float* nw = inp(F.lds, 6) + l * 1024;
    const float* xin = inp(F.lds, 0); const float* cin = inp(F.lds, 2);
    ConvRaw CR; const bool xtile = CONV_IN_SCAN && l == 1;
    if (xtile) conv_issue(F.lds, F.ws, l, (F.vcu * NWAVES + I.wave) * 18 + 17, I.lane, CR);
    constexpr int RB = 3;
    for (int r0 = gw; r0 < NROWS; r0 += NGW * RB) {
        f32x4 v[RB][4];
#pragma unroll
        for (int q = 0; q < RB; ++q) { const int r = r0 + q * NGW; if (r < NROWS) {
            if (l == 0) load_row_f32(r < NLAT ? xin + (size_t)r * D : cin + (size_t)(r - NLAT) * D, I.lane, v[q]); else load_row_f32(H + (size_t)r * D, I.lane, v[q]); } }
#pragma unroll
        for (int q = 0; q < RB; ++q) { const int r = r0 + q * NGW; if (r < NROWS) {
            const int s = row_sample(r);
            if (l != 0) add_expert_out(v[q], r, I.lane, (const int*)(F.ws + WS_SLOT), (const float*)(F.ws + WS_AFFT), (const bf16*)(F.ws + WS_O2), MOD + ((size_t)(l - 1) * 9 + s) * MODW + 5120, esc);
            const float rstd = 1.0f / sqrtf(row_sumsq(v[q], I.lane) * (1.0f / D) + EPS);
            const float* m = MOD + ((size_t)l * 9 + s) * MODW;
#pragma unroll
            for (int j = 0; j < 4; ++j) { const int k = 4 * I.lane + 256 * j;
                if (l != 0) *(f32x4*)(H + (size_t)r * D + k) = v[q][j];
                const f32x4 w = *(const f32x4*)(nw + k), sh = *(const f32x4*)(m + k), sc = *(const f32x4*)(m + 1024 + k);
                st_bf4(HN + (size_t)r * D + k, (v[q][j] * rstd * w) * (sc + 1.0f) + sh); } } }
    }
    if (xtile) conv_finish(CR);
}
__device__ __forceinline__ void p_final(const Frame& F_, float* out) {
    const Frame F = fresh_frame(F_); const Ids I = fresh_ids(F.wave_s);
    const int gw = F.vcu * NWAVES + I.wave, NGW = F.G * NWAVES;
    const float* H = (const float*)(F.ws + WS_H); const float* MOD = (const float*)(F.ws + WS_MOD); const float* nw = inp(F.lds, 27);
    constexpr int RB = 2;
    for (int r0 = gw; r0 < NLAT; r0 += NGW * RB) {
        f32x4 v[RB][4];
#pragma unroll
        for (int q = 0; q < RB; ++q) { const int r = r0 + q * NGW; if (r < NLAT) load_row_f32(H + (size_t)r * D, I.lane, v[q]); }
#pragma unroll
        for (int q = 0; q < RB; ++q) { const int r = r0 + q * NGW; if (r < NLAT) {
            const int s = row_sample(r);
            add_expert_out(v[q], r, I.lane, (const int*)(F.ws + WS_SLOT), (const float*)(F.ws + WS_AFFT), (const bf16*)(F.ws + WS_O2), MOD + ((size_t)1 * 9 + s) * MODW + 5120);
            const float rstd = 1.0f / sqrtf(row_sumsq(v[q], I.lane) * (1.0f / D) + EPS);
#pragma unroll
            for (int j = 0; j < 4; ++j) { const int k = 4 * I.lane + 256 * j; *(f32x4*)(out + (size_t)r * D + k) = v[q][j] * rstd * *(const f32x4*)(nw + k); } } }
    }
}
__device__ __forceinline__ void p6_norm2_router(const Frame& F_, int l, int nrows) {
    const Frame F = fresh_frame(F_); const Ids I = fresh_ids(F.wave_s);
    const int gw = F.vcu * NWAVES + I.wave, NGW = F.G * NWAVES;
    const float* H = (const float*)(F.ws + WS_H); bf16* HN = (bf16*)(F.ws + WS_HN); float* AFFT = (float*)(F.ws + WS_AFFT);
    const float* MOD = (const float*)(F.ws + WS_MOD); const float* nw = inp(F.lds, 7) + l * 1024; const float* rw = inp(F.lds, 23) + (size_t)l * 1024 * NE;
    LAS float* wt = (LAS float*)F.lds;
    for (int i = I.tid; i < 1024 * 4; i += 512) { const int k = i >> 2, q = i & 3; const f32x4 w = *(const f32x4*)(rw + k * 16 + 4 * q);
        wt[(4 * q + 0) * 1024 + k] = w.x; wt[(4 * q + 1) * 1024 + k] = w.y; wt[(4 * q + 2) * 1024 + k] = w.z; wt[(4 * q + 3) * 1024 + k] = w.w; }
    __syncthreads();
    const int lane = I.lane;
    const int myexp = ((lane >> 5) & 1) * 8 + ((lane >> 4) & 1) * 4 + ((lane >> 3) & 1) * 2 + ((lane >> 2) & 1);
    constexpr int RB = 2;
    for (int r0 = gw; r0 < nrows; r0 += NGW * RB) {
        f32x4 v[RB][4];
#pragma unroll
        for (int q = 0; q < RB; ++q) { const int r = r0 + q * NGW; if (r < nrows) load_row_f32(H + (size_t)r * D, lane, v[q]); }
#pragma unroll
        for (int q = 0; q < RB; ++q) { const int r = r0 + q * NGW; if (r < nrows) {
            const int s = row_sample(r);
            const float rstd = 1.0f / sqrtf(row_sumsq(v[q], I.lane) * (1.0f / D) + EPS);
            const float* m = MOD + ((size_t)l * 9 + s) * MODW;
#pragma unroll
            for (int j = 0; j < 4; ++j) { const int k = 4 * lane + 256 * j;
                const f32x4 w = *(const f32x4*)(nw + k), sh = *(const f32x4*)(m + 3072 + k), sc = *(const f32x4*)(m + 4096 + k);
                v[q][j] = (v[q][j] * rstd * w) * (sc + 1.0f) + sh;
                st_bf4(HN + (size_t)r * D + k, v[q][j]); }
            float p[NE];
#pragma unroll
            for (int e = 0; e < NE; ++e) { float a = 0.f;
#pragma unroll
                for (int j = 0; j < 4; ++j) { const f32x4 w = *(const LAS f32x4*)(wt + e * 1024 + 4 * lane + 256 * j); a += (v[q][j].x * w.x + v[q][j].y * w.y) + (v[q][j].z * w.z + v[q][j].w * w.w); }
                p[e] = a; }
            float a8[8], a4[4], a2[2], a1;
            { const bool hi = (lane & 32) != 0;
#pragma unroll
              for (int i = 0; i < 8; ++i) { const float send = hi ? p[i] : p[8 + i], keep = hi ? p[8 + i] : p[i]; a8[i] = keep + shx(send, 32, lane); } }
            { const bool hi = (lane & 16) != 0;
#pragma unroll
              for (int i = 0; i < 4; ++i) { const float send = hi ? a8[i] : a8[4 + i], keep = hi ? a8[4 + i] : a8[i]; a4[i] = keep + shx(send, 16, lane); } }
            { const bool hi = (lane & 8) != 0;
#pragma unroll
              for (int i = 0; i < 2; ++i) { const float send = hi ? a4[i] : a4[2 + i], keep = hi ? a4[2 + i] : a4[i]; a2[i] = keep + shx(send, 8, lane); } }
            { const bool hi = (lane & 4) != 0; const float send = hi ? a2[0] : a2[1], keep = hi ? a2[1] : a2[0]; a1 = keep + shx(send, 4, lane); }
            a1 += shx(a1, 2, lane); a1 += shx(a1, 1, lane);
            float mx = a1;
            mx = fmaxf(mx, shx(mx, 4, lane)); mx = fmaxf(mx, shx(mx, 8, lane)); mx = fmaxf(mx, shx(mx, 16, lane)); mx = fmaxf(mx, shx(mx, 32, lane));
            const float ex = expf(a1 - mx); float den = ex;
            den += shx(den, 4, lane); den += shx(den, 8, lane); den += shx(den, 16, lane); den += shx(den, 32, lane);
            if ((lane & 3) == 0) AFFT[(size_t)myexp * NROWS + r] = ex / den; } }
    }
    __syncthreads();
}
__device__ __forceinline__ int block_excl_scan(int v, LAS int* wsum, int lane, int wave, int& total) {
    int inc = v;
#pragma unroll
    for (int off = 1; off < 64; off <<= 1) { const int o = shidx_i(inc, (lane - off) & 63); if (lane >= off) inc += o; }
    if (lane == 63) wsum[wave] = inc;
    __syncthreads();
    int base = 0, tot = 0;
#pragma unroll
    for (int w = 0; w < 8; ++w) { const int s = wsum[w]; base += (w < wave) ? s : 0; tot += s; }
    __syncthreads();
    total = tot; return base + inc - v;
}
__device__ __forceinline__ void p7_topk(const Frame& F_, int l) {
    const Frame F = fresh_frame(F_); const Ids I = fresh_ids(F.wave_s);
    const float* AFFT = (const float*)(F.ws + WS_AFFT); int* SLOT = (int*)(F.ws + WS_SLOT);
    int* IDXG = (int*)(F.ws + WS_SLOT + 1179648);
    LAS unsigned* hist = (LAS unsigned*)F.lds;
    LAS unsigned* misc = hist + 256;
    LAS int* wsum = (LAS int*)(hist + 264);
    const int nitems = (l == 0 ? 16 : 8) * NE;
    for (int item = F.vcu; item < nitems; item += F.G) {
        const int set = item >> 4, e = item & 15;
        const int n = set < 8 ? SEQ : CTXL, cap = n >> 3;
        const int row0 = set < 8 ? set * SEQ : NLAT + (set - 8) * CTXL, slotbase = set < 8 ? set * 256 : 2048 + (set - 8) * 32;
        unsigned key[4]; const int i0 = 4 * I.tid; const bool valid = i0 < n;
        { f32x4 a = (f32x4){0.f, 0.f, 0.f, 0.f}; if (valid) a = *(const f32x4*)(AFFT + (size_t)e * NROWS + row0 + i0);
          key[0] = __float_as_uint(a.x); key[1] = __float_as_uint(a.y); key[2] = __float_as_uint(a.z); key[3] = __float_as_uint(a.w); }
        unsigned prefix = 0u, kk = (unsigned)cap;
        for (int pass = 3; pass >= 0; --pass) {
            const int shift = 8 * pass;
            if (I.tid < 256) hist[I.tid] = 0u;
            __syncthreads();
            if (valid) {
#pragma unroll
                for (int j = 0; j < 4; ++j) { const bool match = pass == 3 || ((key[j] >> (shift + 8)) == (prefix >> (shift + 8)));
                    if (match) atomicAdd((unsigned*)&hist[(key[j] >> shift) & 255u], 1u); }
            }
            __syncthreads();
            if (I.wave == 0) {
                const unsigned h0 = hist[4 * I.lane], h1 = hist[4 * I.lane + 1], h2 = hist[4 * I.lane + 2], h3 = hist[4 * I.lane + 3];
                const unsigned s = h0 + h1 + h2 + h3; unsigned t = s;
#pragma unroll
                for (int off = 1; off < 64; off <<= 1) { const unsigned o = (unsigned)shidx_i((int)t, (I.lane + off) & 63); if (I.lane + off < 64) t += o; }
                const unsigned above = t - s, c3 = above + h3, c2 = c3 + h2, c1 = c2 + h1, c0 = c1 + h0;
                int d = -1; unsigned nk = 0u;
                if (above < kk && c3 >= kk) { d = 3; nk = kk - above; }
                else if (c3 < kk && c2 >= kk) { d = 2; nk = kk - c3; }
                else if (c2 < kk && c1 >= kk) { d = 1; nk = kk - c2; }
                else if (c1 < kk && c0 >= kk) { d = 0; nk = kk - c1; }
                if (d >= 0) { misc[0] = prefix | ((unsigned)(4 * I.lane + d) << shift); misc[1] = nk; }
            }
            __syncthreads();
            prefix = misc[0]; kk = misc[1];
        }
        int ceq = 0; bool gt[4], eq[4];
#pragma unroll
        for (int j = 0; j < 4; ++j) { gt[j] = valid && key[j] > prefix; eq[j] = valid && key[j] == prefix; ceq += eq[j] ? 1 : 0; }
        int tot; int erank = block_excl_scan(ceq, wsum, I.lane, I.wave, tot);
        bool sel[4]; int csel = 0;
#pragma unroll
        for (int j = 0; j < 4; ++j) { sel[j] = gt[j] || (eq[j] && (unsigned)erank < kk); erank += eq[j] ? 1 : 0; csel += sel[j] ? 1 : 0; }
        int slot = block_excl_scan(csel, wsum, I.lane, I.wave, tot);
        if (valid) {
#pragma unroll
            for (int j = 0; j < 4; ++j) { const int r = row0 + i0 + j;
                if (sel[j]) { if (slot < cap) { IDXG[e * SLOTS + slotbase + slot] = r; SLOT[r * 16 + e] = e * SLOTS + slotbase + slot; } else SLOT[r * 16 + e] = -1; ++slot; }
                else SLOT[r * 16 + e] = -1; }
        }
        __syncthreads();
    }
}

typedef short bf16x8s __attribute__((ext_vector_type(8)));
typedef short s16x4 __attribute__((ext_vector_type(4)));
constexpr int IMGB = 9216;
constexpr int CS_SET = 4 * IMGB + 1024;
constexpr int CS_P = 2 * CS_SET, CS_ST = CS_P + IMGB, CS_NS = CS_ST + 2 * IMGB, CS_GS = CS_NS + 256, CS_GM = CS_GS + 2048, CS_END = CS_GM + 8192;
static_assert(CS_END <= RING_BYTES, "scan LDS map");
__device__ __forceinline__ bf16x8s rowfrag(const LAS unsigned char* img, int row0, int ks, int fr, int fq) { return *(const LAS bf16x8s*)(img + (row0 + fr) * 144 + ks * 64 + fq * 16); }
__device__ __forceinline__ s16x4 tr_rd(const LAS unsigned char* p) { return __builtin_bit_cast(s16x4, __builtin_amdgcn_ds_read_tr16_b64_v4i16((LAS s16x4*)(LAS unsigned char*)p)); }
__device__ __forceinline__ bf16x8s trfrag(const LAS unsigned char* img, int tok0, int col0, int lane) {
    const LAS unsigned char* a = img + (tok0 + 8 * (lane >> 4) + ((lane >> 2) & 3)) * 144 + (col0 + 4 * (lane & 3)) * 2;
    const s16x4 lo = tr_rd(a), hi = tr_rd(a + 4 * 144);
    return (bf16x8s){lo[0], lo[1], lo[2], lo[3], hi[0], hi[1], hi[2], hi[3]};
}
__device__ __forceinline__ f32x4 mfma16(bf16x8s a, bf16x8s b, f32x4 c) { return __builtin_amdgcn_mfma_f32_16x16x32_bf16(a, b, c, 0, 0, 0); }
struct f32x8 { f32x4 a, b; };
__device__ __forceinline__ f32x8 cvt8(v4u w) { f32x8 r; r.a = (f32x4){bf_lo(w.x), bf_hi(w.x), bf_lo(w.y), bf_hi(w.y)}; r.b = (f32x4){bf_lo(w.z), bf_hi(w.z), bf_lo(w.w), bf_hi(w.w)}; return r; }
__device__ __forceinline__ v4u pack8(f32x4 a, f32x4 b) { v4u w; w.x = pg8::cvt_pk_safe(a.x, a.y); w.y = pg8::cvt_pk_safe(a.z, a.w); w.z = pg8::cvt_pk_safe(b.x, b.y); w.w = pg8::cvt_pk_safe(b.z, b.w); return w; }
__device__ __forceinline__ float silu_q(float x) { return x * __builtin_amdgcn_rcpf(1.0f + __expf(-x)); }
__device__ __forceinline__ float sigmoid_q(float x) { return __builtin_amdgcn_rcpf(1.0f + __expf(-x)); }
__device__ __forceinline__ float log_sigmoid_q(float z) { return fminf(z, 0.f) - __logf(1.0f + __expf(-fabsf(z))); }
__device__ __forceinline__ float softplus_q(float x) { return fmaxf(x, 0.f) + __logf(1.0f + __expf(-fabsf(x))); }
template <int N> __device__ __forceinline__ float dpp_row_shr(float v) { return __int_as_float(__builtin_amdgcn_update_dpp(0, __float_as_int(v), 0x110 + N, 0xf, 0xf, true)); }
__device__ __forceinline__ float rdlane(float v, int l) { return __int_as_float(__builtin_amdgcn_readlane(__float_as_int(v), l)); }
__device__ __forceinline__ float wave_incl_scan(float v, int lane) {
    v += dpp_row_shr<1>(v); v += dpp_row_shr<2>(v); v += dpp_row_shr<4>(v); v += dpp_row_shr<8>(v);
    const float t0 = rdlane(v, 15), t1 = rdlane(v, 31), t2 = rdlane(v, 47); const int row = lane >> 4;
    return v + ((row >= 1 ? t0 : 0.f) + (row >= 2 ? t1 : 0.f) + (row >= 3 ? t2 : 0.f));
}
constexpr size_t WS_UC = 701 * MiB, WS_LA = 719 * MiB, WS_END3 = 737 * MiB;
__device__ __forceinline__ void p2t_pretransform(const Frame& F_, int l, bool inplace) {
    const Frame F = fresh_frame(F_); const Ids I = fresh_ids(F.wave_s);
    const int gw = F.vcu * NWAVES + I.wave, NGW = F.G * NWAVES, lane = I.lane;
    bf16* U = (bf16*)(F.ws + WS_U); bf16* UC = (bf16*)(F.ws + WS_UC); float* LA = (float*)(F.ws + WS_LA);
    f32x4 cwa[5], cwb[5], cba, cbb;
    { const float* cw = inp(F.lds, 15) + (size_t)l * 5 * 512 + 8 * lane; const float* cb = inp(F.lds, 16) + l * 512 + 8 * lane;
#pragma unroll
      for (int w = 0; w < 5; ++w) { cwa[w] = *(const f32x4*)(cw + w * 512); cwb[w] = *(const f32x4*)(cw + w * 512 + 4); }
      cba = *(const f32x4*)cb; cbb = *(const f32x4*)(cb + 4); }
    f32x4 gwv[16], gbv;
    { const float* gwp = inp(F.lds, 12) + (size_t)l * 4096 + (lane >> 5) * 2048 + ((4 * lane) & 127);
#pragma unroll
      for (int r = 0; r < 16; ++r) gwv[r] = *(const f32x4*)(gwp + r * 128);
      gbv = *(const f32x4*)(inp(F.lds, 13) + l * 256 + 4 * lane); }
    const int rc = (8 * lane) & 255, rd0 = rc & 63; const bool isq = lane < 32, first = (rd0 & 31) < 16; const int plane = first ? lane + 2 : lane - 2;
    float invf[8];
#pragma unroll
    for (int j = 0; j < 8; ++j) invf[j] = exp2f(-(float)((rd0 & 15) + j) * (13.287712379549449f / 16.0f)) * 0.15915494309189535f;
    constexpr int RB = 2;
    for (int r0 = gw; r0 < NROWS; r0 += NGW * RB) {
        v4u qk[RB], tap[RB][5], lr0[RB], lr1[RB], mk[RB];
#pragma unroll
        for (int q = 0; q < RB; ++q) { const int r = r0 + q * NGW; if (r < NROWS) {
            const bool isctx = r >= NLAT; const int t = isctx ? ((r - NLAT) & (CTXL - 1)) : (r & (SEQ - 1)), len = isctx ? CTXL : SEQ; const size_t rb = (size_t)(r - t);
            const bf16* ur = U + (size_t)r * INP;
            qk[q] = *(const v4u*)(ur + 8 * lane);
#pragma unroll
            for (int w = 0; w < 5; ++w) { const int tt = t + w - 2; const bool ok = tt >= 0 && tt < len; const v4u x = *(const v4u*)(U + (rb + (ok ? tt : t)) * INP + C_SSD + 256 + 8 * lane); tap[q][w] = ok ? x : (v4u){0u, 0u, 0u, 0u}; }
            lr0[q] = *(const v4u*)(ur + C_GLA + 768); lr1[q] = *(const v4u*)(ur + C_GLA + 776);
            mk[q] = (v4u){0u, 0u, 0u, 0u}; if (lane < 32) mk[q] = *(const v4u*)(ur + C_ML + 256 + 8 * lane); } }
#pragma unroll
        for (int q = 0; q < RB; ++q) { const int r = r0 + q * NGW; if (r < NROWS) {
            const bool isctx = r >= NLAT; const int t = isctx ? ((r - NLAT) & (CTXL - 1)) : (r & (SEQ - 1));
            bf16* ur = U + (size_t)r * INP;
            { f32x8 own = cvt8(qk[q]); v4u pq; pq.x = (unsigned)shidx_i((int)qk[q].x, plane); pq.y = (unsigned)shidx_i((int)qk[q].y, plane); pq.z = (unsigned)shidx_i((int)qk[q].z, plane); pq.w = (unsigned)shidx_i((int)qk[q].w, plane);
              const f32x8 par = cvt8(pq); const float sc = isq ? 0.125f : 1.0f;
              if (!isctx) { const float posv = (rd0 < 32) ? (float)(t >> 6) : (float)(t & 63);
#pragma unroll
                  for (int j = 0; j < 8; ++j) { const float rev = posv * invf[j]; const float cs = __builtin_amdgcn_cosf(rev), sn = __builtin_amdgcn_sinf(rev);
                      const float o = j < 4 ? own.a[j & 3] : own.b[j & 3], p = j < 4 ? par.a[j & 3] : par.b[j & 3]; const float n = (first ? o * cs - p * sn : p * sn + o * cs) * sc;
                      if (j < 4) own.a[j & 3] = n; else own.b[j & 3] = n; } }
              else { own.a = own.a * sc; own.b = own.b * sc; }
              const v4u ow = pack8(own.a, own.b); if (inplace) *(v4u*)(ur + 8 * lane) = ow; else asm volatile("" :: "v"(ow)); }
            { f32x4 a0 = cba, a1 = cbb;
#pragma unroll
              for (int w = 0; w < 5; ++w) { const f32x8 x = cvt8(tap[q][w]); a0 += x.a * cwa[w]; a1 += x.b * cwb[w]; }
#pragma unroll
              for (int j = 0; j < 4; ++j) { a0[j] = silu_q(a0[j]); a1[j] = silu_q(a1[j]); }
              *(v4u*)(UC + (size_t)r * 512 + 8 * lane) = pack8(a0, a1); }
            { const f32x8 l0 = cvt8(lr0[q]), l1 = cvt8(lr1[q]); f32x4 z = gbv;
#pragma unroll
              for (int qq = 0; qq < 4; ++qq) { z += gwv[qq] * l0.a[qq] + gwv[4 + qq] * l0.b[qq] + gwv[8 + qq] * l1.a[qq] + gwv[12 + qq] * l1.b[qq]; }
              f32x4 o;
#pragma unroll
              for (int j = 0; j < 4; ++j) o[j] = log_sigmoid_q(z[j]) * (1.0f / 16.0f);
              *(f32x4*)(LA + (size_t)r * 256 + 4 * lane) = o; }
            if (lane < 32) { f32x8 kk = cvt8(mk[q]); kk.a = kk.a * 0.125f; kk.b = kk.b * 0.125f; const v4u kw = pack8(kk.a, kk.b); if (inplace) *(v4u*)(ur + C_ML + 256 + 8 * lane) = kw; else asm volatile("" :: "v"(kw)); } } }
    }
}

constexpr size_t WS_NIN = WS_AFFT + 1179648;
constexpr int S1_SET = 2 * IMGB + 256, S1_GS = 2 * S1_SET, S1_GM = S1_GS + 2048, S1_END = S1_GM + 8192;
struct StRaw { v4u r[10]; float s0, s1; };
__device__ __forceinline__ int nat_chunk(int cc, int dir) { return cc < 4 ? (dir ? 3 - cc : cc) : (dir ? 35 - cc : cc - 4); }

template <int MIX>
__device__ __forceinline__ void state_item(const Frame& F, const Ids& I, int l, int b, int h, int dir, int item) {
    const bf16* U = (const bf16*)(F.ws + WS_U); bf16* SIN = (bf16*)(F.ws + WS_O2) + (size_t)item * 36 * 4096;
    float* NIN = (float*)(F.ws + WS_NIN) + (size_t)((b * 4 + h) * 2 + dir) * 36 * 64;
    LAS unsigned char* sm = F.lds;
    const int lane = I.lane, wave = I.wave, fr = lane & 15, fq = lane >> 4, rt = wave >> 1, cp = wave & 1;
    const int tk = I.tid >> 3, d0 = (I.tid & 7) * 8;
    float c_la = 0.f, c_b0 = 0.f, c_b1 = 0.f;
    if (MIX == 0) c_la = log_sigmoid_f(inp(F.lds, 10)[(l * 2 + dir) * 4 + h]);
    if (MIX == 2) { c_b0 = inp(F.lds, 17)[(l * 2 + dir) * 4 + h]; c_b1 = -expf(inp(F.lds, 18)[(l * 2 + dir) * 4 + h]); }
    if (MIX == 3) { c_b0 = inp(F.lds, 21)[((l * 2 + dir) * 2 + 0) * 4 + h]; c_b1 = inp(F.lds, 21)[((l * 2 + dir) * 2 + 1) * 4 + h]; }
    float invf[8];
#pragma unroll
    for (int j = 0; j < 8; ++j) invf[j] = MIX == 0 ? exp2f(-(float)((d0 & 15) + j) * (13.287712379549449f / 16.0f)) * 0.15915494309189535f : 0.f;
    float gwr[16]; float gbr = 0.f;
    if (MIX == 1) { const float* gw_ = inp(F.lds, 12) + (size_t)(l * 2 + dir) * 16 * 128 + h * 32 + (I.tid & 31);
#pragma unroll
        for (int r = 0; r < 16; ++r) gwr[r] = gw_[r * 128];
        gbr = inp(F.lds, 13)[(l * 2 + dir) * 128 + h * 32 + (I.tid & 31)]; }
    if (MIX == 2) {
        LAS float* cwl = (LAS float*)(sm + S1_GM); const float* cw = inp(F.lds, 15) + (size_t)l * 5 * 512; const float* cb = inp(F.lds, 16) + l * 512; const int g = h >> 1;
        for (int i = I.tid; i < 6 * 128; i += 512) { const int w = i >> 7, c = i & 127; const int ch = c < 64 ? h * 64 + c : 256 + g * 64 + (c - 64); cwl[i] = w < 5 ? cw[w * 512 + ch] : cb[ch]; }
    }
    f32x4 S[2], nst; S[0] = (f32x4){0.f, 0.f, 0.f, 0.f}; S[1] = S[0]; nst = S[0];
    __syncthreads();

    const bf16* UC = (const bf16*)(F.ws + WS_UC); const float* LA = (const float*)(F.ws + WS_LA);
    auto issue = [&](int cc, StRaw& R) {
        const bool isctx = cc < 4; const int rowbase = isctx ? NLAT + b * CTXL : b * SEQ, t0 = 64 * nat_chunk(cc, dir);
        const int t = t0 + tk; const bf16* ur = U + (size_t)(rowbase + t) * INP; const bf16* ul = U + (size_t)(rowbase + t0 + lane) * INP;
        if (MIX == 0) { R.r[0] = *(const v4u*)(ur + C_RET + 256 + h * 64 + d0); R.r[1] = *(const v4u*)(ur + C_RET + 512 + h * 64 + d0); }
        else if (MIX == 1) {
            R.r[1] = *(const v4u*)(ur + C_GLA + 256 + h * 64 + d0); R.r[0] = d0 < 32 ? *(const v4u*)(ur + C_GLA + 128 + h * 32 + d0) : (v4u){0u, 0u, 0u, 0u};
            const int tq = I.tid >> 5, d = I.tid & 31; v4u lf;
            lf.x = __float_as_uint(LA[(size_t)(rowbase + t0 + 4 * tq + 0) * 256 + dir * 128 + h * 32 + d]); lf.y = __float_as_uint(LA[(size_t)(rowbase + t0 + 4 * tq + 1) * 256 + dir * 128 + h * 32 + d]);
            lf.z = __float_as_uint(LA[(size_t)(rowbase + t0 + 4 * tq + 2) * 256 + dir * 128 + h * 32 + d]); lf.w = __float_as_uint(LA[(size_t)(rowbase + t0 + 4 * tq + 3) * 256 + dir * 128 + h * 32 + d]); R.r[2] = lf;
        } else if (MIX == 2) { const int g = h >> 1; const bf16* uc = UC + (size_t)(rowbase + t) * 512;
            R.r[0] = *(const v4u*)(uc + 256 + g * 64 + d0); R.r[1] = *(const v4u*)(uc + h * 64 + d0);
            R.s0 = bf_lo((unsigned)ul[C_SSD + 768 + dir * 4 + h]);
        } else {
            R.r[0] = *(const v4u*)(ur + C_ML + 256 + h * 64 + d0); R.r[1] = *(const v4u*)(ur + C_ML + 512 + h * 64 + d0);
            R.s0 = bf_lo((unsigned)ul[C_ML + 1024 + dir * 8 + h]); R.s1 = bf_lo((unsigned)ul[C_ML + 1024 + dir * 8 + 4 + h]);
        }
    };
    auto finish = [&](int cc, const StRaw& R) {
        LAS unsigned char* set = sm + (cc & 1) * S1_SET; LAS float* ELs = (LAS float*)(set + 2 * IMGB);
        f32x8 k, kp;
        if (MIX != 1) {
            float la, w = 1.f;
            if (MIX == 0) la = c_la;
            else if (MIX == 2) { w = softplus_q(R.s0 + c_b0); la = w * c_b1; }
            else { w = __expf(R.s0 + c_b0); la = log_sigmoid_q(R.s1 + c_b1); }
            const float G = wave_incl_scan(la, lane), T = rdlane(G, 63);
            if (wave == 0) ELs[lane] = __expf(T);
            const float e_l = (dir ? __expf(G - la) : __expf(T - G)) * w;
            const float ck = shidx(e_l, tk);
            k = cvt8(R.r[0]);
            kp.a = k.a * ck; kp.b = k.b * ck;
        } else {
            LAS float* GS = (LAS float*)(sm + S1_GS); LAS float* GM = (LAS float*)(sm + S1_GM);
            const int d = I.tid & 31, tq = I.tid >> 5; float c[4], la4[4]; float run = 0.f;
            la4[0] = __uint_as_float(R.r[2].x); la4[1] = __uint_as_float(R.r[2].y); la4[2] = __uint_as_float(R.r[2].z); la4[3] = __uint_as_float(R.r[2].w);
#pragma unroll
            for (int u = 0; u < 4; ++u) { run += la4[u]; c[u] = run; }
            GS[tq * 32 + d] = run;
            __syncthreads();
            float off = 0.f, tot = 0.f;
#pragma unroll
            for (int qq = 0; qq < 16; ++qq) { const float s = GS[qq * 32 + d]; off += (qq < tq) ? s : 0.f; tot += s; }
#pragma unroll
            for (int u = 0; u < 4; ++u) GM[(4 * tq + u) * 32 + d] = dir ? (off + c[u] - la4[u]) : (tot - (off + c[u]));
            if (tq == 0) { ELs[d] = __expf(tot); ELs[32 + d] = 1.0f; }
            __syncthreads();
            k = cvt8(R.r[0]);
            if (d0 < 32) { const f32x4 g0 = *(const LAS f32x4*)(GM + tk * 32 + d0), g1 = *(const LAS f32x4*)(GM + tk * 32 + d0 + 4);
#pragma unroll
                for (int j = 0; j < 4; ++j) { kp.a[j] = k.a[j] * __expf(g0[j]); kp.b[j] = k.b[j] * __expf(g1[j]); } }
            else kp = k;
        }
        const int ro = tk * 144 + d0 * 2;
        *(LAS v4u*)(set + ro) = pack8(kp.a, kp.b); *(LAS v4u*)(set + IMGB + ro) = R.r[1];
    };

    StRaw Ra, Rb; ConvRaw CR;
    issue(0, Ra); issue(1, Rb); finish(0, Ra);
    const bf16x8s ones = (bf16x8s){0x3F80, 0x3F80, 0x3F80, 0x3F80, 0x3F80, 0x3F80, 0x3F80, 0x3F80};
    auto chunk_body = [&](const int cc, const int cmode, StRaw& Rfar, const StRaw& Rnext) {
        __syncthreads();
        if (cc + 2 < 36) issue(cc + 2, Rfar);
        if (cmode == 1) conv_issue(F.lds, F.ws, l, (F.vcu * NWAVES + wave) * 18 + (cc >> 2), lane, CR);
        const LAS unsigned char* set = sm + (cc & 1) * S1_SET; const LAS unsigned char* KPs = set; const LAS unsigned char* Vs = set + IMGB; const LAS float* ELs = (const LAS float*)(set + 2 * IMGB);
#pragma unroll
        for (int u = 0; u < 2; ++u) { const int ct = 2 * cp + u; v2u sw; sw.x = pg8::cvt_pk_safe(S[u][0], S[u][1]); sw.y = pg8::cvt_pk_safe(S[u][2], S[u][3]);
            *(v2u*)(SIN + (size_t)cc * 4096 + (16 * ct + fr) * 64 + 16 * rt + 4 * fq) = sw; }
        if (MIX == 3) { if (fr == 0 && cp == 0) *(f32x4*)(NIN + cc * 64 + 16 * rt + 4 * fq) = nst; }
        const bf16x8s kf0 = trfrag(KPs, 0, 16 * rt, lane), kf1 = trfrag(KPs, 32, 16 * rt, lane);
        const f32x4 el = *(const LAS f32x4*)(ELs + 16 * rt + 4 * fq);
#pragma unroll
        for (int u = 0; u < 2; ++u) { const int ct = 2 * cp + u; const bf16x8s v0 = trfrag(Vs, 0, 16 * ct, lane), v1 = trfrag(Vs, 32, 16 * ct, lane);
            S[u] = S[u] * el; S[u] = mfma16(kf0, v0, S[u]); S[u] = mfma16(kf1, v1, S[u]); }
        if (MIX == 3) { nst = nst * el; nst = mfma16(kf0, ones, nst); nst = mfma16(kf1, ones, nst); }
        if (cc + 1 < 36) finish(cc + 1, Rnext);
        if (cmode == 2) conv_finish(CR);
    };
    for (int cc = 0; cc < 36; cc += 4) { chunk_body(cc, CONV_IN_SCAN ? 1 : 0, Ra, Rb); chunk_body(cc + 1, CONV_IN_SCAN ? 2 : 0, Rb, Ra); chunk_body(cc + 2, 0, Ra, Rb); chunk_body(cc + 3, 0, Rb, Ra); }
    __syncthreads();
}
__device__ __forceinline__ void p3a_state(const Frame& F_, int l) {
    const Frame F = fresh_frame(F_); const Ids I = fresh_ids(F.wave_s);
    for (int item = F.vcu; item < 256; item += F.G) {
        const int dir = item & 1, h = (item >> 1) & 3, mixer = (item >> 3) & 3, b = item >> 5;
        if (mixer == 0) state_item<0>(F, I, l, b, h, dir, item);
        else if (mixer == 1) state_item<1>(F, I, l, b, h, dir, item);
        else if (mixer == 2) state_item<2>(F, I, l, b, h, dir, item);
        else state_item<3>(F, I, l, b, h, dir, item);
    }
}

constexpr int S2_Q = 0, S2_K = IMGB, S2_V = 2 * IMGB, S2_P = 3 * IMGB, S2_P2 = 4 * IMGB, S2_STF = 5 * IMGB, S2_STB = 6 * IMGB, S2_ARR = 7 * IMGB, S2_NV = S2_ARR + 1024, S2_STAT = S2_NV + 256,
              S2_GS = S2_STAT + 1024, S2_GM = S2_GS + 4096, S2_END = S2_GM + 16384;
constexpr int S2_CST = S2_END, S2_CST_END = S2_CST + 5440 * 4;
static_assert(S2_CST_END <= RING_BYTES && S1_END <= RING_BYTES, "mixer LDS maps");
struct OutAcc { f32x4 y[2]; };
struct HRaw { v4u r[7]; v2u g[2]; float s[4]; };
struct HItem { int mix, b, h, nc, isctx, last; };

template <int MIX>
__device__ __forceinline__ void s2_issue(const Frame& F, const Ids&, int l, const HItem& it, HRaw& R) {
    const Ids I = fresh_ids(F.wave_s);
    const bf16* U = (const bf16*)(F.ws + WS_U); const bf16* SINB = (const bf16*)(F.ws + WS_O2); const float* NINB = (const float*)(F.ws + WS_NIN);
    const int lane = I.lane, wave = I.wave, fr = lane & 15, fq = lane >> 4, rt = wave >> 1, cp = wave & 1, tk = I.tid >> 3, d0 = (I.tid & 7) * 8;
    const int b = it.b, h = it.h, nc = it.nc; const bool isctx = it.isctx;
    const int len = isctx ? CTXL : SEQ, rowbase = isctx ? NLAT + b * CTXL : b * SEQ, t0 = 64 * nc, t = t0 + tk;
    const int item_f = b * 32 + MIX * 8 + h * 2, cc_f = isctx ? nc : 4 + nc, cc_b = isctx ? 3 - nc : 35 - nc;
    const bf16* ur = U + (size_t)(rowbase + t) * INP; const bf16* ul = U + (size_t)(rowbase + t0 + lane) * INP;
    const int row = I.tid >> 3, pc = I.tid & 7;
    const int orow = rowbase + t0 + 16 * rt + fr;
    if (MIX == 0) {
        R.r[0] = *(const v4u*)(ur + C_RET + h * 64 + d0); R.r[1] = *(const v4u*)(ur + C_RET + 256 + h * 64 + d0); R.r[2] = *(const v4u*)(ur + C_RET + 512 + h * 64 + d0);
        R.r[5] = *(const v4u*)(SINB + ((size_t)item_f * 36 + cc_f) * 4096 + row * 64 + 8 * pc); R.r[6] = *(const v4u*)(SINB + ((size_t)(item_f + 1) * 36 + cc_b) * 4096 + row * 64 + 8 * pc);
#pragma unroll
        for (int u = 0; u < 2; ++u) R.g[u] = *(const v2u*)(U + (size_t)orow * INP + C_RET + 768 + h * 64 + 16 * (2 * cp + u) + 4 * fq);
    } else if (MIX == 1) {
        R.r[2] = *(const v4u*)(ur + C_GLA + 256 + h * 64 + d0);
        if (d0 < 32) { R.r[0] = *(const v4u*)(ur + C_GLA + h * 32 + d0); R.r[1] = *(const v4u*)(ur + C_GLA + 128 + h * 32 + d0); } else { R.r[0] = (v4u){0u, 0u, 0u, 0u}; R.r[1] = R.r[0]; }
        R.r[3] = *(const v4u*)(SINB + ((size_t)(item_f + (pc >> 2)) * 36 + (pc < 4 ? cc_f : cc_b)) * 4096 + row * 64 + 8 * (pc & 3));
        { const int tq = I.tid >> 5, d = I.tid & 31; const float* la = (const float*)(F.ws + WS_LA) + (size_t)(rowbase + t0 + 4 * tq) * 256 + h * 32 + d; v4u lf, lb;
          lf.x = __float_as_uint(la[0]); lf.y = __float_as_uint(la[256]); lf.z = __float_as_uint(la[512]); lf.w = __float_as_uint(la[768]);
          lb.x = __float_as_uint(la[128]); lb.y = __float_as_uint(la[128 + 256]); lb.z = __float_as_uint(la[128 + 512]); lb.w = __float_as_uint(la[128 + 768]); R.r[4] = lf; R.r[5] = lb; }
#pragma unroll
        for (int u = 0; u < 2; ++u) R.g[u] = *(const v2u*)(U + (size_t)orow * INP + C_GLA + 512 + h * 64 + 16 * (2 * cp + u) + 4 * fq);
    } else if (MIX == 2) { const int g = h >> 1; const bf16* uc = (const bf16*)(F.ws + WS_UC) + (size_t)(rowbase + t) * 512;
        R.r[0] = *(const v4u*)(uc + h * 64 + d0); R.r[1] = *(const v4u*)(uc + 256 + g * 64 + d0); R.r[2] = *(const v4u*)(uc + 384 + g * 64 + d0);
        R.r[5] = *(const v4u*)(SINB + ((size_t)item_f * 36 + cc_f) * 4096 + row * 64 + 8 * pc); R.r[6] = *(const v4u*)(SINB + ((size_t)(item_f + 1) * 36 + cc_b) * 4096 + row * 64 + 8 * pc);
        R.s[0] = bf_lo((unsigned)ul[C_SSD + 768 + h]); R.s[1] = bf_lo((unsigned)ul[C_SSD + 768 + 4 + h]);
#pragma unroll
        for (int u = 0; u < 2; ++u) R.g[u] = *(const v2u*)(U + (size_t)orow * INP + C_SSD + h * 64 + 16 * (2 * cp + u) + 4 * fq);
    } else {
        R.r[0] = *(const v4u*)(ur + C_ML + h * 64 + d0); R.r[1] = *(const v4u*)(ur + C_ML + 256 + h * 64 + d0); R.r[2] = *(const v4u*)(ur + C_ML + 512 + h * 64 + d0);
        R.r[3] = *(const v4u*)(SINB + ((size_t)item_f * 36 + cc_f) * 4096 + row * 64 + 8 * pc); R.r[4] = *(const v4u*)(SINB + ((size_t)(item_f + 1) * 36 + cc_b) * 4096 + row * 64 + 8 * pc);
        if (I.tid < 32) R.r[5] = *(const v4u*)(NINB + ((size_t)((b * 4 + h) * 2 + (I.tid >> 4)) * 36 + ((I.tid >> 4) ? cc_b : cc_f)) * 64 + 4 * (I.tid & 15));
        R.s[0] = bf_lo((unsigned)ul[C_ML + 1024 + h]); R.s[1] = bf_lo((unsigned)ul[C_ML + 1024 + 4 + h]); R.s[2] = bf_lo((unsigned)ul[C_ML + 1024 + 8 + h]); R.s[3] = bf_lo((unsigned)ul[C_ML + 1024 + 12 + h]);
#pragma unroll
        for (int u = 0; u < 2; ++u) R.g[u] = *(const v2u*)(U + (size_t)orow * INP + C_ML + 768 + h * 64 + 16 * (2 * cp + u) + 4 * fq);
    }
}
template <int MIX>
__device__ __forceinline__ void s2_transform(const Frame& F, const Ids&, int l, const HItem& it, const HRaw& R) {
    const Ids I = fresh_ids(F.wave_s);
    LAS unsigned char* sm = F.lds;
    const int lane = I.lane, wave = I.wave, tk = I.tid >> 3, d0 = (I.tid & 7) * 8; const int h = it.h; const bool isctx = it.isctx; const int t = 64 * it.nc + tk;
    LAS float* GF = (LAS float*)(sm + S2_ARR); LAS float* HB = GF + 64; LAS float* WF = GF + 128; LAS float* WB = GF + 192;
    const int row = I.tid >> 3, pc = I.tid & 7;
    f32x8 q, k, v;
    if (MIX != 1) {
        const v4u sf = (MIX == 0 || MIX == 2) ? R.r[5] : R.r[3], sb = (MIX == 0 || MIX == 2) ? R.r[6] : R.r[4];
        *(LAS v4u*)(sm + S2_STF + row * 144 + pc * 16) = sf; *(LAS v4u*)(sm + S2_STB + row * 144 + pc * 16) = sb;
        if (MIX == 3 && I.tid < 32) { const f32x4 nv = __builtin_bit_cast(f32x4, R.r[5]); v2u w; w.x = pg8::cvt_pk_safe(nv[0], nv[1]); w.y = pg8::cvt_pk_safe(nv[2], nv[3]); *(LAS v2u*)(sm + S2_NV + (I.tid >> 4) * 128 + 8 * (I.tid & 15)) = w; }
        float laf, lab, wf = 1.f, wb = 1.f;
        const LAS float* cst = (const LAS float*)(sm + S2_CST);
        if (MIX == 0) { laf = cst[h]; lab = cst[4 + h]; }
        else if (MIX == 2) { wf = softplus_q(R.s[0] + cst[8 + h]); wb = softplus_q(R.s[1] + cst[12 + h]); laf = wf * cst[16 + h]; lab = wb * cst[20 + h]; }
        else { const LAS float* gb = cst + 32; wf = __expf(R.s[0] + gb[h]); laf = log_sigmoid_q(R.s[1] + gb[4 + h]); wb = __expf(R.s[2] + gb[8 + h]); lab = log_sigmoid_q(R.s[3] + gb[12 + h]); }
        const float Gf = wave_incl_scan(laf, lane), Gb = wave_incl_scan(lab, lane), Tb = rdlane(Gb, 63);
        if (wave == 0) { GF[lane] = Gf; HB[lane] = Tb - Gb + lab; WF[lane] = wf; WB[lane] = wb; }
        const int ro = tk * 144 + d0 * 2;
        *(LAS v4u*)(sm + S2_Q + ro) = MIX == 2 ? R.r[2] : R.r[0]; *(LAS v4u*)(sm + S2_K + ro) = R.r[1]; *(LAS v4u*)(sm + S2_V + ro) = MIX == 2 ? R.r[0] : R.r[2];
    } else {
        *(LAS v4u*)(sm + S2_STF + row * 144 + pc * 16) = R.r[3];
        LAS float* GS = (LAS float*)(sm + S2_GS); LAS float* GM = (LAS float*)(sm + S2_GM);
        const int d = I.tid & 31, tq = I.tid >> 5; float cfw[4], cbw[4], lbw[4]; float runf = 0.f, runb = 0.f;
        const float lfw[4] = {__uint_as_float(R.r[4].x), __uint_as_float(R.r[4].y), __uint_as_float(R.r[4].z), __uint_as_float(R.r[4].w)};
        lbw[0] = __uint_as_float(R.r[5].x); lbw[1] = __uint_as_float(R.r[5].y); lbw[2] = __uint_as_float(R.r[5].z); lbw[3] = __uint_as_float(R.r[5].w);
#pragma unroll
        for (int u = 0; u < 4; ++u) { runf += lfw[u]; cfw[u] = runf; runb += lbw[u]; cbw[u] = runb; }
        GS[tq * 32 + d] = runf; GS[512 + tq * 32 + d] = runb;
        __syncthreads();
        float offf = 0.f, offb = 0.f, totb = 0.f;
#pragma unroll
        for (int qq = 0; qq < 16; ++qq) { const float sf = GS[qq * 32 + d], sb = GS[512 + qq * 32 + d]; offf += (qq < tq) ? sf : 0.f; offb += (qq < tq) ? sb : 0.f; totb += sb; }
#pragma unroll
        for (int u = 0; u < 4; ++u) { GM[(4 * tq + u) * 32 + d] = offf + cfw[u]; GM[2048 + (4 * tq + u) * 32 + d] = totb - (offb + cbw[u]) + lbw[u]; }
        if (I.tid < 64) { GF[I.tid] = 0.f; HB[I.tid] = 0.f; WF[I.tid] = 1.f; WB[I.tid] = 1.f; }
        __syncthreads();
        *(LAS v4u*)(sm + S2_V + tk * 144 + d0 * 2) = R.r[2];
        if (d0 < 32) { q = cvt8(R.r[0]); k = cvt8(R.r[1]);
            const f32x4 gf0 = *(const LAS f32x4*)(GM + tk * 32 + d0), gf1 = *(const LAS f32x4*)(GM + tk * 32 + d0 + 4), gb0 = *(const LAS f32x4*)(GM + 2048 + tk * 32 + d0), gb1 = *(const LAS f32x4*)(GM + 2048 + tk * 32 + d0 + 4);
            f32x8 qf, kf, qb, kb;
#pragma unroll
            for (int j = 0; j < 4; ++j) { qf.a[j] = q.a[j] * 0.17677669529663687f * __expf(gf0[j]); qf.b[j] = q.b[j] * 0.17677669529663687f * __expf(gf1[j]); kf.a[j] = k.a[j] * __expf(-gf0[j]); kf.b[j] = k.b[j] * __expf(-gf1[j]);
                qb.a[j] = q.a[j] * 0.17677669529663687f * __expf(gb0[j]); qb.b[j] = q.b[j] * 0.17677669529663687f * __expf(gb1[j]); kb.a[j] = k.a[j] * __expf(-gb0[j]); kb.b[j] = k.b[j] * __expf(-gb1[j]); }
            const int ro = tk * 144 + d0 * 2;
            *(LAS v4u*)(sm + S2_Q + ro) = pack8(qf.a, qf.b); *(LAS v4u*)(sm + S2_Q + ro + 64) = pack8(qb.a, qb.b); *(LAS v4u*)(sm + S2_K + ro) = pack8(kf.a, kf.b); *(LAS v4u*)(sm + S2_K + ro + 64) = pack8(kb.a, kb.b); }
    }
}
template <int MIX>
__device__ __forceinline__ OutAcc s2_compute(const Frame& F, const Ids&, int l, const HItem& it, const v2u (&zg)[2]) {
    const Ids I = fresh_ids(F.wave_s);
    LAS unsigned char* sm = F.lds;
    const int lane = I.lane, wave = I.wave, fr = lane & 15, fq = lane >> 4, rt = wave >> 1, cp = wave & 1; const int h = it.h;
    const LAS float* GF = (const LAS float*)(sm + S2_ARR); const LAS float* HB = GF + 64; const LAS float* WF = GF + 128; const LAS float* WB = GF + 192;
    const int irow = 16 * rt + fr;
    const float gfi = GF[irow], hbi = HB[irow];
    const bf16x8s qf0 = rowfrag(sm + S2_Q, 16 * rt, 0, fr, fq), qf1 = rowfrag(sm + S2_Q, 16 * rt, 1, fr, fq);
#pragma unroll
    for (int u = 0; u < 2; ++u) { const int jt = 2 * cp + u;
        f32x4 sc = (f32x4){0.f, 0.f, 0.f, 0.f}, sc2 = sc;
        sc = mfma16(rowfrag(sm + S2_K, 16 * jt, 0, fr, fq), qf0, sc);
        if (MIX == 1) sc2 = mfma16(rowfrag(sm + S2_K, 16 * jt, 1, fr, fq), qf1, sc2); else sc = mfma16(rowfrag(sm + S2_K, 16 * jt, 1, fr, fq), qf1, sc);
        const f32x4 gj = *(const LAS f32x4*)(GF + 16 * jt + 4 * fq), hj = *(const LAS f32x4*)(HB + 16 * jt + 4 * fq), wfj = *(const LAS f32x4*)(WF + 16 * jt + 4 * fq), wbj = *(const LAS f32x4*)(WB + 16 * jt + 4 * fq);
        float pa[4], pb[4];
#pragma unroll
        for (int r = 0; r < 4; ++r) { const int j = 16 * jt + 4 * fq + r;
            const float ef = (j <= irow) ? __expf(fminf(gfi - gj[r], 0.f)) * wfj[r] : 0.f, eb = (j >= irow) ? __expf(fminf(hbi - hj[r], 0.f)) * wbj[r] : 0.f;
            if (MIX == 1) { pa[r] = sc[r] * ef + sc2[r] * eb; pb[r] = 0.f; } else if (MIX == 3) { pa[r] = sc[r] * ef; pb[r] = sc[r] * eb; } else { pa[r] = sc[r] * (ef + eb); pb[r] = 0.f; } }
        v2u pw; pw.x = pg8::cvt_pk_safe(pa[0], pa[1]); pw.y = pg8::cvt_pk_safe(pa[2], pa[3]); *(LAS v2u*)(sm + S2_P + irow * 144 + (16 * jt + 4 * fq) * 2) = pw;
        if (MIX == 3) { v2u pw2; pw2.x = pg8::cvt_pk_safe(pb[0], pb[1]); pw2.y = pg8::cvt_pk_safe(pb[2], pb[3]); *(LAS v2u*)(sm + S2_P2 + irow * 144 + (16 * jt + 4 * fq) * 2) = pw2; } }
    f32x4 o2f[2], o2b[2], e2f = (f32x4){0.f, 0.f, 0.f, 0.f}, e2b = e2f;
#pragma unroll
    for (int u = 0; u < 2; ++u) { const int ct = 2 * cp + u; o2f[u] = (f32x4){0.f, 0.f, 0.f, 0.f}; o2b[u] = o2f[u];
        o2f[u] = mfma16(rowfrag(sm + S2_STF, 16 * ct, 0, fr, fq), qf0, o2f[u]); o2f[u] = mfma16(rowfrag(sm + S2_STF, 16 * ct, 1, fr, fq), qf1, o2f[u]);
        if (MIX != 1) { o2b[u] = mfma16(rowfrag(sm + S2_STB, 16 * ct, 0, fr, fq), qf0, o2b[u]); o2b[u] = mfma16(rowfrag(sm + S2_STB, 16 * ct, 1, fr, fq), qf1, o2b[u]); } }
    if (MIX == 3) { const LAS unsigned char* nv = sm + S2_NV;
        e2f = mfma16(*(const LAS bf16x8s*)(nv + fq * 16), qf0, e2f); e2f = mfma16(*(const LAS bf16x8s*)(nv + 64 + fq * 16), qf1, e2f);
        e2b = mfma16(*(const LAS bf16x8s*)(nv + 128 + fq * 16), qf0, e2b); e2b = mfma16(*(const LAS bf16x8s*)(nv + 192 + fq * 16), qf1, e2b); }
    bf16x8s vf[2][2];
#pragma unroll
    for (int u = 0; u < 2; ++u) { vf[u][0] = trfrag(sm + S2_V, 0, 16 * (2 * cp + u), lane); vf[u][1] = trfrag(sm + S2_V, 32, 16 * (2 * cp + u), lane); }
    __syncthreads();
    const bf16x8s pf0 = rowfrag(sm + S2_P, 16 * rt, 0, fr, fq), pf1 = rowfrag(sm + S2_P, 16 * rt, 1, fr, fq);
    const float egf = __expf(gfi), egb = __expf(hbi);
    const bf16x8s ones = (bf16x8s){0x3F80, 0x3F80, 0x3F80, 0x3F80, 0x3F80, 0x3F80, 0x3F80, 0x3F80};
    OutAcc A;
    if (MIX == 3) {
        const bf16x8s pb0 = rowfrag(sm + S2_P2, 16 * rt, 0, fr, fq), pb1 = rowfrag(sm + S2_P2, 16 * rt, 1, fr, fq);
        f32x4 e1f = (f32x4){0.f, 0.f, 0.f, 0.f}, e1b = e1f; e1f = mfma16(ones, pf0, e1f); e1f = mfma16(ones, pf1, e1f); e1b = mfma16(ones, pb0, e1b); e1b = mfma16(ones, pb1, e1b);
        const float sf = 1.0f / fmaxf(fabsf(e1f[0] + egf * e2f[0]), 1.0f), sb = 1.0f / fmaxf(fabsf(e1b[0] + egb * e2b[0]), 1.0f);
#pragma unroll
        for (int u = 0; u < 2; ++u) { f32x4 of = (f32x4){0.f, 0.f, 0.f, 0.f}, ob = of; of = mfma16(vf[u][0], pf0, of); of = mfma16(vf[u][1], pf1, of); ob = mfma16(vf[u][0], pb0, ob); ob = mfma16(vf[u][1], pb1, ob);
            A.y[u] = (of + o2f[u] * egf) * sf + (ob + o2b[u] * egb) * sb; }
    } else {
#pragma unroll
        for (int u = 0; u < 2; ++u) { f32x4 o1 = (f32x4){0.f, 0.f, 0.f, 0.f}; o1 = mfma16(vf[u][0], pf0, o1); o1 = mfma16(vf[u][1], pf1, o1);
            A.y[u] = MIX == 1 ? (o1 + o2f[u]) : (o1 + o2f[u] * egf + o2b[u] * egb); }
    }
    if (MIX == 2) { const float dsk = ((const LAS float*)(sm + S2_CST))[24 + h];
#pragma unroll
        for (int u = 0; u < 2; ++u) { const int c0 = 16 * (2 * cp + u) + 4 * fq; const v2u xw = *(const LAS v2u*)(sm + S2_V + irow * 144 + c0 * 2);
            const f32x4 xs = (f32x4){bf_lo(xw.x), bf_hi(xw.x), bf_lo(xw.y), bf_hi(xw.y)}, z = (f32x4){bf_lo(zg[u].x), bf_hi(zg[u].x), bf_lo(zg[u].y), bf_hi(zg[u].y)};
#pragma unroll
            for (int r = 0; r < 4; ++r) A.y[u][r] = (A.y[u][r] + dsk * xs[r]) * silu_q(z[r]); }
    }
    return A;
}
__device__ __forceinline__ void token_stats(LAS unsigned char* sm, int rt, int cp, int fr, int fq, int lane, float& s1, float& s2) {
    s1 += shx(s1, 16, lane); s1 += shx(s1, 32, lane); s2 += shx(s2, 16, lane); s2 += shx(s2, 32, lane);
    LAS float* ST = (LAS float*)(sm + S2_STAT);
    if (fq == 0) { ST[((16 * rt + fr) * 2 + cp) * 2] = s1; ST[((16 * rt + fr) * 2 + cp) * 2 + 1] = s2; }
    __syncthreads();
    const f32x4 a = *(const LAS f32x4*)(ST + (16 * rt + fr) * 4); s1 = a[0] + a[2]; s2 = a[1] + a[3];
}
__device__ __forceinline__ HItem s2_item(int j, int blk, int G, int NCH, bool ctx_out, int nsu, int u0) {
    HItem it; int c;
    if (j < 4 * nsu) { const int u = blk + (j >> 2) * G; it.mix = 2; it.b = u / NCH; c = u % NCH; it.h = j & 3; it.last = (j & 3) == 3; }
    else { const int u = u0 + (j - 4 * nsu), mh = u % 12, bc = u / 12; it.b = bc / NCH; c = bc % NCH; const int m3 = mh >> 2; it.mix = m3 == 0 ? 0 : (m3 == 1 ? 1 : 3); it.h = mh & 3; it.last = true; }
    it.isctx = ctx_out && c < 4; it.nc = ctx_out ? (it.isctx ? c : c - 4) : c; return it;
}
__device__ __forceinline__ void p3b_output(const Frame& F_, int l, bool ctx_out) {
    const Frame F = fresh_frame(F_); const Ids I = fresh_ids(F.wave_s);
    bf16* Y = (bf16*)(F.ws + WS_Y);
    const int lane = I.lane, wave = I.wave, fr = lane & 15, fq = lane >> 4, rt = wave >> 1, cp = wave & 1;
    const int NCH = ctx_out ? 36 : 32, nssd = 8 * NCH, blk = F.vcu, G = F.G;
    const int extra = nssd - G, nsu = 1 + (blk < extra ? 1 : 0);
    const int per_lo = (16 * NCH * 8) / G - 8, per_hi = per_lo + 4;
    const int u0 = blk < extra ? blk * per_lo : extra * per_lo + (blk - extra) * per_hi, cnt = blk < extra ? per_lo : per_hi, nitems = 4 * nsu + cnt;
    {
        LAS float* cwl = (LAS float*)(F.lds + S2_GM); const float* cw = inp(F.lds, 15) + (size_t)l * 5 * 512; const float* cb = inp(F.lds, 16) + l * 512;
        for (int i = I.tid; i < 6 * 512; i += 512) cwl[i] = i < 2560 ? cw[i] : cb[i - 2560];
        LAS float* cst = (LAS float*)(F.lds + S2_CST);
        if (I.tid < 8) { cst[I.tid] = log_sigmoid_f(inp(F.lds, 10)[l * 8 + I.tid]); cst[8 + I.tid] = inp(F.lds, 17)[l * 8 + I.tid]; cst[16 + I.tid] = -expf(inp(F.lds, 18)[l * 8 + I.tid]); }
        if (I.tid < 4) cst[24 + I.tid] = inp(F.lds, 19)[l * 4 + I.tid];
        if (I.tid < 16) cst[32 + I.tid] = inp(F.lds, 21)[l * 16 + I.tid];
        if (I.tid < 256) { cst[64 + I.tid] = inp(F.lds, 11)[l * 256 + I.tid]; cst[320 + I.tid] = inp(F.lds, 14)[l * 256 + I.tid]; cst[576 + I.tid] = inp(F.lds, 20)[l * 256 + I.tid]; cst[832 + I.tid] = inp(F.lds, 22)[l * 256 + I.tid];
            cst[5184 + I.tid] = inp(F.lds, 13)[l * 256 + I.tid]; }
        for (int i = I.tid; i < 4096; i += 512) cst[1088 + i] = inp(F.lds, 12)[(size_t)l * 4096 + i];
    }
    __syncthreads();
    HRaw Ra;
    { const HItem i0 = s2_item(0, blk, G, NCH, ctx_out, nsu, u0); s2_issue<2>(F, I, l, i0, Ra); }
    unsigned ssdy[3][2][2] = {}; float ssd_s2 = 0.f;
    ConvRaw CR;
    auto item_body = [&](const int j, HRaw& R, const int cmode) {
        const HItem cur = s2_item(j, blk, G, NCH, ctx_out, nsu, u0);
        if (cur.mix == 0) s2_transform<0>(F, I, l, cur, R); else if (cur.mix == 1) s2_transform<1>(F, I, l, cur, R); else if (cur.mix == 2) s2_transform<2>(F, I, l, cur, R); else s2_transform<3>(F, I, l, cur, R);
        const v2u zg[2] = {R.g[0], R.g[1]};
        __syncthreads();
        if (j + 1 < nitems) { const HItem nxt = s2_item(j + 1, blk, G, NCH, ctx_out, nsu, u0);
            if (nxt.mix == 0) s2_issue<0>(F, I, l, nxt, R); else if (nxt.mix == 1) s2_issue<1>(F, I, l, nxt, R); else if (nxt.mix == 2) s2_issue<2>(F, I, l, nxt, R); else s2_issue<3>(F, I, l, nxt, R); }
        if (cmode == 1) conv_issue(F.lds, F.ws, l, (F.vcu * NWAVES + wave) * 18 + 9 + (j >> 1), lane, CR);
        OutAcc A;
        if (cur.mix == 0) A = s2_compute<0>(F, I, l, cur, zg); else if (cur.mix == 1) A = s2_compute<1>(F, I, l, cur, zg); else if (cur.mix == 2) A = s2_compute<2>(F, I, l, cur, zg); else A = s2_compute<3>(F, I, l, cur, zg);
        const int row = (cur.isctx ? NLAT + cur.b * CTXL : cur.b * SEQ) + 64 * cur.nc + 16 * rt + fr;
        if (cur.mix == 2) {
#pragma unroll
            for (int u = 0; u < 2; ++u)
#pragma unroll
                for (int r = 0; r < 4; ++r) ssd_s2 += A.y[u][r] * A.y[u][r];
            if (!cur.last) {
#pragma unroll
                for (int hh = 0; hh < 3; ++hh) {
#pragma unroll
                    for (int u = 0; u < 2; ++u) { const unsigned p0 = pg8::cvt_pk_safe(A.y[u][0], A.y[u][1]), p1 = pg8::cvt_pk_safe(A.y[u][2], A.y[u][3]);
                        ssdy[hh][u][0] = cur.h == hh ? p0 : ssdy[hh][u][0]; ssdy[hh][u][1] = cur.h == hh ? p1 : ssdy[hh][u][1]; } }
                __syncthreads();
            } else {
                float s1 = 0.f, s2 = ssd_s2; token_stats(F.lds, rt, cp, fr, fq, lane, s1, s2); ssd_s2 = 0.f;
                const float rs = 1.0f / sqrtf(s2 * (1.0f / 256.0f) + EPS); const LAS float* nw = (const LAS float*)(F.lds + S2_CST) + 576;
#pragma unroll
                for (int hh = 0; hh < 4; ++hh)
#pragma unroll
                    for (int u = 0; u < 2; ++u) { const int c0 = hh * 64 + 16 * (2 * cp + u) + 4 * fq;
                        const f32x4 yv = hh < 3 ? (f32x4){bf_lo(ssdy[hh < 3 ? hh : 0][u][0]), bf_hi(ssdy[hh < 3 ? hh : 0][u][0]), bf_lo(ssdy[hh < 3 ? hh : 0][u][1]), bf_hi(ssdy[hh < 3 ? hh : 0][u][1])} : A.y[u];
                        st_bf4(Y + (size_t)row * D + 512 + c0, yv * rs * *(const LAS f32x4*)(nw + c0)); }
                __syncthreads();
            }
        } else {
            float s1 = 0.f, s2 = 0.f;
#pragma unroll
            for (int u = 0; u < 2; ++u)
#pragma unroll
                for (int r = 0; r < 4; ++r) { s1 += A.y[u][r]; s2 += A.y[u][r] * A.y[u][r]; }
            token_stats(F.lds, rt, cp, fr, fq, lane, s1, s2);
            const float mean = cur.mix == 0 ? s1 * (1.0f / 64.0f) : 0.f;
            const float rs = 1.0f / sqrtf(fmaxf(s2 * (1.0f / 64.0f) - mean * mean, 0.f) + EPS);
            const LAS float* nw = (const LAS float*)(F.lds + S2_CST) + 64 + (cur.mix == 0 ? 0 : cur.mix == 1 ? 256 : 768) + cur.h * 64;
#pragma unroll
            for (int u = 0; u < 2; ++u) { const int c0 = 16 * (2 * cp + u) + 4 * fq; const f32x4 w = *(const LAS f32x4*)(nw + c0); f32x4 y;
                const f32x4 g = (f32x4){bf_lo(zg[u].x), bf_hi(zg[u].x), bf_lo(zg[u].y), bf_hi(zg[u].y)};
#pragma unroll
                for (int r = 0; r < 4; ++r) y[r] = (A.y[u][r] - mean) * rs * w[r] * (cur.mix == 3 ? sigmoid_q(g[r]) : silu_q(g[r]));
                st_bf4(Y + (size_t)row * D + cur.mix * 256 + cur.h * 64 + c0, y); }
            __syncthreads();
        }
        if (cmode == 2) conv_finish(CR);
    };
    for (int j = 0; j < nitems; j += 2) { item_body(j, Ra, CONV_IN_SCAN ? 1 : 0); item_body(j + 1, Ra, CONV_IN_SCAN ? 2 : 0); }
}

struct Args { const float* in[28]; float* out; unsigned char* ws; int ph_lo, ph_hi, use_bar, never; };
__global__ void __launch_bounds__(NWAVES * 64, 2) fwd_kernel(Args args) {
    extern __shared__ __attribute__((aligned(16))) unsigned char lds[];
    Frame F;
    F.lds = (LAS unsigned char*)lds;
        F.wave_s = __builtin_amdgcn_readfirstlane((int)threadIdx.x >> 6);
    F.G = gridDim.x; { const int bx = blockIdx.x; F.vcu = (F.G % 8 == 0) ? (bx % 8) * (F.G / 8) + bx / 8 : bx; }
    F.ws = args.ws;
    if (args.never) cooperative_groups::this_grid().sync();
    for (int u = F.wave_s * 64 + lane_id(); u < (LDS_BYTES - LDSCTL_OFF) / 4; u += NWAVES * 64) ((LAS unsigned*)(F.lds + LDSCTL_OFF))[u] = 0u;
    __syncthreads();
    if (F.wave_s == 0 && lane_id() == 0) { LAS unsigned long long* tab = (LAS unsigned long long*)(F.lds + LDSCTL_OFF);
#pragma unroll
        for (int i = 0; i < 28; ++i) tab[i] = (unsigned long long)args.in[i];
        tab[28] = (unsigned long long)args.out; }
    __syncthreads();
    XcdBarrier bar; bar.bar = (unsigned*)(F.ws + WS_CTL) + CW_BAR; bar.x = 0; bar.st = nullptr; bar.wave_s = F.wave_s;
    if (args.use_bar) bar = xcd_barrier_post((unsigned*)(F.ws + WS_CTL) + CW_BAR, (volatile LAS unsigned*)(F.lds + MISC_OFF) + 8, F.wave_s);
    const int lo = args.ph_lo, hi = args.ph_hi;
#define IN(k) (lo <= (k) && (k) < hi)
#define SEAM(k) do { if (IN(k) && IN((k) + 1)) xcd_barrier(bar); } while (0)
#ifndef PROBE_DUP
#define PROBE_DUP -1
#endif
#define PH_BEGIN(kind) for (int rep_ = 0; rep_ < ((PROBE_DUP) == (kind) ? 2 : 1); ++rep_) { if (rep_) xcd_barrier(bar);
#define PH_END }
    #ifndef NO_P0
    PH_BEGIN(0) if (IN(0)) { p0_prologue(F); } PH_END
#endif
    SEAM(0);
#pragma unroll
    for (int l = 0; l < 2; ++l) {
        const int pb = 1 + 10 * l;
        const bool ctx_out = l == 0;
        const int mrows = ctx_out ? NROWS : NLAT;
#ifndef NO_P1
        PH_BEGIN(1) if (IN(pb + 0)) { p1_norm1(F, l, rep_ == 0 ? 1.0f : 0.0f); } PH_END
#endif
        SEAM(pb + 0);
        PH_BEGIN(2) if (IN(pb + 1)) {
            const Frame Fg = fresh_frame(F);
            pg8::Gemm g{(const bf16*)(Fg.ws + WS_HN), (const bf16*)(Fg.ws + WS_WTIN) + (size_t)l * INP * 1024, NROWS, INP, D}; pg8::StaticOrder S; S.init(NROWS, INP, F.G, (int)blockIdx.x);
            pg8::EpiStoreBf16 E{(bf16*)(Fg.ws + WS_U), INP, 0, 0};
            pg8::gemm_phase<pg8::EpiStoreBf16, pg8::StaticOrder, PG8_ALIGN, PG8_SP2>(Fg.lds, g, S, E, F.wave_s);
        }
        PH_END
        SEAM(pb + 1);
        PH_BEGIN(11) if (IN(pb + 2)) { p2t_pretransform(F, l, rep_ == 0); } PH_END
        SEAM(pb + 2);
        PH_BEGIN(3) if (IN(pb + 3)) { p3a_state(F, l); } PH_END
        SEAM(pb + 3);
        PH_BEGIN(4) if (IN(pb + 4)) { p3b_output(F, l, ctx_out); } PH_END
        SEAM(pb + 4);
        PH_BEGIN(5) if (IN(pb + 5)) {
            const Frame Fg = fresh_frame(F);
            pg8::Gemm g{(const bf16*)(Fg.ws + WS_Y), (const bf16*)(Fg.ws + WS_WTOUT) + (size_t)l * 1024 * 1024, mrows, D, D}; pg8::StaticOrder S; S.init(mrows, D, F.G, (int)blockIdx.x);
            pg8::EpiOutProj E{(float*)(Fg.ws + WS_H), (const float*)(Fg.ws + WS_MOD) + (size_t)l * 9 * MODW, (l == 0 && rep_ == 0) ? inp(Fg.lds, 0) : nullptr, (l == 0 && rep_ == 0) ? inp(Fg.lds, 2) : nullptr, rep_ == 0 ? 1.0f : 0.0f};
            pg8::gemm_phase<pg8::EpiOutProj, pg8::StaticOrder, PG8_ALIGN, PG8_SP2>(Fg.lds, g, S, E, F.wave_s);
        }
        PH_END
        SEAM(pb + 5);
#ifndef NO_P6
        PH_BEGIN(6) if (IN(pb + 6)) { p6_norm2_router(F, l, mrows); } PH_END
#endif
        SEAM(pb + 6);
#ifndef NO_P7
        PH_BEGIN(7) if (IN(pb + 7)) { p7_topk(F, l); } PH_END
#endif
        SEAM(pb + 7);
        PH_BEGIN(8) if (IN(pb + 8)) {
            const Frame Fg = fresh_frame(F);
            pg8::Gemm g{(const bf16*)(Fg.ws + WS_HN), (const bf16*)(Fg.ws + WS_WTGU) + (size_t)l * NE * 3072 * 1024, NE * SLOTS, NE * 3072, D};
            pg8::GroupedOrder S{ctx_out ? 9 : 8, 12, (int)blockIdx.x};
            pg8::EpiSwiGLU E{(bf16*)(Fg.ws + WS_U)};
            LAS int* idxl = (LAS int*)(Fg.lds + 132096);
            { const int* IDXG = (const int*)(Fg.ws + WS_SLOT + 1179648); const int tid_ = F.wave_s * 64 + lane_id(); pg8::Unit uu;
              for (int ui = 0; ui < 7 && S.next(ui, uu); ++ui) if (tid_ < 256) idxl[ui * 256 + tid_] = IDXG[uu.pm * 256 + tid_];
              __syncthreads(); }
            pg8::gemm_phase<pg8::EpiSwiGLU, pg8::GroupedOrder, PG8_ALIGN, PG8_SP2, true>(Fg.lds, g, S, E, F.wave_s, idxl);
        }
        PH_END
        SEAM(pb + 8);
        PH_BEGIN(9) if (IN(pb + 9)) {
            const Frame Fg = fresh_frame(F);
            pg8::Gemm g{(const bf16*)(Fg.ws + WS_U), (const bf16*)(Fg.ws + WS_WTDN) + (size_t)l * NE * 1024 * FF, NE * SLOTS, NE * 1024, FF};
            pg8::GroupedOrder S{ctx_out ? 9 : 8, 4, (int)blockIdx.x};
            pg8::EpiStoreBf16 E{(bf16*)(Fg.ws + WS_O2), D, 9, 4};
            pg8::gemm_phase<pg8::EpiStoreBf16, pg8::GroupedOrder, PG8_ALIGN, PG8_SP2>(Fg.lds, g, S, E, F.wave_s);
        }
        PH_END
        SEAM(pb + 9);
    }
#ifndef NO_PF
    PH_BEGIN(10) if (IN(21)) { p_final(F, (float*)inp(F.lds, 28)); } PH_END
#endif
#undef IN
#undef SEAM
}

#ifndef MK_ONE_LAUNCH
#define MK_ONE_LAUNCH 1
#endif
extern "C" void kernel_launch(void* const* d_in, const int* in_sizes, int n_in, void* d_out, int out_size, void* d_ws, size_t ws_size, hipStream_t stream) {
    static int grid = 0;
    if (grid == 0) {
        if (n_in != 28 || out_size != NLAT * D || ws_size < WS_END3) { fprintf(stderr, "kernel_launch: unexpected problem (n_in %d, out %d, ws %zu < %zu)\n", n_in, out_size, ws_size, (size_t)WS_END); grid = -1; return; }
        int dev = 0, cus = 0, per_cu = 0;
        if (hipGetDevice(&dev) != hipSuccess || hipDeviceGetAttribute(&cus, hipDeviceAttributeMultiprocessorCount, dev) != hipSuccess) { grid = -1; return; }
        if (hipFuncSetAttribute((const void*)fwd_kernel, hipFuncAttributeMaxDynamicSharedMemorySize, LDS_BYTES) != hipSuccess) { fprintf(stderr, "kernel_launch: hipFuncSetAttribute failed\n"); grid = -1; return; }
        if (hipOccupancyMaxActiveBlocksPerMultiprocessor(&per_cu, (const void*)fwd_kernel, NWAVES * 64, LDS_BYTES) != hipSuccess || per_cu < 1) { fprintf(stderr, "kernel_launch: occupancy query says %d\n", per_cu); (void)hipGetLastError(); per_cu = 1; }
        grid = cus;
        if (grid != 256) { fprintf(stderr, "kernel_launch: built for 256 CUs, device has %d\n", cus); grid = -1; return; }
    }
    if (grid < 0) return;
    (void)hipMemsetAsync((char*)d_ws + WS_CTL, 0, CTL_ZERO_BYTES, stream);
    Args a{};
    for (int i = 0; i < 28; ++i) a.in[i] = (const float*)d_in[i];
    a.out = (float*)d_out; a.ws = (unsigned char*)d_ws; a.never = 0;
#if MK_ONE_LAUNCH
    a.ph_lo = 0; a.ph_hi = NPHASES; a.use_bar = 1;
    void* kargs[] = {&a};
    hipError_t e = hipLaunchCooperativeKernel((const void*)fwd_kernel, dim3(grid), dim3(NWAVES * 64), kargs, LDS_BYTES, stream);
    if (e != hipSuccess) fprintf(stderr, "kernel_launch: cooperative launch failed: %s\n", hipGetErrorString(e));
#else
    for (int ph = 0; ph < NPHASES; ++ph) { a.ph_lo = ph; a.ph_hi = ph + 1; a.use_bar = 0;
        hipLaunchKernelGGL(fwd_kernel, dim3(grid), dim3(NWAVES * 64), LDS_BYTES, stream, a); }
#endif
}
```

```cpp
#include <hip/hip_runtime.h>
#include <hip/hip_cooperative_groups.h>
#include <cstdio>
#include <cstdint>
#define GAS __attribute__((address_space(1)))
#define LAS __attribute__((address_space(3)))
namespace pg8 {
#define PG8_LAS __attribute__((address_space(3)))
typedef unsigned short bf16_t;
typedef short bf16x8 __attribute__((ext_vector_type(8)));
typedef float f32x4 __attribute__((ext_vector_type(4)));
typedef unsigned u32x4 __attribute__((ext_vector_type(4)));
constexpr int BM = 256, BK = 64, HALF = 128, HTB = HALF * BK * 2  , STAGE_BYTES = 8 * HTB, NXCD = 8, WGM = 8;

__host__ __device__ __forceinline__ int lds_byte(int r, int c) { const int st = (r >> 4) * 2 + (c >> 5), rr = r & 15, cc = c & 31, ob = rr * 64 + cc * 2; return st * 1024 + (ob ^ (((ob >> 9) & 1) << 5)); }
__host__ __device__ __forceinline__ void stage_rc(int b, int& R, int& C) { const int st = b / 1024, sb = b % 1024, swz = sb ^ (((sb >> 9) & 1) << 5); R = (st >> 1) * 16 + swz / 64; C = (st & 1) * 32 + (swz % 64) / 2; }
__host__ __device__ __forceinline__ int perm32(int rho) { const int n = rho >> 4, i = rho & 15; return 8 * (i >> 2) + 4 * n + (i & 3); }

struct Unit { int pm, pn; };
struct Gemm { const bf16_t* A; const bf16_t* Bt; int M, N, K; };

struct StaticOrder {
    int nM, nN, nwg, G, c;
    __host__ __device__ void init(int M, int N, int G_, int c_) { nM = M / BM; nN = N / BM; nwg = nM * nN; G = G_; c = c_; }
    __host__ __device__ bool next(int i, Unit& u) const {
        const long L = (long)i * G + c; if (L >= nwg) return false;
        int wgid = (int)L; { const int q = nwg / NXCD, r = nwg % NXCD, xcd = wgid % NXCD, off = wgid / NXCD; wgid = (xcd < r ? xcd * (q + 1) : r * (q + 1) + (xcd - r) * q) + off; }
        const int nig = WGM * nN, gid = wgid / nig, fm = gid * WGM, gsz = (nM - fm) < WGM ? (nM - fm) : WGM;
        u.pm = fm + ((wgid % nig) % gsz); u.pn = (wgid % nig) / gsz; return true;
    }
    __device__ __forceinline__ void a_ready(const Unit&) const {}
    __device__ __forceinline__ void done(const Unit&) const {}
};

__device__ __forceinline__ unsigned cvt_pk_bf16(float lo, float hi) { unsigned r; asm volatile("v_cvt_pk_bf16_f32 %0, %1, %2" : "=v"(r) : "v"(lo), "v"(hi)); return r; }
typedef float f32x2_t __attribute__((ext_vector_type(2))); typedef __bf16 bf16x2_t __attribute__((ext_vector_type(2)));
__device__ __forceinline__ unsigned cvt_pk_safe(float lo, float hi) { const f32x2_t v = {lo, hi}; const bf16x2_t b = __builtin_convertvector(v, bf16x2_t); return __builtin_bit_cast(unsigned, b); }

struct EpiStoreBf16 {
    static constexpr bool PERM = true, AFTER_DRAIN = false;
    bf16_t* O; int ldc; int pm_div, pn_per;
    __device__ __forceinline__ void operator()(const f32x4 (&acc)[2][2][4][2], const Unit& u, int wr, int wc, int fr, int fq) const {
        const int row0 = u.pm * BM + wr * 64 + fr; int pnl = u.pn; if (pm_div) pnl -= (u.pm / pm_div) * pn_per;
        const int col0 = pnl * BM + wc * 32 + 8 * fq;
#pragma unroll
        for (int ai = 0; ai < 2; ++ai)
#pragma unroll
            for (int m = 0; m < 4; ++m) { bf16_t* rowp = O + (size_t)(row0 + ai * HALF + m * 16) * ldc + col0;
#pragma unroll
                for (int bj = 0; bj < 2; ++bj) { const f32x4 v0 = acc[ai][bj][m][0], v1 = acc[ai][bj][m][1];
                    u32x4 w; w.x = cvt_pk_bf16(v0[0], v0[1]); w.y = cvt_pk_bf16(v0[2], v0[3]); w.z = cvt_pk_bf16(v1[0], v1[1]); w.w = cvt_pk_bf16(v1[2], v1[3]);
                    *(u32x4*)(rowp + bj * HALF) = w; } }
    }
};
struct EpiSwiGLU {
    static constexpr bool PERM = false, AFTER_DRAIN = false;
    bf16_t* O;
    __device__ __forceinline__ void operator()(const f32x4 (&acc)[2][2][4][2], const Unit& u, int wr, int wc, int fr, int fq) const {
        const int e = u.pm / 9, pnl = u.pn - e * 12;
        const int row0 = u.pm * BM + wr * 64 + fr, col0 = pnl * 128 + (4 * wc + fq) * 8;
#pragma unroll
        for (int ai = 0; ai < 2; ++ai)
#pragma unroll
            for (int m = 0; m < 4; ++m) {
                float h[8];
#pragma unroll
                for (int bj = 0; bj < 2; ++bj)
#pragma unroll
                    for (int j = 0; j < 4; ++j) { const float g = acc[ai][bj][m][0][j], up = acc[ai][bj][m][1][j]; h[bj * 4 + j] = g * __builtin_amdgcn_rcpf(1.0f + __expf(-g)) * up; }
                u32x4 w; w.x = cvt_pk_bf16(h[0], h[1]); w.y = cvt_pk_bf16(h[2], h[3]); w.z = cvt_pk_bf16(h[4], h[5]); w.w = cvt_pk_bf16(h[6], h[7]);
                *(u32x4*)(O + (size_t)(row0 + ai * HALF + m * 16) * 1536 + col0) = w; }
    }
};
struct EpiOutProj {
    static constexpr bool PERM = true, AFTER_DRAIN = false;
    bf16_t* H; const float* mod;
    const float* xin; const float* cin;
    float gsc;
    __device__ __forceinline__ void operator()(const f32x4 (&acc)[2][2][4][2], const Unit& u, int wr, int wc, int fr, int fq) const {
        const int s = u.pm < 64 ? (u.pm >> 3) : 8;
        const float* g1 = mod + s * 6144 + 2048;
        const int row0 = u.pm * BM + wr * 64 + fr, col0 = u.pn * BM + wc * 32 + 8 * fq;
#pragma unroll
        for (int bj = 0; bj < 2; ++bj) { const f32x4 gv0 = *(const f32x4*)(g1 + col0 + bj * HALF) * gsc, gv1 = *(const f32x4*)(g1 + col0 + bj * HALF + 4) * gsc;
#pragma unroll
            for (int ai = 0; ai < 2; ++ai)
#pragma unroll
                for (int m = 0; m < 4; ++m) { const size_t off = (size_t)(row0 + ai * HALF + m * 16) * 1024 + col0 + bj * HALF; bf16_t* p = H + off;
                    f32x4 o0, o1;
                    if (xin) { const float* bp = u.pm < 64 ? xin + off : cin + (off - (size_t)16384 * 1024); o0 = *(const f32x4*)bp; o1 = *(const f32x4*)(bp + 4); }
                    else { const u32x4 w = *(const u32x4*)p; o0 = (f32x4){__uint_as_float(w.x << 16), __uint_as_float(w.x & 0xffff0000u), __uint_as_float(w.y << 16), __uint_as_float(w.y & 0xffff0000u)};
                        o1 = (f32x4){__uint_as_float(w.z << 16), __uint_as_float(w.z & 0xffff0000u), __uint_as_float(w.w << 16), __uint_as_float(w.w & 0xffff0000u)}; }
                    o0 += gv0 * acc[ai][bj][m][0]; o1 += gv1 * acc[ai][bj][m][1];
                    u32x4 w; w.x = cvt_pk_bf16(o0[0], o0[1]); w.y = cvt_pk_bf16(o0[2], o0[3]); w.z = cvt_pk_bf16(o1[0], o1[1]); w.w = cvt_pk_bf16(o1[2], o1[3]);
                    *(u32x4*)p = w; } }
    }
};
struct GroupedOrder {
    int MT, NT, c;
    __device__ __forceinline__ bool next(int i, Unit& u) const {
        const int xcd = c & 7, j = i * 32 + (c >> 3), per = MT * NT;
        if (j >= 2 * per) return false;
        const int e = 2 * xcd + j / per, q = j % per;
        u.pm = e * 9 + q % MT; u.pn = e * NT + q / MT; return true;
    }
    __device__ __forceinline__ void a_ready(const Unit&) const {}
    __device__ __forceinline__ void done(const Unit&) const {}
};

template <class Epi, class Sched, bool ALIGN_EPI = false, bool SP2 = false, bool GATHER = false>
__device__ __forceinline__ void gemm_phase(PG8_LAS unsigned char* lds, const Gemm g, const Sched& S, const Epi& E, const int wave_s, const PG8_LAS int* idxl = nullptr) {
    unsigned m_ = ~0u; asm volatile("" : "+s"(m_)); const int tid_ = wave_s * 64 + (int)__builtin_amdgcn_mbcnt_hi(m_, __builtin_amdgcn_mbcnt_lo(m_, 0u));
    const int tid = tid_, wid = __builtin_amdgcn_readfirstlane(tid >> 6), lane = tid & 63, wr = wid >> 2, wc = wid & 3, fr = lane & 15, fq = lane >> 4;
    const int K = g.K, nt = K / BK;
    unsigned voffA[2], voffB[2]; int gR[2], gC2[2];
#pragma unroll
    for (int i = 0; i < 2; ++i) { int R, C; stage_rc(tid * 16 + i * 8192, R, C); const int Rb = Epi::PERM ? ((R & ~31) + perm32(R & 31)) : R;
        voffA[i] = (unsigned)(R * K + C) * 2u; voffB[i] = (unsigned)(Rb * K + C) * 2u; gR[i] = R; gC2[i] = 2 * C; }
    const size_t kstep = (size_t)(BK * 2);
    const size_t hstep = (size_t)HALF * K * 2;
    const size_t tstep = 2 * hstep;
    const unsigned ldsw = (unsigned)wid * 1024u;
    const int aoff = lds_byte(wr * 64 + fr, fq * 8), boff = lds_byte(wc * 32 + fr, fq * 8);
#define PG8_SA(b, h) (((b) * 2 + (h)) * HTB)
#define PG8_SB(b, h) ((4 + (b) * 2 + (h)) * HTB)
#define PG8_STAGE(bufoff, gbase, voff) do { _Pragma("unroll") for (int _i = 0; _i < 2; ++_i) \
        __builtin_amdgcn_global_load_lds((const unsigned*)((const char*)(gbase) + (voff)[_i]), (PG8_LAS unsigned*)(lds + (bufoff) + ldsw + _i * 8192), 16, 0, 0); } while (0)
#define PG8_STAGE_A(bufoff, gbase, h, usenext) do { if constexpr (GATHER) { _Pragma("unroll") for (int _i = 0; _i < 2; ++_i) { const unsigned _o = (usenext) ? vn[h][_i] : vo[h][_i]; \
        __builtin_amdgcn_global_load_lds((const unsigned*)((const char*)(gbase) + _o), (PG8_LAS unsigned*)(lds + (bufoff) + ldsw + _i * 8192), 16, 0, 0); } } \
        else { PG8_STAGE(bufoff, (const char*)(gbase) + ((h) ? hstep : (size_t)0), voffA); } } while (0)
#define PG8_LDA(dst, b, h) do { _Pragma("unroll") for (int m = 0; m < 4; ++m) _Pragma("unroll") for (int k = 0; k < 2; ++k) dst[m][k] = *(const PG8_LAS bf16x8*)(lds + PG8_SA(b, h) + aoff + m * 2048 + k * 1024); } while (0)
#define PG8_LDB(dst, b, h) do { _Pragma("unroll") for (int n = 0; n < 2; ++n) _Pragma("unroll") for (int k = 0; k < 2; ++k) dst[n][k] = *(const PG8_LAS bf16x8*)(lds + PG8_SB(b, h) + boff + n * 2048 + k * 1024); } while (0)
#define PG8_MMA(ai, bj, At, Bt) do { __builtin_amdgcn_s_setprio(1); _Pragma("unroll") for (int m = 0; m < 4; ++m) _Pragma("unroll") for (int n = 0; n < 2; ++n) _Pragma("unroll") for (int k = 0; k < 2; ++k) \
        acc[ai][bj][m][n] = __builtin_amdgcn_mfma_f32_16x16x32_bf16(Bt[n][k], At[m][k], acc[ai][bj][m][n], 0, 0, 0); __builtin_amdgcn_s_setprio(0); } while (0)
#define PG8_WAIT_V(n) asm volatile("s_waitcnt vmcnt(" #n ")" ::: "memory")
#define PG8_WAIT_L(n) asm volatile("s_waitcnt lgkmcnt(" #n ")" ::: "memory")
#define PG8_BAR __builtin_amdgcn_s_barrier()
#define PG8_SCHED __builtin_amdgcn_sched_barrier(0)
    Unit cur, nxt; int ui = 0;
    if (!S.next(0, cur)) return;
    f32x4 acc[2][2][4][2];
#pragma unroll
    for (int a = 0; a < 2; ++a)
#pragma unroll
        for (int b = 0; b < 2; ++b)
#pragma unroll
            for (int m = 0; m < 4; ++m)
#pragma unroll
                for (int n = 0; n < 2; ++n) acc[a][b][m][n] = (f32x4){0.f, 0.f, 0.f, 0.f};
    bf16x8 At[4][2], B0[2][2], B1[2][2];
    const char* cA = (const char*)g.A + (GATHER ? (size_t)0 : (size_t)cur.pm * tstep); const char* cB = (const char*)g.Bt + (size_t)cur.pn * tstep;
    unsigned vo[2][2], vn[2][2];
    if constexpr (GATHER) {
#pragma unroll
        for (int h = 0; h < 2; ++h)
#pragma unroll
            for (int i = 0; i < 2; ++i) { vo[h][i] = (unsigned)idxl[h * 128 + gR[i]] * (unsigned)(2 * K) + (unsigned)gC2[i]; vn[h][i] = vo[h][i]; } }
    S.a_ready(cur);
    if constexpr (SP2) {
        PG8_STAGE(PG8_SB(0, 0), cB, voffB); PG8_STAGE(PG8_SB(0, 1), cB + hstep, voffB); PG8_STAGE_A(PG8_SA(0, 0), cA, 0, false); PG8_STAGE_A(PG8_SA(0, 1), cA, 1, false);
        if (wr == 1) PG8_BAR;
        PG8_WAIT_V(2); PG8_BAR;
        PG8_STAGE(PG8_SB(1, 0), cB + kstep, voffB); PG8_STAGE_A(PG8_SA(1, 0), cA + kstep, 0, false); PG8_STAGE(PG8_SB(1, 1), cB + hstep + kstep, voffB);
        PG8_WAIT_V(6); PG8_BAR;
    } else {
        PG8_STAGE(PG8_SB(0, 0), cB, voffB); PG8_STAGE(PG8_SA(0, 0), cA, voffA); PG8_STAGE(PG8_SB(0, 1), cB + hstep, voffB); PG8_STAGE(PG8_SA(0, 1), cA + hstep, voffA);
        if (wr == 1) PG8_BAR;
        PG8_WAIT_V(4); PG8_BAR;
        PG8_STAGE(PG8_SB(1, 0), cB + kstep, voffB); PG8_STAGE(PG8_SA(1, 0), cA + kstep, voffA); PG8_STAGE(PG8_SB(1, 1), cB + hstep + kstep, voffB);
        PG8_WAIT_V(6); PG8_BAR;
    }
    for (;;) {
        const bool has_next = S.next(ui + 1, nxt);
        const char* nA = (has_next && !GATHER) ? (const char*)g.A + (size_t)nxt.pm * tstep : cA; const char* nB = has_next ? (const char*)g.Bt + (size_t)nxt.pn * tstep : cB;
        if constexpr (GATHER) {
#pragma unroll
            for (int h = 0; h < 2; ++h)
#pragma unroll
                for (int i = 0; i < 2; ++i) vn[h][i] = has_next ? (unsigned)idxl[(ui + 1) * 256 + h * 128 + gR[i]] * (unsigned)(2 * K) + (unsigned)gC2[i] : vo[h][i]; }
        for (int t = 0; t < nt; t += 2) {
            const bool last = (t == nt - 2);
            const char* a1 = cA + (size_t)(t + 1) * kstep;
            const char* a2 = last ? nA : cA + (size_t)(t + 2) * kstep; const char* b2 = last ? nB : cB + (size_t)(t + 2) * kstep;
            const char* a3 = a2 + kstep; const char* b3 = b2 + kstep;
            if (last && has_next) S.a_ready(nxt);
            if constexpr (SP2) {
            PG8_LDB(B0, 0, 0); PG8_LDB(B1, 0, 1); PG8_SCHED; PG8_LDA(At, 0, 0); PG8_STAGE_A(PG8_SA(1, 1), a1, 1, false);
            PG8_WAIT_V(8); PG8_WAIT_L(0); PG8_BAR; PG8_MMA(0, 0, At, B0); PG8_MMA(0, 1, At, B1); PG8_BAR; PG8_SCHED;
            PG8_LDA(At, 0, 1); PG8_STAGE(PG8_SB(0, 0), b2, voffB); PG8_STAGE(PG8_SB(0, 1), b2 + hstep, voffB); PG8_STAGE_A(PG8_SA(0, 0), a2, 0, last);
            PG8_WAIT_V(8); PG8_WAIT_L(0); PG8_BAR; PG8_MMA(1, 0, At, B0); PG8_MMA(1, 1, At, B1); PG8_BAR; PG8_SCHED;
            PG8_LDB(B0, 1, 0); PG8_LDB(B1, 1, 1); PG8_SCHED; PG8_LDA(At, 1, 0); PG8_STAGE_A(PG8_SA(0, 1), a2, 1, last);
            PG8_WAIT_V(8); PG8_WAIT_L(0); PG8_BAR; PG8_MMA(0, 0, At, B0); PG8_MMA(0, 1, At, B1); PG8_BAR; PG8_SCHED;
            PG8_LDA(At, 1, 1); PG8_STAGE(PG8_SB(1, 0), b3, voffB); PG8_STAGE(PG8_SB(1, 1), b3 + hstep, voffB); PG8_STAGE_A(PG8_SA(1, 0), a3, 0, last);
            PG8_WAIT_V(8); PG8_WAIT_L(0); PG8_BAR; PG8_MMA(1, 0, At, B0); PG8_MMA(1, 1, At, B1); PG8_BAR; PG8_SCHED;
            } else {
            PG8_LDB(B0, 0, 0); PG8_SCHED; PG8_LDA(At, 0, 0); PG8_STAGE(PG8_SA(1, 1), a1 + hstep, voffA);
            PG8_WAIT_L(8); PG8_BAR; PG8_WAIT_L(0); PG8_MMA(0, 0, At, B0); PG8_BAR; PG8_SCHED;
            PG8_LDB(B1, 0, 1); PG8_STAGE(PG8_SB(0, 0), b2, voffB);
            PG8_BAR; PG8_WAIT_L(0); PG8_MMA(0, 1, At, B1); PG8_BAR;
            PG8_LDA(At, 0, 1); PG8_STAGE(PG8_SA(0, 0), a2, voffA);
            PG8_BAR; PG8_WAIT_L(0); PG8_MMA(1, 0, At, B0); PG8_BAR; PG8_SCHED;
            PG8_STAGE(PG8_SB(0, 1), b2 + hstep, voffB);
            PG8_WAIT_V(6); PG8_BAR; PG8_MMA(1, 1, At, B1); PG8_BAR;
            PG8_LDB(B0, 1, 0); PG8_SCHED; PG8_LDA(At, 1, 0); PG8_STAGE(PG8_SA(0, 1), a2 + hstep, voffA);
            PG8_WAIT_L(8); PG8_BAR; PG8_WAIT_L(0); PG8_MMA(0, 0, At, B0); PG8_BAR; PG8_SCHED;
            PG8_LDB(B1, 1, 1); PG8_STAGE(PG8_SB(1, 0), b3, voffB);
            PG8_BAR; PG8_WAIT_L(0); PG8_MMA(0, 1, At, B1); PG8_BAR;
            PG8_LDA(At, 1, 1); PG8_STAGE(PG8_SA(1, 0), a3, voffA);
            PG8_BAR; PG8_WAIT_L(0); PG8_MMA(1, 0, At, B0); PG8_BAR; PG8_SCHED;
            PG8_STAGE(PG8_SB(1, 1), b3 + hstep, voffB);
            PG8_WAIT_V(6); PG8_BAR; PG8_MMA(1, 1, At, B1); PG8_BAR;
            }
        }
        if constexpr (ALIGN_EPI) { if (wr == 0) PG8_BAR; }
        if constexpr (!Epi::AFTER_DRAIN) { E(acc, cur, wr, wc, fr, fq); S.done(cur); }
        if (!has_next) break;
#pragma unroll
        for (int a = 0; a < 2; ++a)
#pragma unroll
            for (int b = 0; b < 2; ++b)
#pragma unroll
                for (int m = 0; m < 4; ++m)
#pragma unroll
                    for (int n = 0; n < 2; ++n) acc[a][b][m][n] = (f32x4){0.f, 0.f, 0.f, 0.f};
        cur = nxt; cA = nA; cB = nB; ++ui;
        if constexpr (GATHER) {
#pragma unroll
            for (int h = 0; h < 2; ++h)
#pragma unroll
                for (int i = 0; i < 2; ++i) vo[h][i] = vn[h][i]; }
        if constexpr (ALIGN_EPI) { if (wr == 1) PG8_BAR; }
    }
    PG8_WAIT_V(0);
    if constexpr (!ALIGN_EPI) { if (wr == 0) PG8_BAR; }
    PG8_BAR;
    if constexpr (Epi::AFTER_DRAIN) { E.fused(acc, cur, wr, wc, fr, fq, lds, wid, lane); S.done(cur); }
#undef PG8_SA
#undef PG8_SB
#undef PG8_STAGE
#undef PG8_STAGE_A
#undef PG8_LDA
#undef PG8_LDB
#undef PG8_MMA
#undef PG8_WAIT_V
#undef PG8_WAIT_L
#undef PG8_BAR
#undef PG8_SCHED
}
}

#ifndef PG8_SP2
#define PG8_SP2 true
#endif
#ifndef PG8_ALIGN
#define PG8_ALIGN true
#endif

constexpr int D = 1024, NB = 8, SEQ = 2048, CTXL = 256, NLAT = NB * SEQ, NCTX = NB * CTXL, NROWS = NLAT + NCTX;
constexpr int INC = 3624, INP = 3840, NE = 16, FF = 1536, SLOTS = 2304, MODW = 6144;
constexpr float EPS = 1e-6f;
constexpr int C_RET = 0, C_GLA = 1024, C_SSD = 1808, C_ML = 2584;
constexpr size_t MiB = 1u << 20;
constexpr size_t WS_CTL = 0, CTL_ZERO_BYTES = 1 * MiB;
constexpr size_t WS_MOD = 1 * MiB, WS_WTIN = 2 * MiB, WS_WTOUT = 18 * MiB, WS_WTGU = 22 * MiB, WS_WTDN = 214 * MiB, WS_H = 310 * MiB, WS_HN = 382 * MiB,
                 WS_U = 418 * MiB  , WS_O2 = 553 * MiB  , WS_Y = 625 * MiB  , WS_AFFT = 697 * MiB, WS_SLOT = 699 * MiB, WS_END = 701 * MiB;
constexpr int CW_BAR = 4096;
constexpr int RING_BYTES = 131072, LDSCTL_OFF = RING_BYTES, MISC_OFF = LDSCTL_OFF + 320, LDS_BYTES = 147456;
constexpr int NWAVES = 8, NPHASES = 22;

typedef unsigned short bf16;
typedef unsigned v4u __attribute__((ext_vector_type(4)));
typedef unsigned v2u __attribute__((ext_vector_type(2)));
typedef float f32x4 __attribute__((ext_vector_type(4)));
typedef GAS unsigned gu32;
#define LDS_WAIT() asm volatile("s_waitcnt lgkmcnt(0)" ::: "memory")
#define VM_WAIT() asm volatile("s_waitcnt vmcnt(0)" ::: "memory")

#define XB_TMO      128
#define XB_XCNT(j)  (256  + 64 * (j))
#define XB_XSUB(j)  (1280 + 64 * (j))
#define XB_XGEN(j)  (2304 + 64 * (j))
#define XB_TOP      3328
#define XB_TOPGEN   3392
#define XCD_BAR_WORDS 3456
#define XB_SPIN_CAP (1u << 18)

__device__ __forceinline__ unsigned xb_ld(unsigned* p)              { return __hip_atomic_load(p, __ATOMIC_RELAXED, __HIP_MEMORY_SCOPE_AGENT); }
__device__ __forceinline__ unsigned xb_add(unsigned* p, unsigned v) { return __hip_atomic_fetch_add(p, v, __ATOMIC_RELAXED, __HIP_MEMORY_SCOPE_AGENT); }
__device__ __forceinline__ unsigned xb_xcc_id() { return (unsigned)__builtin_amdgcn_s_getreg((3 << 11) | 20) & 0xFu; }
#define XB_SPIN(cond, bar) do { unsigned _sp = 0; while (cond) { __builtin_amdgcn_s_sleep(1); \
    if ((++_sp & 255u) == 0u) { if (xb_ld(&(bar)[XB_TMO])) break; if (_sp > XB_SPIN_CAP) { atomicAdd(&(bar)[XB_TMO], 1u); break; } } } } while (0)

__device__ __forceinline__ int xb_lane_id() { unsigned m = ~0u; asm volatile("" : "+s"(m)); return (int)__builtin_amdgcn_mbcnt_hi(m, __builtin_amdgcn_mbcnt_lo(m, 0u)); }
struct XcdBarrier {
    int wave_s;
    unsigned* bar; unsigned x;
    volatile LAS unsigned* st;
};

__device__ __forceinline__ XcdBarrier xcd_barrier_post(unsigned* bar, volatile LAS unsigned* st, int wave_s) {
    XcdBarrier b; b.bar = bar; b.x = xb_xcc_id(); b.st = st; b.wave_s = wave_s;
    if (wave_s == 0 && xb_lane_id() == 0) (void)xb_add(&bar[XB_XCNT(b.x)], 1u);
    return b;
}
__device__ __forceinline__ void xcd_barrier_complete(unsigned* bar, unsigned x, unsigned& nloc, unsigned& nx) {
    const unsigned G = gridDim.x * gridDim.y * gridDim.z;
    unsigned sum, cnt, mine, sp = 0u;
    for (;;) {
        sum = 0u; cnt = 0u; mine = 0u;
#pragma unroll
        for (unsigned j = 0; j < 16; ++j) { const unsigned c = xb_ld(&bar[XB_XCNT(j)]); sum += c; cnt += (c > 0u) ? 1u : 0u; }
        if (sum == G) { mine = xb_ld(&bar[XB_XCNT(x)]); break; }
        __builtin_amdgcn_s_sleep(1);
        if ((++sp & 255u) == 0u) { if (xb_ld(&bar[XB_TMO])) break; if (sp > XB_SPIN_CAP) { atomicAdd(&bar[XB_TMO], 1u); break; } }
    }
    nloc = mine > 0u ? mine : 1u; nx = cnt > 0u ? cnt : 1u;
}

__device__ __forceinline__ void xcd_barrier(const XcdBarrier& b) {
    asm volatile("s_waitcnt vmcnt(0)" ::: "memory");
    __syncthreads();
    if (b.wave_s == 0 && xb_lane_id() == 0) {
        unsigned* bar = b.bar; asm volatile("" : "+s"(bar));
        __builtin_amdgcn_s_waitcnt(0);
        unsigned nloc = b.st[0], nx = b.st[1];
        if (nloc == 0u) { xcd_barrier_complete(bar, b.x, nloc, nx); b.st[0] = nloc; b.st[1] = nx; }
        const unsigned old = xb_add(&bar[XB_XSUB(b.x)], 1u);
        const unsigned gen = old / nloc;
        if (old + 1u == (gen + 1u) * nloc) {
            __builtin_amdgcn_fence(__ATOMIC_RELEASE, "agent");
            asm volatile("s_waitcnt vmcnt(0)" ::: "memory");
            const unsigned og = xb_add(&bar[XB_TOP], 1u);
            const unsigned tg = og / nx;
            if (og + 1u == (tg + 1u) * nx) xb_add(&bar[XB_TOPGEN], 1u);
            else XB_SPIN(xb_ld(&bar[XB_TOPGEN]) == tg, bar);
            __builtin_amdgcn_fence(__ATOMIC_ACQUIRE, "agent");
            xb_add(&bar[XB_XGEN(b.x)], 1u);
            asm volatile("s_waitcnt vmcnt(0)" ::: "memory");
        } else {
            XB_SPIN(xb_ld(&bar[XB_XGEN(b.x)]) == gen, bar);
            __builtin_amdgcn_fence(__ATOMIC_ACQUIRE, "agent");
            asm volatile("s_waitcnt vmcnt(0)" ::: "memory");
        }
    }
    __syncthreads();
}


struct Frame {
    LAS unsigned char* lds;
    int vcu, G, wave_s;
    unsigned char* ws;
};
struct Ids { int tid, lane, wave; };
__device__ __forceinline__ const float* inp(const LAS unsigned char* lds, int i) {
    const LAS unsigned* t = (const LAS unsigned*)(lds + 131072) + 2 * i;
    const unsigned lo = __builtin_amdgcn_readfirstlane(t[0]), hi = __builtin_amdgcn_readfirstlane(t[1]);
    return (const float*)(GAS const float*)(((unsigned long long)hi << 32) | lo); }
__device__ __forceinline__ Frame fresh_frame(const Frame& F) { Frame G = F; GAS unsigned char* g = (GAS unsigned char*)F.ws; asm volatile("" : "+s"(g), "+s"(G.lds), "+s"(G.vcu), "+s"(G.G), "+s"(G.wave_s)); G.ws = (unsigned char*)g; return G; }
__device__ __forceinline__ int lane_id() { unsigned m = ~0u; asm volatile("" : "+s"(m)); return (int)__builtin_amdgcn_mbcnt_hi(m, __builtin_amdgcn_mbcnt_lo(m, 0u)); }
__device__ __forceinline__ Ids fresh_ids(int wave_s) { Ids I; I.lane = lane_id(); I.wave = wave_s; I.tid = wave_s * 64 + I.lane; return I; }
__device__ __forceinline__ float shx(float v, int mask, int lane) { return __int_as_float(__builtin_amdgcn_ds_bpermute((lane ^ mask) << 2, __float_as_int(v))); }
__device__ __forceinline__ float shidx(float v, int src) { return __int_as_float(__builtin_amdgcn_ds_bpermute(src << 2, __float_as_int(v))); }
__device__ __forceinline__ int shidx_i(int v, int src) { return __builtin_amdgcn_ds_bpermute(src << 2, v); }
__device__ __forceinline__ float wave_sum(float v, int lane) {
#pragma unroll
    for (int o = 1; o < 64; o <<= 1) v += shx(v, o, lane);
    return v;
}
__device__ __forceinline__ float bf_lo(unsigned w) { return __uint_as_float(w << 16); }
__device__ __forceinline__ float bf_hi(unsigned w) { return __uint_as_float(w & 0xffff0000u); }
__device__ __forceinline__ f32x4 ld_bf4(const bf16* p) { const v2u w = *(const v2u*)p; return (f32x4){bf_lo(w.x), bf_hi(w.x), bf_lo(w.y), bf_hi(w.y)}; }
__device__ __forceinline__ void st_bf4(bf16* p, f32x4 v) { v2u w; w.x = pg8::cvt_pk_bf16(v.x, v.y); w.y = pg8::cvt_pk_bf16(v.z, v.w); *(v2u*)p = w; }
__device__ __forceinline__ float silu_f(float x) { return x / (1.0f + expf(-x)); }
__device__ __forceinline__ float sigmoid_f(float x) { return 1.0f / (1.0f + expf(-x)); }
__device__ __forceinline__ float log_sigmoid_f(float z) { return fminf(z, 0.f) - log1pf(expf(-fabsf(z))); }
__device__ __forceinline__ float softplus_f(float x) { return fmaxf(x, 0.f) + log1pf(expf(-fabsf(x))); }
__device__ __forceinline__ int row_sample(int r) { return r < NLAT ? (r >> 11) : 8; }

template <class RowMap>
__device__ __forceinline__ void transpose_item(const float* W, int ldw, int nvalid, int k0, int n0, bf16* WT, int ldt, const RowMap& f, LAS float* scr, int lane) {
    f32x4 t[8];
#pragma unroll
    for (int i = 0; i < 8; ++i) { const int idx = i * 64 + lane, kk = idx >> 3, c = n0 + 4 * (idx & 7);
        t[i] = c < nvalid ? __builtin_nontemporal_load((const f32x4*)(W + (size_t)(k0 + kk) * ldw + c)) : (f32x4){0.f, 0.f, 0.f, 0.f}; }
#pragma unroll
    for (int i = 0; i < 8; ++i) { const int idx = i * 64 + lane, kk = idx >> 3, c4 = 4 * (idx & 7); LAS float* d = scr + kk * 33 + c4; d[0] = t[i].x; d[1] = t[i].y; d[2] = t[i].z; d[3] = t[i].w; }
    LDS_WAIT(); asm volatile("" ::: "memory");
    const int c8 = lane & 7;
#pragma unroll
    for (int j = 0; j < 4; ++j) { const int n = (lane >> 3) + 8 * j, col = n0 + n; const LAS float* s = scr + (8 * c8) * 33 + n;
        if (col < nvalid) { v4u o; o.x = pg8::cvt_pk_bf16(s[0 * 33], s[1 * 33]); o.y = pg8::cvt_pk_bf16(s[2 * 33], s[3 * 33]); o.z = pg8::cvt_pk_bf16(s[4 * 33], s[5 * 33]); o.w = pg8::cvt_pk_bf16(s[6 * 33], s[7 * 33]);
            *(v4u*)(WT + (size_t)f(col) * ldt + k0 + 8 * c8) = o; } }
    LDS_WAIT(); asm volatile("" ::: "memory");
}
struct MapId { int off; __device__ __forceinline__ int operator()(int c) const { return off + c; } };
struct MapGU { int off, n; __device__ __forceinline__ int operator()(int h) const { const int hl = h & 127, q = hl >> 3, wc = q >> 2, fq = q & 3, rem = hl & 7, bj = rem >> 2, j = rem & 3;
    return off + 256 * (h >> 7) + 128 * bj + 32 * wc + 16 * n + 4 * fq + j; } };

__device__ __forceinline__ void p0_prologue(const Frame& F_) {
    const Frame F = fresh_frame(F_); const Ids I = fresh_ids(F.wave_s);
    const float* cvec = inp(F.lds, 1); const float* cctx = inp(F.lds, 3); const float* w_mod = inp(F.lds, 4); const float* b_mod = inp(F.lds, 5);
    float* MOD = (float*)(F.ws + WS_MOD);
    {
        LAS float* sil = (LAS float*)F.lds;
        LAS float* part = (LAS float*)(F.lds + 40960);
        for (int i = I.tid; i < 9 * 1024; i += 512) { const int s = i >> 10, k = i & 1023; const float c = s < 8 ? cvec[s * 1024 + k] : cctx[k]; sil[i] = silu_f(c); }
        __syncthreads();
        for (int item = F.vcu; item < 192; item += F.G) {
            const int l = item / 96, col = (item % 96) * 64 + I.lane;
            float acc[9];
#pragma unroll
            for (int s = 0; s < 9; ++s) acc[s] = 0.f;
            const float* wp = w_mod + (size_t)l * 1024 * MODW + (size_t)(I.wave * 128) * MODW + col;
            for (int k = 0; k < 128; ++k) { const float wv = wp[(size_t)k * MODW];
#pragma unroll
                for (int s = 0; s < 9; ++s) acc[s] += sil[s * 1024 + I.wave * 128 + k] * wv; }
#pragma unroll
            for (int s = 0; s < 9; ++s) part[(I.wave * 9 + s) * 64 + I.lane] = acc[s];
            __syncthreads();
            for (int i = I.tid; i < 9 * 64; i += 512) { const int s = i >> 6, ln = i & 63; float t = 0.f;
#pragma unroll
                for (int w = 0; w < 8; ++w) t += part[(w * 9 + s) * 64 + ln];
                const int cc = (item % 96) * 64 + ln; MOD[((size_t)l * 9 + s) * MODW + cc] = t + b_mod[l * MODW + cc]; }
            __syncthreads();
        }
        __syncthreads();
    }
    {
        bf16* wtin = (bf16*)(F.ws + WS_WTIN);
        const int nchunk = 2 * (INP - INC) * 128;
        for (int i = F.vcu * 512 + I.tid; i < nchunk; i += F.G * 512) { const int l = i / ((INP - INC) * 128), r = i % ((INP - INC) * 128);
            *(v4u*)(wtin + ((size_t)l * INP + INC) * 1024 + (size_t)r * 8) = (v4u){0u, 0u, 0u, 0u}; }
    }
    {
        LAS float* scr = (LAS float*)(F.lds + I.wave * 16384);
        const int gw = F.vcu * NWAVES + I.wave, NGW = F.G * NWAVES;
        constexpr int I_IN = 16 * 114, I_OUT = 16 * 32, I_E = 768, PER_L = I_IN + I_OUT + 16 * 3 * I_E;
#ifndef CONV_IN_SCAN
#define CONV_IN_SCAN 1
#endif
        constexpr int PER_L0 = CONV_IN_SCAN ? (I_IN + I_OUT) : PER_L;
        for (int it = gw; it < 2 * PER_L0; it += NGW) {
            const int l = it / PER_L0; int r = it % PER_L0;
            if (r < I_IN) { const int kb = r / 114, nb = r % 114;
                transpose_item(inp(F.lds, 8) + (size_t)l * 1024 * INC, INC, INC, 64 * kb, 32 * nb, (bf16*)(F.ws + WS_WTIN) + (size_t)l * INP * 1024, 1024, MapId{0}, scr, I.lane); continue; }
            r -= I_IN;
            if (r < I_OUT) { const int kb = r / 32, nb = r % 32;
                transpose_item(inp(F.lds, 9) + (size_t)l * 1024 * 1024, 1024, 1024, 64 * kb, 32 * nb, (bf16*)(F.ws + WS_WTOUT) + (size_t)l * 1024 * 1024, 1024, MapId{0}, scr, I.lane); continue; }
            r -= I_OUT;
            const int e = r / (3 * I_E), q = r % (3 * I_E), kind = q / I_E, t = q % I_E;
            if (kind < 2) { const int kb = t / 48, nb = t % 48;
                transpose_item((kind ? inp(F.lds, 25) : inp(F.lds, 24)) + ((size_t)l * NE + e) * 1024 * FF, FF, FF, 64 * kb, 32 * nb, (bf16*)(F.ws + WS_WTGU) + (size_t)l * NE * 3072 * 1024, 1024, MapGU{e * 3072, kind}, scr, I.lane); }
            else { const int kb = t / 32, nb = t % 32;
                transpose_item(inp(F.lds, 26) + ((size_t)l * NE + e) * FF * 1024, 1024, 1024, 64 * kb, 32 * nb, (bf16*)(F.ws + WS_WTDN) + (size_t)l * NE * 1024 * FF, FF, MapId{e * 1024}, scr, I.lane); }
        }
    }
}

struct ConvRaw { float t[32]; bf16* dp; };
__device__ __forceinline__ void conv_issue(const LAS unsigned char* lds, unsigned char* ws, int l, int idx, int lane, ConvRaw& C) {
    const int e = idx / 2304, q = idx % 2304, kind = q / 768, t = q % 768;
    const float* sp; size_t ldw;
    if (kind < 2) { const int kb = t / 24, nb = t % 24, n = 64 * nb + lane; ldw = FF;
        sp = (kind ? inp(lds, 25) : inp(lds, 24)) + ((size_t)l * NE + e) * 1024 * FF + (size_t)(32 * kb) * FF + n;
        C.dp = (bf16*)(ws + WS_WTGU) + (size_t)l * NE * 3072 * 1024 + (size_t)MapGU{e * 3072, kind}(n) * 1024 + 32 * kb; }
    else { const int kb = t / 16, nb = t % 16, n = 64 * nb + lane; ldw = 1024;
        sp = inp(lds, 26) + ((size_t)l * NE + e) * FF * 1024 + (size_t)(32 * kb) * 1024 + n;
        C.dp = (bf16*)(ws + WS_WTDN) + (size_t)l * NE * 1024 * FF + (size_t)(e * 1024 + n) * FF + 32 * kb; }
#pragma unroll
    for (int i = 0; i < 32; ++i) C.t[i] = __builtin_nontemporal_load(sp + (size_t)i * ldw);
}
__device__ __forceinline__ void conv_finish(const ConvRaw& C) {
#pragma unroll
    for (int q = 0; q < 4; ++q) { v4u o; o.x = pg8::cvt_pk_bf16(C.t[8 * q], C.t[8 * q + 1]); o.y = pg8::cvt_pk_bf16(C.t[8 * q + 2], C.t[8 * q + 3]); o.z = pg8::cvt_pk_bf16(C.t[8 * q + 4], C.t[8 * q + 5]); o.w = pg8::cvt_pk_bf16(C.t[8 * q + 6], C.t[8 * q + 7]);
        *(v4u*)(C.dp + 8 * q) = o; }
}
__device__ __forceinline__ void load_row_f32(const float* p, int lane, f32x4 (&v)[4]) {
#pragma unroll
    for (int j = 0; j < 4; ++j) v[j] = *(const f32x4*)(p + 4 * lane + 256 * j);
}
__device__ __forceinline__ void load_row_bf16(const bf16* p, int lane, f32x4 (&v)[4]) {
#pragma unroll
    for (int j = 0; j < 4; ++j) v[j] = ld_bf4(p + 4 * lane + 256 * j);
}
__device__ __forceinline__ float row_sumsq(const f32x4 (&v)[4], int lane) { float s = 0.f;
#pragma unroll
    for (int j = 0; j < 4; ++j) s += (v[j].x * v[j].x + v[j].y * v[j].y) + (v[j].z * v[j].z + v[j].w * v[j].w);
    return wave_sum(s, lane); }
__device__ __forceinline__ void add_expert_out(f32x4 (&v)[4], int r, int lane, const int* slotmap, const float* afft, const bf16* EO, const float* g2, float esc = 1.0f) {
    f32x4 acc[4];
#pragma unroll
    for (int j = 0; j < 4; ++j) acc[j] = (f32x4){0.f, 0.f, 0.f, 0.f};
    const int sl = lane < NE ? slotmap[r * 16 + lane] : -1;
    const float af = lane < NE ? afft[(size_t)r * NE + lane] : 0.f;
    unsigned mask = (unsigned)__ballot(sl >= 0);
    while (mask) {
        v2u w[4][4]; float a[4];
#pragma unroll
        for (int q = 0; q < 4; ++q) {
            const bool on = mask != 0u; const int e = on ? __builtin_ctz(mask) : 0; if (on) mask &= mask - 1u;
            const int slot = __builtin_amdgcn_readlane(sl, e); a[q] = on ? __int_as_float(__builtin_amdgcn_readlane(__float_as_int(af), e)) : 0.f;
            const bf16* er = EO + (size_t)(on ? slot : 0) * 1024;
#pragma unroll
            for (int j = 0; j < 4; ++j) w[q][j] = on ? *(const v2u*)(er + 4 * lane + 256 * j) : (v2u){0u, 0u};
        }
#pragma unroll
        for (int q = 0; q < 4; ++q)
#pragma unroll
            for (int j = 0; j < 4; ++j) acc[j] += a[q] * (f32x4){bf_lo(w[q][j].x), bf_hi(w[q][j].x), bf_lo(w[q][j].y), bf_hi(w[q][j].y)};
    }
#pragma unroll
    for (int j = 0; j < 4; ++j) v[j] += *(const f32x4*)(g2 + 4 * lane + 256 * j) * esc * acc[j];
}
__device__ __forceinline__ void p1_norm1(const Frame& F_, int l, float esc) {
    const Frame F = fresh_frame(F_); const Ids I = fresh_ids(F.wave_s);
    const int gw = F.vcu * NWAVES + I.wave, NGW = F.G * NWAVES;
    bf16* H = (bf16*)(F.ws + WS_H); bf16* HN = (bf16*)(F.ws + WS_HN);
    const float* MOD = (const float*)(F.ws + WS_MOD); const float* nw = inp(F.lds, 6) + l * 1024;
    const float* xin = inp(F.lds, 0); const float* cin = inp(F.lds, 2);
    ConvRaw CR; const bool xtile = CONV_IN_SCAN && l == 1;
    if (xtile) conv_issue(F.lds, F.ws, l, (F.vcu * NWAVES + I.wave) * 18 + 17, I.lane, CR);
    constexpr int RB = 3;
    for (int r0 = gw; r0 < NROWS; r0 += NGW * RB) {
        f32x4 v[RB][4];
#pragma unroll
        for (int q = 0; q < RB; ++q) { const int r = r0 + q * NGW; if (r < NROWS) {
            if (l == 0) load_row_f32(r < NLAT ? xin + (size_t)r * D : cin + (size_t)(r - NLAT) * D, I.lane, v[q]); else load_row_bf16(H + (size_t)r * D, I.lane, v[q]); } }
#pragma unroll
        for (int q = 0; q < RB; ++q) { const int r = r0 + q * NGW; if (r < NROWS) {
            const int s = row_sample(r);
            if (l != 0) add_expert_out(v[q], r, I.lane, (const int*)(F.ws + WS_SLOT), (const float*)(F.ws + WS_AFFT), (const bf16*)(F.ws + WS_O2), MOD + ((size_t)(l - 1) * 9 + s) * MODW + 5120, esc);
            const float rstd = 1.0f / sqrtf(row_sumsq(v[q], I.lane) * (1.0f / D) + EPS);
            const float* m = MOD + ((size_t)l * 9 + s) * MODW;
#pragma unroll
            for (int j = 0; j < 4; ++j) { const int k = 4 * I.lane + 256 * j;
                if (l != 0) st_bf4(H + (size_t)r * D + k, v[q][j]);
                const f32x4 w = *(const f32x4*)(nw + k), sh = *(const f32x4*)(m + k), sc = *(const f32x4*)(m + 1024 + k);
                st_bf4(HN + (size_t)r * D + k, (v[q][j] * rstd * w) * (sc + 1.0f) + sh); } } }
    }
    if (xtile) conv_finish(CR);
}
__device__ __forceinline__ void p_final(const Frame& F_, float* out) {
    const Frame F = fresh_frame(F_); const Ids I = fresh_ids(F.wave_s);
    const int gw = F.vcu * NWAVES + I.wave, NGW = F.G * NWAVES;
    const bf16* H = (const bf16*)(F.ws + WS_H); const float* MOD = (const float*)(F.ws + WS_MOD); const float* nw = inp(F.lds, 27);
    constexpr int RB = 2;
    for (int r0 = gw; r0 < NLAT; r0 += NGW * RB) {
        f32x4 v[RB][4];
#pragma unroll
        for (int q = 0; q < RB; ++q) { const int r = r0 + q * NGW; if (r < NLAT) load_row_bf16(H + (size_t)r * D, I.lane, v[q]); }
#pragma unroll
        for (int q = 0; q < RB; ++q) { const int r = r0 + q * NGW; if (r < NLAT) {
            const int s = row_sample(r);
            add_expert_out(v[q], r, I.lane, (const int*)(F.ws + WS_SLOT), (const float*)(F.ws + WS_AFFT), (const bf16*)(F.ws + WS_O2), MOD + ((size_t)1 * 9 + s) * MODW + 5120);
            const float rstd = 1.0f / sqrtf(row_sumsq(v[q], I.lane) * (1.0f / D) + EPS);
#pragma unroll
            for (int j = 0; j < 4; ++j) { const int k = 4 * I.lane + 256 * j; *(f32x4*)(out + (size_t)r * D + k) = v[q][j] * rstd * *(const f32x4*)(nw + k); } } }
    }
}
__device__ __forceinline__ void p6_norm2_router(const Frame& F_, int l, int nrows) {
    const Frame F = fresh_frame(F_); const Ids I = fresh_ids(F.wave_s);
    const int gw = F.vcu * NWAVES + I.wave, NGW = F.G * NWAVES;
    const bf16* H = (const bf16*)(F.ws + WS_H); bf16* HN = (bf16*)(F.ws + WS_HN); float* AFFT = (float*)(F.ws + WS_AFFT);
    const float* MOD = (const float*)(F.ws + WS_MOD); const float* nw = inp(F.lds, 7) + l * 1024; const float* rw = inp(F.lds, 23) + (size_t)l * 1024 * NE;
    LAS float* wt = (LAS float*)F.lds;
    for (int i = I.tid; i < 1024 * 4; i += 512) { const int k = i >> 2, q = i & 3; const f32x4 w = *(const f32x4*)(rw + k * 16 + 4 * q);
        wt[(4 * q + 0) * 1024 + k] = w.x; wt[(4 * q + 1) * 1024 + k] = w.y; wt[(4 * q + 2) * 1024 + k] = w.z; wt[(4 * q + 3) * 1024 + k] = w.w; }
    __syncthreads();
    const int lane = I.lane;
    const int myexp = ((lane >> 5) & 1) * 8 + ((lane >> 4) & 1) * 4 + ((lane >> 3) & 1) * 2 + ((lane >> 2) & 1);
    constexpr int RB = 2;
    for (int r0 = gw; r0 < nrows; r0 += NGW * RB) {
        f32x4 v[RB][4];
#pragma unroll
        for (int q = 0; q < RB; ++q) { const int r = r0 + q * NGW; if (r < nrows) load_row_bf16(H + (size_t)r * D, lane, v[q]); }
#pragma unroll
        for (int q = 0; q < RB; ++q) { const int r = r0 + q * NGW; if (r < nrows) {
            const int s = row_sample(r);
            const float rstd = 1.0f / sqrtf(row_sumsq(v[q], I.lane) * (1.0f / D) + EPS);
            const float* m = MOD + ((size_t)l * 9 + s) * MODW;
#pragma unroll
            for (int j = 0; j < 4; ++j) { const int k = 4 * lane + 256 * j;
                const f32x4 w = *(const f32x4*)(nw + k), sh = *(const f32x4*)(m + 3072 + k), sc = *(const f32x4*)(m + 4096 + k);
                v[q][j] = (v[q][j] * rstd * w) * (sc + 1.0f) + sh;
                st_bf4(HN + (size_t)r * D + k, v[q][j]); }
            float p[NE];
#pragma unroll
            for (int e = 0; e < NE; ++e) { float a = 0.f;
#pragma unroll
                for (int j = 0; j < 4; ++j) { const f32x4 w = *(const LAS f32x4*)(wt + e * 1024 + 4 * lane + 256 * j); a += (v[q][j].x * w.x + v[q][j].y * w.y) + (v[q][j].z * w.z + v[q][j].w * w.w); }
                p[e] = a; }
            float a8[8], a4[4], a2[2], a1;
            { const bool hi = (lane & 32) != 0;
#pragma unroll
              for (int i = 0; i < 8; ++i) { const float send = hi ? p[i] : p[8 + i], keep = hi ? p[8 + i] : p[i]; a8[i] = keep + shx(send, 32, lane); } }
            { const bool hi = (lane & 16) != 0;
#pragma unroll
              for (int i = 0; i < 4; ++i) { const float send = hi ? a8[i] : a8[4 + i], keep = hi ? a8[4 + i] : a8[i]; a4[i] = keep + shx(send, 16, lane); } }
            { const bool hi = (lane & 8) != 0;
#pragma unroll
              for (int i = 0; i < 2; ++i) { const float send = hi ? a4[i] : a4[2 + i], keep = hi ? a4[2 + i] : a4[i]; a2[i] = keep + shx(send, 8, lane); } }
            { const bool hi = (lane & 4) != 0; const float send = hi ? a2[0] : a2[1], keep = hi ? a2[1] : a2[0]; a1 = keep + shx(send, 4, lane); }
            a1 += shx(a1, 2, lane); a1 += shx(a1, 1, lane);
            float mx = a1;
            mx = fmaxf(mx, shx(mx, 4, lane)); mx = fmaxf(mx, shx(mx, 8, lane)); mx = fmaxf(mx, shx(mx, 16, lane)); mx = fmaxf(mx, shx(mx, 32, lane));
            const float ex = expf(a1 - mx); float den = ex;
            den += shx(den, 4, lane); den += shx(den, 8, lane); den += shx(den, 16, lane); den += shx(den, 32, lane);
            if ((lane & 3) == 0) AFFT[(size_t)r * NE + myexp] = ex / den; } }
    }
    __syncthreads();
}
__device__ __forceinline__ int block_excl_scan(int v, LAS int* wsum, int lane, int wave, int& total) {
    int inc = v;
#pragma unroll
    for (int off = 1; off < 64; off <<= 1) { const int o = shidx_i(inc, (lane - off) & 63); if (lane >= off) inc += o; }
    if (lane == 63) wsum[wave] = inc;
    __syncthreads();
    int base = 0, tot = 0;
#pragma unroll
    for (int w = 0; w < 8; ++w) { const int s = wsum[w]; base += (w < wave) ? s : 0; tot += s; }
    __syncthreads();
    total = tot; return base + inc - v;
}
__device__ __forceinline__ void p7_topk(const Frame& F_, int l) {
    const Frame F = fresh_frame(F_); const Ids I = fresh_ids(F.wave_s);
    const float* AFFT = (const float*)(F.ws + WS_AFFT); int* SLOT = (int*)(F.ws + WS_SLOT);
    int* IDXG = (int*)(F.ws + WS_SLOT + 1179648);
    LAS unsigned* hist = (LAS unsigned*)F.lds;
    LAS unsigned* misc = hist + 256;
    LAS int* wsum = (LAS int*)(hist + 264);
    const int nitems = (l == 0 ? 16 : 8) * NE;
    for (int item = F.vcu; item < nitems; item += F.G) {
        const int set = item >> 4, e = item & 15;
        const int n = set < 8 ? SEQ : CTXL, cap = n >> 3;
        const int row0 = set < 8 ? set * SEQ : NLAT + (set - 8) * CTXL, slotbase = set < 8 ? set * 256 : 2048 + (set - 8) * 32;
        unsigned key[4]; const int i0 = 4 * I.tid; const bool valid = i0 < n;
        { f32x4 a = (f32x4){0.f, 0.f, 0.f, 0.f}; if (valid) { const float* ap = AFFT + (size_t)(row0 + i0) * NE + e; a = (f32x4){ap[0], ap[NE], ap[2 * NE], ap[3 * NE]}; }
          key[0] = __float_as_uint(a.x); key[1] = __float_as_uint(a.y); key[2] = __float_as_uint(a.z); key[3] = __float_as_uint(a.w); }
        unsigned prefix = 0u, kk = (unsigned)cap;
        for (int pass = 3; pass >= 0; --pass) {
            const int shift = 8 * pass;
            if (I.tid < 256) hist[I.tid] = 0u;
            __syncthreads();
            if (valid) {
#pragma unroll
                for (int j = 0; j < 4; ++j) { const bool match = pass == 3 || ((key[j] >> (shift + 8)) == (prefix >> (shift + 8)));
                    if (match) atomicAdd((unsigned*)&hist[(key[j] >> shift) & 255u], 1u); }
            }
            __syncthreads();
            if (I.wave == 0) {
                const unsigned h0 = hist[4 * I.lane], h1 = hist[4 * I.lane + 1], h2 = hist[4 * I.lane + 2], h3 = hist[4 * I.lane + 3];
                const unsigned s = h0 + h1 + h2 + h3; unsigned t = s;
#pragma unroll
                for (int off = 1; off < 64; off <<= 1) { const unsigned o = (unsigned)shidx_i((int)t, (I.lane + off) & 63); if (I.lane + off < 64) t += o; }
                const unsigned above = t - s, c3 = above + h3, c2 = c3 + h2, c1 = c2 + h1, c0 = c1 + h0;
                int d = -1; unsigned nk = 0u;
                if (above < kk && c3 >= kk) { d = 3; nk = kk - above; }
                else if (c3 < kk && c2 >= kk) { d = 2; nk = kk - c3; }
                else if (c2 < kk && c1 >= kk) { d = 1; nk = kk - c2; }
                else if (c1 < kk && c0 >= kk) { d = 0; nk = kk - c1; }
                if (d >= 0) { misc[0] = prefix | ((unsigned)(4 * I.lane + d) << shift); misc[1] = nk; }
            }
            __syncthreads();
            prefix = misc[0]; kk = misc[1];
        }
        int ceq = 0; bool gt[4], eq[4];
#pragma unroll
        for (int j = 0; j < 4; ++j) { gt[j] = valid && key[j] > prefix; eq[j] = valid && key[j] == prefix; ceq += eq[j] ? 1 : 0; }
        int tot; int erank = block_excl_scan(ceq, wsum, I.lane, I.wave, tot);
        bool sel[4]; int csel = 0;
#pragma unroll
        for (int j = 0; j < 4; ++j) { sel[j] = gt[j] || (eq[j] && (unsigned)erank < kk); erank += eq[j] ? 1 : 0; csel += sel[j] ? 1 : 0; }
        int slot = block_excl_scan(csel, wsum, I.lane, I.wave, tot);
        if (valid) {
#pragma unroll
            for (int j = 0; j < 4; ++j) { const int r = row0 + i0 + j;
                if (sel[j]) { if (slot < cap) { IDXG[e * SLOTS + slotbase + slot] = r; SLOT[r * 16 + e] = e * SLOTS + slotbase + slot; } else SLOT[r * 16 + e] = -1; ++slot; }
                else SLOT[r * 16 + e] = -1; }
        }
        __syncthreads();
    }
}

typedef short bf16x8s __attribute__((ext_vector_type(8)));
typedef short s16x4 __attribute__((ext_vector_type(4)));
constexpr int IMGB = 9216;
constexpr int CS_SET = 4 * IMGB + 1024;
constexpr int CS_P = 2 * CS_SET, CS_ST = CS_P + IMGB, CS_NS = CS_ST + 2 * IMGB, CS_GS = CS_NS + 256, CS_GM = CS_GS + 2048, CS_END = CS_GM + 8192;
static_assert(CS_END <= RING_BYTES, "scan LDS map");
__device__ __forceinline__ bf16x8s rowfrag(const LAS unsigned char* img, int row0, int ks, int fr, int fq) { return *(const LAS bf16x8s*)(img + (row0 + fr) * 144 + ks * 64 + fq * 16); }
__device__ __forceinline__ s16x4 tr_rd(const LAS unsigned char* p) { return __builtin_bit_cast(s16x4, __builtin_amdgcn_ds_read_tr16_b64_v4i16((LAS s16x4*)(LAS unsigned char*)p)); }
__device__ __forceinline__ bf16x8s trfrag(const LAS unsigned char* img, int tok0, int col0, int lane) {
    const LAS unsigned char* a = img + (tok0 + 8 * (lane >> 4) + ((lane >> 2) & 3)) * 144 + (col0 + 4 * (lane & 3)) * 2;
    const s16x4 lo = tr_rd(a), hi = tr_rd(a + 4 * 144);
    return (bf16x8s){lo[0], lo[1], lo[2], lo[3], hi[0], hi[1], hi[2], hi[3]};
}
__device__ __forceinline__ f32x4 mfma16(bf16x8s a, bf16x8s b, f32x4 c) { return __builtin_amdgcn_mfma_f32_16x16x32_bf16(a, b, c, 0, 0, 0); }
struct f32x8 { f32x4 a, b; };
__device__ __forceinline__ f32x8 cvt8(v4u w) { f32x8 r; r.a = (f32x4){bf_lo(w.x), bf_hi(w.x), bf_lo(w.y), bf_hi(w.y)}; r.b = (f32x4){bf_lo(w.z), bf_hi(w.z), bf_lo(w.w), bf_hi(w.w)}; return r; }
__device__ __forceinline__ v4u pack8(f32x4 a, f32x4 b) { v4u w; w.x = pg8::cvt_pk_safe(a.x, a.y); w.y = pg8::cvt_pk_safe(a.z, a.w); w.z = pg8::cvt_pk_safe(b.x, b.y); w.w = pg8::cvt_pk_safe(b.z, b.w); return w; }
__device__ __forceinline__ float silu_q(float x) { return x * __builtin_amdgcn_rcpf(1.0f + __expf(-x)); }
__device__ __forceinline__ float sigmoid_q(float x) { return __builtin_amdgcn_rcpf(1.0f + __expf(-x)); }
__device__ __forceinline__ float log_sigmoid_q(float z) { return fminf(z, 0.f) - __logf(1.0f + __expf(-fabsf(z))); }
__device__ __forceinline__ float softplus_q(float x) { return fmaxf(x, 0.f) + __logf(1.0f + __expf(-fabsf(x))); }
template <int N> __device__ __forceinline__ float dpp_row_shr(float v) { return __int_as_float(__builtin_amdgcn_update_dpp(0, __float_as_int(v), 0x110 + N, 0xf, 0xf, true)); }
__device__ __forceinline__ float rdlane(float v, int l) { return __int_as_float(__builtin_amdgcn_readlane(__float_as_int(v), l)); }
__device__ __forceinline__ float wave_incl_scan(float v, int lane) {
    v += dpp_row_shr<1>(v); v += dpp_row_shr<2>(v); v += dpp_row_shr<4>(v); v += dpp_row_shr<8>(v);
    const float t0 = rdlane(v, 15), t1 = rdlane(v, 31), t2 = rdlane(v, 47); const int row = lane >> 4;
    return v + ((row >= 1 ? t0 : 0.f) + (row >= 2 ? t1 : 0.f) + (row >= 3 ? t2 : 0.f));
}
constexpr size_t WS_UC = 701 * MiB, WS_LA = 719 * MiB, WS_END3 = 737 * MiB;
__device__ __forceinline__ void p2t_pretransform(const Frame& F_, int l, bool inplace) {
    const Frame F = fresh_frame(F_); const Ids I = fresh_ids(F.wave_s);
    const int gw = F.vcu * NWAVES + I.wave, NGW = F.G * NWAVES, lane = I.lane;
    bf16* U = (bf16*)(F.ws + WS_U); bf16* UC = (bf16*)(F.ws + WS_UC); float* LA = (float*)(F.ws + WS_LA);
    f32x4 cwa[5], cwb[5], cba, cbb;
    { const float* cw = inp(F.lds, 15) + (size_t)l * 5 * 512 + 8 * lane; const float* cb = inp(F.lds, 16) + l * 512 + 8 * lane;
#pragma unroll
      for (int w = 0; w < 5; ++w) { cwa[w] = *(const f32x4*)(cw + w * 512); cwb[w] = *(const f32x4*)(cw + w * 512 + 4); }
      cba = *(const f32x4*)cb; cbb = *(const f32x4*)(cb + 4); }
    f32x4 gwv[16], gbv;
    { const float* gwp = inp(F.lds, 12) + (size_t)l * 4096 + (lane >> 5) * 2048 + ((4 * lane) & 127);
#pragma unroll
      for (int r = 0; r < 16; ++r) gwv[r] = *(const f32x4*)(gwp + r * 128);
      gbv = *(const f32x4*)(inp(F.lds, 13) + l * 256 + 4 * lane); }
    const int rc = (8 * lane) & 255, rd0 = rc & 63; const bool isq = lane < 32, first = (rd0 & 31) < 16; const int plane = first ? lane + 2 : lane - 2;
    float invf[8];
#pragma unroll
    for (int j = 0; j < 8; ++j) invf[j] = exp2f(-(float)((rd0 & 15) + j) * (13.287712379549449f / 16.0f)) * 0.15915494309189535f;
    constexpr int RB = 2;
    for (int r0 = gw; r0 < NROWS; r0 += NGW * RB) {
        v4u qk[RB], tap[RB][5], lr0[RB], lr1[RB], mk[RB];
#pragma unroll
        for (int q = 0; q < RB; ++q) { const int r = r0 + q * NGW; if (r < NROWS) {
            const bool isctx = r >= NLAT; const int t = isctx ? ((r - NLAT) & (CTXL - 1)) : (r & (SEQ - 1)), len = isctx ? CTXL : SEQ; const size_t rb = (size_t)(r - t);
            const bf16* ur = U + (size_t)r * INP;
            qk[q] = *(const v4u*)(ur + 8 * lane);
#pragma unroll
            for (int w = 0; w < 5; ++w) { const int tt = t + w - 2; const bool ok = tt >= 0 && tt < len; const v4u x = *(const v4u*)(U + (rb + (ok ? tt : t)) * INP + C_SSD + 256 + 8 * lane); tap[q][w] = ok ? x : (v4u){0u, 0u, 0u, 0u}; }
            lr0[q] = *(const v4u*)(ur + C_GLA + 768); lr1[q] = *(const v4u*)(ur + C_GLA + 776);
            mk[q] = (v4u){0u, 0u, 0u, 0u}; if (lane < 32) mk[q] = *(const v4u*)(ur + C_ML + 256 + 8 * lane); } }
#pragma unroll
        for (int q = 0; q < RB; ++q) { const int r = r0 + q * NGW; if (r < NROWS) {
            const bool isctx = r >= NLAT; const int t = isctx ? ((r - NLAT) & (CTXL - 1)) : (r & (SEQ - 1));
            bf16* ur = U + (size_t)r * INP;
            { f32x8 own = cvt8(qk[q]); v4u pq; pq.x = (unsigned)shidx_i((int)qk[q].x, plane); pq.y = (unsigned)shidx_i((int)qk[q].y, plane); pq.z = (unsigned)shidx_i((int)qk[q].z, plane); pq.w = (unsigned)shidx_i((int)qk[q].w, plane);
              const f32x8 par = cvt8(pq); const float sc = isq ? 0.125f : 1.0f;
              if (!isctx) { const float posv = (rd0 < 32) ? (float)(t >> 6) : (float)(t & 63);
#pragma unroll
                  for (int j = 0; j < 8; ++j) { const float rev = posv * invf[j]; const float cs = __builtin_amdgcn_cosf(rev), sn = __builtin_amdgcn_sinf(rev);
                      const float o = j < 4 ? own.a[j & 3] : own.b[j & 3], p = j < 4 ? par.a[j & 3] : par.b[j & 3]; const float n = (first ? o * cs - p * sn : p * sn + o * cs) * sc;
                      if (j < 4) own.a[j & 3] = n; else own.b[j & 3] = n; } }
              else { own.a = own.a * sc; own.b = own.b * sc; }
              const v4u ow = pack8(own.a, own.b); if (inplace) *(v4u*)(ur + 8 * lane) = ow; else asm volatile("" :: "v"(ow)); }
            { f32x4 a0 = cba, a1 = cbb;
#pragma unroll
              for (int w = 0; w < 5; ++w) { const f32x8 x = cvt8(tap[q][w]); a0 += x.a * cwa[w]; a1 += x.b * cwb[w]; }
#pragma unroll
              for (int j = 0; j < 4; ++j) { a0[j] = silu_q(a0[j]); a1[j] = silu_q(a1[j]); }
              *(v4u*)(UC + (size_t)r * 512 + 8 * lane) = pack8(a0, a1); }
            { const f32x8 l0 = cvt8(lr0[q]), l1 = cvt8(lr1[q]); f32x4 z = gbv;
#pragma unroll
              for (int qq = 0; qq < 4; ++qq) { z += gwv[qq] * l0.a[qq] + gwv[4 + qq] * l0.b[qq] + gwv[8 + qq] * l1.a[qq] + gwv[12 + qq] * l1.b[qq]; }
              f32x4 o;
#pragma unroll
              for (int j = 0; j < 4; ++j) o[j] = log_sigmoid_q(z[j]) * (1.0f / 16.0f);
              *(f32x4*)(LA + (size_t)r * 256 + 4 * lane) = o; }
            if (lane < 32) { f32x8 kk = cvt8(mk[q]); kk.a = kk.a * 0.125f; kk.b = kk.b * 0.125f; const v4u kw = pack8(kk.a, kk.b); if (inplace) *(v4u*)(ur + C_ML + 256 + 8 * lane) = kw; else asm volatile("" :: "v"(kw)); } } }
    }
}

constexpr size_t WS_NIN = WS_AFFT + 1179648;
constexpr int S1_SET = 2 * IMGB + 256, S1_GS = 2 * S1_SET, S1_GM = S1_GS + 2048, S1_END = S1_GM + 8192;
struct StRaw { v4u r[10]; float s0, s1; };
__device__ __forceinline__ int nat_chunk(int cc, int dir) { return cc < 4 ? (dir ? 3 - cc : cc) : (dir ? 35 - cc : cc - 4); }

template <int MIX>
__device__ __forceinline__ void state_item(const Frame& F, const Ids& I, int l, int b, int h, int dir, int item) {
    const bf16* U = (const bf16*)(F.ws + WS_U); bf16* SIN = (bf16*)(F.ws + WS_O2) + (size_t)item * 36 * 4096;
    float* NIN = (float*)(F.ws + WS_NIN) + (size_t)((b * 4 + h) * 2 + dir) * 36 * 64;
    LAS unsigned char* sm = F.lds;
    const int lane = I.lane, wave = I.wave, fr = lane & 15, fq = lane >> 4, rt = wave >> 1, cp = wave & 1;
    const int tk = I.tid >> 3, d0 = (I.tid & 7) * 8;
    float c_la = 0.f, c_b0 = 0.f, c_b1 = 0.f;
    if (MIX == 0) c_la = log_sigmoid_f(inp(F.lds, 10)[(l * 2 + dir) * 4 + h]);
    if (MIX == 2) { c_b0 = inp(F.lds, 17)[(l * 2 + dir) * 4 + h]; c_b1 = -expf(inp(F.lds, 18)[(l * 2 + dir) * 4 + h]); }
    if (MIX == 3) { c_b0 = inp(F.lds, 21)[((l * 2 + dir) * 2 + 0) * 4 + h]; c_b1 = inp(F.lds, 21)[((l * 2 + dir) * 2 + 1) * 4 + h]; }
    float invf[8];
#pragma unroll
    for (int j = 0; j < 8; ++j) invf[j] = MIX == 0 ? exp2f(-(float)((d0 & 15) + j) * (13.287712379549449f / 16.0f)) * 0.15915494309189535f : 0.f;
    float gwr[16]; float gbr = 0.f;
    if (MIX == 1) { const float* gw_ = inp(F.lds, 12) + (size_t)(l * 2 + dir) * 16 * 128 + h * 32 + (I.tid & 31);
#pragma unroll
        for (int r = 0; r < 16; ++r) gwr[r] = gw_[r * 128];
        gbr = inp(F.lds, 13)[(l * 2 + dir) * 128 + h * 32 + (I.tid & 31)]; }
    if (MIX == 2) {
        LAS float* cwl = (LAS float*)(sm + S1_GM); const float* cw = inp(F.lds, 15) + (size_t)l * 5 * 512; const float* cb = inp(F.lds, 16) + l * 512; const int g = h >> 1;
        for (int i = I.tid; i < 6 * 128; i += 512) { const int w = i >> 7, c = i & 127; const int ch = c < 64 ? h * 64 + c : 256 + g * 64 + (c - 64); cwl[i] = w < 5 ? cw[w * 512 + ch] : cb[ch]; }
    }
    f32x4 S[2], nst; S[0] = (f32x4){0.f, 0.f, 0.f, 0.f}; S[1] = S[0]; nst = S[0];
    __syncthreads();

    const bf16* UC = (const bf16*)(F.ws + WS_UC); const float* LA = (const float*)(F.ws + WS_LA);
    auto issue = [&](int cc, StRaw& R) {
        const bool isctx = cc < 4; const int rowbase = isctx ? NLAT + b * CTXL : b * SEQ, t0 = 64 * nat_chunk(cc, dir);
        const int t = t0 + tk; const bf16* ur = U + (size_t)(rowbase + t) * INP; const bf16* ul = U + (size_t)(rowbase + t0 + lane) * INP;
        if (MIX == 0) { R.r[0] = *(const v4u*)(ur + C_RET + 256 + h * 64 + d0); R.r[1] = *(const v4u*)(ur + C_RET + 512 + h * 64 + d0); }
        else if (MIX == 1) {
            R.r[1] = *(const v4u*)(ur + C_GLA + 256 + h * 64 + d0); R.r[0] = d0 < 32 ? *(const v4u*)(ur + C_GLA + 128 + h * 32 + d0) : (v4u){0u, 0u, 0u, 0u};
            const int tq = I.tid >> 5, d = I.tid & 31; v4u lf;
            lf.x = __float_as_uint(LA[(size_t)(rowbase + t0 + 4 * tq + 0) * 256 + dir * 128 + h * 32 + d]); lf.y = __float_as_uint(LA[(size_t)(rowbase + t0 + 4 * tq + 1) * 256 + dir * 128 + h * 32 + d]);
            lf.z = __float_as_uint(LA[(size_t)(rowbase + t0 + 4 * tq + 2) * 256 + dir * 128 + h * 32 + d]); lf.w = __float_as_uint(LA[(size_t)(rowbase + t0 + 4 * tq + 3) * 256 + dir * 128 + h * 32 + d]); R.r[2] = lf;
        } else if (MIX == 2) { const int g = h >> 1; const bf16* uc = UC + (size_t)(rowbase + t) * 512;
            R.r[0] = *(const v4u*)(uc + 256 + g * 64 + d0); R.r[1] = *(const v4u*)(uc + h * 64 + d0);
            R.s0 = bf_lo((unsigned)ul[C_SSD + 768 + dir * 4 + h]);
        } else {
            R.r[0] = *(const v4u*)(ur + C_ML + 256 + h * 64 + d0); R.r[1] = *(const v4u*)(ur + C_ML + 512 + h * 64 + d0);
            R.s0 = bf_lo((unsigned)ul[C_ML + 1024 + dir * 8 + h]); R.s1 = bf_lo((unsigned)ul[C_ML + 1024 + dir * 8 + 4 + h]);
        }
    };
    auto finish = [&](int cc, const StRaw& R) {
        LAS unsigned char* set = sm + (cc & 1) * S1_SET; LAS float* ELs = (LAS float*)(set + 2 * IMGB);
        f32x8 k, kp;
        if (MIX != 1) {
            float la, w = 1.f;
            if (MIX == 0) la = c_la;
            else if (MIX == 2) { w = softplus_q(R.s0 + c_b0); la = w * c_b1; }
            else { w = __expf(R.s0 + c_b0); la = log_sigmoid_q(R.s1 + c_b1); }
            const float G = wave_incl_scan(la, lane), T = rdlane(G, 63);
            if (wave == 0) ELs[lane] = __expf(T);
            const float e_l = (dir ? __expf(G - la) : __expf(T - G)) * w;
            const float ck = shidx(e_l, tk);
            k = cvt8(R.r[0]);
            kp.a = k.a * ck; kp.b = k.b * ck;
        } else {
            LAS float* GS = (LAS float*)(sm + S1_GS); LAS float* GM = (LAS float*)(sm + S1_GM);
            const int d = I.tid & 31, tq = I.tid >> 5; float c[4], la4[4]; float run = 0.f;
            la4[0] = __uint_as_float(R.r[2].x); la4[1] = __uint_as_float(R.r[2].y); la4[2] = __uint_as_float(R.r[2].z); la4[3] = __uint_as_float(R.r[2].w);
#pragma unroll
            for (int u = 0; u < 4; ++u) { run += la4[u]; c[u] = run; }
            GS[tq * 32 + d] = run;
            __syncthreads();
            float off = 0.f, tot = 0.f;
#pragma unroll
            for (int qq = 0; qq < 16; ++qq) { const float s = GS[qq * 32 + d]; off += (qq < tq) ? s : 0.f; tot += s; }
#pragma unroll
            for (int u = 0; u < 4; ++u) GM[(4 * tq + u) * 32 + d] = dir ? (off + c[u] - la4[u]) : (tot - (off + c[u]));
            if (tq == 0) { ELs[d] = __expf(tot); ELs[32 + d] = 1.0f; }
            __syncthreads();
            k = cvt8(R.r[0]);
            if (d0 < 32) { const f32x4 g0 = *(const LAS f32x4*)(GM + tk * 32 + d0), g1 = *(const LAS f32x4*)(GM + tk * 32 + d0 + 4);
#pragma unroll
                for (int j = 0; j < 4; ++j) { kp.a[j] = k.a[j] * __expf(g0[j]); kp.b[j] = k.b[j] * __expf(g1[j]); } }
            else kp = k;
        }
        const int ro = tk * 144 + d0 * 2;
        *(LAS v4u*)(set + ro) = pack8(kp.a, kp.b); *(LAS v4u*)(set + IMGB + ro) = R.r[1];
    };

    StRaw Ra, Rb; ConvRaw CR;
    issue(0, Ra); issue(1, Rb); finish(0, Ra);
    const bf16x8s ones = (bf16x8s){0x3F80, 0x3F80, 0x3F80, 0x3F80, 0x3F80, 0x3F80, 0x3F80, 0x3F80};
    auto chunk_body = [&](const int cc, const int cmode, StRaw& Rfar, const StRaw& Rnext) {
        __syncthreads();
        if (cc + 2 < 36) issue(cc + 2, Rfar);
        if (cmode == 1) conv_issue(F.lds, F.ws, l, (F.vcu * NWAVES + wave) * 18 + (cc >> 2), lane, CR);
        const LAS unsigned char* set = sm + (cc & 1) * S1_SET; const LAS unsigned char* KPs = set; const LAS unsigned char* Vs = set + IMGB; const LAS float* ELs = (const LAS float*)(set + 2 * IMGB);
        { const int row = I.tid >> 3, pc = I.tid & 7; v4u sv = (v4u){0u, 0u, 0u, 0u};
          if (cc > 0) sv = *(const LAS v4u*)(sm + S1_END + (cc & 1) * IMGB + row * 144 + pc * 16);
          *(v4u*)(SIN + (size_t)cc * 4096 + row * 64 + pc * 8) = sv; }
        if (MIX == 3) { if (fr == 0 && cp == 0) *(f32x4*)(NIN + cc * 64 + 16 * rt + 4 * fq) = nst; }
        const bf16x8s kf0 = trfrag(KPs, 0, 16 * rt, lane), kf1 = trfrag(KPs, 32, 16 * rt, lane);
        const f32x4 el = *(const LAS f32x4*)(ELs + 16 * rt + 4 * fq);
#pragma unroll
        for (int u = 0; u < 2; ++u) { const int ct = 2 * cp + u; const bf16x8s v0 = trfrag(Vs, 0, 16 * ct, lane), v1 = trfrag(Vs, 32, 16 * ct, lane);
            S[u] = S[u] * el; S[u] = mfma16(kf0, v0, S[u]); S[u] = mfma16(kf1, v1, S[u]); }
        if (MIX == 3) { nst = nst * el; nst = mfma16(kf0, ones, nst); nst = mfma16(kf1, ones, nst); }
        if (cc + 1 < 36) {
#pragma unroll
            for (int u = 0; u < 2; ++u) { const int ct = 2 * cp + u; v2u sw; sw.x = pg8::cvt_pk_safe(S[u][0], S[u][1]); sw.y = pg8::cvt_pk_safe(S[u][2], S[u][3]);
                *(LAS v2u*)(sm + S1_END + ((cc + 1) & 1) * IMGB + (16 * ct + fr) * 144 + (16 * rt + 4 * fq) * 2) = sw; } }
        if (cc + 1 < 36) finish(cc + 1, Rnext);
        if (cmode == 2) conv_finish(CR);
    };
    for (int cc = 0; cc < 36; cc += 4) { chunk_body(cc, CONV_IN_SCAN ? 1 : 0, Ra, Rb); chunk_body(cc + 1, CONV_IN_SCAN ? 2 : 0, Rb, Ra); chunk_body(cc + 2, 0, Ra, Rb); chunk_body(cc + 3, 0, Rb, Ra); }
    __syncthreads();
}
__device__ __forceinline__ void p3a_state(const Frame& F_, int l) {
    const Frame F = fresh_frame(F_); const Ids I = fresh_ids(F.wave_s);
    for (int item = F.vcu; item < 256; item += F.G) {
        const int dir = item & 1, h = (item >> 1) & 3, mixer = (item >> 3) & 3, b = item >> 5;
        if (mixer == 0) state_item<0>(F, I, l, b, h, dir, item);
        else if (mixer == 1) state_item<1>(F, I, l, b, h, dir, item);
        else if (mixer == 2) state_item<2>(F, I, l, b, h, dir, item);
        else state_item<3>(F, I, l, b, h, dir, item);
    }
}

constexpr int S2_Q = 0, S2_K = IMGB, S2_V = 2 * IMGB, S2_P = 3 * IMGB, S2_P2 = 4 * IMGB, S2_STF = 5 * IMGB, S2_STB = 6 * IMGB, S2_ARR = 7 * IMGB, S2_NV = S2_ARR + 1024, S2_STAT = S2_NV + 256,
              S2_GS = S2_STAT + 1024, S2_GM = S2_GS + 4096, S2_END = S2_GM + 16384;
constexpr int S2_CST = S2_END, S2_CST_END = S2_CST + 5440 * 4;
static_assert(S2_CST_END <= RING_BYTES && S1_END + 2 * IMGB <= RING_BYTES, "mixer LDS maps");
struct OutAcc { f32x4 y[2]; };
struct HRaw { v4u r[7]; v2u g[2]; float s[4]; };
struct HItem { int mix, b, h, nc, isctx, last; };

template <int MIX>
__device__ __forceinline__ void s2_issue(const Frame& F, const Ids&, int l, const HItem& it, HRaw& R) {
    const Ids I = fresh_ids(F.wave_s);
    const bf16* U = (const bf16*)(F.ws + WS_U); const bf16* SINB = (const bf16*)(F.ws + WS_O2); const float* NINB = (const float*)(F.ws + WS_NIN);
    const int lane = I.lane, wave = I.wave, fr = lane & 15, fq = lane >> 4, rt = wave >> 1, cp = wave & 1, tk = I.tid >> 3, d0 = (I.tid & 7) * 8;
    const int b = it.b, h = it.h, nc = it.nc; const bool isctx = it.isctx;
    const int len = isctx ? CTXL : SEQ, rowbase = isctx ? NLAT + b * CTXL : b * SEQ, t0 = 64 * nc, t = t0 + tk;
    const int item_f = b * 32 + MIX * 8 + h * 2, cc_f = isctx ? nc : 4 + nc, cc_b = isctx ? 3 - nc : 35 - nc;
    const bf16* ur = U + (size_t)(rowbase + t) * INP; const bf16* ul = U + (size_t)(rowbase + t0 + lane) * INP;
    const int row = I.tid >> 3, pc = I.tid & 7;
    const int orow = rowbase + t0 + 16 * rt + fr;
    if (MIX == 0) {
        R.r[0] = *(const v4u*)(ur + C_RET + h * 64 + d0); R.r[1] = *(const v4u*)(ur + C_RET + 256 + h * 64 + d0); R.r[2] = *(const v4u*)(ur + C_RET + 512 + h * 64 + d0);
        R.r[5] = *(const v4u*)(SINB + ((size_t)item_f * 36 + cc_f) * 4096 + row * 64 + 8 * pc); R.r[6] = *(const v4u*)(SINB + ((size_t)(item_f + 1) * 36 + cc_b) * 4096 + row * 64 + 8 * pc);
#pragma unroll
        for (int u = 0; u < 2; ++u) R.g[u] = *(const v2u*)(U + (size_t)orow * INP + C_RET + 768 + h * 64 + 16 * (2 * cp + u) + 4 * fq);
    } else if (MIX == 1) {
        R.r[2] = *(const v4u*)(ur + C_GLA + 256 + h * 64 + d0);
        if (d0 < 32) { R.r[0] = *(const v4u*)(ur + C_GLA + h * 32 + d0); R.r[1] = *(const v4u*)(ur + C_GLA + 128 + h * 32 + d0); } else { R.r[0] = (v4u){0u, 0u, 0u, 0u}; R.r[1] = R.r[0]; }
        R.r[3] = *(const v4u*)(SINB + ((size_t)(item_f + (pc >> 2)) * 36 + (pc < 4 ? cc_f : cc_b)) * 4096 + row * 64 + 8 * (pc & 3));
        { const int tq = I.tid >> 5, d = I.tid & 31; const float* la = (const float*)(F.ws + WS_LA) + (size_t)(rowbase + t0 + 4 * tq) * 256 + h * 32 + d; v4u lf, lb;
          lf.x = __float_as_uint(la[0]); lf.y = __float_as_uint(la[256]); lf.z = __float_as_uint(la[512]); lf.w = __float_as_uint(la[768]);
          lb.x = __float_as_uint(la[128]); lb.y = __float_as_uint(la[128 + 256]); lb.z = __float_as_uint(la[128 + 512]); lb.w = __float_as_uint(la[128 + 768]); R.r[4] = lf; R.r[5] = lb; }
#pragma unroll
        for (int u = 0; u < 2; ++u) R.g[u] = *(const v2u*)(U + (size_t)orow * INP + C_GLA + 512 + h * 64 + 16 * (2 * cp + u) + 4 * fq);
    } else if (MIX == 2) { const int g = h >> 1; const bf16* uc = (const bf16*)(F.ws + WS_UC) + (size_t)(rowbase + t) * 512;
        R.r[0] = *(const v4u*)(uc + h * 64 + d0); R.r[1] = *(const v4u*)(uc + 256 + g * 64 + d0); R.r[2] = *(const v4u*)(uc + 384 + g * 64 + d0);
        R.r[5] = *(const v4u*)(SINB + ((size_t)item_f * 36 + cc_f) * 4096 + row * 64 + 8 * pc); R.r[6] = *(const v4u*)(SINB + ((size_t)(item_f + 1) * 36 + cc_b) * 4096 + row * 64 + 8 * pc);
        R.s[0] = bf_lo((unsigned)ul[C_SSD + 768 + h]); R.s[1] = bf_lo((unsigned)ul[C_SSD + 768 + 4 + h]);
#pragma unroll
        for (int u = 0; u < 2; ++u) R.g[u] = *(const v2u*)(U + (size_t)orow * INP + C_SSD + h * 64 + 16 * (2 * cp + u) + 4 * fq);
    } else {
        R.r[0] = *(const v4u*)(ur + C_ML + h * 64 + d0); R.r[1] = *(const v4u*)(ur + C_ML + 256 + h * 64 + d0); R.r[2] = *(const v4u*)(ur + C_ML + 512 + h * 64 + d0);
        R.r[3] = *(const v4u*)(SINB + ((size_t)item_f * 36 + cc_f) * 4096 + row * 64 + 8 * pc); R.r[4] = *(const v4u*)(SINB + ((size_t)(item_f + 1) * 36 + cc_b) * 4096 + row * 64 + 8 * pc);
        if (I.tid < 32) R.r[5] = *(const v4u*)(NINB + ((size_t)((b * 4 + h) * 2 + (I.tid >> 4)) * 36 + ((I.tid >> 4) ? cc_b : cc_f)) * 64 + 4 * (I.tid & 15));
        R.s[0] = bf_lo((unsigned)ul[C_ML + 1024 + h]); R.s[1] = bf_lo((unsigned)ul[C_ML + 1024 + 4 + h]); R.s[2] = bf_lo((unsigned)ul[C_ML + 1024 + 8 + h]); R.s[3] = bf_lo((unsigned)ul[C_ML + 1024 + 12 + h]);
#pragma unroll
        for (int u = 0; u < 2; ++u) R.g[u] = *(const v2u*)(U + (size_t)orow * INP + C_ML + 768 + h * 64 + 16 * (2 * cp + u) + 4 * fq);
    }
}
template <int MIX>
__device__ __forceinline__ void s2_transform(const Frame& F, const Ids&, int l, const HItem& it, const HRaw& R) {
    const Ids I = fresh_ids(F.wave_s);
    LAS unsigned char* sm = F.lds;
    const int lane = I.lane, wave = I.wave, tk = I.tid >> 3, d0 = (I.tid & 7) * 8; const int h = it.h; const bool isctx = it.isctx; const int t = 64 * it.nc + tk;
    LAS float* GF = (LAS float*)(sm + S2_ARR); LAS float* HB = GF + 64; LAS float* WF = GF + 128; LAS float* WB = GF + 192;
    const int row = I.tid >> 3, pc = I.tid & 7;
    f32x8 q, k, v;
    if (MIX != 1) {
        const v4u sf = (MIX == 0 || MIX == 2) ? R.r[5] : R.r[3], sb = (MIX == 0 || MIX == 2) ? R.r[6] : R.r[4];
        *(LAS v4u*)(sm + S2_STF + row * 144 + pc * 16) = sf; *(LAS v4u*)(sm + S2_STB + row * 144 + pc * 16) = sb;
        if (MIX == 3 && I.tid < 32) { const f32x4 nv = __builtin_bit_cast(f32x4, R.r[5]); v2u w; w.x = pg8::cvt_pk_safe(nv[0], nv[1]); w.y = pg8::cvt_pk_safe(nv[2], nv[3]); *(LAS v2u*)(sm + S2_NV + (I.tid >> 4) * 128 + 8 * (I.tid & 15)) = w; }
        float laf, lab, wf = 1.f, wb = 1.f;
        const LAS float* cst = (const LAS float*)(sm + S2_CST);
        if (MIX == 0) { laf = cst[h]; lab = cst[4 + h]; }
        else if (MIX == 2) { wf = softplus_q(R.s[0] + cst[8 + h]); wb = softplus_q(R.s[1] + cst[12 + h]); laf = wf * cst[16 + h]; lab = wb * cst[20 + h]; }
        else { const LAS float* gb = cst + 32; wf = __expf(R.s[0] + gb[h]); laf = log_sigmoid_q(R.s[1] + gb[4 + h]); wb = __expf(R.s[2] + gb[8 + h]); lab = log_sigmoid_q(R.s[3] + gb[12 + h]); }
        const float Gf = wave_incl_scan(laf, lane), Gb = wave_incl_scan(lab, lane), Tb = rdlane(Gb, 63);
        if (wave == 0) { GF[lane] = Gf; HB[lane] = Tb - Gb + lab; WF[lane] = wf; WB[lane] = wb; }
        const int ro = tk * 144 + d0 * 2;
        *(LAS v4u*)(sm + S2_Q + ro) = MIX == 2 ? R.r[2] : R.r[0]; *(LAS v4u*)(sm + S2_K + ro) = R.r[1]; *(LAS v4u*)(sm + S2_V + ro) = MIX == 2 ? R.r[0] : R.r[2];
    } else {
        *(LAS v4u*)(sm + S2_STF + row * 144 + pc * 16) = R.r[3];
        LAS float* GS = (LAS float*)(sm + S2_GS); LAS float* GM = (LAS float*)(sm + S2_GM);
        const int d = I.tid & 31, tq = I.tid >> 5; float cfw[4], cbw[4], lbw[4]; float runf = 0.f, runb = 0.f;
        const float lfw[4] = {__uint_as_float(R.r[4].x), __uint_as_float(R.r[4].y), __uint_as_float(R.r[4].z), __uint_as_float(R.r[4].w)};
        lbw[0] = __uint_as_float(R.r[5].x); lbw[1] = __uint_as_float(R.r[5].y); lbw[2] = __uint_as_float(R.r[5].z); lbw[3] = __uint_as_float(R.r[5].w);
#pragma unroll
        for (int u = 0; u < 4; ++u) { runf += lfw[u]; cfw[u] = runf; runb += lbw[u]; cbw[u] = runb; }
        GS[tq * 32 + d] = runf; GS[512 + tq * 32 + d] = runb;
        __syncthreads();
        float offf = 0.f, offb = 0.f, totb = 0.f;
#pragma unroll
        for (int qq = 0; qq < 16; ++qq) { const float sf = GS[qq * 32 + d], sb = GS[512 + qq * 32 + d]; offf += (qq < tq) ? sf : 0.f; offb += (qq < tq) ? sb : 0.f; totb += sb; }
#pragma unroll
        for (int u = 0; u < 4; ++u) { GM[(4 * tq + u) * 32 + d] = offf + cfw[u]; GM[2048 + (4 * tq + u) * 32 + d] = totb - (offb + cbw[u]) + lbw[u]; }
        if (I.tid < 64) { GF[I.tid] = 0.f; HB[I.tid] = 0.f; WF[I.tid] = 1.f; WB[I.tid] = 1.f; }
        __syncthreads();
        *(LAS v4u*)(sm + S2_V + tk * 144 + d0 * 2) = R.r[2];
        if (d0 < 32) { q = cvt8(R.r[0]); k = cvt8(R.r[1]);
            const f32x4 gf0 = *(const LAS f32x4*)(GM + tk * 32 + d0), gf1 = *(const LAS f32x4*)(GM + tk * 32 + d0 + 4), gb0 = *(const LAS f32x4*)(GM + 2048 + tk * 32 + d0), gb1 = *(const LAS f32x4*)(GM + 2048 + tk * 32 + d0 + 4);
            f32x8 qf, kf, qb, kb;
#pragma unroll
            for (int j = 0; j < 4; ++j) { qf.a[j] = q.a[j] * 0.17677669529663687f * __expf(gf0[j]); qf.b[j] = q.b[j] * 0.17677669529663687f * __expf(gf1[j]); kf.a[j] = k.a[j] * __expf(-gf0[j]); kf.b[j] = k.b[j] * __expf(-gf1[j]);
                qb.a[j] = q.a[j] * 0.17677669529663687f * __expf(gb0[j]); qb.b[j] = q.b[j] * 0.17677669529663687f * __expf(gb1[j]); kb.a[j] = k.a[j] * __expf(-gb0[j]); kb.b[j] = k.b[j] * __expf(-gb1[j]); }
            const int ro = tk * 144 + d0 * 2;
            *(LAS v4u*)(sm + S2_Q + ro) = pack8(qf.a, qf.b); *(LAS v4u*)(sm + S2_Q + ro + 64) = pack8(qb.a, qb.b); *(LAS v4u*)(sm + S2_K + ro) = pack8(kf.a, kf.b); *(LAS v4u*)(sm + S2_K + ro + 64) = pack8(kb.a, kb.b); }
    }
}
template <int MIX>
__device__ __forceinline__ OutAcc s2_compute(const Frame& F, const Ids&, int l, const HItem& it, const v2u (&zg)[2]) {
    const Ids I = fresh_ids(F.wave_s);
    LAS unsigned char* sm = F.lds;
    const int lane = I.lane, wave = I.wave, fr = lane & 15, fq = lane >> 4, rt = wave >> 1, cp = wave & 1; const int h = it.h;
    const LAS float* GF = (const LAS float*)(sm + S2_ARR); const LAS float* HB = GF + 64; const LAS float* WF = GF + 128; const LAS float* WB = GF + 192;
    const int irow = 16 * rt + fr;
    const float gfi = GF[irow], hbi = HB[irow];
    const bf16x8s qf0 = rowfrag(sm + S2_Q, 16 * rt, 0, fr, fq), qf1 = rowfrag(sm + S2_Q, 16 * rt, 1, fr, fq);
#pragma unroll
    for (int u = 0; u < 2; ++u) { const int jt = 2 * cp + u;
        f32x4 sc = (f32x4){0.f, 0.f, 0.f, 0.f}, sc2 = sc;
        sc = mfma16(rowfrag(sm + S2_K, 16 * jt, 0, fr, fq), qf0, sc);
        if (MIX == 1) sc2 = mfma16(rowfrag(sm + S2_K, 16 * jt, 1, fr, fq), qf1, sc2); else sc = mfma16(rowfrag(sm + S2_K, 16 * jt, 1, fr, fq), qf1, sc);
        const f32x4 gj = *(const LAS f32x4*)(GF + 16 * jt + 4 * fq), hj = *(const LAS f32x4*)(HB + 16 * jt + 4 * fq), wfj = *(const LAS f32x4*)(WF + 16 * jt + 4 * fq), wbj = *(const LAS f32x4*)(WB + 16 * jt + 4 * fq);
        float pa[4], pb[4];
#pragma unroll
        for (int r = 0; r < 4; ++r) { const int j = 16 * jt + 4 * fq + r;
            const float ef = (j <= irow) ? __expf(fminf(gfi - gj[r], 0.f)) * wfj[r] : 0.f, eb = (j >= irow) ? __expf(fminf(hbi - hj[r], 0.f)) * wbj[r] : 0.f;
            if (MIX == 1) { pa[r] = sc[r] * ef + sc2[r] * eb; pb[r] = 0.f; } else if (MIX == 3) { pa[r] = sc[r] * ef; pb[r] = sc[r] * eb; } else { pa[r] = sc[r] * (ef + eb); pb[r] = 0.f; } }
        v2u pw; pw.x = pg8::cvt_pk_safe(pa[0], pa[1]); pw.y = pg8::cvt_pk_safe(pa[2], pa[3]); *(LAS v2u*)(sm + S2_P + irow * 144 + (16 * jt + 4 * fq) * 2) = pw;
        if (MIX == 3) { v2u pw2; pw2.x = pg8::cvt_pk_safe(pb[0], pb[1]); pw2.y = pg8::cvt_pk_safe(pb[2], pb[3]); *(LAS v2u*)(sm + S2_P2 + irow * 144 + (16 * jt + 4 * fq) * 2) = pw2; } }
    f32x4 o2f[2], o2b[2], e2f = (f32x4){0.f, 0.f, 0.f, 0.f}, e2b = e2f;
#pragma unroll
    for (int u = 0; u < 2; ++u) { const int ct = 2 * cp + u; o2f[u] = (f32x4){0.f, 0.f, 0.f, 0.f}; o2b[u] = o2f[u];
        o2f[u] = mfma16(rowfrag(sm + S2_STF, 16 * ct, 0, fr, fq), qf0, o2f[u]); o2f[u] = mfma16(rowfrag(sm + S2_STF, 16 * ct, 1, fr, fq), qf1, o2f[u]);
        if (MIX != 1) { o2b[u] = mfma16(rowfrag(sm + S2_STB, 16 * ct, 0, fr, fq), qf0, o2b[u]); o2b[u] = mfma16(rowfrag(sm + S2_STB, 16 * ct, 1, fr, fq), qf1, o2b[u]); } }
    if (MIX == 3) { const LAS unsigned char* nv = sm + S2_NV;
        e2f = mfma16(*(const LAS bf16x8s*)(nv + fq * 16), qf0, e2f); e2f = mfma16(*(const LAS bf16x8s*)(nv + 64 + fq * 16), qf1, e2f);
        e2b = mfma16(*(const LAS bf16x8s*)(nv + 128 + fq * 16), qf0, e2b); e2b = mfma16(*(const LAS bf16x8s*)(nv + 192 + fq * 16), qf1, e2b); }
    bf16x8s vf[2][2];
#pragma unroll
    for (int u = 0; u < 2; ++u) { vf[u][0] = trfrag(sm + S2_V, 0, 16 * (2 * cp + u), lane); vf[u][1] = trfrag(sm + S2_V, 32, 16 * (2 * cp + u), lane); }
    __syncthreads();
    const bf16x8s pf0 = rowfrag(sm + S2_P, 16 * rt, 0, fr, fq), pf1 = rowfrag(sm + S2_P, 16 * rt, 1, fr, fq);
    const float egf = __expf(gfi), egb = __expf(hbi);
    const bf16x8s ones = (bf16x8s){0x3F80, 0x3F80, 0x3F80, 0x3F80, 0x3F80, 0x3F80, 0x3F80, 0x3F80};
    OutAcc A;
    if (MIX == 3) {
        const bf16x8s pb0 = rowfrag(sm + S2_P2, 16 * rt, 0, fr, fq), pb1 = rowfrag(sm + S2_P2, 16 * rt, 1, fr, fq);
        f32x4 e1f = (f32x4){0.f, 0.f, 0.f, 0.f}, e1b = e1f; e1f = mfma16(ones, pf0, e1f); e1f = mfma16(ones, pf1, e1f); e1b = mfma16(ones, pb0, e1b); e1b = mfma16(ones, pb1, e1b);
        const float sf = 1.0f / fmaxf(fabsf(e1f[0] + egf * e2f[0]), 1.0f), sb = 1.0f / fmaxf(fabsf(e1b[0] + egb * e2b[0]), 1.0f);
#pragma unroll
        for (int u = 0; u < 2; ++u) { f32x4 of = (f32x4){0.f, 0.f, 0.f, 0.f}, ob = of; of = mfma16(vf[u][0], pf0, of); of = mfma16(vf[u][1], pf1, of); ob = mfma16(vf[u][0], pb0, ob); ob = mfma16(vf[u][1], pb1, ob);
            A.y[u] = (of + o2f[u] * egf) * sf + (ob + o2b[u] * egb) * sb; }
    } else {
#pragma unroll
        for (int u = 0; u < 2; ++u) { f32x4 o1 = (f32x4){0.f, 0.f, 0.f, 0.f}; o1 = mfma16(vf[u][0], pf0, o1); o1 = mfma16(vf[u][1], pf1, o1);
            A.y[u] = MIX == 1 ? (o1 + o2f[u]) : (o1 + o2f[u] * egf + o2b[u] * egb); }
    }
    if (MIX == 2) { const float dsk = ((const LAS float*)(sm + S2_CST))[24 + h];
#pragma unroll
        for (int u = 0; u < 2; ++u) { const int c0 = 16 * (2 * cp + u) + 4 * fq; const v2u xw = *(const LAS v2u*)(sm + S2_V + irow * 144 + c0 * 2);
            const f32x4 xs = (f32x4){bf_lo(xw.x), bf_hi(xw.x), bf_lo(xw.y), bf_hi(xw.y)}, z = (f32x4){bf_lo(zg[u].x), bf_hi(zg[u].x), bf_lo(zg[u].y), bf_hi(zg[u].y)};
#pragma unroll
            for (int r = 0; r < 4; ++r) A.y[u][r] = (A.y[u][r] + dsk * xs[r]) * silu_q(z[r]); }
    }
    return A;
}
__device__ __forceinline__ void token_stats(LAS unsigned char* sm, int rt, int cp, int fr, int fq, int lane, float& s1, float& s2) {
    s1 += shx(s1, 16, lane); s1 += shx(s1, 32, lane); s2 += shx(s2, 16, lane); s2 += shx(s2, 32, lane);
    LAS float* ST = (LAS float*)(sm + S2_STAT);
    if (fq == 0) { ST[((16 * rt + fr) * 2 + cp) * 2] = s1; ST[((16 * rt + fr) * 2 + cp) * 2 + 1] = s2; }
    __syncthreads();
    const f32x4 a = *(const LAS f32x4*)(ST + (16 * rt + fr) * 4); s1 = a[0] + a[2]; s2 = a[1] + a[3];
}
__device__ __forceinline__ HItem s2_item(int j, int blk, int G, int NCH, bool ctx_out, int nsu, int u0) {
    HItem it; int c;
    if (j < 4 * nsu) { const int u = blk + (j >> 2) * G; it.mix = 2; it.b = u / NCH; c = u % NCH; it.h = j & 3; it.last = (j & 3) == 3; }
    else { const int u = u0 + (j - 4 * nsu), mh = u % 12, bc = u / 12; it.b = bc / NCH; c = bc % NCH; const int m3 = mh >> 2; it.mix = m3 == 0 ? 0 : (m3 == 1 ? 1 : 3); it.h = mh & 3; it.last = true; }
    it.isctx = ctx_out && c < 4; it.nc = ctx_out ? (it.isctx ? c : c - 4) : c; return it;
}
__device__ __forceinline__ void p3b_output(const Frame& F_, int l, bool ctx_out) {
    const Frame F = fresh_frame(F_); const Ids I = fresh_ids(F.wave_s);
    bf16* Y = (bf16*)(F.ws + WS_Y);
    const int lane = I.lane, wave = I.wave, fr = lane & 15, fq = lane >> 4, rt = wave >> 1, cp = wave & 1;
    const int NCH = ctx_out ? 36 : 32, nssd = 8 * NCH, blk = F.vcu, G = F.G;
    const int extra = nssd - G, nsu = 1 + (blk < extra ? 1 : 0);
    const int per_lo = (16 * NCH * 8) / G - 8, per_hi = per_lo + 4;
    const int u0 = blk < extra ? blk * per_lo : extra * per_lo + (blk - extra) * per_hi, cnt = blk < extra ? per_lo : per_hi, nitems = 4 * nsu + cnt;
    {
        LAS float* cwl = (LAS float*)(F.lds + S2_GM); const float* cw = inp(F.lds, 15) + (size_t)l * 5 * 512; const float* cb = inp(F.lds, 16) + l * 512;
        for (int i = I.tid; i < 6 * 512; i += 512) cwl[i] = i < 2560 ? cw[i] : cb[i - 2560];
        LAS float* cst = (LAS float*)(F.lds + S2_CST);
        if (I.tid < 8) { cst[I.tid] = log_sigmoid_f(inp(F.lds, 10)[l * 8 + I.tid]); cst[8 + I.tid] = inp(F.lds, 17)[l * 8 + I.tid]; cst[16 + I.tid] = -expf(inp(F.lds, 18)[l * 8 + I.tid]); }
        if (I.tid < 4) cst[24 + I.tid] = inp(F.lds, 19)[l * 4 + I.tid];
        if (I.tid < 16) cst[32 + I.tid] = inp(F.lds, 21)[l * 16 + I.tid];
        if (I.tid < 256) { cst[64 + I.tid] = inp(F.lds, 11)[l * 256 + I.tid]; cst[320 + I.tid] = inp(F.lds, 14)[l * 256 + I.tid]; cst[576 + I.tid] = inp(F.lds, 20)[l * 256 + I.tid]; cst[832 + I.tid] = inp(F.lds, 22)[l * 256 + I.tid];
            cst[5184 + I.tid] = inp(F.lds, 13)[l * 256 + I.tid]; }
        for (int i = I.tid; i < 4096; i += 512) cst[1088 + i] = inp(F.lds, 12)[(size_t)l * 4096 + i];
    }
    __syncthreads();
    HRaw Ra;
    { const HItem i0 = s2_item(0, blk, G, NCH, ctx_out, nsu, u0); s2_issue<2>(F, I, l, i0, Ra); }
    unsigned ssdy[3][2][2] = {}; float ssd_s2 = 0.f;
    ConvRaw CR;
    auto item_body = [&](const int j, HRaw& R, const int cmode) {
        const HItem cur = s2_item(j, blk, G, NCH, ctx_out, nsu, u0);
        if (cur.mix == 0) s2_transform<0>(F, I, l, cur, R); else if (cur.mix == 1) s2_transform<1>(F, I, l, cur, R); else if (cur.mix == 2) s2_transform<2>(F, I, l, cur, R); else s2_transform<3>(F, I, l, cur, R);
        const v2u zg[2] = {R.g[0], R.g[1]};
        __syncthreads();
        if (j + 1 < nitems) { const HItem nxt = s2_item(j + 1, blk, G, NCH, ctx_out, nsu, u0);
            if (nxt.mix == 0) s2_issue<0>(F, I, l, nxt, R); else if (nxt.mix == 1) s2_issue<1>(F, I, l, nxt, R); else if (nxt.mix == 2) s2_issue<2>(F, I, l, nxt, R); else s2_issue<3>(F, I, l, nxt, R); }
        if (cmode == 1) conv_issue(F.lds, F.ws, l, (F.vcu * NWAVES + wave) * 18 + 9 + (j >> 1), lane, CR);
        OutAcc A;
        if (cur.mix == 0) A = s2_compute<0>(F, I, l, cur, zg); else if (cur.mix == 1) A = s2_compute<1>(F, I, l, cur, zg); else if (cur.mix == 2) A = s2_compute<2>(F, I, l, cur, zg); else A = s2_compute<3>(F, I, l, cur, zg);
        const int row = (cur.isctx ? NLAT + cur.b * CTXL : cur.b * SEQ) + 64 * cur.nc + 16 * rt + fr;
        if (cur.mix == 2) {
#pragma unroll
            for (int u = 0; u < 2; ++u)
#pragma unroll
                for (int r = 0; r < 4; ++r) ssd_s2 += A.y[u][r] * A.y[u][r];
            if (!cur.last) {
#pragma unroll
                for (int hh = 0; hh < 3; ++hh) {
#pragma unroll
                    for (int u = 0; u < 2; ++u) { const unsigned p0 = pg8::cvt_pk_safe(A.y[u][0], A.y[u][1]), p1 = pg8::cvt_pk_safe(A.y[u][2], A.y[u][3]);
                        ssdy[hh][u][0] = cur.h == hh ? p0 : ssdy[hh][u][0]; ssdy[hh][u][1] = cur.h == hh ? p1 : ssdy[hh][u][1]; } }
                __syncthreads();
            } else {
                float s1 = 0.f, s2 = ssd_s2; token_stats(F.lds, rt, cp, fr, fq, lane, s1, s2); ssd_s2 = 0.f;
                const float rs = 1.0f / sqrtf(s2 * (1.0f / 256.0f) + EPS); const LAS float* nw = (const LAS float*)(F.lds + S2_CST) + 576;
#pragma unroll
                for (int hh = 0; hh < 4; ++hh)
#pragma unroll
                    for (int u = 0; u < 2; ++u) { const int c0 = hh * 64 + 16 * (2 * cp + u) + 4 * fq;
                        const f32x4 yv = hh < 3 ? (f32x4){bf_lo(ssdy[hh < 3 ? hh : 0][u][0]), bf_hi(ssdy[hh < 3 ? hh : 0][u][0]), bf_lo(ssdy[hh < 3 ? hh : 0][u][1]), bf_hi(ssdy[hh < 3 ? hh : 0][u][1])} : A.y[u];
                        st_bf4(Y + (size_t)row * D + 512 + c0, yv * rs * *(const LAS f32x4*)(nw + c0)); }
                __syncthreads();
            }
        } else {
            float s1 = 0.f, s2 = 0.f;
#pragma unroll
            for (int u = 0; u < 2; ++u)
#pragma unroll
                for (int r = 0; r < 4; ++r) { s1 += A.y[u][r]; s2 += A.y[u][r] * A.y[u][r]; }
            token_stats(F.lds, rt, cp, fr, fq, lane, s1, s2);
            const float mean = cur.mix == 0 ? s1 * (1.0f / 64.0f) : 0.f;
            const float rs = 1.0f / sqrtf(fmaxf(s2 * (1.0f / 64.0f) - mean * mean, 0.f) + EPS);
            const LAS float* nw = (const LAS float*)(F.lds + S2_CST) + 64 + (cur.mix == 0 ? 0 : cur.mix == 1 ? 256 : 768) + cur.h * 64;
#pragma unroll
            for (int u = 0; u < 2; ++u) { const int c0 = 16 * (2 * cp + u) + 4 * fq; const f32x4 w = *(const LAS f32x4*)(nw + c0); f32x4 y;
                const f32x4 g = (f32x4){bf_lo(zg[u].x), bf_hi(zg[u].x), bf_lo(zg[u].y), bf_hi(zg[u].y)};
#pragma unroll
                for (int r = 0; r < 4; ++r) y[r] = (A.y[u][r] - mean) * rs * w[r] * (cur.mix == 3 ? sigmoid_q(g[r]) : silu_q(g[r]));
                st_bf4(Y + (size_t)row * D + cur.mix * 256 + cur.h * 64 + c0, y); }
            __syncthreads();
        }
        if (cmode == 2) conv_finish(CR);
    };
    for (int j = 0; j < nitems; j += 2) { item_body(j, Ra, CONV_IN_SCAN ? 1 : 0); item_body(j + 1, Ra, CONV_IN_SCAN ? 2 : 0); }
}

struct Args { const float* in[28]; float* out; unsigned char* ws; int ph_lo, ph_hi, use_bar, never; };
__global__ void __launch_bounds__(NWAVES * 64, 2) fwd_kernel(Args args) {
    extern __shared__ __attribute__((aligned(16))) unsigned char lds[];
    Frame F;
    F.lds = (LAS unsigned char*)lds;
        F.wave_s = __builtin_amdgcn_readfirstlane((int)threadIdx.x >> 6);
    F.G = gridDim.x; { const int bx = blockIdx.x; F.vcu = (F.G % 8 == 0) ? (bx % 8) * (F.G / 8) + bx / 8 : bx; }
    F.ws = args.ws;
    if (args.never) cooperative_groups::this_grid().sync();
    for (int u = F.wave_s * 64 + lane_id(); u < (LDS_BYTES - LDSCTL_OFF) / 4; u += NWAVES * 64) ((LAS unsigned*)(F.lds + LDSCTL_OFF))[u] = 0u;
    __syncthreads();
    if (F.wave_s == 0 && lane_id() == 0) { LAS unsigned long long* tab = (LAS unsigned long long*)(F.lds + LDSCTL_OFF);
#pragma unroll
        for (int i = 0; i < 28; ++i) tab[i] = (unsigned long long)args.in[i];
        tab[28] = (unsigned long long)args.out; }
    __syncthreads();
    XcdBarrier bar; bar.bar = (unsigned*)(F.ws + WS_CTL) + CW_BAR; bar.x = 0; bar.st = nullptr; bar.wave_s = F.wave_s;
    if (args.use_bar) bar = xcd_barrier_post((unsigned*)(F.ws + WS_CTL) + CW_BAR, (volatile LAS unsigned*)(F.lds + MISC_OFF) + 8, F.wave_s);
    const int lo = args.ph_lo, hi = args.ph_hi;
#define IN(k) (lo <= (k) && (k) < hi)
#define SEAM(k) do { if (IN(k) && IN((k) + 1)) xcd_barrier(bar); } while (0)
#ifndef PROBE_DUP
#define PROBE_DUP -1
#endif
#define PH_BEGIN(kind) for (int rep_ = 0; rep_ < ((PROBE_DUP) == (kind) ? 2 : 1); ++rep_) { if (rep_) xcd_barrier(bar);
#define PH_END }
    #ifndef NO_P0
    PH_BEGIN(0) if (IN(0)) { p0_prologue(F); } PH_END
#endif
    SEAM(0);
#pragma unroll
    for (int l = 0; l < 2; ++l) {
        const int pb = 1 + 10 * l;
        const bool ctx_out = l == 0;
        const int mrows = ctx_out ? NROWS : NLAT;
#ifndef NO_P1
        PH_BEGIN(1) if (IN(pb + 0)) { p1_norm1(F, l, rep_ == 0 ? 1.0f : 0.0f); } PH_END
#endif
        SEAM(pb + 0);
        PH_BEGIN(2) if (IN(pb + 1)) {
            const Frame Fg = fresh_frame(F);
            pg8::Gemm g{(const bf16*)(Fg.ws + WS_HN), (const bf16*)(Fg.ws + WS_WTIN) + (size_t)l * INP * 1024, NROWS, INP, D}; pg8::StaticOrder S; S.init(NROWS, INP, F.G, (int)blockIdx.x);
            pg8::EpiStoreBf16 E{(bf16*)(Fg.ws + WS_U), INP, 0, 0};
            pg8::gemm_phase<pg8::EpiStoreBf16, pg8::StaticOrder, PG8_ALIGN, PG8_SP2>(Fg.lds, g, S, E, F.wave_s);
        }
        PH_END
        SEAM(pb + 1);
        PH_BEGIN(11) if (IN(pb + 2)) { p2t_pretransform(F, l, rep_ == 0); } PH_END
        SEAM(pb + 2);
        PH_BEGIN(3) if (IN(pb + 3)) { p3a_state(F, l); } PH_END
        SEAM(pb + 3);
        PH_BEGIN(4) if (IN(pb + 4)) { p3b_output(F, l, ctx_out); } PH_END
        SEAM(pb + 4);
        PH_BEGIN(5) if (IN(pb + 5)) {
            const Frame Fg = fresh_frame(F);
            pg8::Gemm g{(const bf16*)(Fg.ws + WS_Y), (const bf16*)(Fg.ws + WS_WTOUT) + (size_t)l * 1024 * 1024, mrows, D, D}; pg8::StaticOrder S; S.init(mrows, D, F.G, (int)blockIdx.x);
            pg8::EpiOutProj E{(bf16*)(Fg.ws + WS_H), (const float*)(Fg.ws + WS_MOD) + (size_t)l * 9 * MODW, (l == 0 && rep_ == 0) ? inp(Fg.lds, 0) : nullptr, (l == 0 && rep_ == 0) ? inp(Fg.lds, 2) : nullptr, rep_ == 0 ? 1.0f : 0.0f};
            pg8::gemm_phase<pg8::EpiOutProj, pg8::StaticOrder, PG8_ALIGN, PG8_SP2>(Fg.lds, g, S, E, F.wave_s);
        }
        PH_END
        SEAM(pb + 5);
#ifndef NO_P6
        PH_BEGIN(6) if (IN(pb + 6)) { p6_norm2_router(F, l, mrows); } PH_END
#endif
        SEAM(pb + 6);
#ifndef NO_P7
        PH_BEGIN(7) if (IN(pb + 7)) { p7_topk(F, l); } PH_END
#endif
        SEAM(pb + 7);
        PH_BEGIN(8) if (IN(pb + 8)) {
            const Frame Fg = fresh_frame(F);
            pg8::Gemm g{(const bf16*)(Fg.ws + WS_HN), (const bf16*)(Fg.ws + WS_WTGU) + (size_t)l * NE * 3072 * 1024, NE * SLOTS, NE * 3072, D};
            pg8::GroupedOrder S{ctx_out ? 9 : 8, 12, (int)blockIdx.x};
            pg8::EpiSwiGLU E{(bf16*)(Fg.ws + WS_U)};
            LAS int* idxl = (LAS int*)(Fg.lds + 132096);
            { const int* IDXG = (const int*)(Fg.ws + WS_SLOT + 1179648); const int tid_ = F.wave_s * 64 + lane_id(); pg8::Unit uu;
              for (int ui = 0; ui < 7 && S.next(ui, uu); ++ui) if (tid_ < 256) idxl[ui * 256 + tid_] = IDXG[uu.pm * 256 + tid_];
              __syncthreads(); }
            pg8::gemm_phase<pg8::EpiSwiGLU, pg8::GroupedOrder, PG8_ALIGN, PG8_SP2, true>(Fg.lds, g, S, E, F.wave_s, idxl);
        }
        PH_END
        SEAM(pb + 8);
        PH_BEGIN(9) if (IN(pb + 9)) {
            const Frame Fg = fresh_frame(F);
            pg8::Gemm g{(const bf16*)(Fg.ws + WS_U), (const bf16*)(Fg.ws + WS_WTDN) + (size_t)l * NE * 1024 * FF, NE * SLOTS, NE * 1024, FF};
            pg8::GroupedOrder S{ctx_out ? 9 : 8, 4, (int)blockIdx.x};
            pg8::EpiStoreBf16 E{(bf16*)(Fg.ws + WS_O2), D, 9, 4};
            pg8::gemm_phase<pg8::EpiStoreBf16, pg8::GroupedOrder, PG8_ALIGN, PG8_SP2>(Fg.lds, g, S, E, F.wave_s);
        }
        PH_END
        SEAM(pb + 9);
    }
#ifndef NO_PF
    PH_BEGIN(10) if (IN(21)) { p_final(F, (float*)inp(F.lds, 28)); } PH_END
#endif
#undef IN
#undef SEAM
}

#ifndef MK_ONE_LAUNCH
#define MK_ONE_LAUNCH 1
#endif
extern "C" void kernel_launch(void* const* d_in, const int* in_sizes, int n_in, void* d_out, int out_size, void* d_ws, size_t ws_size, hipStream_t stream) {
    static int grid = 0;
    if (grid == 0) {
        if (n_in != 28 || out_size != NLAT * D || ws_size < WS_END3) { fprintf(stderr, "kernel_launch: unexpected problem (n_in %d, out %d, ws %zu < %zu)\n", n_in, out_size, ws_size, (size_t)WS_END); grid = -1; return; }
        int dev = 0, cus = 0, per_cu = 0;
        if (hipGetDevice(&dev) != hipSuccess || hipDeviceGetAttribute(&cus, hipDeviceAttributeMultiprocessorCount, dev) != hipSuccess) { grid = -1; return; }
        if (hipFuncSetAttribute((const void*)fwd_kernel, hipFuncAttributeMaxDynamicSharedMemorySize, LDS_BYTES) != hipSuccess) { fprintf(stderr, "kernel_launch: hipFuncSetAttribute failed\n"); grid = -1; return; }
        if (hipOccupancyMaxActiveBlocksPerMultiprocessor(&per_cu, (const void*)fwd_kernel, NWAVES * 64, LDS_BYTES) != hipSuccess || per_cu < 1) { fprintf(stderr, "kernel_launch: occupancy query says %d\n", per_cu); (void)hipGetLastError(); per_cu = 1; }
        grid = cus;
        if (grid != 256) { fprintf(stderr, "kernel_launch: built for 256 CUs, device has %d\n", cus); grid = -1; return; }
    }
    if (grid < 0) return;
    (void)hipMemsetAsync((char*)d_ws + WS_CTL, 0, CTL_ZERO_BYTES, stream);
    Args a{};
    for (int i = 0; i < 28; ++i) a.in[i] = (const float*)d_in[i];
    a.out = (float*)d_out; a.ws = (unsigned char*)d_ws; a.never = 0;
#if MK_ONE_LAUNCH
    a.ph_lo = 0; a.ph_hi = NPHASES; a.use_bar = 1;
    void* kargs[] = {&a};
    hipError_t e = hipLaunchCooperativeKernel((const void*)fwd_kernel, dim3(grid), dim3(NWAVES * 64), kargs, LDS_BYTES, stream);
    if (e != hipSuccess) fprintf(stderr, "kernel_launch: cooperative launch failed: %s\n", hipGetErrorString(e));
#else
    for (int ph = 0; ph < NPHASES; ++ph) { a.ph_lo = ph; a.ph_hi = ph + 1; a.use_bar = 0;
        hipLaunchKernelGGL(fwd_kernel, dim3(grid), dim3(NWAVES * 64), LDS_BYTES, stream, a); }
#endif
}
```

```cpp
#include <hip/hip_runtime.h>
#include <hip/hip_cooperative_groups.h>
#include <cstdio>
#include <cstdint>
#define GAS __attribute__((address_space(1)))
#define LAS __attribute__((address_space(3)))
namespace pg8 {
#define PG8_LAS __attribute__((address_space(3)))
typedef unsigned short bf16_t;
typedef short bf16x8 __attribute__((ext_vector_type(8)));
typedef float f32x4 __attribute__((ext_vector_type(4)));
typedef unsigned u32x4 __attribute__((ext_vector_type(4)));
constexpr int BM = 256, BK = 64, HALF = 128, HTB = HALF * BK * 2  , STAGE_BYTES = 8 * HTB, NXCD = 8, WGM = 8;

__host__ __device__ __forceinline__ int lds_byte(int r, int c) { const int st = (r >> 4) * 2 + (c >> 5), rr = r & 15, cc = c & 31, ob = rr * 64 + cc * 2; return st * 1024 + (ob ^ (((ob >> 9) & 1) << 5)); }
__host__ __device__ __forceinline__ void stage_rc(int b, int& R, int& C) { const int st = b / 1024, sb = b % 1024, swz = sb ^ (((sb >> 9) & 1) << 5); R = (st >> 1) * 16 + swz / 64; C = (st & 1) * 32 + (swz % 64) / 2; }
__host__ __device__ __forceinline__ int perm32(int rho) { const int n = rho >> 4, i = rho & 15; return 8 * (i >> 2) + 4 * n + (i & 3); }

struct Unit { int pm, pn; };
struct Gemm { const bf16_t* A; const bf16_t* Bt; int M, N, K; };

struct StaticOrder {
    int nM, nN, nwg, G, c, W;
    __host__ __device__ void init(int M, int N, int G_, int c_, int W_ = 32) { nM = M / BM; nN = N / BM; nwg = nM * nN; G = G_; c = c_; W = W_; }
    __host__ __device__ bool next(int i, Unit& u) const {
        const int xcd = c % NXCD, w = c / NXCD; if (w >= W) return false;
        const int q = nwg / NXCD, r = nwg % NXCD, off = i * W + w; if (off >= q + (xcd < r ? 1 : 0)) return false;
        const int wgid = (xcd < r ? xcd * (q + 1) : r * (q + 1) + (xcd - r) * q) + off;
        const int nig = WGM * nN, gid = wgid / nig, fm = gid * WGM, gsz = (nM - fm) < WGM ? (nM - fm) : WGM;
        u.pm = fm + ((wgid % nig) % gsz); u.pn = (wgid % nig) / gsz; return true;
    }
    __device__ __forceinline__ void a_ready(const Unit&) const {}
    __device__ __forceinline__ void done(const Unit&) const {}
};

__device__ __forceinline__ unsigned cvt_pk_bf16(float lo, float hi) { unsigned r; asm volatile("v_cvt_pk_bf16_f32 %0, %1, %2" : "=v"(r) : "v"(lo), "v"(hi)); return r; }
typedef float f32x2_t __attribute__((ext_vector_type(2))); typedef __bf16 bf16x2_t __attribute__((ext_vector_type(2)));
__device__ __forceinline__ unsigned cvt_pk_safe(float lo, float hi) { const f32x2_t v = {lo, hi}; const bf16x2_t b = __builtin_convertvector(v, bf16x2_t); return __builtin_bit_cast(unsigned, b); }

struct EpiStoreBf16 {
    static constexpr bool PERM = true, AFTER_DRAIN = false;
    bf16_t* O; int ldc; int pm_div, pn_per;
    __device__ __forceinline__ void operator()(const f32x4 (&acc)[2][2][4][2], const Unit& u, int wr, int wc, int fr, int fq) const {
        const int row0 = u.pm * BM + wr * 64 + fr; int pnl = u.pn; if (pm_div) pnl -= (u.pm / pm_div) * pn_per;
        const int col0 = pnl * BM + wc * 32 + 8 * fq;
#pragma unroll
        for (int ai = 0; ai < 2; ++ai)
#pragma unroll
            for (int m = 0; m < 4; ++m) { bf16_t* rowp = O + (size_t)(row0 + ai * HALF + m * 16) * ldc + col0;
#pragma unroll
                for (int bj = 0; bj < 2; ++bj) { const f32x4 v0 = acc[ai][bj][m][0], v1 = acc[ai][bj][m][1];
                    u32x4 w; w.x = cvt_pk_bf16(v0[0], v0[1]); w.y = cvt_pk_bf16(v0[2], v0[3]); w.z = cvt_pk_bf16(v1[0], v1[1]); w.w = cvt_pk_bf16(v1[2], v1[3]);
                    *(u32x4*)(rowp + bj * HALF) = w; } }
    }
};
struct EpiSwiGLU {
    static constexpr bool PERM = false, AFTER_DRAIN = false;
    bf16_t* O;
    __device__ __forceinline__ void operator()(const f32x4 (&acc)[2][2][4][2], const Unit& u, int wr, int wc, int fr, int fq) const {
        const int e = u.pm / 9, pnl = u.pn - e * 12;
        const int row0 = u.pm * BM + wr * 64 + fr, col0 = pnl * 128 + (4 * wc + fq) * 8;
#pragma unroll
        for (int ai = 0; ai < 2; ++ai)
#pragma unroll
            for (int m = 0; m < 4; ++m) {
                float h[8];
#pragma unroll
                for (int bj = 0; bj < 2; ++bj)
#pragma unroll
                    for (int j = 0; j < 4; ++j) { const float g = acc[ai][bj][m][0][j], up = acc[ai][bj][m][1][j]; h[bj * 4 + j] = g * __builtin_amdgcn_rcpf(1.0f + __expf(-g)) * up; }
                u32x4 w; w.x = cvt_pk_bf16(h[0], h[1]); w.y = cvt_pk_bf16(h[2], h[3]); w.z = cvt_pk_bf16(h[4], h[5]); w.w = cvt_pk_bf16(h[6], h[7]);
                *(u32x4*)(O + (size_t)(row0 + ai * HALF + m * 16) * 1536 + col0) = w; }
    }
};
struct EpiOutProj {
    static constexpr bool PERM = true, AFTER_DRAIN = false;
    bf16_t* H; const float* mod;
    const float* xin; const float* cin;
    float gsc;
    __device__ __forceinline__ void operator()(const f32x4 (&acc)[2][2][4][2], const Unit& u, int wr, int wc, int fr, int fq) const {
        const int s = u.pm < 64 ? (u.pm >> 3) : 8;
        const float* g1 = mod + s * 6144 + 2048;
        const int row0 = u.pm * BM + wr * 64 + fr, col0 = u.pn * BM + wc * 32 + 8 * fq;
#pragma unroll
        for (int bj = 0; bj < 2; ++bj) { const f32x4 gv0 = *(const f32x4*)(g1 + col0 + bj * HALF) * gsc, gv1 = *(const f32x4*)(g1 + col0 + bj * HALF + 4) * gsc;
#pragma unroll
            for (int ai = 0; ai < 2; ++ai)
#pragma unroll
                for (int m = 0; m < 4; ++m) { const size_t off = (size_t)(row0 + ai * HALF + m * 16) * 1024 + col0 + bj * HALF; bf16_t* p = H + off;
                    f32x4 o0, o1;
                    if (xin) { const float* bp = u.pm < 64 ? xin + off : cin + (off - (size_t)16384 * 1024); o0 = *(const f32x4*)bp; o1 = *(const f32x4*)(bp + 4); }
                    else { const u32x4 w = *(const u32x4*)p; o0 = (f32x4){__uint_as_float(w.x << 16), __uint_as_float(w.x & 0xffff0000u), __uint_as_float(w.y << 16), __uint_as_float(w.y & 0xffff0000u)};
                        o1 = (f32x4){__uint_as_float(w.z << 16), __uint_as_float(w.z & 0xffff0000u), __uint_as_float(w.w << 16), __uint_as_float(w.w & 0xffff0000u)}; }
                    o0 += gv0 * acc[ai][bj][m][0]; o1 += gv1 * acc[ai][bj][m][1];
                    u32x4 w; w.x = cvt_pk_bf16(o0[0], o0[1]); w.y = cvt_pk_bf16(o0[2], o0[3]); w.z = cvt_pk_bf16(o1[0], o1[1]); w.w = cvt_pk_bf16(o1[2], o1[3]);
                    *(u32x4*)p = w; } }
    }
};
struct GroupedOrder {
    int MT, NT, c, W;
    __device__ __forceinline__ bool next(int i, Unit& u) const {
        const int xcd = c & 7, j = i * W + (c >> 3), per = MT * NT;
        if ((c >> 3) >= W || j >= 2 * per) return false;
        const int e = 2 * xcd + j / per, q = j % per;
        u.pm = e * 9 + q % MT; u.pn = e * NT + q / MT; return true;
    }
    __device__ __forceinline__ void a_ready(const Unit&) const {}
    __device__ __forceinline__ void done(const Unit&) const {}
};

template <class Epi, class Sched, bool ALIGN_EPI = false, bool SP2 = false, bool GATHER = false>
__device__ __forceinline__ void gemm_phase(PG8_LAS unsigned char* lds, const Gemm g, const Sched& S, const Epi& E, const int wave_s, const PG8_LAS int* idxl = nullptr) {
    unsigned m_ = ~0u; asm volatile("" : "+s"(m_)); const int tid_ = wave_s * 64 + (int)__builtin_amdgcn_mbcnt_hi(m_, __builtin_amdgcn_mbcnt_lo(m_, 0u));
    const int tid = tid_, wid = __builtin_amdgcn_readfirstlane(tid >> 6), lane = tid & 63, wr = wid >> 2, wc = wid & 3, fr = lane & 15, fq = lane >> 4;
    const int K = g.K, nt = K / BK;
    unsigned voffA[2], voffB[2]; int gR[2], gC2[2];
#pragma unroll
    for (int i = 0; i < 2; ++i) { int R, C; stage_rc(tid * 16 + i * 8192, R, C); const int Rb = Epi::PERM ? ((R & ~31) + perm32(R & 31)) : R;
        voffA[i] = (unsigned)(R * K + C) * 2u; voffB[i] = (unsigned)(Rb * K + C) * 2u; gR[i] = R; gC2[i] = 2 * C; }
    const size_t kstep = (size_t)(BK * 2);
    const size_t hstep = (size_t)HALF * K * 2;
    const size_t tstep = 2 * hstep;
    const unsigned ldsw = (unsigned)wid * 1024u;
    const int aoff = lds_byte(wr * 64 + fr, fq * 8), boff = lds_byte(wc * 32 + fr, fq * 8);
#define PG8_SA(b, h) (((b) * 2 + (h)) * HTB)
#define PG8_SB(b, h) ((4 + (b) * 2 + (h)) * HTB)
#define PG8_STAGE(bufoff, gbase, voff) do { _Pragma("unroll") for (int _i = 0; _i < 2; ++_i) \
        __builtin_amdgcn_global_load_lds((const unsigned*)((const char*)(gbase) + (voff)[_i]), (PG8_LAS unsigned*)(lds + (bufoff) + ldsw + _i * 8192), 16, 0, 0); } while (0)
#define PG8_STAGE_A(bufoff, gbase, h, usenext) do { if constexpr (GATHER) { _Pragma("unroll") for (int _i = 0; _i < 2; ++_i) { const unsigned _o = (usenext) ? vn[h][_i] : vo[h][_i]; \
        __builtin_amdgcn_global_load_lds((const unsigned*)((const char*)(gbase) + _o), (PG8_LAS unsigned*)(lds + (bufoff) + ldsw + _i * 8192), 16, 0, 0); } } \
        else { PG8_STAGE(bufoff, (const char*)(gbase) + ((h) ? hstep : (size_t)0), voffA); } } while (0)
#define PG8_LDA(dst, b, h) do { _Pragma("unroll") for (int m = 0; m < 4; ++m) _Pragma("unroll") for (int k = 0; k < 2; ++k) dst[m][k] = *(const PG8_LAS bf16x8*)(lds + PG8_SA(b, h) + aoff + m * 2048 + k * 1024); } while (0)
#define PG8_LDB(dst, b, h) do { _Pragma("unroll") for (int n = 0; n < 2; ++n) _Pragma("unroll") for (int k = 0; k < 2; ++k) dst[n][k] = *(const PG8_LAS bf16x8*)(lds + PG8_SB(b, h) + boff + n * 2048 + k * 1024); } while (0)
#define PG8_MMA(ai, bj, At, Bt) do { __builtin_amdgcn_s_setprio(1); _Pragma("unroll") for (int m = 0; m < 4; ++m) _Pragma("unroll") for (int n = 0; n < 2; ++n) _Pragma("unroll") for (int k = 0; k < 2; ++k) \
        acc[ai][bj][m][n] = __builtin_amdgcn_mfma_f32_16x16x32_bf16(Bt[n][k], At[m][k], acc[ai][bj][m][n], 0, 0, 0); __builtin_amdgcn_s_setprio(0); } while (0)
#define PG8_WAIT_V(n) asm volatile("s_waitcnt vmcnt(" #n ")" ::: "memory")
#define PG8_WAIT_L(n) asm volatile("s_waitcnt lgkmcnt(" #n ")" ::: "memory")
#define PG8_BAR __builtin_amdgcn_s_barrier()
#define PG8_SCHED __builtin_amdgcn_sched_barrier(0)
    Unit cur, nxt; int ui = 0;
    if (!S.next(0, cur)) return;
    f32x4 acc[2][2][4][2];
#pragma unroll
    for (int a = 0; a < 2; ++a)
#pragma unroll
        for (int b = 0; b < 2; ++b)
#pragma unroll
            for (int m = 0; m < 4; ++m)
#pragma unroll
                for (int n = 0; n < 2; ++n) acc[a][b][m][n] = (f32x4){0.f, 0.f, 0.f, 0.f};
    bf16x8 At[4][2], B0[2][2], B1[2][2];
    const char* cA = (const char*)g.A + (GATHER ? (size_t)0 : (size_t)cur.pm * tstep); const char* cB = (const char*)g.Bt + (size_t)cur.pn * tstep;
    unsigned vo[2][2], vn[2][2];
    if constexpr (GATHER) {
#pragma unroll
        for (int h = 0; h < 2; ++h)
#pragma unroll
            for (int i = 0; i < 2; ++i) { vo[h][i] = (unsigned)idxl[h * 128 + gR[i]] * (unsigned)(2 * K) + (unsigned)gC2[i]; vn[h][i] = vo[h][i]; } }
    S.a_ready(cur);
    if constexpr (SP2) {
        PG8_STAGE(PG8_SB(0, 0), cB, voffB); PG8_STAGE(PG8_SB(0, 1), cB + hstep, voffB); PG8_STAGE_A(PG8_SA(0, 0), cA, 0, false); PG8_STAGE_A(PG8_SA(0, 1), cA, 1, false);
        if (wr == 1) PG8_BAR;
        PG8_WAIT_V(2); PG8_BAR;
        PG8_STAGE(PG8_SB(1, 0), cB + kstep, voffB); PG8_STAGE_A(PG8_SA(1, 0), cA + kstep, 0, false); PG8_STAGE(PG8_SB(1, 1), cB + hstep + kstep, voffB);
        PG8_WAIT_V(6); PG8_BAR;
    } else {
        PG8_STAGE(PG8_SB(0, 0), cB, voffB); PG8_STAGE(PG8_SA(0, 0), cA, voffA); PG8_STAGE(PG8_SB(0, 1), cB + hstep, voffB); PG8_STAGE(PG8_SA(0, 1), cA + hstep, voffA);
        if (wr == 1) PG8_BAR;
        PG8_WAIT_V(4); PG8_BAR;
        PG8_STAGE(PG8_SB(1, 0), cB + kstep, voffB); PG8_STAGE(PG8_SA(1, 0), cA + kstep, voffA); PG8_STAGE(PG8_SB(1, 1), cB + hstep + kstep, voffB);
        PG8_WAIT_V(6); PG8_BAR;
    }
    for (;;) {
        const bool has_next = S.next(ui + 1, nxt);
        const char* nA = (has_next && !GATHER) ? (const char*)g.A + (size_t)nxt.pm * tstep : cA; const char* nB = has_next ? (const char*)g.Bt + (size_t)nxt.pn * tstep : cB;
        if constexpr (GATHER) {
#pragma unroll
            for (int h = 0; h < 2; ++h)
#pragma unroll
                for (int i = 0; i < 2; ++i) vn[h][i] = has_next ? (unsigned)idxl[(ui + 1) * 256 + h * 128 + gR[i]] * (unsigned)(2 * K) + (unsigned)gC2[i] : vo[h][i]; }
        for (int t = 0; t < nt; t += 2) {
            const bool last = (t == nt - 2);
            const char* a1 = cA + (size_t)(t + 1) * kstep;
            const char* a2 = last ? nA : cA + (size_t)(t + 2) * kstep; const char* b2 = last ? nB : cB + (size_t)(t + 2) * kstep;
            const char* a3 = a2 + kstep; const char* b3 = b2 + kstep;
            if (last && has_next) S.a_ready(nxt);
            if constexpr (SP2) {
            PG8_LDB(B0, 0, 0); PG8_LDB(B1, 0, 1); PG8_SCHED; PG8_LDA(At, 0, 0); PG8_STAGE_A(PG8_SA(1, 1), a1, 1, false);
            PG8_WAIT_V(8); PG8_WAIT_L(0); PG8_BAR; PG8_MMA(0, 0, At, B0); PG8_MMA(0, 1, At, B1); PG8_BAR; PG8_SCHED;
            PG8_LDA(At, 0, 1); PG8_STAGE(PG8_SB(0, 0), b2, voffB); PG8_STAGE(PG8_SB(0, 1), b2 + hstep, voffB); PG8_STAGE_A(PG8_SA(0, 0), a2, 0, last);
            PG8_WAIT_V(8); PG8_WAIT_L(0); PG8_BAR; PG8_MMA(1, 0, At, B0); PG8_MMA(1, 1, At, B1); PG8_BAR; PG8_SCHED;
            PG8_LDB(B0, 1, 0); PG8_LDB(B1, 1, 1); PG8_SCHED; PG8_LDA(At, 1, 0); PG8_STAGE_A(PG8_SA(0, 1), a2, 1, last);
            PG8_WAIT_V(8); PG8_WAIT_L(0); PG8_BAR; PG8_MMA(0, 0, At, B0); PG8_MMA(0, 1, At, B1); PG8_BAR; PG8_SCHED;
            PG8_LDA(At, 1, 1); PG8_STAGE(PG8_SB(1, 0), b3, voffB); PG8_STAGE(PG8_SB(1, 1), b3 + hstep, voffB); PG8_STAGE_A(PG8_SA(1, 0), a3, 0, last);
            PG8_WAIT_V(8); PG8_WAIT_L(0); PG8_BAR; PG8_MMA(1, 0, At, B0); PG8_MMA(1, 1, At, B1); PG8_BAR; PG8_SCHED;
            } else {
            PG8_LDB(B0, 0, 0); PG8_SCHED; PG8_LDA(At, 0, 0); PG8_STAGE(PG8_SA(1, 1), a1 + hstep, voffA);
            PG8_WAIT_L(8); PG8_BAR; PG8_WAIT_L(0); PG8_MMA(0, 0, At, B0); PG8_BAR; PG8_SCHED;
            PG8_LDB(B1, 0, 1); PG8_STAGE(PG8_SB(0, 0), b2, voffB);
            PG8_BAR; PG8_WAIT_L(0); PG8_MMA(0, 1, At, B1); PG8_BAR;
            PG8_LDA(At, 0, 1); PG8_STAGE(PG8_SA(0, 0), a2, voffA);
            PG8_BAR; PG8_WAIT_L(0); PG8_MMA(1, 0, At, B0); PG8_BAR; PG8_SCHED;
            PG8_STAGE(PG8_SB(0, 1), b2 + hstep, voffB);
            PG8_WAIT_V(6); PG8_BAR; PG8_MMA(1, 1, At, B1); PG8_BAR;
            PG8_LDB(B0, 1, 0); PG8_SCHED; PG8_LDA(At, 1, 0); PG8_STAGE(PG8_SA(0, 1), a2 + hstep, voffA);
            PG8_WAIT_L(8); PG8_BAR; PG8_WAIT_L(0); PG8_MMA(0, 0, At, B0); PG8_BAR; PG8_SCHED;
            PG8_LDB(B1, 1, 1); PG8_STAGE(PG8_SB(1, 0), b3, voffB);
            PG8_BAR; PG8_WAIT_L(0); PG8_MMA(0, 1, At, B1); PG8_BAR;
            PG8_LDA(At, 1, 1); PG8_STAGE(PG8_SA(1, 0), a3, voffA);
            PG8_BAR; PG8_WAIT_L(0); PG8_MMA(1, 0, At, B0); PG8_BAR; PG8_SCHED;
            PG8_STAGE(PG8_SB(1, 1), b3 + hstep, voffB);
            PG8_WAIT_V(6); PG8_BAR; PG8_MMA(1, 1, At, B1); PG8_BAR;
            }
        }
        if constexpr (ALIGN_EPI) { if (wr == 0) PG8_BAR; }
        if constexpr (!Epi::AFTER_DRAIN) { E(acc, cur, wr, wc, fr, fq); S.done(cur); }
        if (!has_next) break;
#pragma unroll
        for (int a = 0; a < 2; ++a)
#pragma unroll
            for (int b = 0; b < 2; ++b)
#pragma unroll
                for (int m = 0; m < 4; ++m)
#pragma unroll
                    for (int n = 0; n < 2; ++n) acc[a][b][m][n] = (f32x4){0.f, 0.f, 0.f, 0.f};
        cur = nxt; cA = nA; cB = nB; ++ui;
        if constexpr (GATHER) {
#pragma unroll
            for (int h = 0; h < 2; ++h)
#pragma unroll
                for (int i = 0; i < 2; ++i) vo[h][i] = vn[h][i]; }
        if constexpr (ALIGN_EPI) { if (wr == 1) PG8_BAR; }
    }
    PG8_WAIT_V(0);
    if constexpr (!ALIGN_EPI) { if (wr == 0) PG8_BAR; }
    PG8_BAR;
    if constexpr (Epi::AFTER_DRAIN) { E.fused(acc, cur, wr, wc, fr, fq, lds, wid, lane); S.done(cur); }
#undef PG8_SA
#undef PG8_SB
#undef PG8_STAGE
#undef PG8_STAGE_A
#undef PG8_LDA
#undef PG8_LDB
#undef PG8_MMA
#undef PG8_WAIT_V
#undef PG8_WAIT_L
#undef PG8_BAR
#undef PG8_SCHED
}
}

#ifndef PG8_SP2
#define PG8_SP2 true
#endif
#ifndef PSPIN
#define PSPIN 0
#endif
#ifndef PS_MASK
#define PS_MASK 0
#endif
#ifndef PS_MULT
#define PS_MULT 8
#endif
#ifndef PS_QK
#define PS_QK -1
#endif
#ifndef CONV_TPW
#define CONV_TPW 1
#endif
#ifndef PG8_ALIGN
#define PG8_ALIGN true
#endif

constexpr int D = 1024, NB = 8, SEQ = 2048, CTXL = 256, NLAT = NB * SEQ, NCTX = NB * CTXL, NROWS = NLAT + NCTX;
constexpr int INC = 3624, INP = 3840, NE = 16, FF = 1536, SLOTS = 2304, MODW = 6144;
constexpr float EPS = 1e-6f;
constexpr int C_RET = 0, C_GLA = 1024, C_SSD = 1808, C_ML = 2584;
constexpr size_t MiB = 1u << 20;
constexpr size_t WS_CTL = 0, CTL_ZERO_BYTES = 1 * MiB;
constexpr size_t WS_MOD = 1 * MiB, WS_WTIN = 2 * MiB, WS_WTOUT = 18 * MiB, WS_WTGU = 22 * MiB, WS_WTDN = 214 * MiB, WS_H = 310 * MiB, WS_HN = 382 * MiB,
                 WS_U = 418 * MiB  , WS_O2 = 553 * MiB  , WS_Y = 625 * MiB  , WS_AFFT = 697 * MiB, WS_SLOT = 699 * MiB, WS_END = 701 * MiB;
constexpr int CW_BAR = 4096;
constexpr int RING_BYTES = 131072, LDSCTL_OFF = RING_BYTES, MISC_OFF = LDSCTL_OFF + 320, LDS_BYTES = 147456;
constexpr int NWAVES = 8, NPHASES = 22;

typedef unsigned short bf16;
typedef unsigned v4u __attribute__((ext_vector_type(4)));
typedef unsigned v2u __attribute__((ext_vector_type(2)));
typedef float f32x4 __attribute__((ext_vector_type(4)));
typedef GAS unsigned gu32;
#define LDS_WAIT() asm volatile("s_waitcnt lgkmcnt(0)" ::: "memory")
#define VM_WAIT() asm volatile("s_waitcnt vmcnt(0)" ::: "memory")

#define XB_TMO      128
#define XB_XCNT(j)  (256  + 64 * (j))
#define XB_XSUB(j)  (1280 + 64 * (j))
#define XB_XGEN(j)  (2304 + 64 * (j))
#define XB_TOP      3328
#define XB_TOPGEN   3392
#define XCD_BAR_WORDS 3456
#define XB_SPIN_CAP (1u << 18)

__device__ __forceinline__ unsigned xb_ld(unsigned* p)              { return __hip_atomic_load(p, __ATOMIC_RELAXED, __HIP_MEMORY_SCOPE_AGENT); }
__device__ __forceinline__ unsigned xb_add(unsigned* p, unsigned v) { return __hip_atomic_fetch_add(p, v, __ATOMIC_RELAXED, __HIP_MEMORY_SCOPE_AGENT); }
__device__ __forceinline__ unsigned xb_xcc_id() { return (unsigned)__builtin_amdgcn_s_getreg((3 << 11) | 20) & 0xFu; }
#define XB_SPIN(cond, bar) do { unsigned _sp = 0; while (cond) { __builtin_amdgcn_s_sleep(1); \
    if ((++_sp & 255u) == 0u) { if (xb_ld(&(bar)[XB_TMO])) break; if (_sp > XB_SPIN_CAP) { atomicAdd(&(bar)[XB_TMO], 1u); break; } } } } while (0)

__device__ __forceinline__ int xb_lane_id() { unsigned m = ~0u; asm volatile("" : "+s"(m)); return (int)__builtin_amdgcn_mbcnt_hi(m, __builtin_amdgcn_mbcnt_lo(m, 0u)); }
struct XcdBarrier {
    int wave_s;
    unsigned* bar; unsigned x;
    volatile LAS unsigned* st;
};

__device__ __forceinline__ XcdBarrier xcd_barrier_post(unsigned* bar, volatile LAS unsigned* st, int wave_s) {
    XcdBarrier b; b.bar = bar; b.x = xb_xcc_id(); b.st = st; b.wave_s = wave_s;
    if (wave_s == 0 && xb_lane_id() == 0) (void)xb_add(&bar[XB_XCNT(b.x)], 1u);
    return b;
}
__device__ __forceinline__ void xcd_barrier_complete(unsigned* bar, unsigned x, unsigned& nloc, unsigned& nx) {
    const unsigned G = gridDim.x * gridDim.y * gridDim.z;
    unsigned sum, cnt, mine, sp = 0u;
    for (;;) {
        sum = 0u; cnt = 0u; mine = 0u;
#pragma unroll
        for (unsigned j = 0; j < 16; ++j) { const unsigned c = xb_ld(&bar[XB_XCNT(j)]); sum += c; cnt += (c > 0u) ? 1u : 0u; }
        if (sum == G) { mine = xb_ld(&bar[XB_XCNT(x)]); break; }
        __builtin_amdgcn_s_sleep(1);
        if ((++sp & 255u) == 0u) { if (xb_ld(&bar[XB_TMO])) break; if (sp > XB_SPIN_CAP) { atomicAdd(&bar[XB_TMO], 1u); break; } }
    }
    nloc = mine > 0u ? mine : 1u; nx = cnt > 0u ? cnt : 1u;
}

__device__ __forceinline__ void xcd_barrier(const XcdBarrier& b) {
    asm volatile("s_waitcnt vmcnt(0)" ::: "memory");
    __syncthreads();
    if (b.wave_s == 0 && xb_lane_id() == 0) {
        unsigned* bar = b.bar; asm volatile("" : "+s"(bar));
        __builtin_amdgcn_s_waitcnt(0);
        unsigned nloc = b.st[0], nx = b.st[1];
        if (nloc == 0u) { xcd_barrier_complete(bar, b.x, nloc, nx); b.st[0] = nloc; b.st[1] = nx; }
        const unsigned old = xb_add(&bar[XB_XSUB(b.x)], 1u);
        const unsigned gen = old / nloc;
        if (old + 1u == (gen + 1u) * nloc) {
            __builtin_amdgcn_fence(__ATOMIC_RELEASE, "agent");
            asm volatile("s_waitcnt vmcnt(0)" ::: "memory");
            const unsigned og = xb_add(&bar[XB_TOP], 1u);
            const unsigned tg = og / nx;
            if (og + 1u == (tg + 1u) * nx) xb_add(&bar[XB_TOPGEN], 1u);
            else XB_SPIN(xb_ld(&bar[XB_TOPGEN]) == tg, bar);
            __builtin_amdgcn_fence(__ATOMIC_ACQUIRE, "agent");
            xb_add(&bar[XB_XGEN(b.x)], 1u);
            asm volatile("s_waitcnt vmcnt(0)" ::: "memory");
        } else {
            XB_SPIN(xb_ld(&bar[XB_XGEN(b.x)]) == gen, bar);
            __builtin_amdgcn_fence(__ATOMIC_ACQUIRE, "agent");
            asm volatile("s_waitcnt vmcnt(0)" ::: "memory");
        }
    }
    __syncthreads();
}


struct Frame {
    LAS unsigned char* lds;
    int vcu, G, wave_s;
    unsigned char* ws;
};
struct Ids { int tid, lane, wave; };
__device__ __forceinline__ const float* inp(const LAS unsigned char* lds, int i) {
    const LAS unsigned* t = (const LAS unsigned*)(lds + 131072) + 2 * i;
    const unsigned lo = __builtin_amdgcn_readfirstlane(t[0]), hi = __builtin_amdgcn_readfirstlane(t[1]);
    return (const float*)(GAS const float*)(((unsigned long long)hi << 32) | lo); }
__device__ __forceinline__ Frame fresh_frame(const Frame& F) { Frame G = F; GAS unsigned char* g = (GAS unsigned char*)F.ws; asm volatile("" : "+s"(g), "+s"(G.lds), "+s"(G.vcu), "+s"(G.G), "+s"(G.wave_s)); G.ws = (unsigned char*)g; return G; }
__device__ __forceinline__ int lane_id() { unsigned m = ~0u; asm volatile("" : "+s"(m)); return (int)__builtin_amdgcn_mbcnt_hi(m, __builtin_amdgcn_mbcnt_lo(m, 0u)); }
__device__ __forceinline__ Ids fresh_ids(int wave_s) { Ids I; I.lane = lane_id(); I.wave = wave_s; I.tid = wave_s * 64 + I.lane; return I; }
__device__ __forceinline__ float shx(float v, int mask, int lane) { return __int_as_float(__builtin_amdgcn_ds_bpermute((lane ^ mask) << 2, __float_as_int(v))); }
__device__ __forceinline__ float shidx(float v, int src) { return __int_as_float(__builtin_amdgcn_ds_bpermute(src << 2, __float_as_int(v))); }
__device__ __forceinline__ int shidx_i(int v, int src) { return __builtin_amdgcn_ds_bpermute(src << 2, v); }
__device__ __forceinline__ float wave_sum(float v, int lane) {
#pragma unroll
    for (int o = 1; o < 64; o <<= 1) v += shx(v, o, lane);
    return v;
}
__device__ __forceinline__ float bf_lo(unsigned w) { return __uint_as_float(w << 16); }
__device__ __forceinline__ float bf_hi(unsigned w) { return __uint_as_float(w & 0xffff0000u); }
__device__ __forceinline__ f32x4 ld_bf4(const bf16* p) { const v2u w = *(const v2u*)p; return (f32x4){bf_lo(w.x), bf_hi(w.x), bf_lo(w.y), bf_hi(w.y)}; }
__device__ __forceinline__ void st_bf4(bf16* p, f32x4 v) { v2u w; w.x = pg8::cvt_pk_bf16(v.x, v.y); w.y = pg8::cvt_pk_bf16(v.z, v.w); *(v2u*)p = w; }
__device__ __forceinline__ float silu_f(float x) { return x / (1.0f + expf(-x)); }
__device__ __forceinline__ float sigmoid_f(float x) { return 1.0f / (1.0f + expf(-x)); }
__device__ __forceinline__ float log_sigmoid_f(float z) { return fminf(z, 0.f) - log1pf(expf(-fabsf(z))); }
__device__ __forceinline__ float softplus_f(float x) { return fmaxf(x, 0.f) + log1pf(expf(-fabsf(x))); }
__device__ __forceinline__ int row_sample(int r) { return r < NLAT ? (r >> 11) : 8; }

template <class RowMap>
__device__ __forceinline__ void transpose_item(const float* W, int ldw, int nvalid, int k0, int n0, bf16* WT, int ldt, const RowMap& f, LAS float* scr, int lane) {
    f32x4 t[8];
#pragma unroll
    for (int i = 0; i < 8; ++i) { const int idx = i * 64 + lane, kk = idx >> 3, c = n0 + 4 * (idx & 7);
        t[i] = c < nvalid ? __builtin_nontemporal_load((const f32x4*)(W + (size_t)(k0 + kk) * ldw + c)) : (f32x4){0.f, 0.f, 0.f, 0.f}; }
#pragma unroll
    for (int i = 0; i < 8; ++i) { const int idx = i * 64 + lane, kk = idx >> 3, c4 = 4 * (idx & 7); LAS float* d = scr + kk * 33 + c4; d[0] = t[i].x; d[1] = t[i].y; d[2] = t[i].z; d[3] = t[i].w; }
    LDS_WAIT(); asm volatile("" ::: "memory");
    const int c8 = lane & 7;
#pragma unroll
    for (int j = 0; j < 4; ++j) { const int n = (lane >> 3) + 8 * j, col = n0 + n; const LAS float* s = scr + (8 * c8) * 33 + n;
        if (col < nvalid) { v4u o; o.x = pg8::cvt_pk_bf16(s[0 * 33], s[1 * 33]); o.y = pg8::cvt_pk_bf16(s[2 * 33], s[3 * 33]); o.z = pg8::cvt_pk_bf16(s[4 * 33], s[5 * 33]); o.w = pg8::cvt_pk_bf16(s[6 * 33], s[7 * 33]);
            *(v4u*)(WT + (size_t)f(col) * ldt + k0 + 8 * c8) = o; } }
    LDS_WAIT(); asm volatile("" ::: "memory");
}
struct MapId { int off; __device__ __forceinline__ int operator()(int c) const { return off + c; } };
struct MapGU { int off, n; __device__ __forceinline__ int operator()(int h) const { const int hl = h & 127, q = hl >> 3, wc = q >> 2, fq = q & 3, rem = hl & 7, bj = rem >> 2, j = rem & 3;
    return off + 256 * (h >> 7) + 128 * bj + 32 * wc + 16 * n + 4 * fq + j; } };

__device__ __forceinline__ void p0_prologue(const Frame& F_) {
    const Frame F = fresh_frame(F_); const Ids I = fresh_ids(F.wave_s);
    const float* cvec = inp(F.lds, 1); const float* cctx = inp(F.lds, 3); const float* w_mod = inp(F.lds, 4); const float* b_mod = inp(F.lds, 5);
    float* MOD = (float*)(F.ws + WS_MOD);
    {
        LAS float* sil = (LAS float*)F.lds;
        LAS float* part = (LAS float*)(F.lds + 40960);
        for (int i = I.tid; i < 9 * 1024; i += 512) { const int s = i >> 10, k = i & 1023; const float c = s < 8 ? cvec[s * 1024 + k] : cctx[k]; sil[i] = silu_f(c); }
        __syncthreads();
        for (int item = F.vcu; item < 192; item += F.G) {
            const int l = item / 96, col = (item % 96) * 64 + I.lane;
            float acc[9];
#pragma unroll
            for (int s = 0; s < 9; ++s) acc[s] = 0.f;
            const float* wp = w_mod + (size_t)l * 1024 * MODW + (size_t)(I.wave * 128) * MODW + col;
            for (int k = 0; k < 128; ++k) { const float wv = wp[(size_t)k * MODW];
#pragma unroll
                for (int s = 0; s < 9; ++s) acc[s] += sil[s * 1024 + I.wave * 128 + k] * wv; }
#pragma unroll
            for (int s = 0; s < 9; ++s) part[(I.wave * 9 + s) * 64 + I.lane] = acc[s];
            __syncthreads();
            for (int i = I.tid; i < 9 * 64; i += 512) { const int s = i >> 6, ln = i & 63; float t = 0.f;
#pragma unroll
                for (int w = 0; w < 8; ++w) t += part[(w * 9 + s) * 64 + ln];
                const int cc = (item % 96) * 64 + ln; MOD[((size_t)l * 9 + s) * MODW + cc] = t + b_mod[l * MODW + cc]; }
            __syncthreads();
        }
        __syncthreads();
    }
    {
        bf16* wtin = (bf16*)(F.ws + WS_WTIN);
        const int nchunk = 2 * (INP - INC) * 128;
        for (int i = F.vcu * 512 + I.tid; i < nchunk; i += F.G * 512) { const int l = i / ((INP - INC) * 128), r = i % ((INP - INC) * 128);
            *(v4u*)(wtin + ((size_t)l * INP + INC) * 1024 + (size_t)r * 8) = (v4u){0u, 0u, 0u, 0u}; }
    }
    {
        LAS float* scr = (LAS float*)(F.lds + I.wave * 16384);
        const int gw = F.vcu * NWAVES + I.wave, NGW = F.G * NWAVES;
        constexpr int I_IN = 16 * 114, I_OUT = 16 * 32, I_E = 768, PER_L = I_IN + I_OUT + 16 * 3 * I_E;
#ifndef CONV_IN_SCAN
#define CONV_IN_SCAN 1
#endif
        constexpr int PER_L0 = CONV_IN_SCAN ? (I_IN + I_OUT) : PER_L;
        for (int it = gw; it < 2 * PER_L0; it += NGW) {
            const int l = it / PER_L0; int r = it % PER_L0;
            if (r < I_IN) { const int kb = r / 114, nb = r % 114;
                transpose_item(inp(F.lds, 8) + (size_t)l * 1024 * INC, INC, INC, 64 * kb, 32 * nb, (bf16*)(F.ws + WS_WTIN) + (size_t)l * INP * 1024, 1024, MapId{0}, scr, I.lane); continue; }
            r -= I_IN;
            if (r < I_OUT) { const int kb = r / 32, nb = r % 32;
                transpose_item(inp(F.lds, 9) + (size_t)l * 1024 * 1024, 1024, 1024, 64 * kb, 32 * nb, (bf16*)(F.ws + WS_WTOUT) + (size_t)l * 1024 * 1024, 1024, MapId{0}, scr, I.lane); continue; }
            r -= I_OUT;
            const int e = r / (3 * I_E), q = r % (3 * I_E), kind = q / I_E, t = q % I_E;
            if (kind < 2) { const int kb = t / 48, nb = t % 48;
                transpose_item((kind ? inp(F.lds, 25) : inp(F.lds, 24)) + ((size_t)l * NE + e) * 1024 * FF, FF, FF, 64 * kb, 32 * nb, (bf16*)(F.ws + WS_WTGU) + (size_t)l * NE * 3072 * 1024, 1024, MapGU{e * 3072, kind}, scr, I.lane); }
            else { const int kb = t / 32, nb = t % 32;
                transpose_item(inp(F.lds, 26) + ((size_t)l * NE + e) * FF * 1024, 1024, 1024, 64 * kb, 32 * nb, (bf16*)(F.ws + WS_WTDN) + (size_t)l * NE * 1024 * FF, FF, MapId{e * 1024}, scr, I.lane); }
        }
    }
}

struct ConvRaw { float t[32]; bf16* dp; };
__device__ __forceinline__ void conv_issue(const LAS unsigned char* lds, unsigned char* ws, int l, int idx, int lane, ConvRaw& C) {
    const int e = idx / 2304, q = idx % 2304, kind = q / 768, t = q % 768;
    const float* sp; size_t ldw;
    if (kind < 2) { const int kb = t / 24, nb = t % 24, n = 64 * nb + lane; ldw = FF;
        sp = (kind ? inp(lds, 25) : inp(lds, 24)) + ((size_t)l * NE + e) * 1024 * FF + (size_t)(32 * kb) * FF + n;
        C.dp = (bf16*)(ws + WS_WTGU) + (size_t)l * NE * 3072 * 1024 + (size_t)MapGU{e * 3072, kind}(n) * 1024 + 32 * kb; }
    else { const int kb = t / 16, nb = t % 16, n = 64 * nb + lane; ldw = 1024;
        sp = inp(lds, 26) + ((size_t)l * NE + e) * FF * 1024 + (size_t)(32 * kb) * 1024 + n;
        C.dp = (bf16*)(ws + WS_WTDN) + (size_t)l * NE * 1024 * FF + (size_t)(e * 1024 + n) * FF + 32 * kb; }
#pragma unroll
    for (int i = 0; i < 32; ++i) C.t[i] = __builtin_nontemporal_load(sp + (size_t)i * ldw);
}
__device__ __forceinline__ void conv_finish(const ConvRaw& C) {
#pragma unroll
    for (int q = 0; q < 4; ++q) { v4u o; o.x = pg8::cvt_pk_bf16(C.t[8 * q], C.t[8 * q + 1]); o.y = pg8::cvt_pk_bf16(C.t[8 * q + 2], C.t[8 * q + 3]); o.z = pg8::cvt_pk_bf16(C.t[8 * q + 4], C.t[8 * q + 5]); o.w = pg8::cvt_pk_bf16(C.t[8 * q + 6], C.t[8 * q + 7]);
        *(v4u*)(C.dp + 8 * q) = o; }
}
constexpr int CW_Q = 8192, CW_DONE = 8704, QN = 4608, Q_GU0 = 1536, Q_L0 = 2304, Q_GU1 = 3840;
constexpr int CONV_IMG = 64 * 144;
__device__ __forceinline__ void conv_tile(const LAS unsigned char* lds, unsigned char* ws, LAS unsigned char* img, int x, int tq, int lane) {
    const int p = ((tq / 96) * 8 + x) * 48 + (tq % 96) / 2, half = tq & 1, l = p / 9216, r = p % 9216;
    const int kq = lane >> 4, nq = lane & 15, pc = lane & 7, rsub = lane >> 3;
    const float* sp; size_t ldw; bf16* dbase; int dld, e, kind, n0;
    if (r < 6144) { e = r / 384; const int q2 = r % 384, t = q2 % 192, k0 = 128 * (t / 24) + 64 * half; kind = q2 / 192; n0 = 64 * (t % 24); ldw = FF; dld = 1024;
        sp = (kind ? inp(lds, 25) : inp(lds, 24)) + ((size_t)l * NE + e) * 1024 * FF + (size_t)k0 * FF + n0;
        dbase = (bf16*)(ws + WS_WTGU) + (size_t)l * NE * 3072 * 1024 + k0; }
    else { const int r2 = r - 6144, t = r2 % 192, k0 = 128 * (t / 16) + 64 * half; e = r2 / 192; kind = 2; n0 = 64 * (t % 16); ldw = 1024; dld = FF;
        sp = inp(lds, 26) + ((size_t)l * NE + e) * FF * 1024 + (size_t)k0 * 1024 + n0;
        dbase = (bf16*)(ws + WS_WTDN) + (size_t)l * NE * 1024 * FF + k0; }
    f32x4 t[16];
#pragma unroll
    for (int i = 0; i < 8; ++i)
#pragma unroll
        for (int h = 0; h < 2; ++h) t[2 * i + h] = __builtin_nontemporal_load((const f32x4*)(sp + (size_t)(8 * i + 2 * kq + h) * ldw) + nq);
    const int g = (nq >> 1) & 7;
#pragma unroll
    for (int i = 0; i < 8; ++i)
#pragma unroll
        for (int c = 0; c < 4; ++c) *(LAS unsigned*)(img + (4 * nq + c) * 144 + (((4 * i + kq) ^ (g << 2)) << 2)) = pg8::cvt_pk_bf16(t[2 * i][c], t[2 * i + 1][c]);
#pragma unroll
    for (int i = 0; i < 8; ++i) { const int n = 8 * i + rsub;
        const v4u w = *(const LAS v4u*)(img + n * 144 + ((pc ^ i) << 4));
        const int row = kind < 2 ? MapGU{e * 3072, kind}(n0 + n) : e * 1024 + n0 + n;
        *(v4u*)(dbase + (size_t)row * dld + 8 * pc) = w; }
}
__device__ __forceinline__ void conv_host(const Frame& F_, int k, unsigned thr, int need) {
    const Frame F = fresh_frame(F_); const int lane = lane_id(), wave = F.wave_s;
    unsigned* ctl = (unsigned*)(F.ws + WS_CTL); const int x = F.vcu >> 5;
    unsigned* q = ctl + CW_Q + 32 * x; unsigned* dn = ctl + CW_DONE + 32 * k;
    volatile LAS int* slot = (volatile LAS int*)(F.lds + MISC_OFF + 64);
    constexpr int TPW = CONV_TPW, BATCH = 7 * TPW;
    if (wave == 0 && lane == 0) { int s0 = QN; if (thr != 0u || (int)xb_ld(q) < need) s0 = (int)xb_add(q, (unsigned)BATCH); slot[0] = s0; }
    __syncthreads();
    for (int it = 0;; ++it) {
        const int s = __builtin_amdgcn_readfirstlane(slot[it & 1]);
        if (s >= QN) break;
        if (wave == 0) {
            if (lane == 0) { const unsigned d = xb_ld(dn); int sn = QN; if (d < thr || s + BATCH < need) sn = (int)xb_add(q, (unsigned)BATCH); slot[(it + 1) & 1] = sn; }
        } else {
#pragma unroll
            for (int j = 0; j < TPW; ++j) { const int tq = s + (wave - 1) * TPW + j;
                if (tq < QN) conv_tile(F.lds, F.ws, F.lds + ((wave - 1) * TPW + j) * CONV_IMG, x, tq, lane); }
        }
        __syncthreads();
    }
}
__device__ __forceinline__ void conv_worker_done(const Frame& F, int k) { if (F.wave_s == 0 && lane_id() == 0) (void)xb_add((unsigned*)(F.ws + WS_CTL) + CW_DONE + 32 * k, 1u); }
__device__ __forceinline__ void load_row_f32(const float* p, int lane, f32x4 (&v)[4]) {
#pragma unroll
    for (int j = 0; j < 4; ++j) v[j] = *(const f32x4*)(p + 4 * lane + 256 * j);
}
__device__ __forceinline__ void load_row_bf16(const bf16* p, int lane, f32x4 (&v)[4]) {
#pragma unroll
    for (int j = 0; j < 4; ++j) v[j] = ld_bf4(p + 4 * lane + 256 * j);
}
__device__ __forceinline__ float row_sumsq(const f32x4 (&v)[4], int lane) { float s = 0.f;
#pragma unroll
    for (int j = 0; j < 4; ++j) s += (v[j].x * v[j].x + v[j].y * v[j].y) + (v[j].z * v[j].z + v[j].w * v[j].w);
    return wave_sum(s, lane); }
__device__ __forceinline__ void add_expert_out(f32x4 (&v)[4], int r, int lane, const int* slotmap, const float* afft, const bf16* EO, const float* g2, float esc = 1.0f) {
    f32x4 acc[4];
#pragma unroll
    for (int j = 0; j < 4; ++j) acc[j] = (f32x4){0.f, 0.f, 0.f, 0.f};
    const int sl = lane < NE ? slotmap[r * 16 + lane] : -1;
    const float af = lane < NE ? afft[(size_t)r * NE + lane] : 0.f;
    unsigned mask = (unsigned)__ballot(sl >= 0);
    while (mask) {
        v2u w[4][4]; float a[4];
#pragma unroll
        for (int q = 0; q < 4; ++q) {
            const bool on = mask != 0u; const int e = on ? __builtin_ctz(mask) : 0; if (on) mask &= mask - 1u;
            const int slot = __builtin_amdgcn_readlane(sl, e); a[q] = on ? __int_as_float(__builtin_amdgcn_readlane(__float_as_int(af), e)) : 0.f;
            const bf16* er = EO + (size_t)(on ? slot : 0) * 1024;
#pragma unroll
            for (int j = 0; j < 4; ++j) w[q][j] = on ? *(const v2u*)(er + 4 * lane + 256 * j) : (v2u){0u, 0u};
        }
#pragma unroll
        for (int q = 0; q < 4; ++q)
#pragma unroll
            for (int j = 0; j < 4; ++j) acc[j] += a[q] * (f32x4){bf_lo(w[q][j].x), bf_hi(w[q][j].x), bf_lo(w[q][j].y), bf_hi(w[q][j].y)};
    }
#pragma unroll
    for (int j = 0; j < 4; ++j) v[j] += *(const f32x4*)(g2 + 4 * lane + 256 * j) * esc * acc[j];
}
__device__ __forceinline__ void p1_norm1(const Frame& F_, int l, float esc) {
    const Frame F = fresh_frame(F_); const Ids I = fresh_ids(F.wave_s);
    const int gw = F.vcu * NWAVES + I.wave, NGW = F.G * NWAVES;
    bf16* H = (bf16*)(F.ws + WS_H); bf16* HN = (bf16*)(F.ws + WS_HN);
    const float* MOD = (const float*)(F.ws + WS_MOD); const float* nw = inp(F.lds, 6) + l * 1024;
    const float* xin = inp(F.lds, 0); const float* cin = inp(F.lds, 2);
    ConvRaw CR; const bool xtile = false;
    if (xtile) conv_issue(F.lds, F.ws, l, (F.vcu * NWAVES + I.wave) * 18 + 17, I.lane, CR);
    constexpr int RB = 3;
    for (int r0 = gw; r0 < NROWS; r0 += NGW * RB) {
        f32x4 v[RB][4];
#pragma unroll
        for (int q = 0; q < RB; ++q) { const int r = r0 + q * NGW; if (r < NROWS) {
            if (l == 0) load_row_f32(r < NLAT ? xin + (size_t)r * D : cin + (size_t)(r - NLAT) * D, I.lane, v[q]); else load_row_bf16(H + (size_t)r * D, I.lane, v[q]); } }
#pragma unroll
        for (int q = 0; q < RB; ++q) { const int r = r0 + q * NGW; if (r < NROWS) {
            const int s = row_sample(r);
            if (l != 0) add_expert_out(v[q], r, I.lane, (const int*)(F.ws + WS_SLOT), (const float*)(F.ws + WS_AFFT), (const bf16*)(F.ws + WS_O2), MOD + ((size_t)(l - 1) * 9 + s) * MODW + 5120, esc);
            const float rstd = 1.0f / sqrtf(row_sumsq(v[q], I.lane) * (1.0f / D) + EPS);
            const float* m = MOD + ((size_t)l * 9 + s) * MODW;
#pragma unroll
            for (int j = 0; j < 4; ++j) { const int k = 4 * I.lane + 256 * j;
                if (l != 0) st_bf4(H + (size_t)r * D + k, v[q][j]);
                const f32x4 w = *(const f32x4*)(nw + k), sh = *(const f32x4*)(m + k), sc = *(const f32x4*)(m + 1024 + k);
                st_bf4(HN + (size_t)r * D + k, (v[q][j] * rstd * w) * (sc + 1.0f) + sh); } } }
    }
    if (xtile) conv_finish(CR);
}
__device__ __forceinline__ void p_final(const Frame& F_, float* out) {
    const Frame F = fresh_frame(F_); const Ids I = fresh_ids(F.wave_s);
    const int gw = F.vcu * NWAVES + I.wave, NGW = F.G * NWAVES;
    const bf16* H = (const bf16*)(F.ws + WS_H); const float* MOD = (const float*)(F.ws + WS_MOD); const float* nw = inp(F.lds, 27);
    constexpr int RB = 2;
    for (int r0 = gw; r0 < NLAT; r0 += NGW * RB) {
        f32x4 v[RB][4];
#pragma unroll
        for (int q = 0; q < RB; ++q) { const int r = r0 + q * NGW; if (r < NLAT) load_row_bf16(H + (size_t)r * D, I.lane, v[q]); }
#pragma unroll
        for (int q = 0; q < RB; ++q) { const int r = r0 + q * NGW; if (r < NLAT) {
            const int s = row_sample(r);
            add_expert_out(v[q], r, I.lane, (const int*)(F.ws + WS_SLOT), (const float*)(F.ws + WS_AFFT), (const bf16*)(F.ws + WS_O2), MOD + ((size_t)1 * 9 + s) * MODW + 5120);
            const float rstd = 1.0f / sqrtf(row_sumsq(v[q], I.lane) * (1.0f / D) + EPS);
#pragma unroll
            for (int j = 0; j < 4; ++j) { const int k = 4 * I.lane + 256 * j; *(f32x4*)(out + (size_t)r * D + k) = v[q][j] * rstd * *(const f32x4*)(nw + k); } } }
    }
}
__device__ __forceinline__ void p6_norm2_router(const Frame& F_, int l, int nrows) {
    const Frame F = fresh_frame(F_); const Ids I = fresh_ids(F.wave_s);
    const int gw = F.vcu * NWAVES + I.wave, NGW = F.G * NWAVES;
    const bf16* H = (const bf16*)(F.ws + WS_H); bf16* HN = (bf16*)(F.ws + WS_HN); float* AFFT = (float*)(F.ws + WS_AFFT);
    const float* MOD = (const float*)(F.ws + WS_MOD); const float* nw = inp(F.lds, 7) + l * 1024; const float* rw = inp(F.lds, 23) + (size_t)l * 1024 * NE;
    LAS float* wt = (LAS float*)F.lds;
    for (int i = I.tid; i < 1024 * 4; i += 512) { const int k = i >> 2, q = i & 3; const f32x4 w = *(const f32x4*)(rw + k * 16 + 4 * q);
        wt[(4 * q + 0) * 1024 + k] = w.x; wt[(4 * q + 1) * 1024 + k] = w.y; wt[(4 * q + 2) * 1024 + k] = w.z; wt[(4 * q + 3) * 1024 + k] = w.w; }
    __syncthreads();
    const int lane = I.lane;
    const int myexp = ((lane >> 5) & 1) * 8 + ((lane >> 4) & 1) * 4 + ((lane >> 3) & 1) * 2 + ((lane >> 2) & 1);
    constexpr int RB = 2;
    for (int r0 = gw; r0 < nrows; r0 += NGW * RB) {
        f32x4 v[RB][4];
#pragma unroll
        for (int q = 0; q < RB; ++q) { const int r = r0 + q * NGW; if (r < nrows) load_row_bf16(H + (size_t)r * D, lane, v[q]); }
#pragma unroll
        for (int q = 0; q < RB; ++q) { const int r = r0 + q * NGW; if (r < nrows) {
            const int s = row_sample(r);
            const float rstd = 1.0f / sqrtf(row_sumsq(v[q], I.lane) * (1.0f / D) + EPS);
            const float* m = MOD + ((size_t)l * 9 + s) * MODW;
#pragma unroll
            for (int j = 0; j < 4; ++j) { const int k = 4 * lane + 256 * j;
                const f32x4 w = *(const f32x4*)(nw + k), sh = *(const f32x4*)(m + 3072 + k), sc = *(const f32x4*)(m + 4096 + k);
                v[q][j] = (v[q][j] * rstd * w) * (sc + 1.0f) + sh;
                st_bf4(HN + (size_t)r * D + k, v[q][j]); }
            float p[NE];
#pragma unroll
            for (int e = 0; e < NE; ++e) { float a = 0.f;
#pragma unroll
                for (int j = 0; j < 4; ++j) { const f32x4 w = *(const LAS f32x4*)(wt + e * 1024 + 4 * lane + 256 * j); a += (v[q][j].x * w.x + v[q][j].y * w.y) + (v[q][j].z * w.z + v[q][j].w * w.w); }
                p[e] = a; }
            float a8[8], a4[4], a2[2], a1;
            { const bool hi = (lane & 32) != 0;
#pragma unroll
              for (int i = 0; i < 8; ++i) { const float send = hi ? p[i] : p[8 + i], keep = hi ? p[8 + i] : p[i]; a8[i] = keep + shx(send, 32, lane); } }
            { const bool hi = (lane & 16) != 0;
#pragma unroll
              for (int i = 0; i < 4; ++i) { const float send = hi ? a8[i] : a8[4 + i], keep = hi ? a8[4 + i] : a8[i]; a4[i] = keep + shx(send, 16, lane); } }
            { const bool hi = (lane & 8) != 0;
#pragma unroll
              for (int i = 0; i < 2; ++i) { const float send = hi ? a4[i] : a4[2 + i], keep = hi ? a4[2 + i] : a4[i]; a2[i] = keep + shx(send, 8, lane); } }
            { const bool hi = (lane & 4) != 0; const float send = hi ? a2[0] : a2[1], keep = hi ? a2[1] : a2[0]; a1 = keep + shx(send, 4, lane); }
            a1 += shx(a1, 2, lane); a1 += shx(a1, 1, lane);
            float mx = a1;
            mx = fmaxf(mx, shx(mx, 4, lane)); mx = fmaxf(mx, shx(mx, 8, lane)); mx = fmaxf(mx, shx(mx, 16, lane)); mx = fmaxf(mx, shx(mx, 32, lane));
            const float ex = expf(a1 - mx); float den = ex;
            den += shx(den, 4, lane); den += shx(den, 8, lane); den += shx(den, 16, lane); den += shx(den, 32, lane);
            if ((lane & 3) == 0) AFFT[(size_t)r * NE + myexp] = ex / den; } }
    }
    __syncthreads();
}
__device__ __forceinline__ int block_excl_scan(int v, LAS int* wsum, int lane, int wave, int& total) {
    int inc = v;
#pragma unroll
    for (int off = 1; off < 64; off <<= 1) { const int o = shidx_i(inc, (lane - off) & 63); if (lane >= off) inc += o; }
    if (lane == 63) wsum[wave] = inc;
    __syncthreads();
    int base = 0, tot = 0;
#pragma unroll
    for (int w = 0; w < 8; ++w) { const int s = wsum[w]; base += (w < wave) ? s : 0; tot += s; }
    __syncthreads();
    total = tot; return base + inc - v;
}
__device__ __forceinline__ void p7_topk(const Frame& F_, int l) {
    const Frame F = fresh_frame(F_); const Ids I = fresh_ids(F.wave_s);
    const float* AFFT = (const float*)(F.ws + WS_AFFT); int* SLOT = (int*)(F.ws + WS_SLOT);
    int* IDXG = (int*)(F.ws + WS_SLOT + 1179648);
    LAS unsigned* hist = (LAS unsigned*)F.lds;
    LAS unsigned* misc = hist + 256;
    LAS int* wsum = (LAS int*)(hist + 264);
    const int nitems = (l == 0 ? 16 : 8) * NE;
    for (int item = F.vcu; item < nitems; item += F.G) {
        const int set = item >> 4, e = item & 15;
        const int n = set < 8 ? SEQ : CTXL, cap = n >> 3;
        const int row0 = set < 8 ? set * SEQ : NLAT + (set - 8) * CTXL, slotbase = set < 8 ? set * 256 : 2048 + (set - 8) * 32;
        unsigned key[4]; const int i0 = 4 * I.tid; const bool valid = i0 < n;
        { f32x4 a = (f32x4){0.f, 0.f, 0.f, 0.f}; if (valid) { const float* ap = AFFT + (size_t)(row0 + i0) * NE + e; a = (f32x4){ap[0], ap[NE], ap[2 * NE], ap[3 * NE]}; }
          key[0] = __float_as_uint(a.x); key[1] = __float_as_uint(a.y); key[2] = __float_as_uint(a.z); key[3] = __float_as_uint(a.w); }
        unsigned prefix = 0u, kk = (unsigned)cap;
        for (int pass = 3; pass >= 0; --pass) {
            const int shift = 8 * pass;
            if (I.tid < 256) hist[I.tid] = 0u;
            __syncthreads();
            if (valid) {
#pragma unroll
                for (int j = 0; j < 4; ++j) { const bool match = pass == 3 || ((key[j] >> (shift + 8)) == (prefix >> (shift + 8)));
                    if (match) atomicAdd((unsigned*)&hist[(key[j] >> shift) & 255u], 1u); }
            }
            __syncthreads();
            if (I.wave == 0) {
                const unsigned h0 = hist[4 * I.lane], h1 = hist[4 * I.lane + 1], h2 = hist[4 * I.lane + 2], h3 = hist[4 * I.lane + 3];
                const unsigned s = h0 + h1 + h2 + h3; unsigned t = s;
#pragma unroll
                for (int off = 1; off < 64; off <<= 1) { const unsigned o = (unsigned)shidx_i((int)t, (I.lane + off) & 63); if (I.lane + off < 64) t += o; }
                const unsigned above = t - s, c3 = above + h3, c2 = c3 + h2, c1 = c2 + h1, c0 = c1 + h0;
                int d = -1; unsigned nk = 0u;
                if (above < kk && c3 >= kk) { d = 3; nk = kk - above; }
                else if (c3 < kk && c2 >= kk) { d = 2; nk = kk - c3; }
                else if (c2 < kk && c1 >= kk) { d = 1; nk = kk - c2; }
                else if (c1 < kk && c0 >= kk) { d = 0; nk = kk - c1; }
                if (d >= 0) { misc[0] = prefix | ((unsigned)(4 * I.lane + d) << shift); misc[1] = nk; }
            }
            __syncthreads();
            prefix = misc[0]; kk = misc[1];
        }
        int ceq = 0; bool gt[4], eq[4];
#pragma unroll
        for (int j = 0; j < 4; ++j) { gt[j] = valid && key[j] > prefix; eq[j] = valid && key[j] == prefix; ceq += eq[j] ? 1 : 0; }
        int tot; int erank = block_excl_scan(ceq, wsum, I.lane, I.wave, tot);
        bool sel[4]; int csel = 0;
#pragma unroll
        for (int j = 0; j < 4; ++j) { sel[j] = gt[j] || (eq[j] && (unsigned)erank < kk); erank += eq[j] ? 1 : 0; csel += sel[j] ? 1 : 0; }
        int slot = block_excl_scan(csel, wsum, I.lane, I.wave, tot);
        if (valid) {
#pragma unroll
            for (int j = 0; j < 4; ++j) { const int r = row0 + i0 + j;
                if (sel[j]) { if (slot < cap) { IDXG[e * SLOTS + slotbase + slot] = r; SLOT[r * 16 + e] = e * SLOTS + slotbase + slot; } else SLOT[r * 16 + e] = -1; ++slot; }
                else SLOT[r * 16 + e] = -1; }
        }
        __syncthreads();
    }
}

typedef short bf16x8s __attribute__((ext_vector_type(8)));
typedef short s16x4 __attribute__((ext_vector_type(4)));
constexpr int IMGB = 9216;
constexpr int CS_SET = 4 * IMGB + 1024;
constexpr int CS_P = 2 * CS_SET, CS_ST = CS_P + IMGB, CS_NS = CS_ST + 2 * IMGB, CS_GS = CS_NS + 256, CS_GM = CS_GS + 2048, CS_END = CS_GM + 8192;
static_assert(CS_END <= RING_BYTES, "scan LDS map");
__device__ __forceinline__ bf16x8s rowfrag(const LAS unsigned char* img, int row0, int ks, int fr, int fq) { return *(const LAS bf16x8s*)(img + (row0 + fr) * 144 + ks * 64 + fq * 16); }
__device__ __forceinline__ s16x4 tr_rd(const LAS unsigned char* p) { return __builtin_bit_cast(s16x4, __builtin_amdgcn_ds_read_tr16_b64_v4i16((LAS s16x4*)(LAS unsigned char*)p)); }
__device__ __forceinline__ bf16x8s trfrag(const LAS unsigned char* img, int tok0, int col0, int lane) {
    const LAS unsigned char* a = img + (tok0 + 8 * (lane >> 4) + ((lane >> 2) & 3)) * 144 + (col0 + 4 * (lane & 3)) * 2;
    const s16x4 lo = tr_rd(a), hi = tr_rd(a + 4 * 144);
    return (bf16x8s){lo[0], lo[1], lo[2], lo[3], hi[0], hi[1], hi[2], hi[3]};
}
__device__ __forceinline__ f32x4 mfma16(bf16x8s a, bf16x8s b, f32x4 c) { return __builtin_amdgcn_mfma_f32_16x16x32_bf16(a, b, c, 0, 0, 0); }
struct f32x8 { f32x4 a, b; };
__device__ __forceinline__ f32x8 cvt8(v4u w) { f32x8 r; r.a = (f32x4){bf_lo(w.x), bf_hi(w.x), bf_lo(w.y), bf_hi(w.y)}; r.b = (f32x4){bf_lo(w.z), bf_hi(w.z), bf_lo(w.w), bf_hi(w.w)}; return r; }
__device__ __forceinline__ v4u pack8(f32x4 a, f32x4 b) { v4u w; w.x = pg8::cvt_pk_safe(a.x, a.y); w.y = pg8::cvt_pk_safe(a.z, a.w); w.z = pg8::cvt_pk_safe(b.x, b.y); w.w = pg8::cvt_pk_safe(b.z, b.w); return w; }
__device__ __forceinline__ float silu_q(float x) { return x * __builtin_amdgcn_rcpf(1.0f + __expf(-x)); }
__device__ __forceinline__ float sigmoid_q(float x) { return __builtin_amdgcn_rcpf(1.0f + __expf(-x)); }
__device__ __forceinline__ float log_sigmoid_q(float z) { return fminf(z, 0.f) - __logf(1.0f + __expf(-fabsf(z))); }
__device__ __forceinline__ float softplus_q(float x) { return fmaxf(x, 0.f) + __logf(1.0f + __expf(-fabsf(x))); }
template <int N> __device__ __forceinline__ float dpp_row_shr(float v) { return __int_as_float(__builtin_amdgcn_update_dpp(0, __float_as_int(v), 0x110 + N, 0xf, 0xf, true)); }
__device__ __forceinline__ float rdlane(float v, int l) { return __int_as_float(__builtin_amdgcn_readlane(__float_as_int(v), l)); }
__device__ __forceinline__ float wave_incl_scan(float v, int lane) {
    v += dpp_row_shr<1>(v); v += dpp_row_shr<2>(v); v += dpp_row_shr<4>(v); v += dpp_row_shr<8>(v);
    const float t0 = rdlane(v, 15), t1 = rdlane(v, 31), t2 = rdlane(v, 47); const int row = lane >> 4;
    return v + ((row >= 1 ? t0 : 0.f) + (row >= 2 ? t1 : 0.f) + (row >= 3 ? t2 : 0.f));
}
constexpr size_t WS_UC = 701 * MiB, WS_LA = 719 * MiB, WS_END3 = 737 * MiB;
__device__ __forceinline__ void p2t_pretransform(const Frame& F_, int l, bool inplace) {
    const Frame F = fresh_frame(F_); const Ids I = fresh_ids(F.wave_s);
    const int gw = F.vcu * NWAVES + I.wave, NGW = F.G * NWAVES, lane = I.lane;
    bf16* U = (bf16*)(F.ws + WS_U); bf16* UC = (bf16*)(F.ws + WS_UC); float* LA = (float*)(F.ws + WS_LA);
    f32x4 cwa[5], cwb[5], cba, cbb;
    { const float* cw = inp(F.lds, 15) + (size_t)l * 5 * 512 + 8 * lane; const float* cb = inp(F.lds, 16) + l * 512 + 8 * lane;
#pragma unroll
      for (int w = 0; w < 5; ++w) { cwa[w] = *(const f32x4*)(cw + w * 512); cwb[w] = *(const f32x4*)(cw + w * 512 + 4); }
      cba = *(const f32x4*)cb; cbb = *(const f32x4*)(cb + 4); }
    f32x4 gwv[16], gbv;
    { const float* gwp = inp(F.lds, 12) + (size_t)l * 4096 + (lane >> 5) * 2048 + ((4 * lane) & 127);
#pragma unroll
      for (int r = 0; r < 16; ++r) gwv[r] = *(const f32x4*)(gwp + r * 128);
      gbv = *(const f32x4*)(inp(F.lds, 13) + l * 256 + 4 * lane); }
    const int rc = (8 * lane) & 255, rd0 = rc & 63; const bool isq = lane < 32, first = (rd0 & 31) < 16; const int plane = first ? lane + 2 : lane - 2;
    float invf[8];
#pragma unroll
    for (int j = 0; j < 8; ++j) invf[j] = exp2f(-(float)((rd0 & 15) + j) * (13.287712379549449f / 16.0f)) * 0.15915494309189535f;
    constexpr int RB = 2;
    for (int r0 = gw; r0 < NROWS; r0 += NGW * RB) {
        v4u qk[RB], tap[RB][5], lr0[RB], lr1[RB], mk[RB];
#pragma unroll
        for (int q = 0; q < RB; ++q) { const int r = r0 + q * NGW; if (r < NROWS) {
            const bool isctx = r >= NLAT; const int t = isctx ? ((r - NLAT) & (CTXL - 1)) : (r & (SEQ - 1)), len = isctx ? CTXL : SEQ; const size_t rb = (size_t)(r - t);
            const bf16* ur = U + (size_t)r * INP;
            qk[q] = *(const v4u*)(ur + 8 * lane);
#pragma unroll
            for (int w = 0; w < 5; ++w) { const int tt = t + w - 2; const bool ok = tt >= 0 && tt < len; const v4u x = *(const v4u*)(U + (rb + (ok ? tt : t)) * INP + C_SSD + 256 + 8 * lane); tap[q][w] = ok ? x : (v4u){0u, 0u, 0u, 0u}; }
            lr0[q] = *(const v4u*)(ur + C_GLA + 768); lr1[q] = *(const v4u*)(ur + C_GLA + 776);
            mk[q] = (v4u){0u, 0u, 0u, 0u}; if (lane < 32) mk[q] = *(const v4u*)(ur + C_ML + 256 + 8 * lane); } }
#pragma unroll
        for (int q = 0; q < RB; ++q) { const int r = r0 + q * NGW; if (r < NROWS) {
            const bool isctx = r >= NLAT; const int t = isctx ? ((r - NLAT) & (CTXL - 1)) : (r & (SEQ - 1));
            bf16* ur = U + (size_t)r * INP;
            { f32x8 own = cvt8(qk[q]); v4u pq; pq.x = (unsigned)shidx_i((int)qk[q].x, plane); pq.y = (unsigned)shidx_i((int)qk[q].y, plane); pq.z = (unsigned)shidx_i((int)qk[q].z, plane); pq.w = (unsigned)shidx_i((int)qk[q].w, plane);
              const f32x8 par = cvt8(pq); const float sc = isq ? 0.125f : 1.0f;
              if (!isctx) { const float posv = (rd0 < 32) ? (float)(t >> 6) : (float)(t & 63);
#pragma unroll
                  for (int j = 0; j < 8; ++j) { const float rev = posv * invf[j]; const float cs = __builtin_amdgcn_cosf(rev), sn = __builtin_amdgcn_sinf(rev);
                      const float o = j < 4 ? own.a[j & 3] : own.b[j & 3], p = j < 4 ? par.a[j & 3] : par.b[j & 3]; const float n = (first ? o * cs - p * sn : p * sn + o * cs) * sc;
                      if (j < 4) own.a[j & 3] = n; else own.b[j & 3] = n; } }
              else { own.a = own.a * sc; own.b = own.b * sc; }
              const v4u ow = pack8(own.a, own.b); if (inplace) *(v4u*)(ur + 8 * lane) = ow; else asm volatile("" :: "v"(ow)); }
            { f32x4 a0 = cba, a1 = cbb;
#pragma unroll
              for (int w = 0; w < 5; ++w) { const f32x8 x = cvt8(tap[q][w]); a0 += x.a * cwa[w]; a1 += x.b * cwb[w]; }
#pragma unroll
              for (int j = 0; j < 4; ++j) { a0[j] = silu_q(a0[j]); a1[j] = silu_q(a1[j]); }
              *(v4u*)(UC + (size_t)r * 512 + 8 * lane) = pack8(a0, a1); }
            { const f32x8 l0 = cvt8(lr0[q]), l1 = cvt8(lr1[q]); f32x4 z = gbv;
#pragma unroll
              for (int qq = 0; qq < 4; ++qq) { z += gwv[qq] * l0.a[qq] + gwv[4 + qq] * l0.b[qq] + gwv[8 + qq] * l1.a[qq] + gwv[12 + qq] * l1.b[qq]; }
              f32x4 o;
#pragma unroll
              for (int j = 0; j < 4; ++j) o[j] = log_sigmoid_q(z[j]) * (1.0f / 16.0f);
              *(f32x4*)(LA + (size_t)r * 256 + 4 * lane) = o; }
            if (lane < 32) { f32x8 kk = cvt8(mk[q]); kk.a = kk.a * 0.125f; kk.b = kk.b * 0.125f; const v4u kw = pack8(kk.a, kk.b); if (inplace) *(v4u*)(ur + C_ML + 256 + 8 * lane) = kw; else asm volatile("" :: "v"(kw)); } } }
    }
}

constexpr size_t WS_NIN = WS_AFFT + 1179648;
constexpr int S1_SET = 2 * IMGB + 256, S1_GS = 2 * S1_SET, S1_GM = S1_GS + 2048, S1_END = S1_GM + 8192;
struct StRaw { v4u r[10]; float s0, s1; };
__device__ __forceinline__ int nat_chunk(int cc, int dir) { return cc < 4 ? (dir ? 3 - cc : cc) : (dir ? 35 - cc : cc - 4); }

template <int MIX>
__device__ __forceinline__ void state_item(const Frame& F, const Ids& I, int l, int b, int h, int dir, int item) {
    const bf16* U = (const bf16*)(F.ws + WS_U); bf16* SIN = (bf16*)(F.ws + WS_O2) + (size_t)item * 36 * 4096;
    float* NIN = (float*)(F.ws + WS_NIN) + (size_t)((b * 4 + h) * 2 + dir) * 36 * 64;
    LAS unsigned char* sm = F.lds;
    const int lane = I.lane, wave = I.wave, fr = lane & 15, fq = lane >> 4, rt = wave >> 1, cp = wave & 1;
    const int tk = I.tid >> 3, d0 = (I.tid & 7) * 8;
    float c_la = 0.f, c_b0 = 0.f, c_b1 = 0.f;
    if (MIX == 0) c_la = log_sigmoid_f(inp(F.lds, 10)[(l * 2 + dir) * 4 + h]);
    if (MIX == 2) { c_b0 = inp(F.lds, 17)[(l * 2 + dir) * 4 + h]; c_b1 = -expf(inp(F.lds, 18)[(l * 2 + dir) * 4 + h]); }
    if (MIX == 3) { c_b0 = inp(F.lds, 21)[((l * 2 + dir) * 2 + 0) * 4 + h]; c_b1 = inp(F.lds, 21)[((l * 2 + dir) * 2 + 1) * 4 + h]; }
    float invf[8];
#pragma unroll
    for (int j = 0; j < 8; ++j) invf[j] = MIX == 0 ? exp2f(-(float)((d0 & 15) + j) * (13.287712379549449f / 16.0f)) * 0.15915494309189535f : 0.f;
    float gwr[16]; float gbr = 0.f;
    if (MIX == 1) { const float* gw_ = inp(F.lds, 12) + (size_t)(l * 2 + dir) * 16 * 128 + h * 32 + (I.tid & 31);
#pragma unroll
        for (int r = 0; r < 16; ++r) gwr[r] = gw_[r * 128];
        gbr = inp(F.lds, 13)[(l * 2 + dir) * 128 + h * 32 + (I.tid & 31)]; }
    if (MIX == 2) {
        LAS float* cwl = (LAS float*)(sm + S1_GM); const float* cw = inp(F.lds, 15) + (size_t)l * 5 * 512; const float* cb = inp(F.lds, 16) + l * 512; const int g = h >> 1;
        for (int i = I.tid; i < 6 * 128; i += 512) { const int w = i >> 7, c = i & 127; const int ch = c < 64 ? h * 64 + c : 256 + g * 64 + (c - 64); cwl[i] = w < 5 ? cw[w * 512 + ch] : cb[ch]; }
    }
    f32x4 S[2], nst; S[0] = (f32x4){0.f, 0.f, 0.f, 0.f}; S[1] = S[0]; nst = S[0];
    __syncthreads();

    const bf16* UC = (const bf16*)(F.ws + WS_UC); const float* LA = (const float*)(F.ws + WS_LA);
    auto issue = [&](int cc, StRaw& R) {
        const bool isctx = cc < 4; const int rowbase = isctx ? NLAT + b * CTXL : b * SEQ, t0 = 64 * nat_chunk(cc, dir);
        const int t = t0 + tk; const bf16* ur = U + (size_t)(rowbase + t) * INP; const bf16* ul = U + (size_t)(rowbase + t0 + lane) * INP;
        if (MIX == 0) { R.r[0] = *(const v4u*)(ur + C_RET + 256 + h * 64 + d0); R.r[1] = *(const v4u*)(ur + C_RET + 512 + h * 64 + d0); }
        else if (MIX == 1) {
            R.r[1] = *(const v4u*)(ur + C_GLA + 256 + h * 64 + d0); R.r[0] = d0 < 32 ? *(const v4u*)(ur + C_GLA + 128 + h * 32 + d0) : (v4u){0u, 0u, 0u, 0u};
            const int tq = I.tid >> 5, d = I.tid & 31; v4u lf;
            lf.x = __float_as_uint(LA[(size_t)(rowbase + t0 + 4 * tq + 0) * 256 + dir * 128 + h * 32 + d]); lf.y = __float_as_uint(LA[(size_t)(rowbase + t0 + 4 * tq + 1) * 256 + dir * 128 + h * 32 + d]);
            lf.z = __float_as_uint(LA[(size_t)(rowbase + t0 + 4 * tq + 2) * 256 + dir * 128 + h * 32 + d]); lf.w = __float_as_uint(LA[(size_t)(rowbase + t0 + 4 * tq + 3) * 256 + dir * 128 + h * 32 + d]); R.r[2] = lf;
        } else if (MIX == 2) { const int g = h >> 1; const bf16* uc = UC + (size_t)(rowbase + t) * 512;
            R.r[0] = *(const v4u*)(uc + 256 + g * 64 + d0); R.r[1] = *(const v4u*)(uc + h * 64 + d0);
            R.s0 = bf_lo((unsigned)ul[C_SSD + 768 + dir * 4 + h]);
        } else {
            R.r[0] = *(const v4u*)(ur + C_ML + 256 + h * 64 + d0); R.r[1] = *(const v4u*)(ur + C_ML + 512 + h * 64 + d0);
            R.s0 = bf_lo((unsigned)ul[C_ML + 1024 + dir * 8 + h]); R.s1 = bf_lo((unsigned)ul[C_ML + 1024 + dir * 8 + 4 + h]);
        }
    };
    auto finish = [&](int cc, const StRaw& R) {
        LAS unsigned char* set = sm + (cc & 1) * S1_SET; LAS float* ELs = (LAS float*)(set + 2 * IMGB);
        f32x8 k, kp;
        if (MIX != 1) {
            float la, w = 1.f;
            if (MIX == 0) la = c_la;
            else if (MIX == 2) { w = softplus_q(R.s0 + c_b0); la = w * c_b1; }
            else { w = __expf(R.s0 + c_b0); la = log_sigmoid_q(R.s1 + c_b1); }
            const float G = wave_incl_scan(la, lane), T = rdlane(G, 63);
            if (wave == 0) ELs[lane] = __expf(T);
            const float e_l = (dir ? __expf(G - la) : __expf(T - G)) * w;
            const float ck = shidx(e_l, tk);
            k = cvt8(R.r[0]);
            kp.a = k.a * ck; kp.b = k.b * ck;
        } else {
            LAS float* GS = (LAS float*)(sm + S1_GS); LAS float* GM = (LAS float*)(sm + S1_GM);
            const int d = I.tid & 31, tq = I.tid >> 5; float c[4], la4[4]; float run = 0.f;
            la4[0] = __uint_as_float(R.r[2].x); la4[1] = __uint_as_float(R.r[2].y); la4[2] = __uint_as_float(R.r[2].z); la4[3] = __uint_as_float(R.r[2].w);
#pragma unroll
            for (int u = 0; u < 4; ++u) { run += la4[u]; c[u] = run; }
            GS[tq * 32 + d] = run;
            __syncthreads();
            float off = 0.f, tot = 0.f;
#pragma unroll
            for (int qq = 0; qq < 16; ++qq) { const float s = GS[qq * 32 + d]; off += (qq < tq) ? s : 0.f; tot += s; }
#pragma unroll
            for (int u = 0; u < 4; ++u) GM[(4 * tq + u) * 32 + d] = dir ? (off + c[u] - la4[u]) : (tot - (off + c[u]));
            if (tq == 0) { ELs[d] = __expf(tot); ELs[32 + d] = 1.0f; }
            __syncthreads();
            k = cvt8(R.r[0]);
            if (d0 < 32) { const f32x4 g0 = *(const LAS f32x4*)(GM + tk * 32 + d0), g1 = *(const LAS f32x4*)(GM + tk * 32 + d0 + 4);
#pragma unroll
                for (int j = 0; j < 4; ++j) { kp.a[j] = k.a[j] * __expf(g0[j]); kp.b[j] = k.b[j] * __expf(g1[j]); } }
            else kp = k;
        }
        const int ro = tk * 144 + d0 * 2;
        *(LAS v4u*)(set + ro) = pack8(kp.a, kp.b); *(LAS v4u*)(set + IMGB + ro) = R.r[1];
    };

    StRaw Ra, Rb; ConvRaw CR;
    issue(0, Ra); issue(1, Rb); finish(0, Ra);
    const bf16x8s ones = (bf16x8s){0x3F80, 0x3F80, 0x3F80, 0x3F80, 0x3F80, 0x3F80, 0x3F80, 0x3F80};
    auto chunk_body = [&](const int cc, const int cmode, StRaw& Rfar, const StRaw& Rnext) {
        __syncthreads();
        if (cc + 2 < 36) issue(cc + 2, Rfar);
        if (cmode == 1) conv_issue(F.lds, F.ws, l, (F.vcu * NWAVES + wave) * 18 + (cc >> 2), lane, CR);
        const LAS unsigned char* set = sm + (cc & 1) * S1_SET; const LAS unsigned char* KPs = set; const LAS unsigned char* Vs = set + IMGB; const LAS float* ELs = (const LAS float*)(set + 2 * IMGB);
        { const int row = I.tid >> 3, pc = I.tid & 7; v4u sv = (v4u){0u, 0u, 0u, 0u};
          if (cc > 0) sv = *(const LAS v4u*)(sm + S1_END + (cc & 1) * IMGB + row * 144 + pc * 16);
          *(v4u*)(SIN + (size_t)cc * 4096 + row * 64 + pc * 8) = sv; }
        if (MIX == 3) { if (fr == 0 && cp == 0) *(f32x4*)(NIN + cc * 64 + 16 * rt + 4 * fq) = nst; }
        const bf16x8s kf0 = trfrag(KPs, 0, 16 * rt, lane), kf1 = trfrag(KPs, 32, 16 * rt, lane);
        const f32x4 el = *(const LAS f32x4*)(ELs + 16 * rt + 4 * fq);
#pragma unroll
        for (int u = 0; u < 2; ++u) { const int ct = 2 * cp + u; const bf16x8s v0 = trfrag(Vs, 0, 16 * ct, lane), v1 = trfrag(Vs, 32, 16 * ct, lane);
            S[u] = S[u] * el; S[u] = mfma16(kf0, v0, S[u]); S[u] = mfma16(kf1, v1, S[u]); }
        if (MIX == 3) { nst = nst * el; nst = mfma16(kf0, ones, nst); nst = mfma16(kf1, ones, nst); }
        if (cc + 1 < 36) {
#pragma unroll
            for (int u = 0; u < 2; ++u) { const int ct = 2 * cp + u; v2u sw; sw.x = pg8::cvt_pk_safe(S[u][0], S[u][1]); sw.y = pg8::cvt_pk_safe(S[u][2], S[u][3]);
                *(LAS v2u*)(sm + S1_END + ((cc + 1) & 1) * IMGB + (16 * ct + fr) * 144 + (16 * rt + 4 * fq) * 2) = sw; } }
        if (cc + 1 < 36) finish(cc + 1, Rnext);
        if (cmode == 2) conv_finish(CR);
    };
    for (int cc = 0; cc < 36; cc += 4) { chunk_body(cc, 0, Ra, Rb); chunk_body(cc + 1, 0, Rb, Ra); chunk_body(cc + 2, 0, Ra, Rb); chunk_body(cc + 3, 0, Rb, Ra); }
    __syncthreads();
}
__device__ __forceinline__ void p3a_state(const Frame& F_, int l) {
    const Frame F = fresh_frame(F_); const Ids I = fresh_ids(F.wave_s);
    for (int item = F.vcu; item < 256; item += F.G) {
        const int dir = item & 1, h = (item >> 1) & 3, mixer = (item >> 3) & 3, b = item >> 5;
        if (mixer == 0) state_item<0>(F, I, l, b, h, dir, item);
        else if (mixer == 1) state_item<1>(F, I, l, b, h, dir, item);
        else if (mixer == 2) state_item<2>(F, I, l, b, h, dir, item);
        else state_item<3>(F, I, l, b, h, dir, item);
    }
}

constexpr int S2_Q = 0, S2_K = IMGB, S2_V = 2 * IMGB, S2_P = 3 * IMGB, S2_P2 = 4 * IMGB, S2_STF = 5 * IMGB, S2_STB = 6 * IMGB, S2_ARR = 7 * IMGB, S2_NV = S2_ARR + 1024, S2_STAT = S2_NV + 256,
              S2_GS = S2_STAT + 1024, S2_GM = S2_GS + 4096, S2_END = S2_GM + 16384;
constexpr int S2_CST = S2_END, S2_CST_END = S2_CST + 5440 * 4;
static_assert(S2_CST_END <= RING_BYTES && S1_END + 2 * IMGB <= RING_BYTES, "mixer LDS maps");
struct OutAcc { f32x4 y[2]; };
struct HRaw { v4u r[7]; v2u g[2]; float s[4]; };
struct HItem { int mix, b, h, nc, isctx, last; };

template <int MIX>
__device__ __forceinline__ void s2_issue(const Frame& F, const Ids&, int l, const HItem& it, HRaw& R) {
    const Ids I = fresh_ids(F.wave_s);
    const bf16* U = (const bf16*)(F.ws + WS_U); const bf16* SINB = (const bf16*)(F.ws + WS_O2); const float* NINB = (const float*)(F.ws + WS_NIN);
    const int lane = I.lane, wave = I.wave, fr = lane & 15, fq = lane >> 4, rt = wave >> 1, cp = wave & 1, tk = I.tid >> 3, d0 = (I.tid & 7) * 8;
    const int b = it.b, h = it.h, nc = it.nc; const bool isctx = it.isctx;
    const int len = isctx ? CTXL : SEQ, rowbase = isctx ? NLAT + b * CTXL : b * SEQ, t0 = 64 * nc, t = t0 + tk;
    const int item_f = b * 32 + MIX * 8 + h * 2, cc_f = isctx ? nc : 4 + nc, cc_b = isctx ? 3 - nc : 35 - nc;
    const bf16* ur = U + (size_t)(rowbase + t) * INP; const bf16* ul = U + (size_t)(rowbase + t0 + lane) * INP;
    const int row = I.tid >> 3, pc = I.tid & 7;
    const int orow = rowbase + t0 + 16 * rt + fr;
    if (MIX == 0) {
        R.r[0] = *(const v4u*)(ur + C_RET + h * 64 + d0); R.r[1] = *(const v4u*)(ur + C_RET + 256 + h * 64 + d0); R.r[2] = *(const v4u*)(ur + C_RET + 512 + h * 64 + d0);
        R.r[5] = *(const v4u*)(SINB + ((size_t)item_f * 36 + cc_f) * 4096 + row * 64 + 8 * pc); R.r[6] = *(const v4u*)(SINB + ((size_t)(item_f + 1) * 36 + cc_b) * 4096 + row * 64 + 8 * pc);
#pragma unroll
        for (int u = 0; u < 2; ++u) R.g[u] = *(const v2u*)(U + (size_t)orow * INP + C_RET + 768 + h * 64 + 16 * (2 * cp + u) + 4 * fq);
    } else if (MIX == 1) {
        R.r[2] = *(const v4u*)(ur + C_GLA + 256 + h * 64 + d0);
        if (d0 < 32) { R.r[0] = *(const v4u*)(ur + C_GLA + h * 32 + d0); R.r[1] = *(const v4u*)(ur + C_GLA + 128 + h * 32 + d0); } else { R.r[0] = (v4u){0u, 0u, 0u, 0u}; R.r[1] = R.r[0]; }
        R.r[3] = *(const v4u*)(SINB + ((size_t)(item_f + (pc >> 2)) * 36 + (pc < 4 ? cc_f : cc_b)) * 4096 + row * 64 + 8 * (pc & 3));
        { const int tq = I.tid >> 5, d = I.tid & 31; const float* la = (const float*)(F.ws + WS_LA) + (size_t)(rowbase + t0 + 4 * tq) * 256 + h * 32 + d; v4u lf, lb;
          lf.x = __float_as_uint(la[0]); lf.y = __float_as_uint(la[256]); lf.z = __float_as_uint(la[512]); lf.w = __float_as_uint(la[768]);
          lb.x = __float_as_uint(la[128]); lb.y = __float_as_uint(la[128 + 256]); lb.z = __float_as_uint(la[128 + 512]); lb.w = __float_as_uint(la[128 + 768]); R.r[4] = lf; R.r[5] = lb; }
#pragma unroll
        for (int u = 0; u < 2; ++u) R.g[u] = *(const v2u*)(U + (size_t)orow * INP + C_GLA + 512 + h * 64 + 16 * (2 * cp + u) + 4 * fq);
    } else if (MIX == 2) { const int g = h >> 1; const bf16* uc = (const bf16*)(F.ws + WS_UC) + (size_t)(rowbase + t) * 512;
        R.r[0] = *(const v4u*)(uc + h * 64 + d0); R.r[1] = *(const v4u*)(uc + 256 + g * 64 + d0); R.r[2] = *(const v4u*)(uc + 384 + g * 64 + d0);
        R.r[5] = *(const v4u*)(SINB + ((size_t)item_f * 36 + cc_f) * 4096 + row * 64 + 8 * pc); R.r[6] = *(const v4u*)(SINB + ((size_t)(item_f + 1) * 36 + cc_b) * 4096 + row * 64 + 8 * pc);
        R.s[0] = bf_lo((unsigned)ul[C_SSD + 768 + h]); R.s[1] = bf_lo((unsigned)ul[C_SSD + 768 + 4 + h]);
#pragma unroll
        for (int u = 0; u < 2; ++u) R.g[u] = *(const v2u*)(U + (size_t)orow * INP + C_SSD + h * 64 + 16 * (2 * cp + u) + 4 * fq);
    } else {
        R.r[0] = *(const v4u*)(ur + C_ML + h * 64 + d0); R.r[1] = *(const v4u*)(ur + C_ML + 256 + h * 64 + d0); R.r[2] = *(const v4u*)(ur + C_ML + 512 + h * 64 + d0);
        R.r[3] = *(const v4u*)(SINB + ((size_t)item_f * 36 + cc_f) * 4096 + row * 64 + 8 * pc); R.r[4] = *(const v4u*)(SINB + ((size_t)(item_f + 1) * 36 + cc_b) * 4096 + row * 64 + 8 * pc);
        if (I.tid < 32) R.r[5] = *(const v4u*)(NINB + ((size_t)((b * 4 + h) * 2 + (I.tid >> 4)) * 36 + ((I.tid >> 4) ? cc_b : cc_f)) * 64 + 4 * (I.tid & 15));
        R.s[0] = bf_lo((unsigned)ul[C_ML + 1024 + h]); R.s[1] = bf_lo((unsigned)ul[C_ML + 1024 + 4 + h]); R.s[2] = bf_lo((unsigned)ul[C_ML + 1024 + 8 + h]); R.s[3] = bf_lo((unsigned)ul[C_ML + 1024 + 12 + h]);
#pragma unroll
        for (int u = 0; u < 2; ++u) R.g[u] = *(const v2u*)(U + (size_t)orow * INP + C_ML + 768 + h * 64 + 16 * (2 * cp + u) + 4 * fq);
    }
}
template <int MIX>
__device__ __forceinline__ void s2_transform(const Frame& F, const Ids&, int l, const HItem& it, const HRaw& R) {
    const Ids I = fresh_ids(F.wave_s);
    LAS unsigned char* sm = F.lds;
    const int lane = I.lane, wave = I.wave, tk = I.tid >> 3, d0 = (I.tid & 7) * 8; const int h = it.h; const bool isctx = it.isctx; const int t = 64 * it.nc + tk;
    LAS float* GF = (LAS float*)(sm + S2_ARR); LAS float* HB = GF + 64; LAS float* WF = GF + 128; LAS float* WB = GF + 192;
    const int row = I.tid >> 3, pc = I.tid & 7;
    f32x8 q, k, v;
    if (MIX != 1) {
        const v4u sf = (MIX == 0 || MIX == 2) ? R.r[5] : R.r[3], sb = (MIX == 0 || MIX == 2) ? R.r[6] : R.r[4];
        *(LAS v4u*)(sm + S2_STF + row * 144 + pc * 16) = sf; *(LAS v4u*)(sm + S2_STB + row * 144 + pc * 16) = sb;
        if (MIX == 3 && I.tid < 32) { const f32x4 nv = __builtin_bit_cast(f32x4, R.r[5]); v2u w; w.x = pg8::cvt_pk_safe(nv[0], nv[1]); w.y = pg8::cvt_pk_safe(nv[2], nv[3]); *(LAS v2u*)(sm + S2_NV + (I.tid >> 4) * 128 + 8 * (I.tid & 15)) = w; }
        float laf, lab, wf = 1.f, wb = 1.f;
        const LAS float* cst = (const LAS float*)(sm + S2_CST);
        if (MIX == 0) { laf = cst[h]; lab = cst[4 + h]; }
        else if (MIX == 2) { wf = softplus_q(R.s[0] + cst[8 + h]); wb = softplus_q(R.s[1] + cst[12 + h]); laf = wf * cst[16 + h]; lab = wb * cst[20 + h]; }
        else { const LAS float* gb = cst + 32; wf = __expf(R.s[0] + gb[h]); laf = log_sigmoid_q(R.s[1] + gb[4 + h]); wb = __expf(R.s[2] + gb[8 + h]); lab = log_sigmoid_q(R.s[3] + gb[12 + h]); }
        const float Gf = wave_incl_scan(laf, lane), Gb = wave_incl_scan(lab, lane), Tb = rdlane(Gb, 63);
        if (wave == 0) { GF[lane] = Gf; HB[lane] = Tb - Gb + lab; WF[lane] = wf; WB[lane] = wb; }
        const int ro = tk * 144 + d0 * 2;
        *(LAS v4u*)(sm + S2_Q + ro) = MIX == 2 ? R.r[2] : R.r[0]; *(LAS v4u*)(sm + S2_K + ro) = R.r[1]; *(LAS v4u*)(sm + S2_V + ro) = MIX == 2 ? R.r[0] : R.r[2];
    } else {
        *(LAS v4u*)(sm + S2_STF + row * 144 + pc * 16) = R.r[3];
        LAS float* GS = (LAS float*)(sm + S2_GS); LAS float* GM = (LAS float*)(sm + S2_GM);
        const int d = I.tid & 31, tq = I.tid >> 5; float cfw[4], cbw[4], lbw[4]; float runf = 0.f, runb = 0.f;
        const float lfw[4] = {__uint_as_float(R.r[4].x), __uint_as_float(R.r[4].y), __uint_as_float(R.r[4].z), __uint_as_float(R.r[4].w)};
        lbw[0] = __uint_as_float(R.r[5].x); lbw[1] = __uint_as_float(R.r[5].y); lbw[2] = __uint_as_float(R.r[5].z); lbw[3] = __uint_as_float(R.r[5].w);
#pragma unroll
        for (int u = 0; u < 4; ++u) { runf += lfw[u]; cfw[u] = runf; runb += lbw[u]; cbw[u] = runb; }
        GS[tq * 32 + d] = runf; GS[512 + tq * 32 + d] = runb;
        __syncthreads();
        float offf = 0.f, offb = 0.f, totb = 0.f;
#pragma unroll
        for (int qq = 0; qq < 16; ++qq) { const float sf = GS[qq * 32 + d], sb = GS[512 + qq * 32 + d]; offf += (qq < tq) ? sf : 0.f; offb += (qq < tq) ? sb : 0.f; totb += sb; }
#pragma unroll
        for (int u = 0; u < 4; ++u) { GM[(4 * tq + u) * 32 + d] = offf + cfw[u]; GM[2048 + (4 * tq + u) * 32 + d] = totb - (offb + cbw[u]) + lbw[u]; }
        if (I.tid < 64) { GF[I.tid] = 0.f; HB[I.tid] = 0.f; WF[I.tid] = 1.f; WB[I.tid] = 1.f; }
        __syncthreads();
        *(LAS v4u*)(sm + S2_V + tk * 144 + d0 * 2) = R.r[2];
        if (d0 < 32) { q = cvt8(R.r[0]); k = cvt8(R.r[1]);
            const f32x4 gf0 = *(const LAS f32x4*)(GM + tk * 32 + d0), gf1 = *(const LAS f32x4*)(GM + tk * 32 + d0 + 4), gb0 = *(const LAS f32x4*)(GM + 2048 + tk * 32 + d0), gb1 = *(const LAS f32x4*)(GM + 2048 + tk * 32 + d0 + 4);
            f32x8 qf, kf, qb, kb;
#pragma unroll
            for (int j = 0; j < 4; ++j) { qf.a[j] = q.a[j] * 0.17677669529663687f * __expf(gf0[j]); qf.b[j] = q.b[j] * 0.17677669529663687f * __expf(gf1[j]); kf.a[j] = k.a[j] * __expf(-gf0[j]); kf.b[j] = k.b[j] * __expf(-gf1[j]);
                qb.a[j] = q.a[j] * 0.17677669529663687f * __expf(gb0[j]); qb.b[j] = q.b[j] * 0.17677669529663687f * __expf(gb1[j]); kb.a[j] = k.a[j] * __expf(-gb0[j]); kb.b[j] = k.b[j] * __expf(-gb1[j]); }
            const int ro = tk * 144 + d0 * 2;
            *(LAS v4u*)(sm + S2_Q + ro) = pack8(qf.a, qf.b); *(LAS v4u*)(sm + S2_Q + ro + 64) = pack8(qb.a, qb.b); *(LAS v4u*)(sm + S2_K + ro) = pack8(kf.a, kf.b); *(LAS v4u*)(sm + S2_K + ro + 64) = pack8(kb.a, kb.b); }
    }
}
template <int MIX>
__device__ __forceinline__ OutAcc s2_compute(const Frame& F, const Ids&, int l, const HItem& it, const v2u (&zg)[2]) {
    const Ids I = fresh_ids(F.wave_s);
    LAS unsigned char* sm = F.lds;
    const int lane = I.lane, wave = I.wave, fr = lane & 15, fq = lane >> 4, rt = wave >> 1, cp = wave & 1; const int h = it.h;
    const LAS float* GF = (const LAS float*)(sm + S2_ARR); const LAS float* HB = GF + 64; const LAS float* WF = GF + 128; const LAS float* WB = GF + 192;
    const int irow = 16 * rt + fr;
    const float gfi = GF[irow], hbi = HB[irow];
    const bf16x8s qf0 = rowfrag(sm + S2_Q, 16 * rt, 0, fr, fq), qf1 = rowfrag(sm + S2_Q, 16 * rt, 1, fr, fq);
#pragma unroll
    for (int u = 0; u < 2; ++u) { const int jt = 2 * cp + u;
        f32x4 sc = (f32x4){0.f, 0.f, 0.f, 0.f}, sc2 = sc;
        sc = mfma16(rowfrag(sm + S2_K, 16 * jt, 0, fr, fq), qf0, sc);
        if (MIX == 1) sc2 = mfma16(rowfrag(sm + S2_K, 16 * jt, 1, fr, fq), qf1, sc2); else sc = mfma16(rowfrag(sm + S2_K, 16 * jt, 1, fr, fq), qf1, sc);
        const f32x4 gj = *(const LAS f32x4*)(GF + 16 * jt + 4 * fq), hj = *(const LAS f32x4*)(HB + 16 * jt + 4 * fq), wfj = *(const LAS f32x4*)(WF + 16 * jt + 4 * fq), wbj = *(const LAS f32x4*)(WB + 16 * jt + 4 * fq);
        float pa[4], pb[4];
#pragma unroll
        for (int r = 0; r < 4; ++r) { const int j = 16 * jt + 4 * fq + r;
            const float ef = (j <= irow) ? __expf(fminf(gfi - gj[r], 0.f)) * wfj[r] : 0.f, eb = (j >= irow) ? __expf(fminf(hbi - hj[r], 0.f)) * wbj[r] : 0.f;
            if (MIX == 1) { pa[r] = sc[r] * ef + sc2[r] * eb; pb[r] = 0.f; } else if (MIX == 3) { pa[r] = sc[r] * ef; pb[r] = sc[r] * eb; } else { pa[r] = sc[r] * (ef + eb); pb[r] = 0.f; } }
        v2u pw; pw.x = pg8::cvt_pk_safe(pa[0], pa[1]); pw.y = pg8::cvt_pk_safe(pa[2], pa[3]); *(LAS v2u*)(sm + S2_P + irow * 144 + (16 * jt + 4 * fq) * 2) = pw;
        if (MIX == 3) { v2u pw2; pw2.x = pg8::cvt_pk_safe(pb[0], pb[1]); pw2.y = pg8::cvt_pk_safe(pb[2], pb[3]); *(LAS v2u*)(sm + S2_P2 + irow * 144 + (16 * jt + 4 * fq) * 2) = pw2; } }
    f32x4 o2f[2], o2b[2], e2f = (f32x4){0.f, 0.f, 0.f, 0.f}, e2b = e2f;
#pragma unroll
    for (int u = 0; u < 2; ++u) { const int ct = 2 * cp + u; o2f[u] = (f32x4){0.f, 0.f, 0.f, 0.f}; o2b[u] = o2f[u];
        o2f[u] = mfma16(rowfrag(sm + S2_STF, 16 * ct, 0, fr, fq), qf0, o2f[u]); o2f[u] = mfma16(rowfrag(sm + S2_STF, 16 * ct, 1, fr, fq), qf1, o2f[u]);
        if (MIX != 1) { o2b[u] = mfma16(rowfrag(sm + S2_STB, 16 * ct, 0, fr, fq), qf0, o2b[u]); o2b[u] = mfma16(rowfrag(sm + S2_STB, 16 * ct, 1, fr, fq), qf1, o2b[u]); } }
    if (MIX == 3) { const LAS unsigned char* nv = sm + S2_NV;
        e2f = mfma16(*(const LAS bf16x8s*)(nv + fq * 16), qf0, e2f); e2f = mfma16(*(const LAS bf16x8s*)(nv + 64 + fq * 16), qf1, e2f);
        e2b = mfma16(*(const LAS bf16x8s*)(nv + 128 + fq * 16), qf0, e2b); e2b = mfma16(*(const LAS bf16x8s*)(nv + 192 + fq * 16), qf1, e2b); }
    bf16x8s vf[2][2];
#pragma unroll
    for (int u = 0; u < 2; ++u) { vf[u][0] = trfrag(sm + S2_V, 0, 16 * (2 * cp + u), lane); vf[u][1] = trfrag(sm + S2_V, 32, 16 * (2 * cp + u), lane); }
    __syncthreads();
    const bf16x8s pf0 = rowfrag(sm + S2_P, 16 * rt, 0, fr, fq), pf1 = rowfrag(sm + S2_P, 16 * rt, 1, fr, fq);
    const float egf = __expf(gfi), egb = __expf(hbi);
    const bf16x8s ones = (bf16x8s){0x3F80, 0x3F80, 0x3F80, 0x3F80, 0x3F80, 0x3F80, 0x3F80, 0x3F80};
    OutAcc A;
    if (MIX == 3) {
        const bf16x8s pb0 = rowfrag(sm + S2_P2, 16 * rt, 0, fr, fq), pb1 = rowfrag(sm + S2_P2, 16 * rt, 1, fr, fq);
        f32x4 e1f = (f32x4){0.f, 0.f, 0.f, 0.f}, e1b = e1f; e1f = mfma16(ones, pf0, e1f); e1f = mfma16(ones, pf1, e1f); e1b = mfma16(ones, pb0, e1b); e1b = mfma16(ones, pb1, e1b);
        const float sf = 1.0f / fmaxf(fabsf(e1f[0] + egf * e2f[0]), 1.0f), sb = 1.0f / fmaxf(fabsf(e1b[0] + egb * e2b[0]), 1.0f);
#pragma unroll
        for (int u = 0; u < 2; ++u) { f32x4 of = (f32x4){0.f, 0.f, 0.f, 0.f}, ob = of; of = mfma16(vf[u][0], pf0, of); of = mfma16(vf[u][1], pf1, of); ob = mfma16(vf[u][0], pb0, ob); ob = mfma16(vf[u][1], pb1, ob);
            A.y[u] = (of + o2f[u] * egf) * sf + (ob + o2b[u] * egb) * sb; }
    } else {
#pragma unroll
        for (int u = 0; u < 2; ++u) { f32x4 o1 = (f32x4){0.f, 0.f, 0.f, 0.f}; o1 = mfma16(vf[u][0], pf0, o1); o1 = mfma16(vf[u][1], pf1, o1);
            A.y[u] = MIX == 1 ? (o1 + o2f[u]) : (o1 + o2f[u] * egf + o2b[u] * egb); }
    }
    if (MIX == 2) { const float dsk = ((const LAS float*)(sm + S2_CST))[24 + h];
#pragma unroll
        for (int u = 0; u < 2; ++u) { const int c0 = 16 * (2 * cp + u) + 4 * fq; const v2u xw = *(const LAS v2u*)(sm + S2_V + irow * 144 + c0 * 2);
            const f32x4 xs = (f32x4){bf_lo(xw.x), bf_hi(xw.x), bf_lo(xw.y), bf_hi(xw.y)}, z = (f32x4){bf_lo(zg[u].x), bf_hi(zg[u].x), bf_lo(zg[u].y), bf_hi(zg[u].y)};
#pragma unroll
            for (int r = 0; r < 4; ++r) A.y[u][r] = (A.y[u][r] + dsk * xs[r]) * silu_q(z[r]); }
    }
    return A;
}
__device__ __forceinline__ void token_stats(LAS unsigned char* sm, int rt, int cp, int fr, int fq, int lane, float& s1, float& s2) {
    s1 += shx(s1, 16, lane); s1 += shx(s1, 32, lane); s2 += shx(s2, 16, lane); s2 += shx(s2, 32, lane);
    LAS float* ST = (LAS float*)(sm + S2_STAT);
    if (fq == 0) { ST[((16 * rt + fr) * 2 + cp) * 2] = s1; ST[((16 * rt + fr) * 2 + cp) * 2 + 1] = s2; }
    __syncthreads();
    const f32x4 a = *(const LAS f32x4*)(ST + (16 * rt + fr) * 4); s1 = a[0] + a[2]; s2 = a[1] + a[3];
}
__device__ __forceinline__ HItem s2_item(int j, int blk, int G, int NCH, bool ctx_out, int nsu, int u0) {
    HItem it; int c;
    if (j < 4 * nsu) { const int u = blk + (j >> 2) * G; it.mix = 2; it.b = u / NCH; c = u % NCH; it.h = j & 3; it.last = (j & 3) == 3; }
    else { const int u = u0 + (j - 4 * nsu), mh = u % 12, bc = u / 12; it.b = bc / NCH; c = bc % NCH; const int m3 = mh >> 2; it.mix = m3 == 0 ? 0 : (m3 == 1 ? 1 : 3); it.h = mh & 3; it.last = true; }
    it.isctx = ctx_out && c < 4; it.nc = ctx_out ? (it.isctx ? c : c - 4) : c; return it;
}
__device__ __forceinline__ void p3b_output(const Frame& F_, int l, bool ctx_out) {
    const Frame F = fresh_frame(F_); const Ids I = fresh_ids(F.wave_s);
    bf16* Y = (bf16*)(F.ws + WS_Y);
    const int lane = I.lane, wave = I.wave, fr = lane & 15, fq = lane >> 4, rt = wave >> 1, cp = wave & 1;
    const int NCH = ctx_out ? 36 : 32, nssd = 8 * NCH, blk = F.vcu, G = F.G;
    const int extra = nssd - G, nsu = 1 + (blk < extra ? 1 : 0);
    const int per_lo = (16 * NCH * 8) / G - 8, per_hi = per_lo + 4;
    const int u0 = blk < extra ? blk * per_lo : extra * per_lo + (blk - extra) * per_hi, cnt = blk < extra ? per_lo : per_hi, nitems = 4 * nsu + cnt;
    {
        LAS float* cwl = (LAS float*)(F.lds + S2_GM); const float* cw = inp(F.lds, 15) + (size_t)l * 5 * 512; const float* cb = inp(F.lds, 16) + l * 512;
        for (int i = I.tid; i < 6 * 512; i += 512) cwl[i] = i < 2560 ? cw[i] : cb[i - 2560];
        LAS float* cst = (LAS float*)(F.lds + S2_CST);
        if (I.tid < 8) { cst[I.tid] = log_sigmoid_f(inp(F.lds, 10)[l * 8 + I.tid]); cst[8 + I.tid] = inp(F.lds, 17)[l * 8 + I.tid]; cst[16 + I.tid] = -expf(inp(F.lds, 18)[l * 8 + I.tid]); }
        if (I.tid < 4) cst[24 + I.tid] = inp(F.lds, 19)[l * 4 + I.tid];
        if (I.tid < 16) cst[32 + I.tid] = inp(F.lds, 21)[l * 16 + I.tid];
        if (I.tid < 256) { cst[64 + I.tid] = inp(F.lds, 11)[l * 256 + I.tid]; cst[320 + I.tid] = inp(F.lds, 14)[l * 256 + I.tid]; cst[576 + I.tid] = inp(F.lds, 20)[l * 256 + I.tid]; cst[832 + I.tid] = inp(F.lds, 22)[l * 256 + I.tid];
            cst[5184 + I.tid] = inp(F.lds, 13)[l * 256 + I.tid]; }
        for (int i = I.tid; i < 4096; i += 512) cst[1088 + i] = inp(F.lds, 12)[(size_t)l * 4096 + i];
    }
    __syncthreads();
    HRaw Ra;
    { const HItem i0 = s2_item(0, blk, G, NCH, ctx_out, nsu, u0); s2_issue<2>(F, I, l, i0, Ra); }
    unsigned ssdy[3][2][2] = {}; float ssd_s2 = 0.f;
    ConvRaw CR;
    auto item_body = [&](const int j, HRaw& R, const int cmode) {
        const HItem cur = s2_item(j, blk, G, NCH, ctx_out, nsu, u0);
        if (cur.mix == 0) s2_transform<0>(F, I, l, cur, R); else if (cur.mix == 1) s2_transform<1>(F, I, l, cur, R); else if (cur.mix == 2) s2_transform<2>(F, I, l, cur, R); else s2_transform<3>(F, I, l, cur, R);
        const v2u zg[2] = {R.g[0], R.g[1]};
        __syncthreads();
        if (j + 1 < nitems) { const HItem nxt = s2_item(j + 1, blk, G, NCH, ctx_out, nsu, u0);
            if (nxt.mix == 0) s2_issue<0>(F, I, l, nxt, R); else if (nxt.mix == 1) s2_issue<1>(F, I, l, nxt, R); else if (nxt.mix == 2) s2_issue<2>(F, I, l, nxt, R); else s2_issue<3>(F, I, l, nxt, R); }
        if (cmode == 1) conv_issue(F.lds, F.ws, l, (F.vcu * NWAVES + wave) * 18 + 9 + (j >> 1), lane, CR);
        OutAcc A;
        if (cur.mix == 0) A = s2_compute<0>(F, I, l, cur, zg); else if (cur.mix == 1) A = s2_compute<1>(F, I, l, cur, zg); else if (cur.mix == 2) A = s2_compute<2>(F, I, l, cur, zg); else A = s2_compute<3>(F, I, l, cur, zg);
        const int row = (cur.isctx ? NLAT + cur.b * CTXL : cur.b * SEQ) + 64 * cur.nc + 16 * rt + fr;
        if (cur.mix == 2) {
#pragma unroll
            for (int u = 0; u < 2; ++u)
#pragma unroll
                for (int r = 0; r < 4; ++r) ssd_s2 += A.y[u][r] * A.y[u][r];
            if (!cur.last) {
#pragma unroll
                for (int hh = 0; hh < 3; ++hh) {
#pragma unroll
                    for (int u = 0; u < 2; ++u) { const unsigned p0 = pg8::cvt_pk_safe(A.y[u][0], A.y[u][1]), p1 = pg8::cvt_pk_safe(A.y[u][2], A.y[u][3]);
                        ssdy[hh][u][0] = cur.h == hh ? p0 : ssdy[hh][u][0]; ssdy[hh][u][1] = cur.h == hh ? p1 : ssdy[hh][u][1]; } }
                __syncthreads();
            } else {
                float s1 = 0.f, s2 = ssd_s2; token_stats(F.lds, rt, cp, fr, fq, lane, s1, s2); ssd_s2 = 0.f;
                const float rs = 1.0f / sqrtf(s2 * (1.0f / 256.0f) + EPS); const LAS float* nw = (const LAS float*)(F.lds + S2_CST) + 576;
#pragma unroll
                for (int hh = 0; hh < 4; ++hh)
#pragma unroll
                    for (int u = 0; u < 2; ++u) { const int c0 = hh * 64 + 16 * (2 * cp + u) + 4 * fq;
                        const f32x4 yv = hh < 3 ? (f32x4){bf_lo(ssdy[hh < 3 ? hh : 0][u][0]), bf_hi(ssdy[hh < 3 ? hh : 0][u][0]), bf_lo(ssdy[hh < 3 ? hh : 0][u][1]), bf_hi(ssdy[hh < 3 ? hh : 0][u][1])} : A.y[u];
                        st_bf4(Y + (size_t)row * D + 512 + c0, yv * rs * *(const LAS f32x4*)(nw + c0)); }
                __syncthreads();
            }
        } else {
            float s1 = 0.f, s2 = 0.f;
#pragma unroll
            for (int u = 0; u < 2; ++u)
#pragma unroll
                for (int r = 0; r < 4; ++r) { s1 += A.y[u][r]; s2 += A.y[u][r] * A.y[u][r]; }
            token_stats(F.lds, rt, cp, fr, fq, lane, s1, s2);
            const float mean = cur.mix == 0 ? s1 * (1.0f / 64.0f) : 0.f;
            const float rs = 1.0f / sqrtf(fmaxf(s2 * (1.0f / 64.0f) - mean * mean, 0.f) + EPS);
            const LAS float* nw = (const LAS float*)(F.lds + S2_CST) + 64 + (cur.mix == 0 ? 0 : cur.mix == 1 ? 256 : 768) + cur.h * 64;
#pragma unroll
            for (int u = 0; u < 2; ++u) { const int c0 = 16 * (2 * cp + u) + 4 * fq; const f32x4 w = *(const LAS f32x4*)(nw + c0); f32x4 y;
                const f32x4 g = (f32x4){bf_lo(zg[u].x), bf_hi(zg[u].x), bf_lo(zg[u].y), bf_hi(zg[u].y)};
#pragma unroll
                for (int r = 0; r < 4; ++r) y[r] = (A.y[u][r] - mean) * rs * w[r] * (cur.mix == 3 ? sigmoid_q(g[r]) : silu_q(g[r]));
                st_bf4(Y + (size_t)row * D + cur.mix * 256 + cur.h * 64 + c0, y); }
            __syncthreads();
        }
        if (cmode == 2) conv_finish(CR);
    };
    for (int j = 0; j < nitems; j += 2) { item_body(j, Ra, 0); item_body(j + 1, Ra, 0); }
}

struct Args { const float* in[28]; float* out; unsigned char* ws; int ph_lo, ph_hi, use_bar, never; };
__global__ void __launch_bounds__(NWAVES * 64, 2) fwd_kernel(Args args) {
    extern __shared__ __attribute__((aligned(16))) unsigned char lds[];
    Frame F;
    F.lds = (LAS unsigned char*)lds;
        F.wave_s = __builtin_amdgcn_readfirstlane((int)threadIdx.x >> 6);
    F.G = gridDim.x; { const int bx = blockIdx.x; F.vcu = (F.G % 8 == 0) ? (bx % 8) * (F.G / 8) + bx / 8 : bx; }
    F.ws = args.ws;
    if (args.never) cooperative_groups::this_grid().sync();
    for (int u = F.wave_s * 64 + lane_id(); u < (LDS_BYTES - LDSCTL_OFF) / 4; u += NWAVES * 64) ((LAS unsigned*)(F.lds + LDSCTL_OFF))[u] = 0u;
    __syncthreads();
    if (F.wave_s == 0 && lane_id() == 0) { LAS unsigned long long* tab = (LAS unsigned long long*)(F.lds + LDSCTL_OFF);
#pragma unroll
        for (int i = 0; i < 28; ++i) tab[i] = (unsigned long long)args.in[i];
        tab[28] = (unsigned long long)args.out; }
    __syncthreads();
    XcdBarrier bar; bar.bar = (unsigned*)(F.ws + WS_CTL) + CW_BAR; bar.x = 0; bar.st = nullptr; bar.wave_s = F.wave_s;
    if (args.use_bar) bar = xcd_barrier_post((unsigned*)(F.ws + WS_CTL) + CW_BAR, (volatile LAS unsigned*)(F.lds + MISC_OFF) + 8, F.wave_s);
    const int lo = args.ph_lo, hi = args.ph_hi;
#define IN(k) (lo <= (k) && (k) < hi)
#define PS_REC(i) do { if (PSPIN && blockIdx.x == 0 && F.wave_s == 0 && lane_id() == 0) { ((unsigned long long*)(F.ws + WS_CTL + 655360))[i] = __builtin_amdgcn_s_memrealtime(); ((unsigned*)(F.ws + WS_CTL + 659456))[i] = xb_ld((unsigned*)(F.ws + WS_CTL) + 8192); } } while (0)
    PS_REC(0);
#define SEAM(k) do { if (IN(k) && IN((k) + 1)) xcd_barrier(bar); PS_REC((k) + 1); } while (0)
#ifndef PROBE_DUP
#define PROBE_DUP -1
#endif
#define PH_BEGIN(kind) for (int rep_ = 0; rep_ < ((PROBE_DUP) == (kind) ? 2 : 1); ++rep_) { if (rep_) xcd_barrier(bar);
#define PH_END }
    #ifndef NO_P0
    PH_BEGIN(0) if (IN(0)) { p0_prologue(F); } PH_END
#endif
    SEAM(0);
#pragma unroll
    for (int l = 0; l < 2; ++l) {
        const int pb = 1 + 10 * l;
        const bool ctx_out = l == 0;
        const int mrows = ctx_out ? NROWS : NLAT;
#ifndef NO_P1
        PH_BEGIN(1) if (IN(pb + 0)) { p1_norm1(F, l, rep_ == 0 ? 1.0f : 0.0f); } PH_END
#endif
        SEAM(pb + 0);
        PH_BEGIN(2) if (IN(pb + 1)) {
            const Frame Fg = fresh_frame(F);
            pg8::Gemm g{(const bf16*)(Fg.ws + WS_HN), (const bf16*)(Fg.ws + WS_WTIN) + (size_t)l * INP * 1024, NROWS, INP, D}; pg8::StaticOrder S; S.init(NROWS, INP, F.G, (int)blockIdx.x, 27);
            pg8::EpiStoreBf16 E{(bf16*)(Fg.ws + WS_U), INP, 0, 0};
            pg8::gemm_phase<pg8::EpiStoreBf16, pg8::StaticOrder, PG8_ALIGN, PG8_SP2>(Fg.lds, g, S, E, F.wave_s);
            if (((int)blockIdx.x >> 3) < 27) conv_worker_done(F, 4 * l + 0); else conv_host(F, 4 * l + 0, 1u, 0);
        }
        PH_END
        SEAM(pb + 1);
        PH_BEGIN(11) if (IN(pb + 2)) { p2t_pretransform(F, l, rep_ == 0); } PH_END
        SEAM(pb + 2);
        PH_BEGIN(3) if (IN(pb + 3)) { p3a_state(F, l); } PH_END
        SEAM(pb + 3);
        PH_BEGIN(4) if (IN(pb + 4)) { p3b_output(F, l, ctx_out); } PH_END
        SEAM(pb + 4);
        PH_BEGIN(5) if (IN(pb + 5)) {
            const Frame Fg = fresh_frame(F);
            pg8::Gemm g{(const bf16*)(Fg.ws + WS_Y), (const bf16*)(Fg.ws + WS_WTOUT) + (size_t)l * 1024 * 1024, mrows, D, D}; pg8::StaticOrder S; S.init(mrows, D, F.G, (int)blockIdx.x, l == 0 ? 18 : 32);
            pg8::EpiOutProj E{(bf16*)(Fg.ws + WS_H), (const float*)(Fg.ws + WS_MOD) + (size_t)l * 9 * MODW, (l == 0 && rep_ == 0) ? inp(Fg.lds, 0) : nullptr, (l == 0 && rep_ == 0) ? inp(Fg.lds, 2) : nullptr, rep_ == 0 ? 1.0f : 0.0f};
            pg8::gemm_phase<pg8::EpiOutProj, pg8::StaticOrder, PG8_ALIGN, PG8_SP2>(Fg.lds, g, S, E, F.wave_s);
            if (l == 0) { if (((int)blockIdx.x >> 3) < 18) conv_worker_done(F, 4 * l + 1); else conv_host(F, 4 * l + 1, 1u, 0); }
        }
        PH_END
        SEAM(pb + 5);
#ifndef NO_P6
        PH_BEGIN(6) if (IN(pb + 6)) { p6_norm2_router(F, l, mrows); } PH_END
#endif
        SEAM(pb + 6);
#ifndef NO_P7
        PH_BEGIN(7) if (IN(pb + 7)) { p7_topk(F, l); conv_host(F, 4 * l + 1, 0u, l == 0 ? Q_GU0 : Q_GU1); } PH_END
#endif
        SEAM(pb + 7);
        PH_BEGIN(8) if (IN(pb + 8)) {
            const Frame Fg = fresh_frame(F);
            pg8::Gemm g{(const bf16*)(Fg.ws + WS_HN), (const bf16*)(Fg.ws + WS_WTGU) + (size_t)l * NE * 3072 * 1024, NE * SLOTS, NE * 3072, D};
            pg8::GroupedOrder S{ctx_out ? 9 : 8, 12, (int)blockIdx.x, ctx_out ? 31 : 32};
            pg8::EpiSwiGLU E{(bf16*)(Fg.ws + WS_U)};
            LAS int* idxl = (LAS int*)(Fg.lds + 132096);
            { const int* IDXG = (const int*)(Fg.ws + WS_SLOT + 1179648); const int tid_ = F.wave_s * 64 + lane_id(); pg8::Unit uu;
              for (int ui = 0; ui < 7 && S.next(ui, uu); ++ui) if (tid_ < 256) idxl[ui * 256 + tid_] = IDXG[uu.pm * 256 + tid_];
              __syncthreads(); }
            pg8::gemm_phase<pg8::EpiSwiGLU, pg8::GroupedOrder, PG8_ALIGN, PG8_SP2, true>(Fg.lds, g, S, E, F.wave_s, idxl);
            if (l == 0 && ((int)blockIdx.x >> 3) >= 31) conv_host(F, 4 * l + 2, 9u, Q_L0);
            else { conv_worker_done(F, 4 * l + 2); conv_host(F, 4 * l + 2, 0u, l == 0 ? Q_L0 : QN); }
        }
        PH_END
        SEAM(pb + 8);
        PH_BEGIN(9) if (IN(pb + 9)) {
            const Frame Fg = fresh_frame(F);
            pg8::Gemm g{(const bf16*)(Fg.ws + WS_U), (const bf16*)(Fg.ws + WS_WTDN) + (size_t)l * NE * 1024 * FF, NE * SLOTS, NE * 1024, FF};
            pg8::GroupedOrder S{ctx_out ? 9 : 8, 4, (int)blockIdx.x, ctx_out ? 24 : 32};
            pg8::EpiStoreBf16 E{(bf16*)(Fg.ws + WS_O2), D, 9, 4};
            pg8::gemm_phase<pg8::EpiStoreBf16, pg8::GroupedOrder, PG8_ALIGN, PG8_SP2>(Fg.lds, g, S, E, F.wave_s);
            if (l == 0) { if (((int)blockIdx.x >> 3) < 24) conv_worker_done(F, 4 * l + 3); else conv_host(F, 4 * l + 3, 1u, 0); }
        }
        PH_END
        SEAM(pb + 9);
    }
#ifndef NO_PF
    PH_BEGIN(10) if (IN(21)) { p_final(F, (float*)inp(F.lds, 28)); } PH_END
#endif
    if (PSPIN && blockIdx.x == 0 && F.wave_s == 0 && lane_id() == 0) { PS_REC(22);
        const unsigned long long* ts = (const unsigned long long*)(F.ws + WS_CTL + 655360); const unsigned* qh = (const unsigned*)(F.ws + WS_CTL + 659456);
        unsigned long long m = 0;
        for (int ph = 0; ph < 22; ++ph) if (((unsigned)(PS_MASK) >> ph) & 1u) m += ts[ph + 1] - ts[ph];
        if ((PS_QK) >= 0) m = qh[(PS_QK) + 1];
        const unsigned long long t0 = __builtin_amdgcn_s_memrealtime(), tend = t0 + m * (PS_MULT);
        while (__builtin_amdgcn_s_memrealtime() < tend) __builtin_amdgcn_s_sleep(8); }
#undef IN
#undef SEAM
}

#ifndef MK_ONE_LAUNCH
#define MK_ONE_LAUNCH 1
#endif
extern "C" void kernel_launch(void* const* d_in, const int* in_sizes, int n_in, void* d_out, int out_size, void* d_ws, size_t ws_size, hipStream_t stream) {
    static int grid = 0;
    if (grid == 0) {
        if (n_in != 28 || out_size != NLAT * D || ws_size < WS_END3) { fprintf(stderr, "kernel_launch: unexpected problem (n_in %d, out %d, ws %zu < %zu)\n", n_in, out_size, ws_size, (size_t)WS_END); grid = -1; return; }
        int dev = 0, cus = 0, per_cu = 0;
        if (hipGetDevice(&dev) != hipSuccess || hipDeviceGetAttribute(&cus, hipDeviceAttributeMultiprocessorCount, dev) != hipSuccess) { grid = -1; return; }
        if (hipFuncSetAttribute((const void*)fwd_kernel, hipFuncAttributeMaxDynamicSharedMemorySize, LDS_BYTES) != hipSuccess) { fprintf(stderr, "kernel_launch: hipFuncSetAttribute failed\n"); grid = -1; return; }
        if (hipOccupancyMaxActiveBlocksPerMultiprocessor(&per_cu, (const void*)fwd_kernel, NWAVES * 64, LDS_BYTES) != hipSuccess || per_cu < 1) { fprintf(stderr, "kernel_launch: occupancy query says %d\n", per_cu); (void)hipGetLastError(); per_cu = 1; }
        grid = cus;
        if (grid != 256) { fprintf(stderr, "kernel_launch: built for 256 CUs, device has %d\n", cus); grid = -1; return; }
    }
    if (grid < 0) return;
    (void)hipMemsetAsync((char*)d_ws + WS_CTL, 0, CTL_ZERO_BYTES, stream);
    Args a{};
    for (int i = 0; i < 28; ++i) a.in[i] = (const float*)d_in[i];
    a.out = (float*)d_out; a.ws = (unsigned char*)d_ws; a.never = 0;
#if MK_ONE_LAUNCH
    a.ph_lo = 0; a.ph_hi = NPHASES; a.use_bar = 1;
    void* kargs[] = {&a};
    hipError_t e = hipLaunchCooperativeKernel((const void*)fwd_kernel, dim3(grid), dim3(NWAVES * 64), kargs, LDS_BYTES, stream);
    if (e != hipSuccess) fprintf(stderr, "kernel_launch: cooperative launch failed: %s\n", hipGetErrorString(e));
#else
    for (int ph = 0; ph < NPHASES; ++ph) { a.ph_lo = ph; a.ph_hi = ph + 1; a.use_bar = 0;
        hipLaunchKernelGGL(fwd_kernel, dim3(grid), dim3(NWAVES * 64), LDS_BYTES, stream, a); }
#endif
}
```

```cpp
#include <hip/hip_runtime.h>
#include <hip/hip_cooperative_groups.h>
#include <cstdio>
#include <cstdint>
#define GAS __attribute__((address_space(1)))
#define LAS __attribute__((address_space(3)))
namespace pg8 {
#define PG8_LAS __attribute__((address_space(3)))
typedef unsigned short bf16_t;
typedef short bf16x8 __attribute__((ext_vector_type(8)));
typedef float f32x4 __attribute__((ext_vector_type(4)));
typedef unsigned u32x4 __attribute__((ext_vector_type(4)));
constexpr int BM = 256, BK = 64, HALF = 128, HTB = HALF * BK * 2  , STAGE_BYTES = 8 * HTB, NXCD = 8, WGM = 8;

__host__ __device__ __forceinline__ int lds_byte(int r, int c) { const int st = (r >> 4) * 2 + (c >> 5), rr = r & 15, cc = c & 31, ob = rr * 64 + cc * 2; return st * 1024 + (ob ^ (((ob >> 9) & 1) << 5)); }
__host__ __device__ __forceinline__ void stage_rc(int b, int& R, int& C) { const int st = b / 1024, sb = b % 1024, swz = sb ^ (((sb >> 9) & 1) << 5); R = (st >> 1) * 16 + swz / 64; C = (st & 1) * 32 + (swz % 64) / 2; }
__host__ __device__ __forceinline__ int perm32(int rho) { const int n = rho >> 4, i = rho & 15; return 8 * (i >> 2) + 4 * n + (i & 3); }

struct Unit { int pm, pn; };
struct Gemm { const bf16_t* A; const bf16_t* Bt; int M, N, K; };

struct StaticOrder {
    int nM, nN, nwg, G, c, W;
    __host__ __device__ void init(int M, int N, int G_, int c_, int W_ = 32) { nM = M / BM; nN = N / BM; nwg = nM * nN; G = G_; c = c_; W = W_; }
    __host__ __device__ bool next(int i, Unit& u) const {
        const int xcd = c % NXCD, w = c / NXCD; if (w >= W) return false;
        const int q = nwg / NXCD, r = nwg % NXCD, off = i * W + w; if (off >= q + (xcd < r ? 1 : 0)) return false;
        const int wgid = (xcd < r ? xcd * (q + 1) : r * (q + 1) + (xcd - r) * q) + off;
        const int nig = WGM * nN, gid = wgid / nig, fm = gid * WGM, gsz = (nM - fm) < WGM ? (nM - fm) : WGM;
        u.pm = fm + ((wgid % nig) % gsz); u.pn = (wgid % nig) / gsz; return true;
    }
    __device__ __forceinline__ void a_ready(const Unit&) const {}
    __device__ __forceinline__ void done(const Unit&) const {}
};

__device__ __forceinline__ unsigned cvt_pk_bf16(float lo, float hi) { unsigned r; asm volatile("v_cvt_pk_bf16_f32 %0, %1, %2" : "=v"(r) : "v"(lo), "v"(hi)); return r; }
typedef float f32x2_t __attribute__((ext_vector_type(2))); typedef __bf16 bf16x2_t __attribute__((ext_vector_type(2)));
__device__ __forceinline__ unsigned cvt_pk_safe(float lo, float hi) { const f32x2_t v = {lo, hi}; const bf16x2_t b = __builtin_convertvector(v, bf16x2_t); return __builtin_bit_cast(unsigned, b); }

struct EpiStoreBf16 {
    static constexpr bool PERM = true, AFTER_DRAIN = false;
    bf16_t* O; int ldc; int pm_div, pn_per;
    __device__ __forceinline__ void operator()(const f32x4 (&acc)[2][2][4][2], const Unit& u, int wr, int wc, int fr, int fq) const {
        const int row0 = u.pm * BM + wr * 64 + fr; int pnl = u.pn; if (pm_div) pnl -= (u.pm / pm_div) * pn_per;
        const int col0 = pnl * BM + wc * 32 + 8 * fq;
#pragma unroll
        for (int ai = 0; ai < 2; ++ai)
#pragma unroll
            for (int m = 0; m < 4; ++m) { bf16_t* rowp = O + (size_t)(row0 + ai * HALF + m * 16) * ldc + col0;
#pragma unroll
                for (int bj = 0; bj < 2; ++bj) { const f32x4 v0 = acc[ai][bj][m][0], v1 = acc[ai][bj][m][1];
                    u32x4 w; w.x = cvt_pk_bf16(v0[0], v0[1]); w.y = cvt_pk_bf16(v0[2], v0[3]); w.z = cvt_pk_bf16(v1[0], v1[1]); w.w = cvt_pk_bf16(v1[2], v1[3]);
                    *(u32x4*)(rowp + bj * HALF) = w; } }
    }
};
struct EpiSwiGLU {
    static constexpr bool PERM = false, AFTER_DRAIN = false;
    bf16_t* O;
    __device__ __forceinline__ void operator()(const f32x4 (&acc)[2][2][4][2], const Unit& u, int wr, int wc, int fr, int fq) const {
        const int e = u.pm / 9, pnl = u.pn - e * 12;
        const int row0 = u.pm * BM + wr * 64 + fr, col0 = pnl * 128 + (4 * wc + fq) * 8;
#pragma unroll
        for (int ai = 0; ai < 2; ++ai)
#pragma unroll
            for (int m = 0; m < 4; ++m) {
                float h[8];
#pragma unroll
                for (int bj = 0; bj < 2; ++bj)
#pragma unroll
                    for (int j = 0; j < 4; ++j) { const float g = acc[ai][bj][m][0][j], up = acc[ai][bj][m][1][j]; h[bj * 4 + j] = g * __builtin_amdgcn_rcpf(1.0f + __expf(-g)) * up; }
                u32x4 w; w.x = cvt_pk_bf16(h[0], h[1]); w.y = cvt_pk_bf16(h[2], h[3]); w.z = cvt_pk_bf16(h[4], h[5]); w.w = cvt_pk_bf16(h[6], h[7]);
                *(u32x4*)(O + (size_t)(row0 + ai * HALF + m * 16) * 1536 + col0) = w; }
    }
};
struct EpiOutProj {
    static constexpr bool PERM = true, AFTER_DRAIN = false;
    bf16_t* H; const float* mod;
    const float* xin; const float* cin;
    float gsc;
    __device__ __forceinline__ void operator()(const f32x4 (&acc)[2][2][4][2], const Unit& u, int wr, int wc, int fr, int fq) const {
        const int s = u.pm < 64 ? (u.pm >> 3) : 8;
        const float* g1 = mod + s * 6144 + 2048;
        const int row0 = u.pm * BM + wr * 64 + fr, col0 = u.pn * BM + wc * 32 + 8 * fq;
#pragma unroll
        for (int bj = 0; bj < 2; ++bj) { const f32x4 gv0 = *(const f32x4*)(g1 + col0 + bj * HALF) * gsc, gv1 = *(const f32x4*)(g1 + col0 + bj * HALF + 4) * gsc;
#pragma unroll
            for (int ai = 0; ai < 2; ++ai)
#pragma unroll
                for (int m = 0; m < 4; ++m) { const size_t off = (size_t)(row0 + ai * HALF + m * 16) * 1024 + col0 + bj * HALF; bf16_t* p = H + off;
                    f32x4 o0, o1;
                    if (xin) { const float* bp = u.pm < 64 ? xin + off : cin + (off - (size_t)16384 * 1024); o0 = *(const f32x4*)bp; o1 = *(const f32x4*)(bp + 4); }
                    else { const u32x4 w = *(const u32x4*)p; o0 = (f32x4){__uint_as_float(w.x << 16), __uint_as_float(w.x & 0xffff0000u), __uint_as_float(w.y << 16), __uint_as_float(w.y & 0xffff0000u)};
                        o1 = (f32x4){__uint_as_float(w.z << 16), __uint_as_float(w.z & 0xffff0000u), __uint_as_float(w.w << 16), __uint_as_float(w.w & 0xffff0000u)}; }
                    o0 += gv0 * acc[ai][bj][m][0]; o1 += gv1 * acc[ai][bj][m][1];
                    u32x4 w; w.x = cvt_pk_bf16(o0[0], o0[1]); w.y = cvt_pk_bf16(o0[2], o0[3]); w.z = cvt_pk_bf16(o1[0], o1[1]); w.w = cvt_pk_bf16(o1[2], o1[3]);
                    *(u32x4*)p = w; } }
    }
};
struct GroupedOrder {
    int MT, NT, c, W;
    __device__ __forceinline__ bool next(int i, Unit& u) const {
        const int xcd = c & 7, j = i * W + (c >> 3), per = MT * NT;
        if ((c >> 3) >= W || j >= 2 * per) return false;
        const int e = 2 * xcd + j / per, q = j % per;
        u.pm = e * 9 + q % MT; u.pn = e * NT + q / MT; return true;
    }
    __device__ __forceinline__ void a_ready(const Unit&) const {}
    __device__ __forceinline__ void done(const Unit&) const {}
};

template <class Epi, class Sched, bool ALIGN_EPI = false, bool SP2 = false, bool GATHER = false>
__device__ __forceinline__ void gemm_phase(PG8_LAS unsigned char* lds, const Gemm g, const Sched& S, const Epi& E, const int wave_s, const PG8_LAS int* idxl = nullptr) {
    unsigned m_ = ~0u; asm volatile("" : "+s"(m_)); const int tid_ = wave_s * 64 + (int)__builtin_amdgcn_mbcnt_hi(m_, __builtin_amdgcn_mbcnt_lo(m_, 0u));
    const int tid = tid_, wid = __builtin_amdgcn_readfirstlane(tid >> 6), lane = tid & 63, wr = wid >> 2, wc = wid & 3, fr = lane & 15, fq = lane >> 4;
    const int K = g.K, nt = K / BK;
    unsigned voffA[2], voffB[2]; int gR[2], gC2[2];
#pragma unroll
    for (int i = 0; i < 2; ++i) { int R, C; stage_rc(tid * 16 + i * 8192, R, C); const int Rb = Epi::PERM ? ((R & ~31) + perm32(R & 31)) : R;
        voffA[i] = (unsigned)(R * K + C) * 2u; voffB[i] = (unsigned)(Rb * K + C) * 2u; gR[i] = R; gC2[i] = 2 * C; }
    const size_t kstep = (size_t)(BK * 2);
    const size_t hstep = (size_t)HALF * K * 2;
    const size_t tstep = 2 * hstep;
    const unsigned ldsw = (unsigned)wid * 1024u;
    const int aoff = lds_byte(wr * 64 + fr, fq * 8), boff = lds_byte(wc * 32 + fr, fq * 8);
#define PG8_SA(b, h) (((b) * 2 + (h)) * HTB)
#define PG8_SB(b, h) ((4 + (b) * 2 + (h)) * HTB)
#define PG8_STAGE(bufoff, gbase, voff) do { _Pragma("unroll") for (int _i = 0; _i < 2; ++_i) \
        __builtin_amdgcn_global_load_lds((const unsigned*)((const char*)(gbase) + (voff)[_i]), (PG8_LAS unsigned*)(lds + (bufoff) + ldsw + _i * 8192), 16, 0, 0); } while (0)
#define PG8_STAGE_A(bufoff, gbase, h, usenext) do { if constexpr (GATHER) { _Pragma("unroll") for (int _i = 0; _i < 2; ++_i) { const unsigned _o = (usenext) ? vn[h][_i] : vo[h][_i]; \
        __builtin_amdgcn_global_load_lds((const unsigned*)((const char*)(gbase) + _o), (PG8_LAS unsigned*)(lds + (bufoff) + ldsw + _i * 8192), 16, 0, 0); } } \
        else { PG8_STAGE(bufoff, (const char*)(gbase) + ((h) ? hstep : (size_t)0), voffA); } } while (0)
#define PG8_LDA(dst, b, h) do { _Pragma("unroll") for (int m = 0; m < 4; ++m) _Pragma("unroll") for (int k = 0; k < 2; ++k) dst[m][k] = *(const PG8_LAS bf16x8*)(lds + PG8_SA(b, h) + aoff + m * 2048 + k * 1024); } while (0)
#define PG8_LDB(dst, b, h) do { _Pragma("unroll") for (int n = 0; n < 2; ++n) _Pragma("unroll") for (int k = 0; k < 2; ++k) dst[n][k] = *(const PG8_LAS bf16x8*)(lds + PG8_SB(b, h) + boff + n * 2048 + k * 1024); } while (0)
#define PG8_MMA(ai, bj, At, Bt) do { __builtin_amdgcn_s_setprio(1); _Pragma("unroll") for (int m = 0; m < 4; ++m) _Pragma("unroll") for (int n = 0; n < 2; ++n) _Pragma("unroll") for (int k = 0; k < 2; ++k) \
        acc[ai][bj][m][n] = __builtin_amdgcn_mfma_f32_16x16x32_bf16(Bt[n][k], At[m][k], acc[ai][bj][m][n], 0, 0, 0); __builtin_amdgcn_s_setprio(0); } while (0)
#define PG8_WAIT_V(n) asm volatile("s_waitcnt vmcnt(" #n ")" ::: "memory")
#define PG8_WAIT_L(n) asm volatile("s_waitcnt lgkmcnt(" #n ")" ::: "memory")
#define PG8_BAR __builtin_amdgcn_s_barrier()
#define PG8_SCHED __builtin_amdgcn_sched_barrier(0)
    Unit cur, nxt; int ui = 0;
    if (!S.next(0, cur)) return;
    f32x4 acc[2][2][4][2];
#pragma unroll
    for (int a = 0; a < 2; ++a)
#pragma unroll
        for (int b = 0; b < 2; ++b)
#pragma unroll
            for (int m = 0; m < 4; ++m)
#pragma unroll
                for (int n = 0; n < 2; ++n) acc[a][b][m][n] = (f32x4){0.f, 0.f, 0.f, 0.f};
    bf16x8 At[4][2], B0[2][2], B1[2][2];
    const char* cA = (const char*)g.A + (GATHER ? (size_t)0 : (size_t)cur.pm * tstep); const char* cB = (const char*)g.Bt + (size_t)cur.pn * tstep;
    unsigned vo[2][2], vn[2][2];
    if constexpr (GATHER) {
#pragma unroll
        for (int h = 0; h < 2; ++h)
#pragma unroll
            for (int i = 0; i < 2; ++i) { vo[h][i] = (unsigned)idxl[h * 128 + gR[i]] * (unsigned)(2 * K) + (unsigned)gC2[i]; vn[h][i] = vo[h][i]; } }
    S.a_ready(cur);
    if constexpr (SP2) {
        PG8_STAGE(PG8_SB(0, 0), cB, voffB); PG8_STAGE(PG8_SB(0, 1), cB + hstep, voffB); PG8_STAGE_A(PG8_SA(0, 0), cA, 0, false); PG8_STAGE_A(PG8_SA(0, 1), cA, 1, false);
        if (wr == 1) PG8_BAR;
        PG8_WAIT_V(2); PG8_BAR;
        PG8_STAGE(PG8_SB(1, 0), cB + kstep, voffB); PG8_STAGE_A(PG8_SA(1, 0), cA + kstep, 0, false); PG8_STAGE(PG8_SB(1, 1), cB + hstep + kstep, voffB);
        PG8_WAIT_V(6); PG8_BAR;
    } else {
        PG8_STAGE(PG8_SB(0, 0), cB, voffB); PG8_STAGE(PG8_SA(0, 0), cA, voffA); PG8_STAGE(PG8_SB(0, 1), cB + hstep, voffB); PG8_STAGE(PG8_SA(0, 1), cA + hstep, voffA);
        if (wr == 1) PG8_BAR;
        PG8_WAIT_V(4); PG8_BAR;
        PG8_STAGE(PG8_SB(1, 0), cB + kstep, voffB); PG8_STAGE(PG8_SA(1, 0), cA + kstep, voffA); PG8_STAGE(PG8_SB(1, 1), cB + hstep + kstep, voffB);
        PG8_WAIT_V(6); PG8_BAR;
    }
    for (;;) {
        const bool has_next = S.next(ui + 1, nxt);
        const char* nA = (has_next && !GATHER) ? (const char*)g.A + (size_t)nxt.pm * tstep : cA; const char* nB = has_next ? (const char*)g.Bt + (size_t)nxt.pn * tstep : cB;
        if constexpr (GATHER) {
#pragma unroll
            for (int h = 0; h < 2; ++h)
#pragma unroll
                for (int i = 0; i < 2; ++i) vn[h][i] = has_next ? (unsigned)idxl[(ui + 1) * 256 + h * 128 + gR[i]] * (unsigned)(2 * K) + (unsigned)gC2[i] : vo[h][i]; }
        for (int t = 0; t < nt; t += 2) {
            const bool last = (t == nt - 2);
            const char* a1 = cA + (size_t)(t + 1) * kstep;
            const char* a2 = last ? nA : cA + (size_t)(t + 2) * kstep; const char* b2 = last ? nB : cB + (size_t)(t + 2) * kstep;
            const char* a3 = a2 + kstep; const char* b3 = b2 + kstep;
            if (last && has_next) S.a_ready(nxt);
            if constexpr (SP2) {
            PG8_LDB(B0, 0, 0); PG8_LDB(B1, 0, 1); PG8_SCHED; PG8_LDA(At, 0, 0); PG8_STAGE_A(PG8_SA(1, 1), a1, 1, false);
            PG8_WAIT_V(8); PG8_WAIT_L(0); PG8_BAR; PG8_MMA(0, 0, At, B0); PG8_MMA(0, 1, At, B1); PG8_BAR; PG8_SCHED;
            PG8_LDA(At, 0, 1); PG8_STAGE(PG8_SB(0, 0), b2, voffB); PG8_STAGE(PG8_SB(0, 1), b2 + hstep, voffB); PG8_STAGE_A(PG8_SA(0, 0), a2, 0, last);
            PG8_WAIT_V(8); PG8_WAIT_L(0); PG8_BAR; PG8_MMA(1, 0, At, B0); PG8_MMA(1, 1, At, B1); PG8_BAR; PG8_SCHED;
            PG8_LDB(B0, 1, 0); PG8_LDB(B1, 1, 1); PG8_SCHED; PG8_LDA(At, 1, 0); PG8_STAGE_A(PG8_SA(0, 1), a2, 1, last);
            PG8_WAIT_V(8); PG8_WAIT_L(0); PG8_BAR; PG8_MMA(0, 0, At, B0); PG8_MMA(0, 1, At, B1); PG8_BAR; PG8_SCHED;
            PG8_LDA(At, 1, 1); PG8_STAGE(PG8_SB(1, 0), b3, voffB); PG8_STAGE(PG8_SB(1, 1), b3 + hstep, voffB); PG8_STAGE_A(PG8_SA(1, 0), a3, 0, last);
            PG8_WAIT_V(8); PG8_WAIT_L(0); PG8_BAR; PG8_MMA(1, 0, At, B0); PG8_MMA(1, 1, At, B1); PG8_BAR; PG8_SCHED;
            } else {
            PG8_LDB(B0, 0, 0); PG8_SCHED; PG8_LDA(At, 0, 0); PG8_STAGE(PG8_SA(1, 1), a1 + hstep, voffA);
            PG8_WAIT_L(8); PG8_BAR; PG8_WAIT_L(0); PG8_MMA(0, 0, At, B0); PG8_BAR; PG8_SCHED;
            PG8_LDB(B1, 0, 1); PG8_STAGE(PG8_SB(0, 0), b2, voffB);
            PG8_BAR; PG8_WAIT_L(0); PG8_MMA(0, 1, At, B1); PG8_BAR;
            PG8_LDA(At, 0, 1); PG8_STAGE(PG8_SA(0, 0), a2, voffA);
            PG8_BAR; PG8_WAIT_L(0); PG8_MMA(1, 0, At, B0); PG8_BAR; PG8_SCHED;
            PG8_STAGE(PG8_SB(0, 1), b2 + hstep, voffB);
            PG8_WAIT_V(6); PG8_BAR; PG8_MMA(1, 1, At, B1); PG8_BAR;
            PG8_LDB(B0, 1, 0); PG8_SCHED; PG8_LDA(At, 1, 0); PG8_STAGE(PG8_SA(0, 1), a2 + hstep, voffA);
            PG8_WAIT_L(8); PG8_BAR; PG8_WAIT_L(0); PG8_MMA(0, 0, At, B0); PG8_BAR; PG8_SCHED;
            PG8_LDB(B1, 1, 1); PG8_STAGE(PG8_SB(1, 0), b3, voffB);
            PG8_BAR; PG8_WAIT_L(0); PG8_MMA(0, 1, At, B1); PG8_BAR;
            PG8_LDA(At, 1, 1); PG8_STAGE(PG8_SA(1, 0), a3, voffA);
            PG8_BAR; PG8_WAIT_L(0); PG8_MMA(1, 0, At, B0); PG8_BAR; PG8_SCHED;
            PG8_STAGE(PG8_SB(1, 1), b3 + hstep, voffB);
            PG8_WAIT_V(6); PG8_BAR; PG8_MMA(1, 1, At, B1); PG8_BAR;
            }
        }
        if constexpr (ALIGN_EPI) { if (wr == 0) PG8_BAR; }
        if constexpr (!Epi::AFTER_DRAIN) { E(acc, cur, wr, wc, fr, fq); S.done(cur); }
        if (!has_next) break;
#pragma unroll
        for (int a = 0; a < 2; ++a)
#pragma unroll
            for (int b = 0; b < 2; ++b)
#pragma unroll
                for (int m = 0; m < 4; ++m)
#pragma unroll
                    for (int n = 0; n < 2; ++n) acc[a][b][m][n] = (f32x4){0.f, 0.f, 0.f, 0.f};
        cur = nxt; cA = nA; cB = nB; ++ui;
        if constexpr (GATHER) {
#pragma unroll
            for (int h = 0; h < 2; ++h)
#pragma unroll
                for (int i = 0; i < 2; ++i) vo[h][i] = vn[h][i]; }
        if constexpr (ALIGN_EPI) { if (wr == 1) PG8_BAR; }
    }
    PG8_WAIT_V(0);
    if constexpr (!ALIGN_EPI) { if (wr == 0) PG8_BAR; }
    PG8_BAR;
    if constexpr (Epi::AFTER_DRAIN) { E.fused(acc, cur, wr, wc, fr, fq, lds, wid, lane); S.done(cur); }
#undef PG8_SA
#undef PG8_SB
#undef PG8_STAGE
#undef PG8_STAGE_A
#undef PG8_LDA
#undef PG8_LDB
#undef PG8_MMA
#undef PG8_WAIT_V
#undef PG8_WAIT_L
#undef PG8_BAR
#undef PG8_SCHED
}
}

#ifndef PG8_SP2
#define PG8_SP2 true
#endif
#ifndef PSPIN
#define PSPIN 0
#endif
#ifndef PS_MASK
#define PS_MASK 0
#endif
#ifndef PS_MULT
#define PS_MULT 8
#endif
#ifndef PS_QK
#define PS_QK -1
#endif
#ifndef P6_RB
#define P6_RB 3
#endif
#ifndef CAP_OP0
#define CAP_OP0 2000
#endif
#ifndef CAP_G20
#define CAP_G20 3950
#endif
#ifndef CONV_TPW
#define CONV_TPW 1
#endif
#ifndef PG8_ALIGN
#define PG8_ALIGN true
#endif

constexpr int D = 1024, NB = 8, SEQ = 2048, CTXL = 256, NLAT = NB * SEQ, NCTX = NB * CTXL, NROWS = NLAT + NCTX;
constexpr int INC = 3624, INP = 3840, NE = 16, FF = 1536, SLOTS = 2304, MODW = 6144;
constexpr float EPS = 1e-6f;
constexpr int C_RET = 0, C_GLA = 1024, C_SSD = 1808, C_ML = 2584;
constexpr size_t MiB = 1u << 20;
constexpr size_t WS_CTL = 0, CTL_ZERO_BYTES = 1 * MiB;
constexpr size_t WS_MOD = 1 * MiB, WS_WTIN = 2 * MiB, WS_WTOUT = 18 * MiB, WS_WTGU = 22 * MiB, WS_WTDN = 214 * MiB, WS_H = 310 * MiB, WS_HN = 382 * MiB,
                 WS_U = 418 * MiB  , WS_O2 = 553 * MiB  , WS_Y = 625 * MiB  , WS_AFFT = 697 * MiB, WS_SLOT = 699 * MiB, WS_END = 701 * MiB;
constexpr int CW_BAR = 4096;
constexpr int RING_BYTES = 131072, LDSCTL_OFF = RING_BYTES, MISC_OFF = LDSCTL_OFF + 320, LDS_BYTES = 147456;
constexpr int NWAVES = 8, NPHASES = 22;

typedef unsigned short bf16;
typedef unsigned v4u __attribute__((ext_vector_type(4)));
typedef unsigned v2u __attribute__((ext_vector_type(2)));
typedef float f32x4 __attribute__((ext_vector_type(4)));
typedef GAS unsigned gu32;
#define LDS_WAIT() asm volatile("s_waitcnt lgkmcnt(0)" ::: "memory")
#define VM_WAIT() asm volatile("s_waitcnt vmcnt(0)" ::: "memory")

#define XB_TMO      128
#define XB_XCNT(j)  (256  + 64 * (j))
#define XB_XSUB(j)  (1280 + 64 * (j))
#define XB_XGEN(j)  (2304 + 64 * (j))
#define XB_TOP      3328
#define XB_TOPGEN   3392
#define XCD_BAR_WORDS 3456
#define XB_SPIN_CAP (1u << 18)

__device__ __forceinline__ unsigned xb_ld(unsigned* p)              { return __hip_atomic_load(p, __ATOMIC_RELAXED, __HIP_MEMORY_SCOPE_AGENT); }
__device__ __forceinline__ unsigned xb_add(unsigned* p, unsigned v) { return __hip_atomic_fetch_add(p, v, __ATOMIC_RELAXED, __HIP_MEMORY_SCOPE_AGENT); }
__device__ __forceinline__ unsigned xb_xcc_id() { return (unsigned)__builtin_amdgcn_s_getreg((3 << 11) | 20) & 0xFu; }
#define XB_SPIN(cond, bar) do { unsigned _sp = 0; while (cond) { __builtin_amdgcn_s_sleep(1); \
    if ((++_sp & 255u) == 0u) { if (xb_ld(&(bar)[XB_TMO])) break; if (_sp > XB_SPIN_CAP) { atomicAdd(&(bar)[XB_TMO], 1u); break; } } } } while (0)

__device__ __forceinline__ int xb_lane_id() { unsigned m = ~0u; asm volatile("" : "+s"(m)); return (int)__builtin_amdgcn_mbcnt_hi(m, __builtin_amdgcn_mbcnt_lo(m, 0u)); }
struct XcdBarrier {
    int wave_s;
    unsigned* bar; unsigned x;
    volatile LAS unsigned* st;
};

__device__ __forceinline__ XcdBarrier xcd_barrier_post(unsigned* bar, volatile LAS unsigned* st, int wave_s) {
    XcdBarrier b; b.bar = bar; b.x = xb_xcc_id(); b.st = st; b.wave_s = wave_s;
    if (wave_s == 0 && xb_lane_id() == 0) (void)xb_add(&bar[XB_XCNT(b.x)], 1u);
    return b;
}
__device__ __forceinline__ void xcd_barrier_complete(unsigned* bar, unsigned x, unsigned& nloc, unsigned& nx) {
    const unsigned G = gridDim.x * gridDim.y * gridDim.z;
    unsigned sum, cnt, mine, sp = 0u;
    for (;;) {
        sum = 0u; cnt = 0u; mine = 0u;
#pragma unroll
        for (unsigned j = 0; j < 16; ++j) { const unsigned c = xb_ld(&bar[XB_XCNT(j)]); sum += c; cnt += (c > 0u) ? 1u : 0u; }
        if (sum == G) { mine = xb_ld(&bar[XB_XCNT(x)]); break; }
        __builtin_amdgcn_s_sleep(1);
        if ((++sp & 255u) == 0u) { if (xb_ld(&bar[XB_TMO])) break; if (sp > XB_SPIN_CAP) { atomicAdd(&bar[XB_TMO], 1u); break; } }
    }
    nloc = mine > 0u ? mine : 1u; nx = cnt > 0u ? cnt : 1u;
}

__device__ __forceinline__ void xcd_barrier(const XcdBarrier& b) {
    asm volatile("s_waitcnt vmcnt(0)" ::: "memory");
    __syncthreads();
    if (b.wave_s == 0 && xb_lane_id() == 0) {
        unsigned* bar = b.bar; asm volatile("" : "+s"(bar));
        __builtin_amdgcn_s_waitcnt(0);
        unsigned nloc = b.st[0], nx = b.st[1];
        if (nloc == 0u) { xcd_barrier_complete(bar, b.x, nloc, nx); b.st[0] = nloc; b.st[1] = nx; }
        const unsigned old = xb_add(&bar[XB_XSUB(b.x)], 1u);
        const unsigned gen = old / nloc;
        if (old + 1u == (gen + 1u) * nloc) {
            __builtin_amdgcn_fence(__ATOMIC_RELEASE, "agent");
            asm volatile("s_waitcnt vmcnt(0)" ::: "memory");
            const unsigned og = xb_add(&bar[XB_TOP], 1u);
            const unsigned tg = og / nx;
            if (og + 1u == (tg + 1u) * nx) xb_add(&bar[XB_TOPGEN], 1u);
            else XB_SPIN(xb_ld(&bar[XB_TOPGEN]) == tg, bar);
            __builtin_amdgcn_fence(__ATOMIC_ACQUIRE, "agent");
            xb_add(&bar[XB_XGEN(b.x)], 1u);
            asm volatile("s_waitcnt vmcnt(0)" ::: "memory");
        } else {
            XB_SPIN(xb_ld(&bar[XB_XGEN(b.x)]) == gen, bar);
            __builtin_amdgcn_fence(__ATOMIC_ACQUIRE, "agent");
            asm volatile("s_waitcnt vmcnt(0)" ::: "memory");
        }
    }
    __syncthreads();
}


struct Frame {
    LAS unsigned char* lds;
    int vcu, G, wave_s;
    unsigned char* ws;
};
struct Ids { int tid, lane, wave; };
__device__ __forceinline__ const float* inp(const LAS unsigned char* lds, int i) {
    const LAS unsigned* t = (const LAS unsigned*)(lds + 131072) + 2 * i;
    const unsigned lo = __builtin_amdgcn_readfirstlane(t[0]), hi = __builtin_amdgcn_readfirstlane(t[1]);
    return (const float*)(GAS const float*)(((unsigned long long)hi << 32) | lo); }
__device__ __forceinline__ Frame fresh_frame(const Frame& F) { Frame G = F; GAS unsigned char* g = (GAS unsigned char*)F.ws; asm volatile("" : "+s"(g), "+s"(G.lds), "+s"(G.vcu), "+s"(G.G), "+s"(G.wave_s)); G.ws = (unsigned char*)g; return G; }
__device__ __forceinline__ int lane_id() { unsigned m = ~0u; asm volatile("" : "+s"(m)); return (int)__builtin_amdgcn_mbcnt_hi(m, __builtin_amdgcn_mbcnt_lo(m, 0u)); }
__device__ __forceinline__ Ids fresh_ids(int wave_s) { Ids I; I.lane = lane_id(); I.wave = wave_s; I.tid = wave_s * 64 + I.lane; return I; }
__device__ __forceinline__ float shx(float v, int mask, int lane) { return __int_as_float(__builtin_amdgcn_ds_bpermute((lane ^ mask) << 2, __float_as_int(v))); }
__device__ __forceinline__ float shidx(float v, int src) { return __int_as_float(__builtin_amdgcn_ds_bpermute(src << 2, __float_as_int(v))); }
__device__ __forceinline__ int shidx_i(int v, int src) { return __builtin_amdgcn_ds_bpermute(src << 2, v); }
__device__ __forceinline__ float wave_sum(float v, int lane) {
#pragma unroll
    for (int o = 1; o < 64; o <<= 1) v += shx(v, o, lane);
    return v;
}
template <int N> __device__ __forceinline__ float p6_ror(float v) { return __int_as_float(__builtin_amdgcn_update_dpp(0, __float_as_int(v), 0x120 + N, 0xf, 0xf, true)); }
__device__ __forceinline__ float p6_rdl(float v, int l) { return __int_as_float(__builtin_amdgcn_readlane(__float_as_int(v), l)); }
__device__ __forceinline__ float p6_row_sum(float v) { v += p6_ror<8>(v); v += p6_ror<4>(v); v += p6_ror<2>(v); v += p6_ror<1>(v); return v; }
__device__ __forceinline__ float p6_row_max(float v) { v = fmaxf(v, p6_ror<8>(v)); v = fmaxf(v, p6_ror<4>(v)); v = fmaxf(v, p6_ror<2>(v)); v = fmaxf(v, p6_ror<1>(v)); return v; }
__device__ __forceinline__ float wave_sum_dpp(float v) { v = p6_row_sum(v); return (p6_rdl(v, 0) + p6_rdl(v, 16)) + (p6_rdl(v, 32) + p6_rdl(v, 48)); }
__device__ __forceinline__ float bf_lo(unsigned w) { return __uint_as_float(w << 16); }
__device__ __forceinline__ float bf_hi(unsigned w) { return __uint_as_float(w & 0xffff0000u); }
__device__ __forceinline__ float bf_elem(v4u q, int e) { const unsigned w = e < 4 ? (e < 2 ? q.x : q.y) : (e < 6 ? q.z : q.w); return (e & 1) ? bf_hi(w) : bf_lo(w); }
__device__ __forceinline__ f32x4 ld_bf4(const bf16* p) { const v2u w = *(const v2u*)p; return (f32x4){bf_lo(w.x), bf_hi(w.x), bf_lo(w.y), bf_hi(w.y)}; }
__device__ __forceinline__ void st_bf4(bf16* p, f32x4 v) { v2u w; w.x = pg8::cvt_pk_bf16(v.x, v.y); w.y = pg8::cvt_pk_bf16(v.z, v.w); *(v2u*)p = w; }
__device__ __forceinline__ void st_bf4_lds(LAS unsigned char* p, f32x4 v) { v2u w; w.x = pg8::cvt_pk_bf16(v.x, v.y); w.y = pg8::cvt_pk_bf16(v.z, v.w); *(LAS v2u*)p = w; }
__device__ __forceinline__ float silu_f(float x) { return x / (1.0f + expf(-x)); }
__device__ __forceinline__ float sigmoid_f(float x) { return 1.0f / (1.0f + expf(-x)); }
__device__ __forceinline__ float log_sigmoid_f(float z) { return fminf(z, 0.f) - log1pf(expf(-fabsf(z))); }
__device__ __forceinline__ float softplus_f(float x) { return fmaxf(x, 0.f) + log1pf(expf(-fabsf(x))); }
__device__ __forceinline__ int row_sample(int r) { return r < NLAT ? (r >> 11) : 8; }

template <class RowMap>
__device__ __forceinline__ void transpose_item(const float* W, int ldw, int nvalid, int k0, int n0, bf16* WT, int ldt, const RowMap& f, LAS float* scr, int lane) {
    f32x4 t[8];
#pragma unroll
    for (int i = 0; i < 8; ++i) { const int idx = i * 64 + lane, kk = idx >> 3, c = n0 + 4 * (idx & 7);
        t[i] = c < nvalid ? __builtin_nontemporal_load((const f32x4*)(W + (size_t)(k0 + kk) * ldw + c)) : (f32x4){0.f, 0.f, 0.f, 0.f}; }
#pragma unroll
    for (int i = 0; i < 8; ++i) { const int idx = i * 64 + lane, kk = idx >> 3, c4 = 4 * (idx & 7); LAS float* d = scr + kk * 33 + c4; d[0] = t[i].x; d[1] = t[i].y; d[2] = t[i].z; d[3] = t[i].w; }
    LDS_WAIT(); asm volatile("" ::: "memory");
    const int c8 = lane & 7;
#pragma unroll
    for (int j = 0; j < 4; ++j) { const int n = (lane >> 3) + 8 * j, col = n0 + n; const LAS float* s = scr + (8 * c8) * 33 + n;
        if (col < nvalid) { v4u o; o.x = pg8::cvt_pk_bf16(s[0 * 33], s[1 * 33]); o.y = pg8::cvt_pk_bf16(s[2 * 33], s[3 * 33]); o.z = pg8::cvt_pk_bf16(s[4 * 33], s[5 * 33]); o.w = pg8::cvt_pk_bf16(s[6 * 33], s[7 * 33]);
            *(v4u*)(WT + (size_t)f(col) * ldt + k0 + 8 * c8) = o; } }
    LDS_WAIT(); asm volatile("" ::: "memory");
}
struct MapId { int off; __device__ __forceinline__ int operator()(int c) const { return off + c; } };
struct MapGU { int off, n; __device__ __forceinline__ int operator()(int h) const { const int hl = h & 127, q = hl >> 3, wc = q >> 2, fq = q & 3, rem = hl & 7, bj = rem >> 2, j = rem & 3;
    return off + 256 * (h >> 7) + 128 * bj + 32 * wc + 16 * n + 4 * fq + j; } };

__device__ __forceinline__ void p0_prologue(const Frame& F_) {
    const Frame F = fresh_frame(F_); const Ids I = fresh_ids(F.wave_s);
    const float* cvec = inp(F.lds, 1); const float* cctx = inp(F.lds, 3); const float* w_mod = inp(F.lds, 4); const float* b_mod = inp(F.lds, 5);
    float* MOD = (float*)(F.ws + WS_MOD);
    {
        LAS float* sil = (LAS float*)F.lds;
        LAS float* part = (LAS float*)(F.lds + 40960);
        for (int i = I.tid; i < 9 * 1024; i += 512) { const int s = i >> 10, k = i & 1023; const float c = s < 8 ? cvec[s * 1024 + k] : cctx[k]; sil[i] = silu_f(c); }
        __syncthreads();
        for (int item = F.vcu; item < 192; item += F.G) {
            const int l = item / 96, col = (item % 96) * 64 + I.lane;
            float acc[9];
#pragma unroll
            for (int s = 0; s < 9; ++s) acc[s] = 0.f;
            const float* wp = w_mod + (size_t)l * 1024 * MODW + (size_t)(I.wave * 128) * MODW + col;
            for (int kb = 0; kb < 128; kb += 64) { float wv[64];
#pragma unroll
                for (int u = 0; u < 64; ++u) wv[u] = __builtin_nontemporal_load(wp + (size_t)(kb + u) * MODW);
#pragma unroll
                for (int u = 0; u < 64; ++u)
#pragma unroll
                    for (int s = 0; s < 9; ++s) acc[s] += sil[s * 1024 + I.wave * 128 + kb + u] * wv[u]; }
#pragma unroll
            for (int s = 0; s < 9; ++s) part[(I.wave * 9 + s) * 64 + I.lane] = acc[s];
            __syncthreads();
            for (int i = I.tid; i < 9 * 64; i += 512) { const int s = i >> 6, ln = i & 63; float t = 0.f;
#pragma unroll
                for (int w = 0; w < 8; ++w) t += part[(w * 9 + s) * 64 + ln];
                const int cc = (item % 96) * 64 + ln; MOD[((size_t)l * 9 + s) * MODW + cc] = t + b_mod[l * MODW + cc]; }
            __syncthreads();
        }
        __syncthreads();
    }
    if (PSPIN && blockIdx.x == 0 && I.tid == 0) ((unsigned long long*)(F.ws + WS_CTL + 655360))[40] = __builtin_amdgcn_s_memrealtime();
    {
        bf16* wtin = (bf16*)(F.ws + WS_WTIN);
        const int nchunk = 2 * (INP - INC) * 128;
        for (int i = F.vcu * 512 + I.tid; i < nchunk; i += F.G * 512) { const int l = i / ((INP - INC) * 128), r = i % ((INP - INC) * 128);
            *(v4u*)(wtin + ((size_t)l * INP + INC) * 1024 + (size_t)r * 8) = (v4u){0u, 0u, 0u, 0u}; }
    }
    {
        LAS float* scr = (LAS float*)(F.lds + I.wave * 16384);
        const int gw = F.vcu * NWAVES + I.wave, NGW = F.G * NWAVES;
        constexpr int I_IN = 16 * 114, I_OUT = 16 * 32, I_E = 768, PER_L = I_IN + I_OUT + 16 * 3 * I_E;
#ifndef CONV_IN_SCAN
#define CONV_IN_SCAN 1
#endif
        constexpr int PER_L0 = CONV_IN_SCAN ? (I_IN + I_OUT) : PER_L;
        for (int it = gw; it < 2 * PER_L0; it += NGW) {
            const int l = it / PER_L0; int r = it % PER_L0;
            if (r < I_IN) { const int kb = r / 114, nb = r % 114;
                transpose_item(inp(F.lds, 8) + (size_t)l * 1024 * INC, INC, INC, 64 * kb, 32 * nb, (bf16*)(F.ws + WS_WTIN) + (size_t)l * INP * 1024, 1024, MapId{0}, scr, I.lane); continue; }
            r -= I_IN;
            if (r < I_OUT) { const int kb = r / 32, nb = r % 32;
                transpose_item(inp(F.lds, 9) + (size_t)l * 1024 * 1024, 1024, 1024, 64 * kb, 32 * nb, (bf16*)(F.ws + WS_WTOUT) + (size_t)l * 1024 * 1024, 1024, MapId{0}, scr, I.lane); continue; }
            r -= I_OUT;
            const int e = r / (3 * I_E), q = r % (3 * I_E), kind = q / I_E, t = q % I_E;
            if (kind < 2) { const int kb = t / 48, nb = t % 48;
                transpose_item((kind ? inp(F.lds, 25) : inp(F.lds, 24)) + ((size_t)l * NE + e) * 1024 * FF, FF, FF, 64 * kb, 32 * nb, (bf16*)(F.ws + WS_WTGU) + (size_t)l * NE * 3072 * 1024, 1024, MapGU{e * 3072, kind}, scr, I.lane); }
            else { const int kb = t / 32, nb = t % 32;
                transpose_item(inp(F.lds, 26) + ((size_t)l * NE + e) * FF * 1024, 1024, 1024, 64 * kb, 32 * nb, (bf16*)(F.ws + WS_WTDN) + (size_t)l * NE * 1024 * FF, FF, MapId{e * 1024}, scr, I.lane); }
        }
    }
    if (PSPIN && blockIdx.x == 0 && I.tid == 0) { asm volatile("s_waitcnt vmcnt(0)" ::: "memory"); ((unsigned long long*)(F.ws + WS_CTL + 655360))[41] = __builtin_amdgcn_s_memrealtime(); }
}

struct ConvRaw { float t[32]; bf16* dp; };
__device__ __forceinline__ void conv_issue(const LAS unsigned char* lds, unsigned char* ws, int l, int idx, int lane, ConvRaw& C) {
    const int e = idx / 2304, q = idx % 2304, kind = q / 768, t = q % 768;
    const float* sp; size_t ldw;
    if (kind < 2) { const int kb = t / 24, nb = t % 24, n = 64 * nb + lane; ldw = FF;
        sp = (kind ? inp(lds, 25) : inp(lds, 24)) + ((size_t)l * NE + e) * 1024 * FF + (size_t)(32 * kb) * FF + n;
        C.dp = (bf16*)(ws + WS_WTGU) + (size_t)l * NE * 3072 * 1024 + (size_t)MapGU{e * 3072, kind}(n) * 1024 + 32 * kb; }
    else { const int kb = t / 16, nb = t % 16, n = 64 * nb + lane; ldw = 1024;
        sp = inp(lds, 26) + ((size_t)l * NE + e) * FF * 1024 + (size_t)(32 * kb) * 1024 + n;
        C.dp = (bf16*)(ws + WS_WTDN) + (size_t)l * NE * 1024 * FF + (size_t)(e * 1024 + n) * FF + 32 * kb; }
#pragma unroll
    for (int i = 0; i < 32; ++i) C.t[i] = __builtin_nontemporal_load(sp + (size_t)i * ldw);
}
__device__ __forceinline__ void conv_finish(const ConvRaw& C) {
#pragma unroll
    for (int q = 0; q < 4; ++q) { v4u o; o.x = pg8::cvt_pk_bf16(C.t[8 * q], C.t[8 * q + 1]); o.y = pg8::cvt_pk_bf16(C.t[8 * q + 2], C.t[8 * q + 3]); o.z = pg8::cvt_pk_bf16(C.t[8 * q + 4], C.t[8 * q + 5]); o.w = pg8::cvt_pk_bf16(C.t[8 * q + 6], C.t[8 * q + 7]);
        *(v4u*)(C.dp + 8 * q) = o; }
}
constexpr int CW_Q = 8192, CW_DONE = 8704, QN = 4608, Q_GU0 = 1536, Q_L0 = 2304, Q_GU1 = 3840;
constexpr int CONV_IMG = 64 * 144;
__device__ __forceinline__ void conv_tile(const LAS unsigned char* lds, unsigned char* ws, LAS unsigned char* img, int x, int tq, int lane) {
    const int p = ((tq / 96) * 8 + x) * 48 + (tq % 96) / 2, half = tq & 1, l = p / 9216, r = p % 9216;
    const int kq = lane >> 4, nq = lane & 15, pc = lane & 7, rsub = lane >> 3;
    const float* sp; size_t ldw; bf16* dbase; int dld, e, kind, n0;
    if (r < 6144) { e = r / 384; const int q2 = r % 384, t = q2 % 192, k0 = 128 * (t / 24) + 64 * half; kind = q2 / 192; n0 = 64 * (t % 24); ldw = FF; dld = 1024;
        sp = (kind ? inp(lds, 25) : inp(lds, 24)) + ((size_t)l * NE + e) * 1024 * FF + (size_t)k0 * FF + n0;
        dbase = (bf16*)(ws + WS_WTGU) + (size_t)l * NE * 3072 * 1024 + k0; }
    else { const int r2 = r - 6144, t = r2 % 192, k0 = 128 * (t / 16) + 64 * half; e = r2 / 192; kind = 2; n0 = 64 * (t % 16); ldw = 1024; dld = FF;
        sp = inp(lds, 26) + ((size_t)l * NE + e) * FF * 1024 + (size_t)k0 * 1024 + n0;
        dbase = (bf16*)(ws + WS_WTDN) + (size_t)l * NE * 1024 * FF + k0; }
    f32x4 t[16];
#pragma unroll
    for (int i = 0; i < 8; ++i)
#pragma unroll
        for (int h = 0; h < 2; ++h) t[2 * i + h] = __builtin_nontemporal_load((const f32x4*)(sp + (size_t)(8 * i + 2 * kq + h) * ldw) + nq);
    const int g = (nq >> 1) & 7;
#pragma unroll
    for (int i = 0; i < 8; ++i)
#pragma unroll
        for (int c = 0; c < 4; ++c) *(LAS unsigned*)(img + (4 * nq + c) * 144 + (((4 * i + kq) ^ (g << 2)) << 2)) = pg8::cvt_pk_bf16(t[2 * i][c], t[2 * i + 1][c]);
#pragma unroll
    for (int i = 0; i < 8; ++i) { const int n = 8 * i + rsub;
        const v4u w = *(const LAS v4u*)(img + n * 144 + ((pc ^ i) << 4));
        const int row = kind < 2 ? MapGU{e * 3072, kind}(n0 + n) : e * 1024 + n0 + n;
        *(v4u*)(dbase + (size_t)row * dld + 8 * pc) = w; }
}
__device__ __forceinline__ void conv_host(const Frame& F_, int k, unsigned thr, int need, int cap = QN, int peek = -1) {
    const Frame F = fresh_frame(F_); const int lane = lane_id(), wave = F.wave_s;
    unsigned* ctl = (unsigned*)(F.ws + WS_CTL); const int x = F.vcu >> 5;
    unsigned* q = ctl + CW_Q + 32 * x; unsigned* dn = ctl + CW_DONE + 32 * k;
    volatile LAS int* slot = (volatile LAS int*)(F.lds + MISC_OFF + 64);
    constexpr int TPW = CONV_TPW, BATCH = 7 * TPW;
    if (wave == 0 && lane == 0) { int s0 = QN; bool go = thr != 0u; if (!go) { int hd = peek; if (hd < need) hd = (int)xb_ld(q); go = hd < need; } if (go) s0 = (int)xb_add(q, (unsigned)BATCH); slot[0] = s0; }
    __syncthreads();
    for (int it = 0;; ++it) {
        const int s = __builtin_amdgcn_readfirstlane(slot[it & 1]);
        if (s >= QN) break;
        if (wave == 0) {
            if (lane == 0) { const unsigned d = xb_ld(dn); int sn = QN; if ((d < thr && s + BATCH < cap) || s + BATCH < need) sn = (int)xb_add(q, (unsigned)BATCH); slot[(it + 1) & 1] = sn; }
        } else {
#pragma unroll
            for (int j = 0; j < TPW; ++j) { const int tq = s + (wave - 1) * TPW + j;
                if (tq < QN) conv_tile(F.lds, F.ws, F.lds + ((wave - 1) * TPW + j) * CONV_IMG, x, tq, lane); }
        }
        __syncthreads();
    }
}
__device__ __forceinline__ void conv_worker_done(const Frame& F, int k) { if (F.wave_s == 0 && lane_id() == 0) (void)xb_add((unsigned*)(F.ws + WS_CTL) + CW_DONE + 32 * k, 1u); }
__device__ __forceinline__ void load_row_f32(const float* p, int lane, f32x4 (&v)[4]) {
#pragma unroll
    for (int j = 0; j < 4; ++j) v[j] = *(const f32x4*)(p + 4 * lane + 256 * j);
}
__device__ __forceinline__ void load_row_bf16(const bf16* p, int lane, f32x4 (&v)[4]) {
#pragma unroll
    for (int j = 0; j < 4; ++j) v[j] = ld_bf4(p + 4 * lane + 256 * j);
}
__device__ __forceinline__ float row_sumsq(const f32x4 (&v)[4], int lane) { float s = 0.f;
#pragma unroll
    for (int j = 0; j < 4; ++j) s += (v[j].x * v[j].x + v[j].y * v[j].y) + (v[j].z * v[j].z + v[j].w * v[j].w);
    return wave_sum(s, lane); }
__device__ __forceinline__ void add_expert_out_pre(f32x4 (&v)[4], int sl, float af, int lane, const bf16* EO, const float* g2, float esc);
__device__ __forceinline__ void add_expert_out(f32x4 (&v)[4], int r, int lane, const int* slotmap, const float* afft, const bf16* EO, const float* g2, float esc = 1.0f) {
    const int sl = lane < NE ? slotmap[r * 16 + lane] : -1;
    const float af = lane < NE ? afft[(size_t)r * NE + lane] : 0.f;
    add_expert_out_pre(v, sl, af, lane, EO, g2, esc);
}
__device__ __forceinline__ void expert_acc(f32x4 (&acc)[4], int sl, float af, int lane, const bf16* EO) {
#pragma unroll
    for (int j = 0; j < 4; ++j) acc[j] = (f32x4){0.f, 0.f, 0.f, 0.f};
    unsigned mask = (unsigned)__ballot(sl >= 0);
    while (mask) {
        v2u w[4][4]; float a[4];
#pragma unroll
        for (int q = 0; q < 4; ++q) {
            const bool on = mask != 0u; const int e = on ? __builtin_ctz(mask) : 0; if (on) mask &= mask - 1u;
            const int slot = __builtin_amdgcn_readlane(sl, e); a[q] = on ? __int_as_float(__builtin_amdgcn_readlane(__float_as_int(af), e)) : 0.f;
            const bf16* er = EO + (size_t)(on ? slot : 0) * 1024;
#pragma unroll
            for (int j = 0; j < 4; ++j) w[q][j] = on ? *(const v2u*)(er + 4 * lane + 256 * j) : (v2u){0u, 0u};
        }
#pragma unroll
        for (int q = 0; q < 4; ++q)
#pragma unroll
            for (int j = 0; j < 4; ++j) acc[j] += a[q] * (f32x4){bf_lo(w[q][j].x), bf_hi(w[q][j].x), bf_lo(w[q][j].y), bf_hi(w[q][j].y)};
    }
}
__device__ __forceinline__ void add_expert_out_pre(f32x4 (&v)[4], int sl, float af, int lane, const bf16* EO, const float* g2, float esc) {
    f32x4 acc[4]; expert_acc(acc, sl, af, lane, EO);
#pragma unroll
    for (int j = 0; j < 4; ++j) v[j] += *(const f32x4*)(g2 + 4 * lane + 256 * j) * esc * acc[j];
}
template <int L> struct P1Raw;
template <> struct P1Raw<0> { f32x4 x[3][4]; };
template <> struct P1Raw<1> { v2u h[3][4]; int sl[3]; float af[3]; };
template <int L>
__device__ __forceinline__ void p1_norm1_t(const Frame& F_, float esc) {
    const Frame F = fresh_frame(F_); const Ids I = fresh_ids(F.wave_s);
    const int gw = F.vcu * NWAVES + I.wave, NGW = F.G * NWAVES, lane = I.lane;
    bf16* H = (bf16*)(F.ws + WS_H); bf16* HN = (bf16*)(F.ws + WS_HN);
    const float* MOD = (const float*)(F.ws + WS_MOD); const float* nw = inp(F.lds, 6) + L * 1024;
    const float* xin = inp(F.lds, 0); const float* cin = inp(F.lds, 2);
    const int* slotmap = (const int*)(F.ws + WS_SLOT); const float* afft = (const float*)(F.ws + WS_AFFT);
    constexpr int RB = 3; const int step = NGW * RB;
    LAS float* MA = (LAS float*)F.lds; LAS float* MB = MA + 9 * 1024; LAS float* MG = MB + 9 * 1024;
    auto issue = [&](const int r0, P1Raw<L>& R) {
#pragma unroll
        for (int q = 0; q < RB; ++q) { const int r = r0 + q * NGW;
            if constexpr (L == 0) {
#pragma unroll
                for (int j = 0; j < 4; ++j) R.x[q][j] = (f32x4){0.f, 0.f, 0.f, 0.f};
                if (r < NROWS) load_row_f32(r < NLAT ? xin + (size_t)r * D : cin + (size_t)(r - NLAT) * D, lane, R.x[q]);
            } else {
#pragma unroll
                for (int j = 0; j < 4; ++j) R.h[q][j] = (v2u){0u, 0u};
                R.sl[q] = -1; R.af[q] = 0.f;
                if (r < NROWS) {
#pragma unroll
                    for (int j = 0; j < 4; ++j) R.h[q][j] = *(const v2u*)(H + (size_t)r * D + 4 * lane + 256 * j);
                    if (lane < NE) { R.sl[q] = slotmap[r * 16 + lane]; R.af[q] = afft[(size_t)r * NE + lane]; } } } }
    };
    auto process = [&](const int r0, const P1Raw<L>& R) {
#pragma unroll
        for (int q = 0; q < RB; ++q) { const int r = r0 + q * NGW; if (r < NROWS) {
            const int s = row_sample(r);
            f32x4 v[4];
            if constexpr (L == 0) {
#pragma unroll
                for (int j = 0; j < 4; ++j) v[j] = R.x[q][j];
            } else {
#pragma unroll
                for (int j = 0; j < 4; ++j) v[j] = (f32x4){bf_lo(R.h[q][j].x), bf_hi(R.h[q][j].x), bf_lo(R.h[q][j].y), bf_hi(R.h[q][j].y)};
                f32x4 acc[4]; expert_acc(acc, R.sl[q], R.af[q], lane, (const bf16*)(F.ws + WS_O2));
#pragma unroll
                for (int j = 0; j < 4; ++j) v[j] += *(const LAS f32x4*)(MG + s * 1024 + 4 * lane + 256 * j) * esc * acc[j]; }
            float ssq = 0.f;
#pragma unroll
            for (int j = 0; j < 4; ++j) ssq += (v[j].x * v[j].x + v[j].y * v[j].y) + (v[j].z * v[j].z + v[j].w * v[j].w);
            const float rstd = 1.0f / sqrtf(wave_sum_dpp(ssq) * (1.0f / D) + EPS);
#pragma unroll
            for (int j = 0; j < 4; ++j) { const int k = 4 * lane + 256 * j;
                if (L != 0) st_bf4(H + (size_t)r * D + k, v[j]);
                st_bf4(HN + (size_t)r * D + k, (v[j] * rstd) * *(const LAS f32x4*)(MA + s * 1024 + k) + *(const LAS f32x4*)(MB + s * 1024 + k)); } } }
    };
    P1Raw<L> Ra, Rb;
    issue(gw, Ra);
    for (int i = I.tid; i < 9 * 256; i += 512) { const int s = i >> 8, k = 4 * (i & 255); const float* m = MOD + ((size_t)L * 9 + s) * MODW;
        const f32x4 w = *(const f32x4*)(nw + k), sh = *(const f32x4*)(m + k), sc = *(const f32x4*)(m + 1024 + k);
        *(LAS f32x4*)(MA + s * 1024 + k) = w * (sc + 1.0f); *(LAS f32x4*)(MB + s * 1024 + k) = sh;
        if (L != 0) *(LAS f32x4*)(MG + s * 1024 + k) = *(const f32x4*)(MOD + ((size_t)(L - 1) * 9 + s) * MODW + 5120 + k); }
    __syncthreads();
    for (int r0 = gw; r0 < NROWS; r0 += 2 * step) {
        if (r0 + step < NROWS) issue(r0 + step, Rb);
        process(r0, Ra);
        if (r0 + step < NROWS) { if (r0 + 2 * step < NROWS) issue(r0 + 2 * step, Ra); process(r0 + step, Rb); }
    }
}
__device__ __forceinline__ void p1_norm1(const Frame& F, int l, float esc) { if (l == 0) p1_norm1_t<0>(F, esc); else p1_norm1_t<1>(F, esc); }
struct PFRaw { v2u h[2][4]; int sl[2]; float af[2]; };
__device__ __forceinline__ void p_final(const Frame& F_, float* out) {
    const Frame F = fresh_frame(F_); const Ids I = fresh_ids(F.wave_s);
    const int gw = F.vcu * NWAVES + I.wave, NGW = F.G * NWAVES, lane = I.lane;
    const bf16* H = (const bf16*)(F.ws + WS_H); const float* MOD = (const float*)(F.ws + WS_MOD); const float* nw = inp(F.lds, 27);
    const int* slotmap = (const int*)(F.ws + WS_SLOT); const float* afft = (const float*)(F.ws + WS_AFFT);
    constexpr int RB = 2; const int step = NGW * RB;
    LAS float* MG = (LAS float*)F.lds;
    f32x4 nwr[4];
#pragma unroll
    for (int j = 0; j < 4; ++j) nwr[j] = *(const f32x4*)(nw + 4 * lane + 256 * j);
    auto issue = [&](const int r0, PFRaw& R) {
#pragma unroll
        for (int q = 0; q < RB; ++q) { const int r = r0 + q * NGW;
#pragma unroll
            for (int j = 0; j < 4; ++j) R.h[q][j] = (v2u){0u, 0u};
            R.sl[q] = -1; R.af[q] = 0.f;
            if (r < NLAT) {
#pragma unroll
                for (int j = 0; j < 4; ++j) R.h[q][j] = *(const v2u*)(H + (size_t)r * D + 4 * lane + 256 * j);
                if (lane < NE) { R.sl[q] = slotmap[r * 16 + lane]; R.af[q] = afft[(size_t)r * NE + lane]; } } }
    };
    auto process = [&](const int r0, const PFRaw& R) {
#pragma unroll
        for (int q = 0; q < RB; ++q) { const int r = r0 + q * NGW; if (r < NLAT) {
            const int s = row_sample(r);
            f32x4 v[4];
#pragma unroll
            for (int j = 0; j < 4; ++j) v[j] = (f32x4){bf_lo(R.h[q][j].x), bf_hi(R.h[q][j].x), bf_lo(R.h[q][j].y), bf_hi(R.h[q][j].y)};
            { f32x4 acc[4]; expert_acc(acc, R.sl[q], R.af[q], lane, (const bf16*)(F.ws + WS_O2));
#pragma unroll
              for (int j = 0; j < 4; ++j) v[j] += *(const LAS f32x4*)(MG + s * 1024 + 4 * lane + 256 * j) * acc[j]; }
            float ssq = 0.f;
#pragma unroll
            for (int j = 0; j < 4; ++j) ssq += (v[j].x * v[j].x + v[j].y * v[j].y) + (v[j].z * v[j].z + v[j].w * v[j].w);
            const float rstd = 1.0f / sqrtf(wave_sum_dpp(ssq) * (1.0f / D) + EPS);
#pragma unroll
            for (int j = 0; j < 4; ++j) { const int k = 4 * lane + 256 * j; *(f32x4*)(out + (size_t)r * D + k) = v[j] * rstd * nwr[j]; } } }
    };
    PFRaw Ra, Rb;
    issue(gw, Ra);
    for (int i = I.tid; i < 8 * 256; i += 512) { const int s = i >> 8, k = 4 * (i & 255); *(LAS f32x4*)(MG + s * 1024 + k) = *(const f32x4*)(MOD + ((size_t)9 + s) * MODW + 5120 + k); }
    __syncthreads();
    for (int r0 = gw; r0 < NLAT; r0 += 2 * step) {
        if (r0 + step < NLAT) issue(r0 + step, Rb);
        process(r0, Ra);
        if (r0 + step < NLAT) { if (r0 + 2 * step < NLAT) issue(r0 + 2 * step, Ra); process(r0 + step, Rb); }
    }
}
typedef short p6_bf8 __attribute__((ext_vector_type(8)));
__device__ __forceinline__ void p6_norm2_router(const Frame& F_, int l, int nrows) {
    const Frame F = fresh_frame(F_); const Ids I = fresh_ids(F.wave_s);
    const bf16* H = (const bf16*)(F.ws + WS_H); bf16* HN = (bf16*)(F.ws + WS_HN); float* AFFT = (float*)(F.ws + WS_AFFT);
    const float* MOD = (const float*)(F.ws + WS_MOD); const float* nw = inp(F.lds, 7) + l * 1024; const float* rw = inp(F.lds, 23) + (size_t)l * 1024 * NE;
    LAS unsigned char* WH = F.lds; LAS unsigned char* WL = F.lds + 32768;
    LAS unsigned char* XH = F.lds + 65536; LAS unsigned char* XL = F.lds + 98304;
    LAS float* PX = (LAS float*)(F.lds + 132096);
    const int lane = I.lane, w = I.wave;
    for (int i = I.tid; i < 4096; i += 512) { const int k = i >> 2, q = i & 3; const f32x4 wv = *(const f32x4*)(rw + k * 16 + 4 * q);
#pragma unroll
        for (int c = 0; c < 4; ++c) { const int e = 4 * q + c; const unsigned hb = pg8::cvt_pk_bf16(wv[c], wv[c]) & 0xffffu; const unsigned lb = pg8::cvt_pk_bf16(wv[c] - __uint_as_float(hb << 16), 0.f) & 0xffffu;
            const int off = e * 2048 + (((k >> 3) ^ (e & 7)) << 4) + (k & 7) * 2;
            *(LAS unsigned short*)(WH + off) = (unsigned short)hb; *(LAS unsigned short*)(WL + off) = (unsigned short)lb; } }
    const int nper = nrows >> 8, ngrp = (nper + 15) >> 4;
    v2u raw[2][4];
#pragma unroll
    for (int q = 0; q < 2; ++q) { const int i = 2 * w + q;
#pragma unroll
        for (int j = 0; j < 4; ++j) raw[q][j] = (v2u){0u, 0u};
        if (i < nper) { const bf16* p = H + ((size_t)i * 256 + F.vcu) * D;
#pragma unroll
            for (int j = 0; j < 4; ++j) raw[q][j] = *(const v2u*)(p + 4 * lane + 256 * j); } }
    f32x4 nwr[4], psh[4], psc[4];
    { const int smp = (2 * w) >> 3; const float* mo = MOD + ((size_t)l * 9 + smp) * MODW;
#pragma unroll
      for (int j = 0; j < 4; ++j) { const int k = 4 * lane + 256 * j; nwr[j] = *(const f32x4*)(nw + k); psh[j] = *(const f32x4*)(mo + 3072 + k); psc[j] = *(const f32x4*)(mo + 4096 + k); } }
    for (int g = 0; g < ngrp; ++g) {
        f32x4 v[2][4];
#pragma unroll
        for (int q = 0; q < 2; ++q)
#pragma unroll
            for (int j = 0; j < 4; ++j) v[q][j] = (f32x4){bf_lo(raw[q][j].x), bf_hi(raw[q][j].x), bf_lo(raw[q][j].y), bf_hi(raw[q][j].y)};
        f32x4 ma[4], mb[4];
#pragma unroll
        for (int j = 0; j < 4; ++j) { ma[j] = nwr[j] * (psc[j] + 1.0f); mb[j] = psh[j]; }
        if (g + 1 < ngrp) { const int smp = (16 * (g + 1) + 2 * w) >> 3; const float* mo = MOD + ((size_t)l * 9 + (smp < 9 ? smp : 8)) * MODW;
#pragma unroll
            for (int j = 0; j < 4; ++j) { const int k = 4 * lane + 256 * j; psh[j] = *(const f32x4*)(mo + 3072 + k); psc[j] = *(const f32x4*)(mo + 4096 + k); } }
#pragma unroll
        for (int q = 0; q < 2; ++q) { const int i = 16 * (g + 1) + 2 * w + q;
            if (g + 1 < ngrp && i < nper) { const bf16* p = H + ((size_t)i * 256 + F.vcu) * D;
#pragma unroll
                for (int j = 0; j < 4; ++j) raw[q][j] = *(const v2u*)(p + 4 * lane + 256 * j); } }
        float ss[2];
#pragma unroll
        for (int q = 0; q < 2; ++q) { float s = 0.f;
#pragma unroll
            for (int j = 0; j < 4; ++j) s += (v[q][j].x * v[q][j].x + v[q][j].y * v[q][j].y) + (v[q][j].z * v[q][j].z + v[q][j].w * v[q][j].w);
            ss[q] = p6_row_sum(s); }
#pragma unroll
        for (int q = 0; q < 2; ++q) { const int i = 16 * g + 2 * w + q, m = 2 * w + q; const bool ok = i < nper; const int r = ok ? i * 256 + F.vcu : F.vcu;
            const float tot = (p6_rdl(ss[q], 0) + p6_rdl(ss[q], 16)) + (p6_rdl(ss[q], 32) + p6_rdl(ss[q], 48));
            const float rstd = 1.0f / sqrtf(tot * (1.0f / D) + EPS);
#pragma unroll
            for (int j = 0; j < 4; ++j) { const int k = 4 * lane + 256 * j;
                const f32x4 y = (v[q][j] * rstd) * ma[j] + mb[j];
                v2u hb; hb.x = pg8::cvt_pk_bf16(y.x, y.y); hb.y = pg8::cvt_pk_bf16(y.z, y.w);
                if (ok) *(v2u*)(HN + (size_t)r * D + k) = hb;
                v2u lb; lb.x = pg8::cvt_pk_bf16(y.x - bf_lo(hb.x), y.y - bf_hi(hb.x)); lb.y = pg8::cvt_pk_bf16(y.z - bf_lo(hb.y), y.w - bf_hi(hb.y));
                const int off = m * 2048 + ((((lane >> 1) + 32 * j) ^ (m & 7)) << 4) + (lane & 1) * 8;
                *(LAS v2u*)(XH + off) = hb; *(LAS v2u*)(XL + off) = lb; } }
        __syncthreads();
        f32x4 acc = (f32x4){0.f, 0.f, 0.f, 0.f};
        { const int m = lane & 15, kq = lane >> 4;
#pragma unroll
          for (int s = 0; s < 4; ++s) { const int off = m * 2048 + (((16 * w + 4 * s + kq) ^ (m & 7)) << 4);
              const p6_bf8 ah = *(const LAS p6_bf8*)(XH + off), al = *(const LAS p6_bf8*)(XL + off), bh = *(const LAS p6_bf8*)(WH + off), bl = *(const LAS p6_bf8*)(WL + off);
              acc = __builtin_amdgcn_mfma_f32_16x16x32_bf16(ah, bh, acc, 0, 0, 0); acc = __builtin_amdgcn_mfma_f32_16x16x32_bf16(ah, bl, acc, 0, 0, 0); acc = __builtin_amdgcn_mfma_f32_16x16x32_bf16(al, bh, acc, 0, 0, 0); }
#pragma unroll
          for (int rg = 0; rg < 4; ++rg) PX[w * 256 + (4 * kq + rg) * 16 + m] = acc[rg]; }
        __syncthreads();
        { const int m = 2 * w + ((lane >> 4) & 1), e = lane & 15; float lg = 0.f;
#pragma unroll
          for (int ww = 0; ww < 8; ++ww) lg += PX[ww * 256 + m * 16 + e];
          const float mx = p6_row_max(lg), ex = expf(lg - mx), den = p6_row_sum(ex);
          const int i = 16 * g + m;
          if (lane < 32 && i < nper) AFFT[(size_t)(i * 256 + F.vcu) * NE + e] = ex / den; }
    }
    __syncthreads();
}
__device__ __forceinline__ int block_excl_scan(int v, LAS int* wsum, int lane, int wave, int& total) {
    int inc = v;
#pragma unroll
    for (int off = 1; off < 64; off <<= 1) { const int o = shidx_i(inc, (lane - off) & 63); if (lane >= off) inc += o; }
    if (lane == 63) wsum[wave] = inc;
    __syncthreads();
    int base = 0, tot = 0;
#pragma unroll
    for (int w = 0; w < 8; ++w) { const int s = wsum[w]; base += (w < wave) ? s : 0; tot += s; }
    __syncthreads();
    total = tot; return base + inc - v;
}
__device__ __forceinline__ void p7_topk(const Frame& F_, int l) {
    const Frame F = fresh_frame(F_); const Ids I = fresh_ids(F.wave_s);
    const float* AFFT = (const float*)(F.ws + WS_AFFT); int* SLOT = (int*)(F.ws + WS_SLOT);
    int* IDXG = (int*)(F.ws + WS_SLOT + 1179648);
    LAS unsigned* hist = (LAS unsigned*)F.lds;
    LAS unsigned* misc = hist + 256;
    LAS int* wsum = (LAS int*)(hist + 264);
    const int nitems = (l == 0 ? 16 : 8) * NE;
    for (int item = F.vcu; item < nitems; item += F.G) {
        const int set = item >> 4, e = item & 15;
        const int n = set < 8 ? SEQ : CTXL, cap = n >> 3;
        const int row0 = set < 8 ? set * SEQ : NLAT + (set - 8) * CTXL, slotbase = set < 8 ? set * 256 : 2048 + (set - 8) * 32;
        unsigned key[4]; const int i0 = 4 * I.tid; const bool valid = i0 < n;
        { f32x4 a = (f32x4){0.f, 0.f, 0.f, 0.f}; if (valid) { const float* ap = AFFT + (size_t)(row0 + i0) * NE + e; a = (f32x4){ap[0], ap[NE], ap[2 * NE], ap[3 * NE]}; }
          key[0] = __float_as_uint(a.x); key[1] = __float_as_uint(a.y); key[2] = __float_as_uint(a.z); key[3] = __float_as_uint(a.w); }
        unsigned prefix = 0u, kk = (unsigned)cap;
        for (int pass = 3; pass >= 0; --pass) {
            const int shift = 8 * pass;
            if (I.tid < 256) hist[I.tid] = 0u;
            __syncthreads();
            if (valid) {
#pragma unroll
                for (int j = 0; j < 4; ++j) { const bool match = pass == 3 || ((key[j] >> (shift + 8)) == (prefix >> (shift + 8)));
                    if (match) atomicAdd((unsigned*)&hist[(key[j] >> shift) & 255u], 1u); }
            }
            __syncthreads();
            if (I.wave == 0) {
                const unsigned h0 = hist[4 * I.lane], h1 = hist[4 * I.lane + 1], h2 = hist[4 * I.lane + 2], h3 = hist[4 * I.lane + 3];
                const unsigned s = h0 + h1 + h2 + h3; unsigned t = s;
#pragma unroll
                for (int off = 1; off < 64; off <<= 1) { const unsigned o = (unsigned)shidx_i((int)t, (I.lane + off) & 63); if (I.lane + off < 64) t += o; }
                const unsigned above = t - s, c3 = above + h3, c2 = c3 + h2, c1 = c2 + h1, c0 = c1 + h0;
                int d = -1; unsigned nk = 0u;
                if (above < kk && c3 >= kk) { d = 3; nk = kk - above; }
                else if (c3 < kk && c2 >= kk) { d = 2; nk = kk - c3; }
                else if (c2 < kk && c1 >= kk) { d = 1; nk = kk - c2; }
                else if (c1 < kk && c0 >= kk) { d = 0; nk = kk - c1; }
                if (d >= 0) { misc[0] = prefix | ((unsigned)(4 * I.lane + d) << shift); misc[1] = nk; }
            }
            __syncthreads();
            prefix = misc[0]; kk = misc[1];
        }
        int ceq = 0; bool gt[4], eq[4];
#pragma unroll
        for (int j = 0; j < 4; ++j) { gt[j] = valid && key[j] > prefix; eq[j] = valid && key[j] == prefix; ceq += eq[j] ? 1 : 0; }
        int tot; int erank = block_excl_scan(ceq, wsum, I.lane, I.wave, tot);
        bool sel[4]; int csel = 0;
#pragma unroll
        for (int j = 0; j < 4; ++j) { sel[j] = gt[j] || (eq[j] && (unsigned)erank < kk); erank += eq[j] ? 1 : 0; csel += sel[j] ? 1 : 0; }
        int slot = block_excl_scan(csel, wsum, I.lane, I.wave, tot);
        if (valid) {
#pragma unroll
            for (int j = 0; j < 4; ++j) { const int r = row0 + i0 + j;
                if (sel[j]) { if (slot < cap) { IDXG[e * SLOTS + slotbase + slot] = r; SLOT[r * 16 + e] = e * SLOTS + slotbase + slot; } else SLOT[r * 16 + e] = -1; ++slot; }
                else SLOT[r * 16 + e] = -1; }
        }
        __syncthreads();
    }
}

typedef short bf16x8s __attribute__((ext_vector_type(8)));
typedef short s16x4 __attribute__((ext_vector_type(4)));
constexpr int IMGB = 9216;
constexpr int CS_SET = 4 * IMGB + 1024;
constexpr int CS_P = 2 * CS_SET, CS_ST = CS_P + IMGB, CS_NS = CS_ST + 2 * IMGB, CS_GS = CS_NS + 256, CS_GM = CS_GS + 2048, CS_END = CS_GM + 8192;
static_assert(CS_END <= RING_BYTES, "scan LDS map");
__device__ __forceinline__ bf16x8s rowfrag(const LAS unsigned char* img, int row0, int ks, int fr, int fq) { return *(const LAS bf16x8s*)(img + (row0 + fr) * 144 + ks * 64 + fq * 16); }
__device__ __forceinline__ s16x4 tr_rd(const LAS unsigned char* p) { return __builtin_bit_cast(s16x4, __builtin_amdgcn_ds_read_tr16_b64_v4i16((LAS s16x4*)(LAS unsigned char*)p)); }
__device__ __forceinline__ bf16x8s trfrag(const LAS unsigned char* img, int tok0, int col0, int lane) {
    const LAS unsigned char* a = img + (tok0 + 8 * (lane >> 4) + ((lane >> 2) & 3)) * 144 + (col0 + 4 * (lane & 3)) * 2;
    const s16x4 lo = tr_rd(a), hi = tr_rd(a + 4 * 144);
    return (bf16x8s){lo[0], lo[1], lo[2], lo[3], hi[0], hi[1], hi[2], hi[3]};
}
__device__ __forceinline__ f32x4 mfma16(bf16x8s a, bf16x8s b, f32x4 c) { return __builtin_amdgcn_mfma_f32_16x16x32_bf16(a, b, c, 0, 0, 0); }
struct f32x8 { f32x4 a, b; };
__device__ __forceinline__ f32x8 cvt8(v4u w) { f32x8 r; r.a = (f32x4){bf_lo(w.x), bf_hi(w.x), bf_lo(w.y), bf_hi(w.y)}; r.b = (f32x4){bf_lo(w.z), bf_hi(w.z), bf_lo(w.w), bf_hi(w.w)}; return r; }
__device__ __forceinline__ v4u pack8(f32x4 a, f32x4 b) { v4u w; w.x = pg8::cvt_pk_safe(a.x, a.y); w.y = pg8::cvt_pk_safe(a.z, a.w); w.z = pg8::cvt_pk_safe(b.x, b.y); w.w = pg8::cvt_pk_safe(b.z, b.w); return w; }
__device__ __forceinline__ float silu_q(float x) { return x * __builtin_amdgcn_rcpf(1.0f + __expf(-x)); }
__device__ __forceinline__ float sigmoid_q(float x) { return __builtin_amdgcn_rcpf(1.0f + __expf(-x)); }
__device__ __forceinline__ float log_sigmoid_q(float z) { return fminf(z, 0.f) - __logf(1.0f + __expf(-fabsf(z))); }
__device__ __forceinline__ float softplus_q(float x) { return fmaxf(x, 0.f) + __logf(1.0f + __expf(-fabsf(x))); }
template <int N> __device__ __forceinline__ float dpp_row_shr(float v) { return __int_as_float(__builtin_amdgcn_update_dpp(0, __float_as_int(v), 0x110 + N, 0xf, 0xf, true)); }
__device__ __forceinline__ float rdlane(float v, int l) { return __int_as_float(__builtin_amdgcn_readlane(__float_as_int(v), l)); }
__device__ __forceinline__ float wave_incl_scan(float v, int lane) {
    v += dpp_row_shr<1>(v); v += dpp_row_shr<2>(v); v += dpp_row_shr<4>(v); v += dpp_row_shr<8>(v);
    const float t0 = rdlane(v, 15), t1 = rdlane(v, 31), t2 = rdlane(v, 47); const int row = lane >> 4;
    return v + ((row >= 1 ? t0 : 0.f) + (row >= 2 ? t1 : 0.f) + (row >= 3 ? t2 : 0.f));
}
constexpr size_t WS_UC = 701 * MiB, WS_LA = 719 * MiB, WS_END3 = 737 * MiB;
__device__ __forceinline__ void p2t_pretransform(const Frame& F_, int l, bool inplace) {
    const Frame F = fresh_frame(F_); const Ids I = fresh_ids(F.wave_s);
    const int gw = F.vcu * NWAVES + I.wave, NGW = F.G * NWAVES, lane = I.lane;
    bf16* U = (bf16*)(F.ws + WS_U); bf16* UC = (bf16*)(F.ws + WS_UC); float* LA = (float*)(F.ws + WS_LA);
    f32x4 cwa[5], cwb[5], cba, cbb;
    { const float* cw = inp(F.lds, 15) + (size_t)l * 5 * 512 + 8 * lane; const float* cb = inp(F.lds, 16) + l * 512 + 8 * lane;
#pragma unroll
      for (int w = 0; w < 5; ++w) { cwa[w] = *(const f32x4*)(cw + w * 512); cwb[w] = *(const f32x4*)(cw + w * 512 + 4); }
      cba = *(const f32x4*)cb; cbb = *(const f32x4*)(cb + 4); }
    f32x4 gwv[16], gbv;
    { const float* gwp = inp(F.lds, 12) + (size_t)l * 4096 + (lane >> 5) * 2048 + ((4 * lane) & 127);
#pragma unroll
      for (int r = 0; r < 16; ++r) gwv[r] = *(const f32x4*)(gwp + r * 128);
      gbv = *(const f32x4*)(inp(F.lds, 13) + l * 256 + 4 * lane); }
    const int rc = (8 * lane) & 255, rd0 = rc & 63; const bool isq = lane < 32, first = (rd0 & 31) < 16; const int plane = first ? lane + 2 : lane - 2;
    float invf[8];
#pragma unroll
    for (int j = 0; j < 8; ++j) invf[j] = exp2f(-(float)((rd0 & 15) + j) * (13.287712379549449f / 16.0f)) * 0.15915494309189535f;
    constexpr int RB = 2;
    for (int r0 = gw; r0 < NROWS; r0 += NGW * RB) {
        v4u qk[RB], tap[RB][5], lr0[RB], lr1[RB], mk[RB];
#pragma unroll
        for (int q = 0; q < RB; ++q) { const int r = r0 + q * NGW; if (r < NROWS) {
            const bool isctx = r >= NLAT; const int t = isctx ? ((r - NLAT) & (CTXL - 1)) : (r & (SEQ - 1)), len = isctx ? CTXL : SEQ; const size_t rb = (size_t)(r - t);
            const bf16* ur = U + (size_t)r * INP;
            qk[q] = *(const v4u*)(ur + 8 * lane);
#pragma unroll
            for (int w = 0; w < 5; ++w) { const int tt = t + w - 2; const bool ok = tt >= 0 && tt < len; const v4u x = *(const v4u*)(U + (rb + (ok ? tt : t)) * INP + C_SSD + 256 + 8 * lane); tap[q][w] = ok ? x : (v4u){0u, 0u, 0u, 0u}; }
            lr0[q] = *(const v4u*)(ur + C_GLA + 768); lr1[q] = *(const v4u*)(ur + C_GLA + 776);
            mk[q] = (v4u){0u, 0u, 0u, 0u}; if (lane < 32) mk[q] = *(const v4u*)(ur + C_ML + 256 + 8 * lane); } }
#pragma unroll
        for (int q = 0; q < RB; ++q) { const int r = r0 + q * NGW; if (r < NROWS) {
            const bool isctx = r >= NLAT; const int t = isctx ? ((r - NLAT) & (CTXL - 1)) : (r & (SEQ - 1));
            bf16* ur = U + (size_t)r * INP;
            { f32x8 own = cvt8(qk[q]); v4u pq; pq.x = (unsigned)shidx_i((int)qk[q].x, plane); pq.y = (unsigned)shidx_i((int)qk[q].y, plane); pq.z = (unsigned)shidx_i((int)qk[q].z, plane); pq.w = (unsigned)shidx_i((int)qk[q].w, plane);
              const f32x8 par = cvt8(pq); const float sc = isq ? 0.125f : 1.0f;
              if (!isctx) { const float posv = (rd0 < 32) ? (float)(t >> 6) : (float)(t & 63);
#pragma unroll
                  for (int j = 0; j < 8; ++j) { const float rev = posv * invf[j]; const float cs = __builtin_amdgcn_cosf(rev), sn = __builtin_amdgcn_sinf(rev);
                      const float o = j < 4 ? own.a[j & 3] : own.b[j & 3], p = j < 4 ? par.a[j & 3] : par.b[j & 3]; const float n = (first ? o * cs - p * sn : p * sn + o * cs) * sc;
                      if (j < 4) own.a[j & 3] = n; else own.b[j & 3] = n; } }
              else { own.a = own.a * sc; own.b = own.b * sc; }
              const v4u ow = pack8(own.a, own.b); if (inplace) *(v4u*)(ur + 8 * lane) = ow; else asm volatile("" :: "v"(ow)); }
            { f32x4 a0 = cba, a1 = cbb;
#pragma unroll
              for (int w = 0; w < 5; ++w) { const f32x8 x = cvt8(tap[q][w]); a0 += x.a * cwa[w]; a1 += x.b * cwb[w]; }
#pragma unroll
              for (int j = 0; j < 4; ++j) { a0[j] = silu_q(a0[j]); a1[j] = silu_q(a1[j]); }
              *(v4u*)(UC + (size_t)r * 512 + 8 * lane) = pack8(a0, a1); }
            { const f32x8 l0 = cvt8(lr0[q]), l1 = cvt8(lr1[q]); f32x4 z = gbv;
#pragma unroll
              for (int qq = 0; qq < 4; ++qq) { z += gwv[qq] * l0.a[qq] + gwv[4 + qq] * l0.b[qq] + gwv[8 + qq] * l1.a[qq] + gwv[12 + qq] * l1.b[qq]; }
              f32x4 o;
#pragma unroll
              for (int j = 0; j < 4; ++j) o[j] = log_sigmoid_q(z[j]) * (1.0f / 16.0f);
              *(f32x4*)(LA + (size_t)r * 256 + 4 * lane) = o; }
            if (lane < 32) { f32x8 kk = cvt8(mk[q]); kk.a = kk.a * 0.125f; kk.b = kk.b * 0.125f; const v4u kw = pack8(kk.a, kk.b); if (inplace) *(v4u*)(ur + C_ML + 256 + 8 * lane) = kw; else asm volatile("" :: "v"(kw)); } } }
    }
}

constexpr size_t WS_NIN = WS_AFFT + 1179648;
constexpr int S1_SET = 2 * IMGB + 256, S1_GS = 2 * S1_SET, S1_GM = S1_GS + 2048, S1_END = S1_GM + 8192;
struct StRaw { v4u r[10]; float s0, s1; };
__device__ __forceinline__ int nat_chunk(int cc, int dir) { return cc < 4 ? (dir ? 3 - cc : cc) : (dir ? 35 - cc : cc - 4); }

template <int MIX>
__device__ __forceinline__ void state_item(const Frame& F, const Ids& I, int l, int b, int h, int dir, int item) {
    const bf16* U = (const bf16*)(F.ws + WS_U); bf16* SIN = (bf16*)(F.ws + WS_O2) + (size_t)item * 36 * 4096;
    float* NIN = (float*)(F.ws + WS_NIN) + (size_t)((b * 4 + h) * 2 + dir) * 36 * 64;
    LAS unsigned char* sm = F.lds;
    const int lane = I.lane, wave = I.wave, fr = lane & 15, fq = lane >> 4, rt = wave >> 1, cp = wave & 1;
    const int tk = I.tid >> 3, d0 = (I.tid & 7) * 8;
    float c_la = 0.f, c_b0 = 0.f, c_b1 = 0.f;
    if (MIX == 0) c_la = log_sigmoid_f(inp(F.lds, 10)[(l * 2 + dir) * 4 + h]);
    if (MIX == 2) { c_b0 = inp(F.lds, 17)[(l * 2 + dir) * 4 + h]; c_b1 = -expf(inp(F.lds, 18)[(l * 2 + dir) * 4 + h]); }
    if (MIX == 3) { c_b0 = inp(F.lds, 21)[((l * 2 + dir) * 2 + 0) * 4 + h]; c_b1 = inp(F.lds, 21)[((l * 2 + dir) * 2 + 1) * 4 + h]; }
    float invf[8];
#pragma unroll
    for (int j = 0; j < 8; ++j) invf[j] = MIX == 0 ? exp2f(-(float)((d0 & 15) + j) * (13.287712379549449f / 16.0f)) * 0.15915494309189535f : 0.f;
    f32x4 S[2], nst; S[0] = (f32x4){0.f, 0.f, 0.f, 0.f}; S[1] = S[0]; nst = S[0];
    __syncthreads();

    const bf16* UC = (const bf16*)(F.ws + WS_UC); const float* LA = (const float*)(F.ws + WS_LA);
    auto issue = [&](int cc, StRaw& R) {
        const bool isctx = cc < 4; const int rowbase = isctx ? NLAT + b * CTXL : b * SEQ, t0 = 64 * nat_chunk(cc, dir);
        const int t = t0 + tk; const bf16* ur = U + (size_t)(rowbase + t) * INP; const bf16* ul = U + (size_t)(rowbase + t0 + lane) * INP;
        if (MIX == 0) { R.r[0] = *(const v4u*)(ur + C_RET + 256 + h * 64 + d0); R.r[1] = *(const v4u*)(ur + C_RET + 512 + h * 64 + d0); }
        else if (MIX == 1) {
            R.r[1] = *(const v4u*)(ur + C_GLA + 256 + h * 64 + d0); R.r[0] = d0 < 32 ? *(const v4u*)(ur + C_GLA + 128 + h * 32 + d0) : (v4u){0u, 0u, 0u, 0u};
            const int tq = I.tid >> 5, d = I.tid & 31; v4u lf;
            lf.x = __float_as_uint(LA[(size_t)(rowbase + t0 + 4 * tq + 0) * 256 + dir * 128 + h * 32 + d]); lf.y = __float_as_uint(LA[(size_t)(rowbase + t0 + 4 * tq + 1) * 256 + dir * 128 + h * 32 + d]);
            lf.z = __float_as_uint(LA[(size_t)(rowbase + t0 + 4 * tq + 2) * 256 + dir * 128 + h * 32 + d]); lf.w = __float_as_uint(LA[(size_t)(rowbase + t0 + 4 * tq + 3) * 256 + dir * 128 + h * 32 + d]); R.r[2] = lf;
        } else if (MIX == 2) { const int g = h >> 1; const bf16* uc = UC + (size_t)(rowbase + t) * 512;
            R.r[0] = *(const v4u*)(uc + 256 + g * 64 + d0); R.r[1] = *(const v4u*)(uc + h * 64 + d0);
            R.s0 = bf_lo((unsigned)ul[C_SSD + 768 + dir * 4 + h]);
        } else {
            R.r[0] = *(const v4u*)(ur + C_ML + 256 + h * 64 + d0); R.r[1] = *(const v4u*)(ur + C_ML + 512 + h * 64 + d0);
            R.r[2] = *(const v4u*)(ul + C_ML + 1024 + dir * 8);
        }
    };
    auto finish = [&](int cc, const StRaw& R) {
        LAS unsigned char* set = sm + (cc & 1) * S1_SET; LAS float* ELs = (LAS float*)(set + 2 * IMGB);
        f32x8 k, kp;
        if (MIX != 1) {
            float la, w = 1.f;
            if (MIX == 0) la = c_la;
            else if (MIX == 2) { w = softplus_q(R.s0 + c_b0); la = w * c_b1; }
            else { w = __expf(bf_elem(R.r[2], h) + c_b0); la = log_sigmoid_q(bf_elem(R.r[2], 4 + h) + c_b1); }
            const float G = wave_incl_scan(la, lane), T = rdlane(G, 63);
            if (wave == 0) ELs[lane] = __expf(T);
            const float e_l = (dir ? __expf(G - la) : __expf(T - G)) * w;
            const float ck = shidx(e_l, tk);
            k = cvt8(R.r[0]);
            kp.a = k.a * ck; kp.b = k.b * ck;
        } else {
            LAS float* GS = (LAS float*)(sm + S1_GS); LAS float* GM = (LAS float*)(sm + S1_GM);
            const int d = I.tid & 31, tq = I.tid >> 5; float c[4], la4[4]; float run = 0.f;
            la4[0] = __uint_as_float(R.r[2].x); la4[1] = __uint_as_float(R.r[2].y); la4[2] = __uint_as_float(R.r[2].z); la4[3] = __uint_as_float(R.r[2].w);
#pragma unroll
            for (int u = 0; u < 4; ++u) { run += la4[u]; c[u] = run; }
            GS[tq * 32 + d] = run;
            __syncthreads();
            float off = 0.f, tot = 0.f;
#pragma unroll
            for (int qq = 0; qq < 16; ++qq) { const float s = GS[qq * 32 + d]; off += (qq < tq) ? s : 0.f; tot += s; }
#pragma unroll
            for (int u = 0; u < 4; ++u) GM[(4 * tq + u) * 32 + d] = dir ? (off + c[u] - la4[u]) : (tot - (off + c[u]));
            if (tq == 0) { ELs[d] = __expf(tot); ELs[32 + d] = 1.0f; }
            __syncthreads();
            k = cvt8(R.r[0]);
            if (d0 < 32) { const f32x4 g0 = *(const LAS f32x4*)(GM + tk * 32 + d0), g1 = *(const LAS f32x4*)(GM + tk * 32 + d0 + 4);
#pragma unroll
                for (int j = 0; j < 4; ++j) { kp.a[j] = k.a[j] * __expf(g0[j]); kp.b[j] = k.b[j] * __expf(g1[j]); } }
            else kp = k;
        }
        const int ro = tk * 144 + d0 * 2;
        *(LAS v4u*)(set + ro) = pack8(kp.a, kp.b); *(LAS v4u*)(set + IMGB + ro) = R.r[1];
    };

    StRaw Ra, Rb; ConvRaw CR;
    issue(0, Ra); issue(1, Rb); finish(0, Ra);
    const bf16x8s ones = (bf16x8s){0x3F80, 0x3F80, 0x3F80, 0x3F80, 0x3F80, 0x3F80, 0x3F80, 0x3F80};
    auto chunk_body = [&](const int cc, const int cmode, StRaw& Rfar, const StRaw& Rnext) {
        __syncthreads();
        if (cc + 2 < 36) issue(cc + 2, Rfar);
        if (cmode == 1) conv_issue(F.lds, F.ws, l, (F.vcu * NWAVES + wave) * 18 + (cc >> 2), lane, CR);
        const LAS unsigned char* set = sm + (cc & 1) * S1_SET; const LAS unsigned char* KPs = set; const LAS unsigned char* Vs = set + IMGB; const LAS float* ELs = (const LAS float*)(set + 2 * IMGB);
        { const int row = I.tid >> 3, pc = I.tid & 7; v4u sv = (v4u){0u, 0u, 0u, 0u};
          if (cc > 0) sv = *(const LAS v4u*)(sm + S1_END + (cc & 1) * IMGB + row * 144 + pc * 16);
          *(v4u*)(SIN + (size_t)cc * 4096 + row * 64 + pc * 8) = sv; }
        if (MIX == 3) { if (fr == 0 && cp == 0) *(f32x4*)(NIN + cc * 64 + 16 * rt + 4 * fq) = nst; }
        const bf16x8s kf0 = trfrag(KPs, 0, 16 * rt, lane), kf1 = trfrag(KPs, 32, 16 * rt, lane);
        const f32x4 el = *(const LAS f32x4*)(ELs + 16 * rt + 4 * fq);
#pragma unroll
        for (int u = 0; u < 2; ++u) { const int ct = 2 * cp + u; const bf16x8s v0 = trfrag(Vs, 0, 16 * ct, lane), v1 = trfrag(Vs, 32, 16 * ct, lane);
            S[u] = S[u] * el; S[u] = mfma16(kf0, v0, S[u]); S[u] = mfma16(kf1, v1, S[u]); }
        if (MIX == 3) { nst = nst * el; nst = mfma16(kf0, ones, nst); nst = mfma16(kf1, ones, nst); }
        if (cc + 1 < 36) {
#pragma unroll
            for (int u = 0; u < 2; ++u) { const int ct = 2 * cp + u; v2u sw; sw.x = pg8::cvt_pk_safe(S[u][0], S[u][1]); sw.y = pg8::cvt_pk_safe(S[u][2], S[u][3]);
                *(LAS v2u*)(sm + S1_END + ((cc + 1) & 1) * IMGB + (16 * ct + fr) * 144 + (16 * rt + 4 * fq) * 2) = sw; } }
        if (cc + 1 < 36) finish(cc + 1, Rnext);
        if (cmode == 2) conv_finish(CR);
    };
    for (int cc = 0; cc < 36; cc += 4) { chunk_body(cc, 0, Ra, Rb); chunk_body(cc + 1, 0, Rb, Ra); chunk_body(cc + 2, 0, Ra, Rb); chunk_body(cc + 3, 0, Rb, Ra); }
    __syncthreads();
}
__device__ __forceinline__ void p3a_state(const Frame& F_, int l) {
    const Frame F = fresh_frame(F_); const Ids I = fresh_ids(F.wave_s);
    for (int item = F.vcu; item < 256; item += F.G) {
        const int dir = item & 1, h = (item >> 1) & 3, mixer = (item >> 3) & 3, b = item >> 5;
        if (mixer == 0) state_item<0>(F, I, l, b, h, dir, item);
        else if (mixer == 1) state_item<1>(F, I, l, b, h, dir, item);
        else if (mixer == 2) state_item<2>(F, I, l, b, h, dir, item);
        else state_item<3>(F, I, l, b, h, dir, item);
    }
}

constexpr int S2_Q = 0, S2_K = IMGB, S2_V = 2 * IMGB, S2_P = 3 * IMGB, S2_P2 = 4 * IMGB, S2_STF = 5 * IMGB, S2_STB = 6 * IMGB, S2_ARR = 7 * IMGB, S2_NV = S2_ARR + 1024, S2_STAT = S2_NV + 256,
              S2_GS = S2_STAT + 1024, S2_GM = S2_GS + 4096, S2_END = S2_GM + 16384;
constexpr int S2_CST = S2_END, S2_CST_END = S2_CST + 5440 * 4, S2_YS = S2_CST_END  , S2_GI = S2_YS  ;
static_assert(S2_YS + 17408 <= RING_BYTES && S1_END + 2 * IMGB <= RING_BYTES && 64 * 528 <= 5 * IMGB, "mixer LDS maps");
struct OutAcc { f32x4 y[2]; };
struct HRaw { v4u r[7]; v2u g[2]; float s[4]; };
struct HItem { int mix, b, h, nc, isctx, last; };

template <int MIX>
__device__ __forceinline__ void s2_issue(const Frame& F, const Ids&, int l, const HItem& it, HRaw& R) {
    const Ids I = fresh_ids(F.wave_s);
    const bf16* U = (const bf16*)(F.ws + WS_U); const bf16* SINB = (const bf16*)(F.ws + WS_O2); const float* NINB = (const float*)(F.ws + WS_NIN);
    const int lane = I.lane, wave = I.wave, fr = lane & 15, fq = lane >> 4, rt = wave >> 1, cp = wave & 1, tk = I.tid >> 3, d0 = (I.tid & 7) * 8;
    const int b = it.b, h = it.h, nc = it.nc; const bool isctx = it.isctx;
    const int len = isctx ? CTXL : SEQ, rowbase = isctx ? NLAT + b * CTXL : b * SEQ, t0 = 64 * nc, t = t0 + tk;
    const int item_f = b * 32 + MIX * 8 + h * 2, cc_f = isctx ? nc : 4 + nc, cc_b = isctx ? 3 - nc : 35 - nc;
    const bf16* ur = U + (size_t)(rowbase + t) * INP; const bf16* ul = U + (size_t)(rowbase + t0 + lane) * INP;
    const int row = I.tid >> 3, pc = I.tid & 7;
    const int orow = rowbase + t0 + 16 * rt + fr;
    if (MIX == 0) {
        R.r[0] = *(const v4u*)(ur + C_RET + h * 64 + d0); R.r[1] = *(const v4u*)(ur + C_RET + 256 + h * 64 + d0); R.r[2] = *(const v4u*)(ur + C_RET + 512 + h * 64 + d0);
        R.r[5] = *(const v4u*)(SINB + ((size_t)item_f * 36 + cc_f) * 4096 + row * 64 + 8 * pc); R.r[6] = *(const v4u*)(SINB + ((size_t)(item_f + 1) * 36 + cc_b) * 4096 + row * 64 + 8 * pc);
        { const v4u gv = *(const v4u*)(ur + C_RET + 768 + h * 64 + d0); R.g[0] = (v2u){gv.x, gv.y}; R.g[1] = (v2u){gv.z, gv.w}; }
    } else if (MIX == 1) {
        R.r[2] = *(const v4u*)(ur + C_GLA + 256 + h * 64 + d0);
        if (d0 < 32) { R.r[0] = *(const v4u*)(ur + C_GLA + h * 32 + d0); R.r[1] = *(const v4u*)(ur + C_GLA + 128 + h * 32 + d0); } else { R.r[0] = (v4u){0u, 0u, 0u, 0u}; R.r[1] = R.r[0]; }
        R.r[3] = *(const v4u*)(SINB + ((size_t)(item_f + (pc >> 2)) * 36 + (pc < 4 ? cc_f : cc_b)) * 4096 + row * 64 + 8 * (pc & 3));
        { const int tq = I.tid >> 5, d = I.tid & 31; const float* la = (const float*)(F.ws + WS_LA) + (size_t)(rowbase + t0 + 4 * tq) * 256 + h * 32 + d; v4u lf, lb;
          lf.x = __float_as_uint(la[0]); lf.y = __float_as_uint(la[256]); lf.z = __float_as_uint(la[512]); lf.w = __float_as_uint(la[768]);
          lb.x = __float_as_uint(la[128]); lb.y = __float_as_uint(la[128 + 256]); lb.z = __float_as_uint(la[128 + 512]); lb.w = __float_as_uint(la[128 + 768]); R.r[4] = lf; R.r[5] = lb; }
        { const v4u gv = *(const v4u*)(ur + C_GLA + 512 + h * 64 + d0); R.g[0] = (v2u){gv.x, gv.y}; R.g[1] = (v2u){gv.z, gv.w}; }
    } else if (MIX == 2) { const int g = h >> 1; const bf16* uc = (const bf16*)(F.ws + WS_UC) + (size_t)(rowbase + t) * 512;
        R.r[0] = *(const v4u*)(uc + h * 64 + d0); R.r[1] = *(const v4u*)(uc + 256 + g * 64 + d0); R.r[2] = *(const v4u*)(uc + 384 + g * 64 + d0);
        R.r[5] = *(const v4u*)(SINB + ((size_t)item_f * 36 + cc_f) * 4096 + row * 64 + 8 * pc); R.r[6] = *(const v4u*)(SINB + ((size_t)(item_f + 1) * 36 + cc_b) * 4096 + row * 64 + 8 * pc);
        if (wave == 0) { R.s[0] = bf_lo((unsigned)ul[C_SSD + 768 + h]); R.s[1] = bf_lo((unsigned)ul[C_SSD + 768 + 4 + h]); }
        { const v4u gv = *(const v4u*)(ur + C_SSD + h * 64 + d0); R.g[0] = (v2u){gv.x, gv.y}; R.g[1] = (v2u){gv.z, gv.w}; }
    } else {
        R.r[0] = *(const v4u*)(ur + C_ML + h * 64 + d0); R.r[1] = *(const v4u*)(ur + C_ML + 256 + h * 64 + d0); R.r[2] = *(const v4u*)(ur + C_ML + 512 + h * 64 + d0);
        R.r[3] = *(const v4u*)(SINB + ((size_t)item_f * 36 + cc_f) * 4096 + row * 64 + 8 * pc); R.r[4] = *(const v4u*)(SINB + ((size_t)(item_f + 1) * 36 + cc_b) * 4096 + row * 64 + 8 * pc);
        if (I.tid < 32) R.r[5] = *(const v4u*)(NINB + ((size_t)((b * 4 + h) * 2 + (I.tid >> 4)) * 36 + ((I.tid >> 4) ? cc_b : cc_f)) * 64 + 4 * (I.tid & 15));
        if (wave == 0) { const v4u gf = *(const v4u*)(ul + C_ML + 1024), gb = *(const v4u*)(ul + C_ML + 1024 + 8);
            R.s[0] = bf_elem(gf, h); R.s[1] = bf_elem(gf, 4 + h); R.s[2] = bf_elem(gb, h); R.s[3] = bf_elem(gb, 4 + h); }
        { const v4u gv = *(const v4u*)(ur + C_ML + 768 + h * 64 + d0); R.g[0] = (v2u){gv.x, gv.y}; R.g[1] = (v2u){gv.z, gv.w}; }
    }
}
template <int MIX>
__device__ __forceinline__ void s2_transform(const Frame& F, const Ids&, int l, const HItem& it, const HRaw& R) {
    const Ids I = fresh_ids(F.wave_s);
    LAS unsigned char* sm = F.lds;
    const int lane = I.lane, wave = I.wave, tk = I.tid >> 3, d0 = (I.tid & 7) * 8; const int h = it.h; const bool isctx = it.isctx; const int t = 64 * it.nc + tk;
    LAS float* GF = (LAS float*)(sm + S2_ARR); LAS float* HB = GF + 64; LAS float* WF = GF + 128; LAS float* WB = GF + 192;
    const int row = I.tid >> 3, pc = I.tid & 7;
    if (MIX == 2) *(LAS v4u*)(sm + S2_GI + tk * 144 + d0 * 2) = (v4u){R.g[0].x, R.g[0].y, R.g[1].x, R.g[1].y};
    f32x8 q, k, v;
    if (MIX != 1) {
        const v4u sf = (MIX == 0 || MIX == 2) ? R.r[5] : R.r[3], sb = (MIX == 0 || MIX == 2) ? R.r[6] : R.r[4];
        *(LAS v4u*)(sm + S2_STF + row * 144 + pc * 16) = sf; *(LAS v4u*)(sm + S2_STB + row * 144 + pc * 16) = sb;
        if (MIX == 3 && I.tid < 32) { const f32x4 nv = __builtin_bit_cast(f32x4, R.r[5]); v2u w; w.x = pg8::cvt_pk_safe(nv[0], nv[1]); w.y = pg8::cvt_pk_safe(nv[2], nv[3]); *(LAS v2u*)(sm + S2_NV + (I.tid >> 4) * 128 + 8 * (I.tid & 15)) = w; }
        if (wave == 0) {
            float laf, lab, wf = 1.f, wb = 1.f;
            const LAS float* cst = (const LAS float*)(sm + S2_CST);
            if (MIX == 0) { laf = cst[h]; lab = cst[4 + h]; }
            else if (MIX == 2) { wf = softplus_q(R.s[0] + cst[8 + h]); wb = softplus_q(R.s[1] + cst[12 + h]); laf = wf * cst[16 + h]; lab = wb * cst[20 + h]; }
            else { const LAS float* gb = cst + 32; wf = __expf(R.s[0] + gb[h]); laf = log_sigmoid_q(R.s[1] + gb[4 + h]); wb = __expf(R.s[2] + gb[8 + h]); lab = log_sigmoid_q(R.s[3] + gb[12 + h]); }
            const float Gf = wave_incl_scan(laf, lane), Gb = wave_incl_scan(lab, lane), Tb = rdlane(Gb, 63);
            GF[lane] = Gf; HB[lane] = Tb - Gb + lab; WF[lane] = wf; WB[lane] = wb; }
        const int ro = tk * 144 + d0 * 2;
        *(LAS v4u*)(sm + S2_Q + ro) = MIX == 2 ? R.r[2] : R.r[0]; *(LAS v4u*)(sm + S2_K + ro) = R.r[1]; *(LAS v4u*)(sm + S2_V + ro) = MIX == 2 ? R.r[0] : R.r[2];
    } else {
        *(LAS v4u*)(sm + S2_STF + row * 144 + pc * 16) = R.r[3];
        LAS float* GS = (LAS float*)(sm + S2_GS); LAS float* GM = (LAS float*)(sm + S2_GM);
        const int d = I.tid & 31, tq = I.tid >> 5; float cfw[4], cbw[4], lbw[4]; float runf = 0.f, runb = 0.f;
        const float lfw[4] = {__uint_as_float(R.r[4].x), __uint_as_float(R.r[4].y), __uint_as_float(R.r[4].z), __uint_as_float(R.r[4].w)};
        lbw[0] = __uint_as_float(R.r[5].x); lbw[1] = __uint_as_float(R.r[5].y); lbw[2] = __uint_as_float(R.r[5].z); lbw[3] = __uint_as_float(R.r[5].w);
#pragma unroll
        for (int u = 0; u < 4; ++u) { runf += lfw[u]; cfw[u] = runf; runb += lbw[u]; cbw[u] = runb; }
        GS[tq * 32 + d] = runf; GS[512 + tq * 32 + d] = runb;
        __syncthreads();
        float offf = 0.f, offb = 0.f, totb = 0.f;
#pragma unroll
        for (int qq = 0; qq < 16; ++qq) { const float sf = GS[qq * 32 + d], sb = GS[512 + qq * 32 + d]; offf += (qq < tq) ? sf : 0.f; offb += (qq < tq) ? sb : 0.f; totb += sb; }
#pragma unroll
        for (int u = 0; u < 4; ++u) { GM[(4 * tq + u) * 32 + d] = offf + cfw[u]; GM[2048 + (4 * tq + u) * 32 + d] = totb - (offb + cbw[u]) + lbw[u]; }
        if (I.tid < 64) { GF[I.tid] = 0.f; HB[I.tid] = 0.f; WF[I.tid] = 1.f; WB[I.tid] = 1.f; }
        __syncthreads();
        *(LAS v4u*)(sm + S2_V + tk * 144 + d0 * 2) = R.r[2];
        if (d0 < 32) { q = cvt8(R.r[0]); k = cvt8(R.r[1]);
            const f32x4 gf0 = *(const LAS f32x4*)(GM + tk * 32 + d0), gf1 = *(const LAS f32x4*)(GM + tk * 32 + d0 + 4), gb0 = *(const LAS f32x4*)(GM + 2048 + tk * 32 + d0), gb1 = *(const LAS f32x4*)(GM + 2048 + tk * 32 + d0 + 4);
            f32x8 qf, kf, qb, kb;
#pragma unroll
            for (int j = 0; j < 4; ++j) { qf.a[j] = q.a[j] * 0.17677669529663687f * __expf(gf0[j]); qf.b[j] = q.b[j] * 0.17677669529663687f * __expf(gf1[j]); kf.a[j] = k.a[j] * __expf(-gf0[j]); kf.b[j] = k.b[j] * __expf(-gf1[j]);
                qb.a[j] = q.a[j] * 0.17677669529663687f * __expf(gb0[j]); qb.b[j] = q.b[j] * 0.17677669529663687f * __expf(gb1[j]); kb.a[j] = k.a[j] * __expf(-gb0[j]); kb.b[j] = k.b[j] * __expf(-gb1[j]); }
            const int ro = tk * 144 + d0 * 2;
            *(LAS v4u*)(sm + S2_Q + ro) = pack8(qf.a, qf.b); *(LAS v4u*)(sm + S2_Q + ro + 64) = pack8(qb.a, qb.b); *(LAS v4u*)(sm + S2_K + ro) = pack8(kf.a, kf.b); *(LAS v4u*)(sm + S2_K + ro + 64) = pack8(kb.a, kb.b); }
    }
}
template <int MIX>
__device__ __forceinline__ OutAcc s2_compute(const Frame& F, const Ids&, int l, const HItem& it, const v2u (&zg)[2]) {
    const Ids I = fresh_ids(F.wave_s);
    LAS unsigned char* sm = F.lds;
    const int lane = I.lane, wave = I.wave, fr = lane & 15, fq = lane >> 4, rt = wave >> 1, cp = wave & 1; const int h = it.h;
    const LAS float* GF = (const LAS float*)(sm + S2_ARR); const LAS float* HB = GF + 64; const LAS float* WF = GF + 128; const LAS float* WB = GF + 192;
    const int irow = 16 * rt + fr;
    const float gfi = GF[irow], hbi = HB[irow];
    const bf16x8s qf0 = rowfrag(sm + S2_Q, 16 * rt, 0, fr, fq), qf1 = rowfrag(sm + S2_Q, 16 * rt, 1, fr, fq);
#pragma unroll
    for (int u = 0; u < 2; ++u) { const int jt = 2 * cp + u;
        f32x4 sc = (f32x4){0.f, 0.f, 0.f, 0.f}, sc2 = sc;
        sc = mfma16(rowfrag(sm + S2_K, 16 * jt, 0, fr, fq), qf0, sc);
        if (MIX == 1) sc2 = mfma16(rowfrag(sm + S2_K, 16 * jt, 1, fr, fq), qf1, sc2); else sc = mfma16(rowfrag(sm + S2_K, 16 * jt, 1, fr, fq), qf1, sc);
        const f32x4 gj = *(const LAS f32x4*)(GF + 16 * jt + 4 * fq), hj = *(const LAS f32x4*)(HB + 16 * jt + 4 * fq), wfj = *(const LAS f32x4*)(WF + 16 * jt + 4 * fq), wbj = *(const LAS f32x4*)(WB + 16 * jt + 4 * fq);
        float pa[4], pb[4];
#pragma unroll
        for (int r = 0; r < 4; ++r) { const int j = 16 * jt + 4 * fq + r;
            const float ef = (j <= irow) ? __expf(fminf(gfi - gj[r], 0.f)) * wfj[r] : 0.f, eb = (j >= irow) ? __expf(fminf(hbi - hj[r], 0.f)) * wbj[r] : 0.f;
            if (MIX == 1) { pa[r] = sc[r] * ef + sc2[r] * eb; pb[r] = 0.f; } else if (MIX == 3) { pa[r] = sc[r] * ef; pb[r] = sc[r] * eb; } else { pa[r] = sc[r] * (ef + eb); pb[r] = 0.f; } }
        v2u pw; pw.x = pg8::cvt_pk_safe(pa[0], pa[1]); pw.y = pg8::cvt_pk_safe(pa[2], pa[3]); *(LAS v2u*)(sm + S2_P + irow * 144 + (16 * jt + 4 * fq) * 2) = pw;
        if (MIX == 3) { v2u pw2; pw2.x = pg8::cvt_pk_safe(pb[0], pb[1]); pw2.y = pg8::cvt_pk_safe(pb[2], pb[3]); *(LAS v2u*)(sm + S2_P2 + irow * 144 + (16 * jt + 4 * fq) * 2) = pw2; } }
    f32x4 o2f[2], o2b[2], e2f = (f32x4){0.f, 0.f, 0.f, 0.f}, e2b = e2f;
#pragma unroll
    for (int u = 0; u < 2; ++u) { const int ct = 2 * cp + u; o2f[u] = (f32x4){0.f, 0.f, 0.f, 0.f}; o2b[u] = o2f[u];
        o2f[u] = mfma16(rowfrag(sm + S2_STF, 16 * ct, 0, fr, fq), qf0, o2f[u]); o2f[u] = mfma16(rowfrag(sm + S2_STF, 16 * ct, 1, fr, fq), qf1, o2f[u]);
        if (MIX != 1) { o2b[u] = mfma16(rowfrag(sm + S2_STB, 16 * ct, 0, fr, fq), qf0, o2b[u]); o2b[u] = mfma16(rowfrag(sm + S2_STB, 16 * ct, 1, fr, fq), qf1, o2b[u]); } }
    if (MIX == 3) { const LAS unsigned char* nv = sm + S2_NV;
        e2f = mfma16(*(const LAS bf16x8s*)(nv + fq * 16), qf0, e2f); e2f = mfma16(*(const LAS bf16x8s*)(nv + 64 + fq * 16), qf1, e2f);
        e2b = mfma16(*(const LAS bf16x8s*)(nv + 128 + fq * 16), qf0, e2b); e2b = mfma16(*(const LAS bf16x8s*)(nv + 192 + fq * 16), qf1, e2b); }
    bf16x8s vf[2][2];
#pragma unroll
    for (int u = 0; u < 2; ++u) { vf[u][0] = trfrag(sm + S2_V, 0, 16 * (2 * cp + u), lane); vf[u][1] = trfrag(sm + S2_V, 32, 16 * (2 * cp + u), lane); }
    __syncthreads();
    const bf16x8s pf0 = rowfrag(sm + S2_P, 16 * rt, 0, fr, fq), pf1 = rowfrag(sm + S2_P, 16 * rt, 1, fr, fq);
    const float egf = __expf(gfi), egb = __expf(hbi);
    const bf16x8s ones = (bf16x8s){0x3F80, 0x3F80, 0x3F80, 0x3F80, 0x3F80, 0x3F80, 0x3F80, 0x3F80};
    OutAcc A;
    if (MIX == 3) {
        const bf16x8s pb0 = rowfrag(sm + S2_P2, 16 * rt, 0, fr, fq), pb1 = rowfrag(sm + S2_P2, 16 * rt, 1, fr, fq);
        f32x4 e1f = (f32x4){0.f, 0.f, 0.f, 0.f}, e1b = e1f; e1f = mfma16(ones, pf0, e1f); e1f = mfma16(ones, pf1, e1f); e1b = mfma16(ones, pb0, e1b); e1b = mfma16(ones, pb1, e1b);
        const float sf = 1.0f / fmaxf(fabsf(e1f[0] + egf * e2f[0]), 1.0f), sb = 1.0f / fmaxf(fabsf(e1b[0] + egb * e2b[0]), 1.0f);
#pragma unroll
        for (int u = 0; u < 2; ++u) { f32x4 of = (f32x4){0.f, 0.f, 0.f, 0.f}, ob = of; of = mfma16(vf[u][0], pf0, of); of = mfma16(vf[u][1], pf1, of); ob = mfma16(vf[u][0], pb0, ob); ob = mfma16(vf[u][1], pb1, ob);
            A.y[u] = (of + o2f[u] * egf) * sf + (ob + o2b[u] * egb) * sb; }
    } else {
#pragma unroll
        for (int u = 0; u < 2; ++u) { f32x4 o1 = (f32x4){0.f, 0.f, 0.f, 0.f}; o1 = mfma16(vf[u][0], pf0, o1); o1 = mfma16(vf[u][1], pf1, o1);
            A.y[u] = MIX == 1 ? (o1 + o2f[u]) : (o1 + o2f[u] * egf + o2b[u] * egb); }
    }
    if (MIX == 2) { const float dsk = ((const LAS float*)(sm + S2_CST))[24 + h];
#pragma unroll
        for (int u = 0; u < 2; ++u) { const int c0 = 16 * (2 * cp + u) + 4 * fq; const v2u xw = *(const LAS v2u*)(sm + S2_V + irow * 144 + c0 * 2);
            const f32x4 xs = (f32x4){bf_lo(xw.x), bf_hi(xw.x), bf_lo(xw.y), bf_hi(xw.y)}, z = (f32x4){bf_lo(zg[u].x), bf_hi(zg[u].x), bf_lo(zg[u].y), bf_hi(zg[u].y)};
#pragma unroll
            for (int r = 0; r < 4; ++r) A.y[u][r] = (A.y[u][r] + dsk * xs[r]) * silu_q(z[r]); }
    }
    return A;
}
__device__ __forceinline__ void token_stats(LAS unsigned char* sm, int rt, int cp, int fr, int fq, int lane, float& s1, float& s2) {
    s1 += shx(s1, 16, lane); s1 += shx(s1, 32, lane); s2 += shx(s2, 16, lane); s2 += shx(s2, 32, lane);
    LAS float* ST = (LAS float*)(sm + S2_STAT);
    if (fq == 0) { ST[((16 * rt + fr) * 2 + cp) * 2] = s1; ST[((16 * rt + fr) * 2 + cp) * 2 + 1] = s2; }
    __syncthreads();
    const f32x4 a = *(const LAS f32x4*)(ST + (16 * rt + fr) * 4); s1 = a[0] + a[2]; s2 = a[1] + a[3];
}
__device__ __forceinline__ HItem s2_item(int j, int blk, int G, int NCH, bool ctx_out, int nsu, int u0) {
    HItem it; int c;
    if (j < 4 * nsu) { const int u = blk + (j >> 2) * G; it.mix = 2; it.b = u / NCH; c = u % NCH; it.h = j & 3; it.last = (j & 3) == 3; }
    else { const int u = u0 + (j - 4 * nsu), mh = u % 12, bc = u / 12; it.b = bc / NCH; c = bc % NCH; const int m3 = mh >> 2; it.mix = m3 == 0 ? 0 : (m3 == 1 ? 1 : 3); it.h = mh & 3; it.last = true; }
    it.isctx = ctx_out && c < 4; it.nc = ctx_out ? (it.isctx ? c : c - 4) : c; return it;
}
__device__ __forceinline__ void p3b_output(const Frame& F_, int l, bool ctx_out) {
    const Frame F = fresh_frame(F_); const Ids I = fresh_ids(F.wave_s);
    bf16* Y = (bf16*)(F.ws + WS_Y);
    const int lane = I.lane, wave = I.wave, fr = lane & 15, fq = lane >> 4, rt = wave >> 1, cp = wave & 1;
    const int NCH = ctx_out ? 36 : 32, nssd = 8 * NCH, blk = F.vcu, G = F.G;
    const int extra = nssd - G, nsu = 1 + (blk < extra ? 1 : 0);
    const int per_lo = (16 * NCH * 8) / G - 8, per_hi = per_lo + 4;
    const int u0 = blk < extra ? blk * per_lo : extra * per_lo + (blk - extra) * per_hi, cnt = blk < extra ? per_lo : per_hi, nitems = 4 * nsu + cnt;
    HRaw Ra;
    { const HItem i0 = s2_item(0, blk, G, NCH, ctx_out, nsu, u0); s2_issue<2>(F, I, l, i0, Ra); }
    {
        LAS float* cst = (LAS float*)(F.lds + S2_CST);
        if (I.tid < 8) { cst[I.tid] = log_sigmoid_f(inp(F.lds, 10)[l * 8 + I.tid]); cst[8 + I.tid] = inp(F.lds, 17)[l * 8 + I.tid]; cst[16 + I.tid] = -expf(inp(F.lds, 18)[l * 8 + I.tid]); }
        if (I.tid < 4) cst[24 + I.tid] = inp(F.lds, 19)[l * 4 + I.tid];
        if (I.tid < 16) cst[32 + I.tid] = inp(F.lds, 21)[l * 16 + I.tid];
        if (I.tid < 256) { cst[64 + I.tid] = inp(F.lds, 11)[l * 256 + I.tid]; cst[320 + I.tid] = inp(F.lds, 14)[l * 256 + I.tid]; cst[576 + I.tid] = inp(F.lds, 20)[l * 256 + I.tid]; cst[832 + I.tid] = inp(F.lds, 22)[l * 256 + I.tid];
            }
    }
    __syncthreads();
    unsigned ssdy[3][2][2] = {}; float ssd_s2 = 0.f;
    ConvRaw CR;
    unsigned long long tacc0 = 0, tacc1 = 0, tacc2 = 0, tacc3 = 0;
#define S2T(n) do { if (PSPIN) { const unsigned long long t_ = __builtin_amdgcn_s_memrealtime(); tacc##n += t_ - tlast; tlast = t_; } } while (0)
    auto item_body = [&](const int j, HRaw& R, const int cmode) {
        unsigned long long tlast = PSPIN ? __builtin_amdgcn_s_memrealtime() : 0ull;
        const HItem cur = s2_item(j, blk, G, NCH, ctx_out, nsu, u0);
        if (cur.mix == 0) s2_transform<0>(F, I, l, cur, R); else if (cur.mix == 1) s2_transform<1>(F, I, l, cur, R); else if (cur.mix == 2) s2_transform<2>(F, I, l, cur, R); else s2_transform<3>(F, I, l, cur, R);
        const v4u zgv = (v4u){R.g[0].x, R.g[0].y, R.g[1].x, R.g[1].y};
        S2T(0);
        __syncthreads();
        S2T(1);
        v2u zg[2];
#pragma unroll
        for (int u = 0; u < 2; ++u) zg[u] = cur.mix == 2 ? *(const LAS v2u*)(F.lds + S2_GI + (16 * rt + fr) * 144 + (16 * (2 * cp + u) + 4 * fq) * 2) : (v2u){0u, 0u};
        if (j + 1 < nitems) { const HItem nxt = s2_item(j + 1, blk, G, NCH, ctx_out, nsu, u0);
            if (nxt.mix == 0) s2_issue<0>(F, I, l, nxt, R); else if (nxt.mix == 1) s2_issue<1>(F, I, l, nxt, R); else if (nxt.mix == 2) s2_issue<2>(F, I, l, nxt, R); else s2_issue<3>(F, I, l, nxt, R); }
        if (cmode == 1) conv_issue(F.lds, F.ws, l, (F.vcu * NWAVES + wave) * 18 + 9 + (j >> 1), lane, CR);
        OutAcc A;
        if (cur.mix == 0) A = s2_compute<0>(F, I, l, cur, zg); else if (cur.mix == 1) A = s2_compute<1>(F, I, l, cur, zg); else if (cur.mix == 2) A = s2_compute<2>(F, I, l, cur, zg); else A = s2_compute<3>(F, I, l, cur, zg);
        S2T(2);
        const int row = (cur.isctx ? NLAT + cur.b * CTXL : cur.b * SEQ) + 64 * cur.nc + 16 * rt + fr;
        if (cur.mix == 2) {
#pragma unroll
            for (int u = 0; u < 2; ++u)
#pragma unroll
                for (int r = 0; r < 4; ++r) ssd_s2 += A.y[u][r] * A.y[u][r];
            if (!cur.last) {
#pragma unroll
                for (int hh = 0; hh < 3; ++hh) {
#pragma unroll
                    for (int u = 0; u < 2; ++u) { const unsigned p0 = pg8::cvt_pk_safe(A.y[u][0], A.y[u][1]), p1 = pg8::cvt_pk_safe(A.y[u][2], A.y[u][3]);
                        ssdy[hh][u][0] = cur.h == hh ? p0 : ssdy[hh][u][0]; ssdy[hh][u][1] = cur.h == hh ? p1 : ssdy[hh][u][1]; } }
                __syncthreads();
            } else {
                float s1 = 0.f, s2 = ssd_s2; token_stats(F.lds, rt, cp, fr, fq, lane, s1, s2); ssd_s2 = 0.f;
                const float rs = 1.0f / sqrtf(s2 * (1.0f / 256.0f) + EPS); const LAS float* nw = (const LAS float*)(F.lds + S2_CST) + 576;
#pragma unroll
                for (int hh = 0; hh < 4; ++hh)
#pragma unroll
                    for (int u = 0; u < 2; ++u) { const int c0 = hh * 64 + 16 * (2 * cp + u) + 4 * fq;
                        const f32x4 yv = hh < 3 ? (f32x4){bf_lo(ssdy[hh < 3 ? hh : 0][u][0]), bf_hi(ssdy[hh < 3 ? hh : 0][u][0]), bf_lo(ssdy[hh < 3 ? hh : 0][u][1]), bf_hi(ssdy[hh < 3 ? hh : 0][u][1])} : A.y[u];
                        st_bf4_lds(F.lds + S2_Q + (16 * rt + fr) * 528 + c0 * 2, yv * rs * *(const LAS f32x4*)(nw + c0)); }
                __syncthreads();
                { const int r2 = I.tid >> 3, pc = I.tid & 7; bf16* yp = Y + (size_t)(row - (16 * rt + fr) + r2) * D + 512;
#pragma unroll
                  for (int hh = 0; hh < 4; ++hh) *(v4u*)(yp + (pc + 8 * hh) * 8) = *(const LAS v4u*)(F.lds + S2_Q + r2 * 528 + (pc + 8 * hh) * 16); }
                __syncthreads();
            }
        } else {
            float s1 = 0.f, s2 = 0.f;
#pragma unroll
            for (int u = 0; u < 2; ++u)
#pragma unroll
                for (int r = 0; r < 4; ++r) { s1 += A.y[u][r]; s2 += A.y[u][r] * A.y[u][r]; }
            s1 += shx(s1, 16, lane); s1 += shx(s1, 32, lane); s2 += shx(s2, 16, lane); s2 += shx(s2, 32, lane);
            LAS float* ST = (LAS float*)(F.lds + S2_STAT); LAS float* AY = (LAS float*)(F.lds + S2_YS);
            if (fq == 0) { ST[((16 * rt + fr) * 2 + cp) * 2] = s1; ST[((16 * rt + fr) * 2 + cp) * 2 + 1] = s2; }
#pragma unroll
            for (int u = 0; u < 2; ++u) *(LAS f32x4*)(AY + (16 * rt + fr) * 68 + 16 * (2 * cp + u) + 4 * fq) = A.y[u];
            __syncthreads();
            { const int tk2 = I.tid >> 3, d8 = (I.tid & 7) * 8;
              const f32x4 st = *(const LAS f32x4*)(ST + tk2 * 4); const float t1 = st[0] + st[2], t2 = st[1] + st[3];
              const float mean = cur.mix == 0 ? t1 * (1.0f / 64.0f) : 0.f;
              const float rs = 1.0f / sqrtf(fmaxf(t2 * (1.0f / 64.0f) - mean * mean, 0.f) + EPS);
              const LAS float* nw = (const LAS float*)(F.lds + S2_CST) + 64 + (cur.mix == 0 ? 0 : cur.mix == 1 ? 256 : 768) + cur.h * 64 + d8;
              const f32x4 a0 = *(const LAS f32x4*)(AY + tk2 * 68 + d8), a1 = *(const LAS f32x4*)(AY + tk2 * 68 + d8 + 4), w0 = *(const LAS f32x4*)nw, w1 = *(const LAS f32x4*)(nw + 4);
              const f32x8 g = cvt8(zgv); f32x4 y0, y1;
#pragma unroll
              for (int r = 0; r < 4; ++r) { y0[r] = (a0[r] - mean) * rs * w0[r] * (cur.mix == 3 ? sigmoid_q(g.a[r]) : silu_q(g.a[r])); y1[r] = (a1[r] - mean) * rs * w1[r] * (cur.mix == 3 ? sigmoid_q(g.b[r]) : silu_q(g.b[r])); }
              *(v4u*)(Y + (size_t)(row - (16 * rt + fr) + tk2) * D + cur.mix * 256 + cur.h * 64 + d8) = pack8(y0, y1); }
        }
        if (cmode == 2) conv_finish(CR);
        S2T(3);
    };
    for (int j = 0; j < nitems; j += 2) { item_body(j, Ra, 0); item_body(j + 1, Ra, 0); }
    if (PSPIN && blockIdx.x == 0 && I.tid == 0) { unsigned long long* ts = (unsigned long long*)(F.ws + WS_CTL + 655360); ts[44] += tacc0; ts[45] += tacc1; ts[46] += tacc2; ts[47] += tacc3; }
}

struct Args { const float* in[28]; float* out; unsigned char* ws; int ph_lo, ph_hi, use_bar, never; };
__global__ void __launch_bounds__(NWAVES * 64, 2) fwd_kernel(Args args) {
    extern __shared__ __attribute__((aligned(16))) unsigned char lds[];
    Frame F;
    F.lds = (LAS unsigned char*)lds;
        F.wave_s = __builtin_amdgcn_readfirstlane((int)threadIdx.x >> 6);
    F.G = gridDim.x; { const int bx = blockIdx.x; F.vcu = (F.G % 8 == 0) ? (bx % 8) * (F.G / 8) + bx / 8 : bx; }
    F.ws = args.ws;
    if (args.never) cooperative_groups::this_grid().sync();
    for (int u = F.wave_s * 64 + lane_id(); u < (LDS_BYTES - LDSCTL_OFF) / 4; u += NWAVES * 64) ((LAS unsigned*)(F.lds + LDSCTL_OFF))[u] = 0u;
    __syncthreads();
    if (F.wave_s == 0 && lane_id() == 0) { LAS unsigned long long* tab = (LAS unsigned long long*)(F.lds + LDSCTL_OFF);
#pragma unroll
        for (int i = 0; i < 28; ++i) tab[i] = (unsigned long long)args.in[i];
        tab[28] = (unsigned long long)args.out; }
    __syncthreads();
    XcdBarrier bar; bar.bar = (unsigned*)(F.ws + WS_CTL) + CW_BAR; bar.x = 0; bar.st = nullptr; bar.wave_s = F.wave_s;
    if (args.use_bar) bar = xcd_barrier_post((unsigned*)(F.ws + WS_CTL) + CW_BAR, (volatile LAS unsigned*)(F.lds + MISC_OFF) + 8, F.wave_s);
    const int lo = args.ph_lo, hi = args.ph_hi;
#define IN(k) (lo <= (k) && (k) < hi)
#define PS_REC(i) do { if (PSPIN && blockIdx.x == 0 && F.wave_s == 0 && lane_id() == 0) { ((unsigned long long*)(F.ws + WS_CTL + 655360))[i] = __builtin_amdgcn_s_memrealtime(); ((unsigned*)(F.ws + WS_CTL + 659456))[i] = xb_ld((unsigned*)(F.ws + WS_CTL) + 8192); } } while (0)
    PS_REC(0);
#define SEAM(k) do { if (IN(k) && IN((k) + 1)) xcd_barrier(bar); PS_REC((k) + 1); } while (0)
#ifndef PROBE_DUP
#define PROBE_DUP -1
#endif
#define PH_BEGIN(kind) for (int rep_ = 0; rep_ < ((PROBE_DUP) == (kind) ? 2 : 1); ++rep_) { if (rep_) xcd_barrier(bar);
#define PH_END }
    #ifndef NO_P0
    PH_BEGIN(0) if (IN(0)) { p0_prologue(F); } PH_END
#endif
    SEAM(0);
#pragma unroll
    for (int l = 0; l < 2; ++l) {
        const int pb = 1 + 10 * l;
        const bool ctx_out = l == 0;
        const int mrows = ctx_out ? NROWS : NLAT;
#ifndef NO_P1
        PH_BEGIN(1) if (IN(pb + 0)) { p1_norm1(F, l, rep_ == 0 ? 1.0f : 0.0f); } PH_END
#endif
        SEAM(pb + 0);
        PH_BEGIN(2) if (IN(pb + 1)) {
            const Frame Fg = fresh_frame(F);
            pg8::Gemm g{(const bf16*)(Fg.ws + WS_HN), (const bf16*)(Fg.ws + WS_WTIN) + (size_t)l * INP * 1024, NROWS, INP, D}; pg8::StaticOrder S; S.init(NROWS, INP, F.G, (int)blockIdx.x, 27);
            pg8::EpiStoreBf16 E{(bf16*)(Fg.ws + WS_U), INP, 0, 0};
            pg8::gemm_phase<pg8::EpiStoreBf16, pg8::StaticOrder, PG8_ALIGN, PG8_SP2>(Fg.lds, g, S, E, F.wave_s);
            if (((int)blockIdx.x >> 3) < 27) conv_worker_done(F, 4 * l + 0); else conv_host(F, 4 * l + 0, 1u, 0);
        }
        PH_END
        SEAM(pb + 1);
        PH_BEGIN(11) if (IN(pb + 2)) { p2t_pretransform(F, l, rep_ == 0); } PH_END
        SEAM(pb + 2);
        PH_BEGIN(3) if (IN(pb + 3)) { p3a_state(F, l); } PH_END
        SEAM(pb + 3);
        PH_BEGIN(4) if (IN(pb + 4)) { p3b_output(F, l, ctx_out); } PH_END
        SEAM(pb + 4);
        PH_BEGIN(5) if (IN(pb + 5)) {
            const Frame Fg = fresh_frame(F);
            pg8::Gemm g{(const bf16*)(Fg.ws + WS_Y), (const bf16*)(Fg.ws + WS_WTOUT) + (size_t)l * 1024 * 1024, mrows, D, D}; pg8::StaticOrder S; S.init(mrows, D, F.G, (int)blockIdx.x, l == 0 ? 18 : 32);
            pg8::EpiOutProj E{(bf16*)(Fg.ws + WS_H), (const float*)(Fg.ws + WS_MOD) + (size_t)l * 9 * MODW, (l == 0 && rep_ == 0) ? inp(Fg.lds, 0) : nullptr, (l == 0 && rep_ == 0) ? inp(Fg.lds, 2) : nullptr, rep_ == 0 ? 1.0f : 0.0f};
            pg8::gemm_phase<pg8::EpiOutProj, pg8::StaticOrder, PG8_ALIGN, PG8_SP2>(Fg.lds, g, S, E, F.wave_s);
            if (l == 0) { if (((int)blockIdx.x >> 3) < 18) conv_worker_done(F, 4 * l + 1); else conv_host(F, 4 * l + 1, 1u, 0, CAP_OP0); }
        }
        PH_END
        SEAM(pb + 5);
#ifndef NO_P6
        PH_BEGIN(6) if (IN(pb + 6)) { p6_norm2_router(F, l, mrows); } PH_END
#endif
        SEAM(pb + 6);
#ifndef NO_P7
        PH_BEGIN(7) if (IN(pb + 7)) { int pk = -1; if (F.wave_s == 0 && lane_id() == 0) pk = (int)xb_ld((unsigned*)(F.ws + WS_CTL) + CW_Q + 32 * (F.vcu >> 5));
            p7_topk(F, l); conv_host(F, 4 * l + 1, 0u, l == 0 ? Q_GU0 : Q_GU1, QN, pk); } PH_END
#endif
        SEAM(pb + 7);
        PH_BEGIN(8) if (IN(pb + 8)) {
            const Frame Fg = fresh_frame(F);
            pg8::Gemm g{(const bf16*)(Fg.ws + WS_HN), (const bf16*)(Fg.ws + WS_WTGU) + (size_t)l * NE * 3072 * 1024, NE * SLOTS, NE * 3072, D};
            pg8::GroupedOrder S{ctx_out ? 9 : 8, 12, (int)blockIdx.x, ctx_out ? 31 : 32};
            pg8::EpiSwiGLU E{(bf16*)(Fg.ws + WS_U)};
            LAS int* idxl = (LAS int*)(Fg.lds + 132096);
            { const int* IDXG = (const int*)(Fg.ws + WS_SLOT + 1179648); const int tid_ = F.wave_s * 64 + lane_id(); pg8::Unit uu;
              for (int ui = 0; ui < 7 && S.next(ui, uu); ++ui) if (tid_ < 256) idxl[ui * 256 + tid_] = IDXG[uu.pm * 256 + tid_];
              __syncthreads(); }
            pg8::gemm_phase<pg8::EpiSwiGLU, pg8::GroupedOrder, PG8_ALIGN, PG8_SP2, true>(Fg.lds, g, S, E, F.wave_s, idxl);
            if (l == 0 && ((int)blockIdx.x >> 3) >= 31) conv_host(F, 4 * l + 2, 9u, Q_L0);
            else { conv_worker_done(F, 4 * l + 2); conv_host(F, 4 * l + 2, 0u, l == 0 ? Q_L0 : QN); }
        }
        PH_END
        SEAM(pb + 8);
        PH_BEGIN(9) if (IN(pb + 9)) {
            const Frame Fg = fresh_frame(F);
            pg8::Gemm g{(const bf16*)(Fg.ws + WS_U), (const bf16*)(Fg.ws + WS_WTDN) + (size_t)l * NE * 1024 * FF, NE * SLOTS, NE * 1024, FF};
            pg8::GroupedOrder S{ctx_out ? 9 : 8, 4, (int)blockIdx.x, ctx_out ? 24 : 32};
            pg8::EpiStoreBf16 E{(bf16*)(Fg.ws + WS_O2), D, 9, 4};
            pg8::gemm_phase<pg8::EpiStoreBf16, pg8::GroupedOrder, PG8_ALIGN, PG8_SP2>(Fg.lds, g, S, E, F.wave_s);
            if (l == 0) { if (((int)blockIdx.x >> 3) < 24) conv_worker_done(F, 4 * l + 3); else conv_host(F, 4 * l + 3, 1u, 0, CAP_G20); }
        }
        PH_END
        SEAM(pb + 9);
    }
#ifndef NO_PF
    PH_BEGIN(10) if (IN(21)) { p_final(F, (float*)inp(F.lds, 28)); } PH_END
#endif
    if (PSPIN && blockIdx.x == 0 && F.wave_s == 0 && lane_id() == 0) { PS_REC(22);
        const unsigned long long* ts = (const unsigned long long*)(F.ws + WS_CTL + 655360); const unsigned* qh = (const unsigned*)(F.ws + WS_CTL + 659456);
        unsigned long long m = 0;
        for (int ph = 0; ph < 22; ++ph) if (((unsigned)(PS_MASK) >> ph) & 1u) m += ts[ph + 1] - ts[ph];
        if ((PS_QK) >= 0) m = qh[(PS_QK) + 1];
#ifdef PS_S2
        m = ts[44 + (PS_S2)];
#endif
#ifdef PS_P0
        m = (PS_P0) == 1 ? ts[40] - ts[0] : (PS_P0) == 2 ? ts[41] - ts[40] : ts[1] - ts[41];
#endif
#ifdef PS_X
        m = 0; for (int l = 0; l < 2; ++l) { const int ph = 7 + 10 * l; const unsigned long long a = ts[ph], b = ts[32 + 2 * l], c = ts[33 + 2 * l], d = ts[ph + 1];
            m += (PS_X) == 1 ? b - a : (PS_X) == 2 ? c - b : d - c; }
#endif
        const unsigned long long t0 = __builtin_amdgcn_s_memrealtime(), tend = t0 + m * (PS_MULT);
        while (__builtin_amdgcn_s_memrealtime() < tend) __builtin_amdgcn_s_sleep(8); }
#undef IN
#undef SEAM
}

#ifndef MK_ONE_LAUNCH
#define MK_ONE_LAUNCH 1
#endif
extern "C" void kernel_launch(void* const* d_in, const int* in_sizes, int n_in, void* d_out, int out_size, void* d_ws, size_t ws_size, hipStream_t stream) {
    static int grid = 0;
    if (grid == 0) {
        if (n_in != 28 || out_size != NLAT * D || ws_size < WS_END3) { fprintf(stderr, "kernel_launch: unexpected problem (n_in %d, out %d, ws %zu < %zu)\n", n_in, out_size, ws_size, (size_t)WS_END); grid = -1; return; }
        int dev = 0, cus = 0, per_cu = 0;
        if (hipGetDevice(&dev) != hipSuccess || hipDeviceGetAttribute(&cus, hipDeviceAttributeMultiprocessorCount, dev) != hipSuccess) { grid = -1; return; }
        if (hipFuncSetAttribute((const void*)fwd_kernel, hipFuncAttributeMaxDynamicSharedMemorySize, LDS_BYTES) != hipSuccess) { fprintf(stderr, "kernel_launch: hipFuncSetAttribute failed\n"); grid = -1; return; }
        if (hipOccupancyMaxActiveBlocksPerMultiprocessor(&per_cu, (const void*)fwd_kernel, NWAVES * 64, LDS_BYTES) != hipSuccess || per_cu < 1) { fprintf(stderr, "kernel_launch: occupancy query says %d\n", per_cu); (void)hipGetLastError(); per_cu = 1; }
        grid = cus;
        if (grid != 256) { fprintf(stderr, "kernel_launch: built for 256 CUs, device has %d\n", cus); grid = -1; return; }
    }
    if (grid < 0) return;
    (void)hipMemsetAsync((char*)d_ws + WS_CTL, 0, PSPIN ? CTL_ZERO_BYTES : (size_t)65536, stream);
    Args a{};
    for (int i = 0; i < 28; ++i) a.in[i] = (const float*)d_in[i];
    a.out = (float*)d_out; a.ws = (unsigned char*)d_ws; a.never = 0;
#if MK_ONE_LAUNCH
    a.ph_lo = 0; a.ph_hi = NPHASES; a.use_bar = 1;
    void* kargs[] = {&a};
    hipError_t e = hipLaunchCooperativeKernel((const void*)fwd_kernel, dim3(grid), dim3(NWAVES * 64), kargs, LDS_BYTES, stream);
    if (e != hipSuccess) fprintf(stderr, "kernel_launch: cooperative launch failed: %s\n", hipGetErrorString(e));
#else
    for (int ph = 0; ph < NPHASES; ++ph) { a.ph_lo = ph; a.ph_hi = ph + 1; a.use_bar = 0;
        hipLaunchKernelGGL(fwd_kernel, dim3(grid), dim3(NWAVES * 64), LDS_BYTES, stream, a); }
#endif
}
```
